# Optimizing an MI355X kernel written in HIP

```python
import math
import jax, jax.numpy as jnp
from jax import lax
import numpy as np

D_MODEL = 1024
BATCH = 4
SEQ = 8192
DEPTH = 4

RET_HEADS = 4
RET_DK = 128
RET_DV = 256
RET_CHUNK = 128
RET_THETA = 10000.0
NSA_HEADS = 16
NSA_GROUPS = 2
HEAD_DIM = 64
ROPE_DIM = HEAD_DIM // 4
ROPE_THETA = 500000.0
CMP_LEN = 32
CMP_STRIDE = 16
CMP_HIDDEN = 4 * HEAD_DIM
SLC_BLOCK = 64
SLC_TOPK = 16
WINDOW = 512
Q_BLOCK = 128
N_EXPERTS = 32
TOP_K = 4
D_FF = D_MODEL
SWIGLU_LIMIT = 7.0
SWIGLU_ALPHA = 1.702
MOE_BLOCK = 256
NORM_EPS = 1e-6

RET_QK = RET_HEADS * RET_DK
RET_V = RET_HEADS * RET_DV
NSA_Q = NSA_HEADS * HEAD_DIM
NSA_KV = NSA_GROUPS * HEAD_DIM
NSA_GATE = NSA_HEADS * 3
IN_SIZES = (RET_QK, RET_QK, RET_V, RET_V, NSA_Q, NSA_KV, NSA_KV, NSA_KV, NSA_KV, NSA_KV, NSA_KV, NSA_GATE, 2 * D_MODEL)
IN_SPLIT = tuple(int(v) for v in np.cumsum(IN_SIZES)[:-1])
IN_TOTAL = int(sum(IN_SIZES))

kernel_name = 'hybrid_retention_nsa_moe'


def rms_norm(x, w):
    xf = x.astype(jnp.float32)
    y = xf * lax.rsqrt(jnp.mean(xf * xf, axis=-1, keepdims=True) + NORM_EPS)
    return (y * w.astype(jnp.float32)).astype(x.dtype)


def rope_tables(pos, rot_dim, theta):
    inv = theta ** (-jnp.arange(0, rot_dim, 2, dtype=jnp.float32) / rot_dim)
    ang = pos.astype(jnp.float32)[:, None] * inv[None, :]
    return jnp.cos(ang), jnp.sin(ang)


def apply_rope(x, cos, sin):
    r = 2 * cos.shape[-1]
    xr, xp = x[..., :r], x[..., r:]
    x1, x2 = xr[..., : r // 2], xr[..., r // 2:]
    c, s = cos.astype(x.dtype), sin.astype(x.dtype)
    return jnp.concatenate([x1 * c - x2 * s, x1 * s + x2 * c, xp], axis=-1)


def masked_softmax(s, mask):
    s = jnp.where(mask, s.astype(jnp.float32), -jnp.inf)
    m = jnp.max(s, axis=-1, keepdims=True)
    m = jnp.where(jnp.isfinite(m), m, 0.0)
    p = jnp.exp(s - m)
    den = jnp.sum(p, axis=-1, keepdims=True)
    return p / jnp.where(den > 0, den, 1.0)


def retention(q, k, v, g, gn_w):
    B, S = q.shape[:2]
    dt = q.dtype
    cos, sin = rope_tables(jnp.arange(S), RET_DK, RET_THETA)
    q = apply_rope(q, cos[:, None], sin[:, None])
    k = apply_rope(k, cos[:, None], sin[:, None]) * (RET_DK ** -0.5)
    C = RET_CHUNK
    NC = S // C
    qc = q.reshape(B, NC, C, RET_HEADS, RET_DK)
    kc = k.reshape(B, NC, C, RET_HEADS, RET_DK)
    vc = v.reshape(B, NC, C, RET_HEADS, RET_DV)
    log_g = jnp.log1p(-jnp.exp2(-5.0 - jnp.arange(RET_HEADS, dtype=jnp.float32)))
    n = jnp.arange(C, dtype=jnp.float32)
    diff = n[:, None] - n[None, :]
    decay_in = jnp.where(diff >= 0, jnp.exp(log_g[:, None, None] * jnp.maximum(diff, 0.0)), 0.0)
    zeta = jnp.exp(log_g[None, :] * (C - 1 - n)[:, None])
    xi = jnp.exp(log_g[None, :] * (n + 1)[:, None])
    chunk_decay = jnp.exp(log_g * C).astype(dt)
    scores = jnp.einsum('bcnhd,bcmhd->bchnm', qc, kc) * decay_in.astype(dt)
    inner = jnp.einsum('bchnm,bcmhe->bcnhe', scores, vc)
    u = jnp.einsum('bcmhd,bcmhe->cbhde', kc * zeta[:, :, None].astype(dt), vc)

    def step(r, u_c):
        return chunk_decay[None, :, None, None] * r + u_c, r

    _, r_prev = lax.scan(step, jnp.zeros_like(u[0]), u)
    cross = jnp.einsum('bcnhd,cbhde->bcnhe', qc, r_prev) * xi[:, :, None].astype(dt)
    o = (inner + cross).reshape(B, S, RET_HEADS, RET_DV).astype(jnp.float32)
    mu = jnp.mean(o, axis=-1, keepdims=True)
    var = jnp.mean(jnp.square(o - mu), axis=-1, keepdims=True)
    o = ((o - mu) * lax.rsqrt(var + NORM_EPS)).reshape(B, S, RET_V) * gn_w.astype(jnp.float32)
    return (jax.nn.silu(g.astype(jnp.float32)) * o).astype(dt)


def nsa(q, kc_tok, vc_tok, ks, vs, kw, vw, gates, qk_w, cmp_pos, cmp_w1, cmp_w2):
    B, S = q.shape[:2]
    dt = q.dtype
    G, Hg, d = NSA_GROUPS, NSA_HEADS // NSA_GROUPS, HEAD_DIM
    cos, sin = rope_tables(jnp.arange(S), ROPE_DIM, ROPE_THETA)
    q = apply_rope(rms_norm(q, qk_w[0]), cos[:, None], sin[:, None])
    ks = apply_rope(rms_norm(ks, qk_w[2]), cos[:, None], sin[:, None])
    kw = apply_rope(rms_norm(kw, qk_w[3]), cos[:, None], sin[:, None])

    ratio = CMP_LEN // CMP_STRIDE
    n_cmp = S // CMP_STRIDE - ratio + 1

    def compress(t, pe, w1, w2):
        c = t.reshape(B, S // CMP_STRIDE, CMP_STRIDE, G, d)
        blocks = jnp.concatenate([c[:, j:j + n_cmp] for j in range(ratio)], axis=2)
        blocks = blocks + pe[None, None, :, None, :]
        blocks = blocks.transpose(0, 3, 1, 2, 4).reshape(B, G, n_cmp, CMP_LEN * d)
        return jax.nn.gelu(blocks @ w1) @ w2

    k_cmp = compress(kc_tok, cmp_pos[0], cmp_w1[0], cmp_w2[0])
    v_cmp = compress(vc_tok, cmp_pos[1], cmp_w1[1], cmp_w2[1])
    cmp_end = jnp.arange(n_cmp) * CMP_STRIDE + CMP_LEN - 1
    cc, cs = rope_tables(cmp_end, ROPE_DIM, ROPE_THETA)
    k_cmp = apply_rope(rms_norm(k_cmp, qk_w[1]), cc, cs)

    n_slc = S // SLC_BLOCK
    n_sel = min(SLC_TOPK, n_slc)
    ci = np.arange(n_cmp)[:, None]
    sj = np.arange(n_slc)[None, :]
    overlap = jnp.asarray(((ci * CMP_STRIDE < (sj + 1) * SLC_BLOCK) & (ci * CMP_STRIDE + CMP_LEN > sj * SLC_BLOCK)).astype(np.float32))
    k_blk = ks.reshape(B, n_slc, SLC_BLOCK, G, d).transpose(0, 3, 1, 2, 4)
    v_blk = vs.reshape(B, n_slc, SLC_BLOCK, G, d).transpose(0, 3, 1, 2, 4)
    gather = jax.vmap(jax.vmap(lambda t, ix: t[ix]))

    kw_pad = jnp.pad(kw, ((0, 0), (WINDOW, 0), (0, 0), (0, 0)))
    vw_pad = jnp.pad(vw, ((0, 0), (WINDOW, 0), (0, 0), (0, 0)))

    nq = S // Q_BLOCK
    q_blocks = q.reshape(B, nq, Q_BLOCK, G, Hg, d).transpose(1, 0, 2, 3, 4, 5)
    g_blocks = gates.reshape(B, nq, Q_BLOCK, NSA_HEADS, 3).transpose(1, 0, 2, 3, 4)
    scale = HEAD_DIM ** -0.5
    jj = jnp.arange(n_slc)

    def block_fn(args):
        qb, gb, bi = args
        t = bi * Q_BLOCK + jnp.arange(Q_BLOCK)
        s_c = jnp.einsum('bqghd,bgnd->bghqn', qb, k_cmp) * scale
        p_c = masked_softmax(s_c, cmp_end[None, :] <= t[:, None])
        o_c = jnp.einsum('bghqn,bgnd->bqghd', p_c.astype(dt), v_cmp)
        imp = jnp.einsum('bghqn,nj->bgqj', p_c, overlap)
        cur = t // SLC_BLOCK
        valid = jj[None, :] <= cur[:, None]
        forced = (jj[None, :] == 0) | (jj[None, :] == cur[:, None]) | (jj[None, :] == cur[:, None] - 1)
        imp = jnp.where(forced, jnp.inf, jnp.where(valid, imp, -jnp.inf))
        _, idx = lax.top_k(imp, n_sel)
        ksel = gather(k_blk, idx)
        vsel = gather(v_blk, idx)
        kpos = idx[..., None] * SLC_BLOCK + jnp.arange(SLC_BLOCK)
        m_s = (kpos <= t[:, None, None]).reshape(B, G, 1, Q_BLOCK, n_sel * SLC_BLOCK)
        s_s = jnp.einsum('bqghd,bgqkld->bghqkl', qb, ksel).reshape(B, G, Hg, Q_BLOCK, n_sel * SLC_BLOCK) * scale
        p_s = masked_softmax(s_s, m_s).reshape(B, G, Hg, Q_BLOCK, n_sel, SLC_BLOCK)
        o_s = jnp.einsum('bghqkl,bgqkld->bqghd', p_s.astype(dt), vsel)
        start = bi * Q_BLOCK
        kwb = lax.dynamic_slice_in_dim(kw_pad, start, WINDOW + Q_BLOCK, axis=1)
        vwb = lax.dynamic_slice_in_dim(vw_pad, start, WINDOW + Q_BLOCK, axis=1)
        kp = start - WINDOW + jnp.arange(WINDOW + Q_BLOCK)
        m_w = (kp[None, :] <= t[:, None]) & (kp[None, :] > t[:, None] - WINDOW) & (kp[None, :] >= 0)
        s_w = jnp.einsum('bqghd,bkgd->bghqk', qb, kwb) * scale
        p_w = masked_softmax(s_w, m_w)
        o_w = jnp.einsum('bghqk,bkgd->bqghd', p_w.astype(dt), vwb)
        gg = jax.nn.sigmoid(gb).reshape(B, Q_BLOCK, G, Hg, 3, 1)
        o = gg[..., 0, :] * o_c + gg[..., 1, :] * o_s + gg[..., 2, :] * o_w
        return o.reshape(B, Q_BLOCK, NSA_Q)

    out = lax.map(block_fn, (q_blocks, g_blocks, jnp.arange(nq)))
    return out.transpose(1, 0, 2, 3).reshape(B, S, NSA_Q)


def moe(h, router_w, router_b, w_gu, b_gu, w_d, b_d):
    B, S, D = h.shape
    N = B * S
    xt = h.reshape(N, D)
    logits = (xt @ router_w + router_b).astype(jnp.float32)
    top_v, top_e = lax.top_k(logits, TOP_K)
    wts = jax.nn.softmax(top_v, axis=-1).astype(h.dtype)
    M = N * TOP_K
    flat_e = top_e.reshape(-1)
    flat_tok = jnp.repeat(jnp.arange(N), TOP_K)
    order = jnp.argsort(flat_e)
    se, stok, sw = flat_e[order], flat_tok[order], wts.reshape(-1)[order]
    counts = jnp.bincount(flat_e, length=N_EXPERTS)
    padded = (counts + MOE_BLOCK - 1) // MOE_BLOCK * MOE_BLOCK
    ustart = jnp.cumsum(counts) - counts
    pend = jnp.cumsum(padded)
    pstart = pend - padded
    dest = pstart[se] + (jnp.arange(M) - ustart[se])
    n_blocks = -(-M // MOE_BLOCK) + N_EXPERTS
    rows = n_blocks * MOE_BLOCK
    xbuf = jnp.zeros((rows, D), h.dtype).at[dest].set(xt[stok])
    blk_e = jnp.minimum(jnp.searchsorted(pend, jnp.arange(n_blocks) * MOE_BLOCK, side='right'), N_EXPERTS - 1)

    def expert_block(args):
        xb, e = args
        gu = xb @ w_gu[e] + b_gu[e]
        gate = jnp.minimum(gu[:, :D_FF], SWIGLU_LIMIT)
        up = jnp.clip(gu[:, D_FF:], -SWIGLU_LIMIT, SWIGLU_LIMIT)
        glu = gate * jax.nn.sigmoid(gate * SWIGLU_ALPHA)
        return ((up + 1.0) * glu) @ w_d[e] + b_d[e]

    ybuf = lax.map(expert_block, (xbuf.reshape(n_blocks, MOE_BLOCK, D), blk_e)).reshape(rows, D)
    y = ybuf[dest] * sw[:, None]
    return jax.ops.segment_sum(y, stok, num_segments=N).reshape(B, S, D)


def setup_inputs(seed: int = 0) -> dict:
    key = jax.random.key(seed)
    ks = jax.random.split(key, 18)
    f32 = jnp.float32
    nrm = lambda k, shape, s: jax.random.normal(k, shape, f32) * s
    resid = (2 * DEPTH) ** -0.5
    return {
        'x': nrm(ks[0], (BATCH, SEQ, D_MODEL), 1.0),
        'norm1_w': 1.0 + nrm(ks[1], (DEPTH, D_MODEL), 0.02),
        'w_in': nrm(ks[2], (DEPTH, D_MODEL, IN_TOTAL), D_MODEL ** -0.5),
        'ret_gn_w': 1.0 + nrm(ks[3], (DEPTH, RET_V), 0.02),
        'qk_norm_w': 1.0 + nrm(ks[4], (DEPTH, 4, HEAD_DIM), 0.02),
        'cmp_pos': nrm(ks[5], (DEPTH, 2, CMP_LEN, HEAD_DIM), 0.1),
        'cmp_w1': nrm(ks[6], (DEPTH, 2, CMP_LEN * HEAD_DIM, CMP_HIDDEN), (CMP_LEN * HEAD_DIM) ** -0.5),
        'cmp_w2': nrm(ks[7], (DEPTH, 2, CMP_HIDDEN, HEAD_DIM), CMP_HIDDEN ** -0.5),
        'w_o_ret': nrm(ks[8], (DEPTH, RET_V, D_MODEL), RET_V ** -0.5),
        'w_o_nsa': nrm(ks[9], (DEPTH, NSA_Q, D_MODEL), NSA_Q ** -0.5),
        'w_out': nrm(ks[10], (DEPTH, D_MODEL, D_MODEL), D_MODEL ** -0.5 * resid),
        'norm2_w': 1.0 + nrm(ks[11], (DEPTH, D_MODEL), 0.02),
        'router_w': nrm(ks[12], (DEPTH, D_MODEL, N_EXPERTS), D_MODEL ** -0.5),
        'router_b': nrm(ks[13], (DEPTH, N_EXPERTS), 0.01),
        'w_gate_up': nrm(ks[14], (DEPTH, N_EXPERTS, D_MODEL, 2 * D_FF), D_MODEL ** -0.5),
        'b_gate_up': nrm(ks[15], (DEPTH, N_EXPERTS, 2 * D_FF), 0.01),
        'w_down': nrm(ks[16], (DEPTH, N_EXPERTS, D_FF, D_MODEL), D_FF ** -0.5 * resid),
        'b_down': nrm(ks[17], (DEPTH, N_EXPERTS, D_MODEL), 0.01),
    }


def reference(x, norm1_w, w_in, ret_gn_w, qk_norm_w, cmp_pos, cmp_w1, cmp_w2, w_o_ret, w_o_nsa, w_out, norm2_w, router_w, router_b, w_gate_up, b_gate_up, w_down, b_down):
    B, S = x.shape[:2]
    for l in range(DEPTH):
        h = rms_norm(x, norm1_w[l])
        proj = h @ w_in[l]
        (rq, rk, rv, rg, nq_, kc, vc, kslc, vslc, kwin, vwin, ng, mg) = jnp.split(proj, IN_SPLIT, axis=-1)
        ret = retention(rq.reshape(B, S, RET_HEADS, RET_DK), rk.reshape(B, S, RET_HEADS, RET_DK),
                        rv.reshape(B, S, RET_HEADS, RET_DV), rg, ret_gn_w[l])
        kv = lambda t: t.reshape(B, S, NSA_GROUPS, HEAD_DIM)
        att = nsa(nq_.reshape(B, S, NSA_HEADS, HEAD_DIM), kv(kc), kv(vc), kv(kslc), kv(vslc), kv(kwin), kv(vwin),
                  ng.reshape(B, S, NSA_HEADS, 3), qk_norm_w[l], cmp_pos[l], cmp_w1[l], cmp_w2[l])
        gate = jax.nn.sigmoid(mg)
        mix = gate[..., :D_MODEL] * (ret @ w_o_ret[l]) + gate[..., D_MODEL:] * (att @ w_o_nsa[l])
        x = x + mix @ w_out[l]
        x = x + moe(rms_norm(x, norm2_w[l]), router_w[l], router_b[l], w_gate_up[l], b_gate_up[l], w_down[l], b_down[l])
    return x
```

```cpp
#include <hip/hip_runtime.h>
#include <stdint.h>
#include <stdio.h>

#ifndef MK_ONE_LAUNCH
#define MK_ONE_LAUNCH 1
#endif

#define LAS __attribute__((address_space(3)))
typedef unsigned short bf16_t;
typedef short bf16x8 __attribute__((ext_vector_type(8)));
typedef float f32x4 __attribute__((ext_vector_type(4)));
typedef float f32x2 __attribute__((ext_vector_type(2)));
typedef unsigned u32x4 __attribute__((ext_vector_type(4)));
typedef unsigned u32x2 __attribute__((ext_vector_type(2)));

constexpr int D = 1024, NB = 4, SEQ = 8192, NTOK = NB * SEQ, NL = 4;
constexpr int NPROJ = 7168, IN_TOTAL = 6960;
constexpr int C_RQ = 0, C_RK = 512, C_RV = 1024, C_RG = 2048, C_NQ = 3072, C_KC = 4096, C_VC = 4224, C_KS = 4352, C_VS = 4480, C_KW = 4608, C_VW = 4736, C_NG = 4864, C_MG = 5120;
constexpr int NEXP = 32, XROWS = 139264;
constexpr int NWAVES = 8, NTHREADS = 512;
constexpr float NORM_EPS = 1e-6f;

constexpr size_t al256(size_t x) { return (x + 255) & ~(size_t)255; }
constexpr size_t WS_CTL = 0, CTL_BYTES = 65536;
constexpr size_t WS_HIST = WS_CTL + CTL_BYTES;
constexpr size_t WS_META = WS_HIST + 1024 * 32 * 4;
constexpr size_t WS_ROPER = WS_META + 32768;
constexpr size_t WS_ROPEN = WS_ROPER + (size_t)SEQ * 64 * 2 * 4;
constexpr size_t WS_PEB = WS_ROPEN + (size_t)SEQ * 8 * 2 * 4;
constexpr size_t WS_RWF = al256(WS_PEB + 8 * NL * 2 * 256 * 4);
constexpr size_t WS_RSTD = WS_RWF + (size_t)NL * 32 * 2 * 2 * 512 * 2;
constexpr size_t WS_WIN = al256(WS_RSTD + (size_t)NTOK * 4);
constexpr size_t WS_WO = WS_WIN + (size_t)NL * NPROJ * D * 2;
constexpr size_t WS_WOUT = WS_WO + (size_t)NL * D * 2048 * 2;
constexpr size_t WS_WC1 = WS_WOUT + (size_t)NL * D * D * 2;
constexpr size_t WS_WGU = WS_WC1 + (size_t)NL * 2 * 256 * 2048 * 2;
constexpr size_t WS_WD = WS_WGU + (size_t)NL * NEXP * 2048 * D * 2;
constexpr size_t WS_H = WS_WD + (size_t)NL * NEXP * D * D * 2;
constexpr size_t WS_PROJ = WS_H + (size_t)NTOK * D * 2;
constexpr size_t WS_QR = WS_PROJ + (size_t)NTOK * NPROJ * 2;
constexpr size_t WS_KR = WS_QR + (size_t)NTOK * 512 * 2;
constexpr size_t WS_KZT = WS_KR + (size_t)NTOK * 512 * 2;
constexpr size_t WS_VT = WS_KZT + (size_t)NTOK * 512 * 2;
constexpr size_t WS_RT = WS_VT + (size_t)NTOK * 1024 * 2;
constexpr size_t WS_QN = WS_RT + (size_t)16 * 64 * 256 * 128 * 2;
constexpr size_t WS_KS = WS_QN + (size_t)NTOK * 1024 * 2;
constexpr size_t WS_VST = WS_KS + (size_t)NTOK * 128 * 2;
constexpr size_t WS_KW = WS_VST + (size_t)NTOK * 128 * 2;
constexpr size_t WS_VWT = WS_KW + (size_t)NTOK * 128 * 2;
constexpr size_t WS_KCT = WS_VWT + (size_t)NTOK * 128 * 2;
constexpr size_t WS_VCT = WS_KCT + (size_t)NTOK * 128 * 2 + 4096;
constexpr size_t WS_HID = WS_VCT + (size_t)NTOK * 128 * 2 + 4096;
constexpr size_t WS_KCMP = WS_HID + (size_t)2 * 8 * 512 * 256 * 2;
constexpr size_t WS_VCMPT = WS_KCMP + (size_t)8 * 512 * 64 * 2;
constexpr size_t WS_RA = WS_VCMPT + (size_t)8 * 512 * 64 * 2;
constexpr size_t WS_MIX = WS_RA + (size_t)NTOK * 2048 * 2;
constexpr size_t WS_TE = WS_MIX + (size_t)NTOK * D * 2;
constexpr size_t WS_TW = WS_TE + (size_t)NTOK * 16;
constexpr size_t WS_RANK = WS_TW + (size_t)NTOK * 16;
constexpr size_t WS_SLOT = WS_RANK + (size_t)NTOK * 16;
constexpr size_t WS_ROWTOK = WS_SLOT + (size_t)NTOK * 16;
constexpr size_t WS_RSROW = WS_ROWTOK + (size_t)XROWS * 4;
constexpr size_t WS_XBUF = al256(WS_RSROW + (size_t)XROWS * 4);
constexpr size_t WS_ACT = WS_XBUF + (size_t)XROWS * D * 2;
constexpr size_t WS_END = WS_ACT + (size_t)XROWS * D * 2;

constexpr int LDS_SCRATCH = 149504;
constexpr int LDS_CTL_OFF = LDS_SCRATCH;
constexpr int LDS_BYTES = LDS_SCRATCH + 1024;

__device__ __forceinline__ float bf2f(bf16_t v) { return __uint_as_float(((unsigned)v) << 16); }
__device__ __forceinline__ float bflo(unsigned w) { return __uint_as_float(w << 16); }
__device__ __forceinline__ float bfhi(unsigned w) { return __uint_as_float(w & 0xffff0000u); }
__device__ __forceinline__ unsigned f2bf(float f) { unsigned u = __float_as_uint(f); return (u + 0x7fffu + ((u >> 16) & 1u)) >> 16; }
typedef __bf16 bf16x2_t __attribute__((ext_vector_type(2)));
__device__ __forceinline__ unsigned pk2(float lo, float hi) { const f32x2 v = {lo, hi}; const bf16x2_t r = __builtin_convertvector(v, bf16x2_t); return __builtin_bit_cast(unsigned, r); }
__device__ __forceinline__ float fexp2(float x) { return __builtin_amdgcn_exp2f(x); }
__device__ __forceinline__ float frcp(float x) { return __builtin_amdgcn_rcpf(x); }
__device__ __forceinline__ float sigmoidf_(float x) { return frcp(1.0f + fexp2(-1.4426950408889634f * x)); }
__device__ __forceinline__ bf16x8 mk8(u32x4 v) { return __builtin_bit_cast(bf16x8, v); }
__device__ __forceinline__ bf16x8 ld8(const bf16_t* p) { return __builtin_bit_cast(bf16x8, *(const u32x4*)p); }
__device__ __forceinline__ f32x4 mfma16(bf16x8 a, bf16x8 b, f32x4 c) { return __builtin_amdgcn_mfma_f32_16x16x32_bf16(a, b, c, 0, 0, 0); }
#define MFMA_FENCE() do { __builtin_amdgcn_sched_barrier(0); asm volatile("s_nop 7\n\ts_nop 7" ::: "memory"); __builtin_amdgcn_sched_barrier(0); } while (0)
__device__ __forceinline__ float sum8(float v) { v += __int_as_float(__builtin_amdgcn_update_dpp(0, __float_as_int(v), 0xB1, 0xf, 0xf, true));
    v += __int_as_float(__builtin_amdgcn_update_dpp(0, __float_as_int(v), 0x4E, 0xf, 0xf, true)); v += __int_as_float(__builtin_amdgcn_update_dpp(0, __float_as_int(v), 0x141, 0xf, 0xf, true)); return v; }
__device__ __forceinline__ float wave_sum(float v) {
#pragma unroll
    for (int o = 32; o >= 1; o >>= 1) v += __shfl_xor(v, o);
    return v;
}

#define XB_TMO      128
#define XB_XCNT(j)  (256  + 64 * (j))
#define XB_XSUB(j)  (1280 + 64 * (j))
#define XB_XGEN(j)  (2304 + 64 * (j))
#define XB_TOP      3328
#define XB_TOPGEN   3392
#define XCD_BAR_WORDS 3456
#define XB_SPIN_CAP (1u << 18)
__device__ __forceinline__ unsigned xb_ld(unsigned* p)              { return __hip_atomic_load(p, __ATOMIC_RELAXED, __HIP_MEMORY_SCOPE_AGENT); }
__device__ __forceinline__ unsigned xb_add(unsigned* p, unsigned v) { return __hip_atomic_fetch_add(p, v, __ATOMIC_RELAXED, __HIP_MEMORY_SCOPE_AGENT); }
__device__ __forceinline__ unsigned xb_xcc_id() { return (unsigned)__builtin_amdgcn_s_getreg((3 << 11) | 20) & 0xFu; }
#define XB_SPIN(cond, bar) do { unsigned _sp = 0; while (cond) { __builtin_amdgcn_s_sleep(1); \
    if ((++_sp & 255u) == 0u) { if (xb_ld(&(bar)[XB_TMO])) break; if (_sp > XB_SPIN_CAP) { atomicAdd(&(bar)[XB_TMO], 1u); break; } } } } while (0)
struct XcdBarrier { unsigned* bar; unsigned x; volatile LAS unsigned* st; };
__device__ __forceinline__ XcdBarrier xcd_barrier_post(unsigned* bar, volatile LAS unsigned* st) {
    XcdBarrier b; b.bar = bar; b.x = xb_xcc_id(); b.st = st;
    if (threadIdx.x == 0) (void)xb_add(&bar[XB_XCNT(b.x)], 1u);
    return b;
}
__device__ __forceinline__ void xcd_barrier_complete(unsigned* bar, unsigned x, unsigned& nloc, unsigned& nx) {
    const unsigned G = gridDim.x * gridDim.y * gridDim.z;
    unsigned sum, cnt, mine, sp = 0u;
    for (;;) {
        sum = 0u; cnt = 0u; mine = 0u;
#pragma unroll
        for (unsigned j = 0; j < 16; ++j) { const unsigned c = xb_ld(&bar[XB_XCNT(j)]); sum += c; cnt += (c > 0u) ? 1u : 0u; mine = (j == x) ? c : mine; }
        if (sum == G) break;
        __builtin_amdgcn_s_sleep(1);
        if ((++sp & 255u) == 0u) { if (xb_ld(&bar[XB_TMO])) break; if (sp > XB_SPIN_CAP) { atomicAdd(&bar[XB_TMO], 1u); break; } }
    }
    nloc = mine > 0u ? mine : 1u; nx = cnt > 0u ? cnt : 1u;
}
__device__ __forceinline__ void xcd_barrier(const XcdBarrier& b) {
    asm volatile("s_waitcnt vmcnt(0)" ::: "memory");
    __syncthreads();
    if (threadIdx.x == 0) {
        unsigned* bar = b.bar;
        __builtin_amdgcn_s_waitcnt(0);
        unsigned nloc = b.st[0], nx = b.st[1];
        if (nloc == 0u) { xcd_barrier_complete(bar, b.x, nloc, nx); b.st[0] = nloc; b.st[1] = nx; }
        const unsigned old = xb_add(&bar[XB_XSUB(b.x)], 1u);
        const unsigned gen = old / nloc;
        if (old + 1u == (gen + 1u) * nloc) {
            __builtin_amdgcn_fence(__ATOMIC_RELEASE, "agent");
            asm volatile("s_waitcnt vmcnt(0)" ::: "memory");
            const unsigned og = xb_add(&bar[XB_TOP], 1u);
            const unsigned tg = og / nx;
            if (og + 1u == (tg + 1u) * nx) xb_add(&bar[XB_TOPGEN], 1u);
            else XB_SPIN(xb_ld(&bar[XB_TOPGEN]) == tg, bar);
            __builtin_amdgcn_fence(__ATOMIC_ACQUIRE, "agent");
            xb_add(&bar[XB_XGEN(b.x)], 1u);
            asm volatile("s_waitcnt vmcnt(0)" ::: "memory");
        } else {
            XB_SPIN(xb_ld(&bar[XB_XGEN(b.x)]) == gen, bar);
            __builtin_amdgcn_fence(__ATOMIC_ACQUIRE, "agent");
            asm volatile("s_waitcnt vmcnt(0)" ::: "memory");
        }
    }
    __syncthreads();
}

struct Args { const float* in[18]; float* out; unsigned char* ws; int ph_lo, ph_hi; };
struct Ctx {
    const float *x_in, *norm1_w, *w_in, *ret_gn_w, *qk_norm_w, *cmp_pos, *cmp_w1, *cmp_w2, *w_o_ret, *w_o_nsa, *w_out, *norm2_w, *router_w, *router_b, *w_gate_up, *b_gate_up, *w_down, *b_down;
    float* out; unsigned char* ws; LAS unsigned char* lds;
    int tid, lane, wave, gw, G, wave0;
};
#define WSP(T, off) ((T*)(c.ws + (off)))

namespace g8 {
constexpr int BM = 256, BK = 64, HALF = 128, HTB = HALF * BK * 2, STAGE_BYTES = 8 * HTB, NXCD = 8, WGM = 8;
__device__ __forceinline__ int lds_byte(int r, int c) { const int st = (r >> 4) * 2 + (c >> 5), rr = r & 15, cc = c & 31, ob = rr * 64 + cc * 2; return st * 1024 + (ob ^ (((ob >> 9) & 1) << 5)); }
__device__ __forceinline__ void stage_rc(int b, int& R, int& C) { const int st = b / 1024, sb = b % 1024, swz = sb ^ (((sb >> 9) & 1) << 5); R = (st >> 1) * 16 + swz / 64; C = (st & 1) * 32 + (swz % 64) / 2; }
__device__ __forceinline__ int perm32(int rho) { const int n = rho >> 4, i = rho & 15; return 8 * (i >> 2) + 4 * n + (i & 3); }

struct Unit { const char* A; const char* B; int pm, pn, e; };

struct SchedPlain {
    static constexpr bool GATHER = false;
    const char* A; const char* B; size_t tA, tB; int nM, nN, nwg, G, c;
    __device__ __forceinline__ bool next(int i, Unit& u) const {
        const long L = (long)i * G + c; if (L >= nwg) return false;
        int wgid = (int)L; { const int q = nwg / NXCD, r = nwg % NXCD, xcd = wgid % NXCD, off = wgid / NXCD; wgid = (xcd < r ? xcd * (q + 1) : r * (q + 1) + (xcd - r) * q) + off; }
        const int nig = WGM * nN, gid = wgid / nig, fm = gid * WGM, gsz = (nM - fm) < WGM ? (nM - fm) : WGM;
        u.pm = fm + ((wgid % nig) % gsz); u.pn = (wgid % nig) / gsz; u.e = 0;
        u.A = A + (size_t)u.pm * tA; u.B = B + (size_t)u.pn * tB; return true;
    }
};
struct SchedCmp {         static constexpr bool GATHER = false;
    const char* KCT; const char* VCT; const char* W; int G, c;
    __device__ __forceinline__ bool next(int i, Unit& u) const {
        const int idx = i * G + c; if (idx >= 256) return false;
        const int ksl = idx & 7, r = idx >> 3, kv = r >> 4, bg = (r >> 1) & 7, half = r & 1;
        u.A = (kv ? VCT : KCT) + ((size_t)bg * SEQ * 64 + (size_t)half * 256 * 1024 + (size_t)ksl * 256) * 2;
        u.B = W + ((size_t)kv * 256 * 2048 + (size_t)ksl * 256) * 2; u.pm = (kv * 8 + bg) * 2 + half; u.pn = 0; u.e = ksl; return true;
    }
};
struct SchedMoe {
    static constexpr bool GATHER = false;
    const char* A; const char* W; const LAS int* tab; int NT; size_t wstride;
    __device__ __forceinline__ bool next(int i, Unit& u) const {
        const int v = __builtin_amdgcn_readfirstlane(tab[i]); if (v < 0) return false;
        const int rb = v & 0xfff, pn = (v >> 12) & 0xf, e = v >> 16;
        u.A = A + (size_t)rb * 256 * 1024 * 2; u.B = W + (size_t)e * wstride + (size_t)pn * 256 * 1024 * 2; u.pm = rb; u.pn = pn; u.e = e; return true;
    }
};
struct SchedMoeG {
    static constexpr bool GATHER = true;
    const char* A; const char* W; const LAS int* tab; int NT; size_t wstride; const int* rowtok;
    __device__ __forceinline__ bool next(int i, Unit& u) const {
        const int v = __builtin_amdgcn_readfirstlane(tab[i]); if (v < 0) return false;
        const int rb = v & 0xfff, pn = (v >> 12) & 0xf, e = v >> 16;
        u.A = A; u.B = W + (size_t)e * wstride + (size_t)pn * 256 * 1024 * 2; u.pm = rb; u.pn = pn; u.e = e; return true;
    }
};
__device__ __forceinline__ void moe_units(LAS int* tab, const int* meta, const int NT, const int G, const int c, const int tid) {
    if (tid < 256) {
        int v = -1; const int i = tid;
        if ((G & 7) == 0) { const int x = c & 7, q = i * (G >> 3) + (c >> 3); const int nb = meta[16 + x];
            if (q < nb * NT) { const int rbi = q / NT, pn = q - rbi * NT, rb = meta[1024 + 640 * x + rbi]; v = rb | (pn << 12) | (meta[64 + rb] << 16); } }
        else { const int idx = i * G + c; const int nblk = meta[0]; if (idx < nblk * NT) { const int rb = idx / NT, pn = idx - rb * NT; v = rb | (pn << 12) | (meta[64 + rb] << 16); } }
        tab[i] = v;
    }
    __syncthreads();
}

typedef f32x4 Acc[2][2][4][2];

struct EpiBf16 {
    struct Pre {}; __device__ __forceinline__ void pre(Pre&, const Unit&, int, int, int, int) const {}
    static constexpr bool PERM = true;
    bf16_t* O; int ldc;
    __device__ __forceinline__ void operator()(const Acc& acc, const Unit& u, int wr, int wc, int fr, int fq, const Pre&) const {
        const int row0 = u.pm * BM + wr * 64 + fr, col0 = u.pn * BM + wc * 32 + 8 * fq;
#pragma unroll
        for (int ai = 0; ai < 2; ++ai)
#pragma unroll
            for (int m = 0; m < 4; ++m) { bf16_t* rowp = O + (size_t)(row0 + ai * HALF + m * 16) * ldc + col0;
#pragma unroll
                for (int bj = 0; bj < 2; ++bj) { const f32x4 v0 = acc[ai][bj][m][0], v1 = acc[ai][bj][m][1];
                    u32x4 w; w.x = pk2(v0[0], v0[1]); w.y = pk2(v0[2], v0[3]); w.z = pk2(v1[0], v1[1]); w.w = pk2(v1[2], v1[3]);
                    *(u32x4*)(rowp + bj * HALF) = w; } }
    }
};
struct EpiSlab {
    struct Pre {}; __device__ __forceinline__ void pre(Pre&, const Unit&, int, int, int, int) const {}
    static constexpr bool PERM = false;
    float* O;
    __device__ __forceinline__ void operator()(const Acc& acc, const Unit& u, int wr, int wc, int fr, int fq, const Pre&) const {
        const int row0 = u.pm * BM + wr * 64 + fr, col0 = wc * 32 + 4 * fq;
        float* base = O + (size_t)u.e * 8192 * 256;
#pragma unroll
        for (int ai = 0; ai < 2; ++ai)
#pragma unroll
            for (int m = 0; m < 4; ++m) { const size_t off = (size_t)(row0 + ai * HALF + m * 16) * 256 + col0;
#pragma unroll
                for (int bj = 0; bj < 2; ++bj)
#pragma unroll
                    for (int n = 0; n < 2; ++n) *(f32x4*)(base + off + bj * HALF + n * 16) = acc[ai][bj][m][n]; }
    }
};
struct EpiGate {
    struct Pre {}; __device__ __forceinline__ void pre(Pre&, const Unit&, int, int, int, int) const {}
    static constexpr bool PERM = true;
    bf16_t* O; const bf16_t* proj; int second;
    __device__ __forceinline__ void operator()(const Acc& acc, const Unit& u, int wr, int wc, int fr, int fq, const Pre&) const {
        const int row0 = u.pm * BM + wr * 64 + fr, col0 = u.pn * BM + wc * 32 + 8 * fq;
#pragma unroll
        for (int ai = 0; ai < 2; ++ai)
#pragma unroll
            for (int m = 0; m < 4; ++m) { const size_t row = (size_t)(row0 + ai * HALF + m * 16); const bf16_t* rp = proj + row * NPROJ + C_MG + (second ? 1024 : 0) + col0;
#pragma unroll
                for (int bj = 0; bj < 2; ++bj) { const u32x4 wb = *(const u32x4*)(rp + bj * HALF); u32x4 prev = {0u, 0u, 0u, 0u};
                    if (second) prev = *(const u32x4*)(O + row * D + col0 + bj * HALF);
                    float o[8];
#pragma unroll
                    for (int j = 0; j < 8; ++j) { const unsigned ub = wb[j >> 1], up = prev[j >> 1]; const float b = (j & 1) ? bfhi(ub) : bflo(ub), pv = (j & 1) ? bfhi(up) : bflo(up);
                        o[j] = pv + (j < 4 ? acc[ai][bj][m][0][j] : acc[ai][bj][m][1][j - 4]) * sigmoidf_(b); }
                    u32x4 w; w.x = pk2(o[0], o[1]); w.y = pk2(o[2], o[3]); w.z = pk2(o[4], o[5]); w.w = pk2(o[6], o[7]);
                    *(u32x4*)(O + row * D + col0 + bj * HALF) = w; } }
    }
};
struct EpiSwiglu {
    static constexpr bool PERM = true;
    bf16_t* O; const float* bgu;
    const float* rsrow;
    LAS unsigned char* rsl;
    struct Pre {};
    __device__ __forceinline__ void pre(Pre&, const Unit& u, int wc, int fq, int wid, int lane) const {
        LAS unsigned char* my = rsl + wid * 768;
        const float* rp = rsrow + u.pm * BM + (wid >> 2) * 64 + lane;
        __builtin_amdgcn_global_load_lds((const unsigned*)rp, (LAS unsigned*)my, 4, 0, 0);
        __builtin_amdgcn_global_load_lds((const unsigned*)(rp + HALF), (LAS unsigned*)(my + 256), 4, 0, 0);
        const float* bp = bgu + (size_t)u.e * 2048 + u.pn * 128 + wc * 32 + (lane & 31) + (lane >> 5) * 1024;
        __builtin_amdgcn_global_load_lds((const unsigned*)bp, (LAS unsigned*)(my + 512), 4, 0, 0); }
    __device__ __forceinline__ void operator()(const Acc& acc, const Unit& u, int wr, int wc, int fr, int fq, const Pre&) const {
        const int row0 = u.pm * BM + wr * 64 + fr, col0 = u.pn * 128 + wc * 32 + 8 * fq;
        const LAS unsigned char* my = rsl + (wr * 4 + wc) * 768;
        const f32x4 g0 = *(const LAS f32x4*)(my + 512 + 32 * fq), g1 = *(const LAS f32x4*)(my + 512 + 32 * fq + 16), u0 = *(const LAS f32x4*)(my + 640 + 32 * fq), u1 = *(const LAS f32x4*)(my + 640 + 32 * fq + 16);
#pragma unroll
        for (int ai = 0; ai < 2; ++ai)
#pragma unroll
            for (int m = 0; m < 4; ++m) { float o[8]; const float rs = *(const LAS float*)(my + ai * 256 + (m * 16 + fr) * 4);
#pragma unroll
                for (int j = 0; j < 8; ++j) {
                    float gv = (j < 4 ? acc[ai][0][m][0][j] * rs + g0[j] : acc[ai][0][m][1][j - 4] * rs + g1[j - 4]);
                    float uv = (j < 4 ? acc[ai][1][m][0][j] * rs + u0[j] : acc[ai][1][m][1][j - 4] * rs + u1[j - 4]);
                    gv = fminf(gv, 7.0f); uv = fminf(fmaxf(uv, -7.0f), 7.0f);
                    const float glu = gv * frcp(1.0f + fexp2(-1.702f * 1.4426950408889634f * gv)); o[j] = (uv + 1.0f) * glu; }
                u32x4 w; w.x = pk2(o[0], o[1]); w.y = pk2(o[2], o[3]); w.z = pk2(o[4], o[5]); w.w = pk2(o[6], o[7]);
                *(u32x4*)(O + (size_t)(row0 + ai * HALF + m * 16) * D + col0) = w; }
    }
};
struct EpiDown {
    static constexpr bool PERM = true;
    bf16_t* O; const float* bd;
    struct Pre { f32x4 b[2][2]; };
    __device__ __forceinline__ void pre(Pre& p, const Unit& u, int wc, int fq, int wid, int lane) const { const float* bp = bd + (size_t)u.e * D + u.pn * BM + wc * 32 + 8 * fq;
#pragma unroll
        for (int bj = 0; bj < 2; ++bj) { p.b[bj][0] = *(const f32x4*)(bp + bj * HALF); p.b[bj][1] = *(const f32x4*)(bp + bj * HALF + 4); } }
    __device__ __forceinline__ void operator()(const Acc& acc, const Unit& u, int wr, int wc, int fr, int fq, const Pre& p) const {
        const int row0 = u.pm * BM + wr * 64 + fr, col0 = u.pn * BM + wc * 32 + 8 * fq;
#pragma unroll
        for (int bj = 0; bj < 2; ++bj) { const f32x4 b0 = p.b[bj][0], b1 = p.b[bj][1];
#pragma unroll
            for (int ai = 0; ai < 2; ++ai)
#pragma unroll
                for (int m = 0; m < 4; ++m) { const f32x4 v0 = acc[ai][bj][m][0] + b0, v1 = acc[ai][bj][m][1] + b1;
                    u32x4 w; w.x = pk2(v0[0], v0[1]); w.y = pk2(v0[2], v0[3]); w.z = pk2(v1[0], v1[1]); w.w = pk2(v1[2], v1[3]);
                    *(u32x4*)(O + (size_t)(row0 + ai * HALF + m * 16) * D + col0 + bj * HALF) = w; } }
    }
};

template <class Epi, class Sched>
__device__ __forceinline__ void gemm_phase(LAS unsigned char* lds, const int tid, const int K, const unsigned lda, const unsigned ldb, const Sched& S, const Epi& E) {
    const int wid = __builtin_amdgcn_readfirstlane(tid >> 6), lane = tid & 63, wr = wid >> 2, wc = wid & 3, fr = lane & 15, fq = lane >> 4;
    const int nt = K / BK;
    unsigned voffA[2], voffB[2]; int Rs[2];
#pragma unroll
    for (int i = 0; i < 2; ++i) { int R, C; stage_rc(tid * 16 + i * 8192, R, C); const int Rb = Epi::PERM ? ((R & ~31) + perm32(R & 31)) : R; Rs[i] = R;
        voffA[i] = Sched::GATHER ? (unsigned)C * 2u : (unsigned)R * lda + (unsigned)C * 2u; voffB[i] = (unsigned)Rb * ldb + (unsigned)C * 2u; }
    unsigned offc[2][2] = {{0u, 0u}, {0u, 0u}}, offn[2][2] = {{0u, 0u}, {0u, 0u}};
    const size_t kstep = (size_t)(BK * 2);
    const size_t hstepA = (size_t)HALF * lda, hstepB = (size_t)HALF * ldb;
    const unsigned ldsw = (unsigned)wid * 1024u;
    const int aoff = lds_byte(wr * 64 + fr, fq * 8), boff = lds_byte(wc * 32 + fr, fq * 8);
#define G8_SA(b, h) (((b) * 2 + (h)) * HTB)
#define G8_SB(b, h) ((4 + (b) * 2 + (h)) * HTB)
#define G8_STAGE(bufoff, gbase, voff) do { _Pragma("unroll") for (int _i = 0; _i < 2; ++_i) \
        __builtin_amdgcn_global_load_lds((const unsigned*)((const char*)(gbase) + (voff)[_i]), (LAS unsigned*)(lds + (bufoff) + ldsw + _i * 8192), 16, 0, 0); } while (0)
#define G8_STAGEA(bufoff, kt, h, nx) do { _Pragma("unroll") for (int _i = 0; _i < 2; ++_i) { \
        const char* _g = Sched::GATHER ? (cA + (size_t)(kt) * kstep + ((nx) ? offn[h][_i] : offc[h][_i]) + voffA[_i]) : (((nx) ? nA : cA) + (size_t)(kt) * kstep + (size_t)(h) * hstepA + voffA[_i]); \
        __builtin_amdgcn_global_load_lds((const unsigned*)_g, (LAS unsigned*)(lds + (bufoff) + ldsw + _i * 8192), 16, 0, 0); } } while (0)
#define G8_LOADOFF(dst, un) do { if constexpr (Sched::GATHER) { _Pragma("unroll") for (int _h = 0; _h < 2; ++_h) _Pragma("unroll") for (int _i = 0; _i < 2; ++_i) \
        dst[_h][_i] = (unsigned)S.rowtok[(un).pm * 256 + _h * 128 + Rs[_i]] * (unsigned)(D * 2); } } while (0)
#define G8_LDA(dst, b, h) do { _Pragma("unroll") for (int m = 0; m < 4; ++m) _Pragma("unroll") for (int k = 0; k < 2; ++k) dst[m][k] = *(const LAS bf16x8*)(lds + G8_SA(b, h) + aoff + m * 2048 + k * 1024); } while (0)
#define G8_LDB(dst, b, h) do { _Pragma("unroll") for (int n = 0; n < 2; ++n) _Pragma("unroll") for (int k = 0; k < 2; ++k) dst[n][k] = *(const LAS bf16x8*)(lds + G8_SB(b, h) + boff + n * 2048 + k * 1024); } while (0)
#define G8_MMA(ai, bj, At, Bt) do { __builtin_amdgcn_s_setprio(1); _Pragma("unroll") for (int m = 0; m < 4; ++m) _Pragma("unroll") for (int n = 0; n < 2; ++n) _Pragma("unroll") for (int k = 0; k < 2; ++k) \
        acc[ai][bj][m][n] = __builtin_amdgcn_mfma_f32_16x16x32_bf16(Bt[n][k], At[m][k], acc[ai][bj][m][n], 0, 0, 0); __builtin_amdgcn_s_setprio(0); } while (0)
#define G8_WAIT_V(n) asm volatile("s_waitcnt vmcnt(" #n ")" ::: "memory")
#define G8_WAIT_L(n) asm volatile("s_waitcnt lgkmcnt(" #n ")" ::: "memory")
#define G8_BAR __builtin_amdgcn_s_barrier()
#define G8_SCHED __builtin_amdgcn_sched_barrier(0)
    Unit cur, nxt; int ui = 0;
    if (!S.next(0, cur)) return;
    Acc acc;
#pragma unroll
    for (int a = 0; a < 2; ++a)
#pragma unroll
        for (int b = 0; b < 2; ++b)
#pragma unroll
            for (int m = 0; m < 4; ++m)
#pragma unroll
                for (int n = 0; n < 2; ++n) acc[a][b][m][n] = (f32x4){0.f, 0.f, 0.f, 0.f};
    bf16x8 At[4][2], B0[2][2], B1[2][2];
    const char* cA = cur.A; const char* cB = cur.B; const char* nA = cA;
    typename Epi::Pre epre; E.pre(epre, cur, wc, fq, wid, lane);
    G8_LOADOFF(offc, cur);
    if constexpr (Sched::GATHER) asm volatile("s_waitcnt vmcnt(0)" ::: "memory");
    G8_STAGE(G8_SB(0, 0), cB, voffB); G8_STAGEA(G8_SA(0, 0), 0, 0, false); G8_STAGE(G8_SB(0, 1), cB + hstepB, voffB); G8_STAGEA(G8_SA(0, 1), 0, 1, false);
    if (wr == 1) G8_BAR;
    G8_WAIT_V(4); G8_BAR;
    G8_STAGE(G8_SB(1, 0), cB + kstep, voffB); G8_STAGEA(G8_SA(1, 0), 1, 0, false); G8_STAGE(G8_SB(1, 1), cB + hstepB + kstep, voffB);
    G8_WAIT_V(6); G8_BAR;
    for (;;) {
        const bool has_next = S.next(ui + 1, nxt);
        nA = has_next ? nxt.A : cA; const char* nB = has_next ? nxt.B : cB;
        if (has_next) G8_LOADOFF(offn, nxt);
        else { _Pragma("unroll") for (int _h = 0; _h < 2; ++_h) _Pragma("unroll") for (int _i = 0; _i < 2; ++_i) offn[_h][_i] = offc[_h][_i]; }
        for (int t = 0; t < nt; t += 2) {
            const bool last = (t == nt - 2);
            const char* b2 = last ? nB : cB + (size_t)(t + 2) * kstep;
            const char* b3 = b2 + kstep;
            const int k2 = last ? 0 : t + 2, k3 = last ? 1 : t + 3;
            G8_LDB(B0, 0, 0); G8_SCHED; G8_LDA(At, 0, 0); G8_STAGEA(G8_SA(1, 1), t + 1, 1, false);
            G8_WAIT_L(8); G8_BAR; G8_WAIT_L(0); G8_MMA(0, 0, At, B0); G8_BAR; G8_SCHED;
            G8_LDB(B1, 0, 1); G8_STAGE(G8_SB(0, 0), b2, voffB);
            G8_BAR; G8_WAIT_L(0); G8_MMA(0, 1, At, B1); G8_BAR;
            G8_LDA(At, 0, 1); G8_STAGEA(G8_SA(0, 0), k2, 0, last);
            G8_BAR; G8_WAIT_L(0); G8_MMA(1, 0, At, B0); G8_BAR; G8_SCHED;
            G8_STAGE(G8_SB(0, 1), b2 + hstepB, voffB);
            G8_WAIT_V(6); G8_BAR; G8_MMA(1, 1, At, B1); G8_BAR;
            G8_LDB(B0, 1, 0); G8_SCHED; G8_LDA(At, 1, 0); G8_STAGEA(G8_SA(0, 1), k2, 1, last);
            G8_WAIT_L(8); G8_BAR; G8_WAIT_L(0); G8_MMA(0, 0, At, B0); G8_BAR; G8_SCHED;
            G8_LDB(B1, 1, 1); G8_STAGE(G8_SB(1, 0), b3, voffB);
            G8_BAR; G8_WAIT_L(0); G8_MMA(0, 1, At, B1); G8_BAR;
            G8_LDA(At, 1, 1); G8_STAGEA(G8_SA(1, 0), k3, 0, last);
            G8_BAR; G8_WAIT_L(0); G8_MMA(1, 0, At, B0); G8_BAR; G8_SCHED;
            G8_STAGE(G8_SB(1, 1), b3 + hstepB, voffB);
            G8_WAIT_V(6); G8_BAR; G8_MMA(1, 1, At, B1); G8_BAR;
        }
        MFMA_FENCE();
        E(acc, cur, wr, wc, fr, fq, epre);
        if (!has_next) break;
#pragma unroll
        for (int a = 0; a < 2; ++a)
#pragma unroll
            for (int b = 0; b < 2; ++b)
#pragma unroll
                for (int m = 0; m < 4; ++m)
#pragma unroll
                    for (int n = 0; n < 2; ++n) acc[a][b][m][n] = (f32x4){0.f, 0.f, 0.f, 0.f};
        cur = nxt; cA = nA; cB = nB; ++ui;
        { _Pragma("unroll") for (int _h = 0; _h < 2; ++_h) _Pragma("unroll") for (int _i = 0; _i < 2; ++_i) offc[_h][_i] = offn[_h][_i]; }
        E.pre(epre, cur, wc, fq, wid, lane);
    }
    G8_WAIT_V(0);
    if (wr == 0) G8_BAR;
    G8_BAR;
#undef G8_SA
#undef G8_SB
#undef G8_STAGE
#undef G8_LDA
#undef G8_STAGEA
#undef G8_LOADOFF
#undef G8_LDB
#undef G8_MMA
#undef G8_WAIT_V
#undef G8_WAIT_L
#undef G8_BAR
#undef G8_SCHED
}
}

struct ConvR { f32x4 v[16]; };
template <int MODE>
__device__ __forceinline__ void conv_item(const float* __restrict__ src, int ldS, int col4  , int k0, bf16_t* __restrict__ dst  , int K, int kq, const float* __restrict__ ksc  , ConvR& r) {
    if (MODE != 2) {
#pragma unroll
        for (int j = 0; j < 16; ++j) r.v[j] = col4 >= 0 ? *(const f32x4*)(src + (size_t)(k0 + kq * 16 + j) * ldS + col4) : (f32x4){0.f, 0.f, 0.f, 0.f};
    }
    if (MODE != 1) {
        if (ksc) {
#pragma unroll
            for (int j = 0; j < 16; ++j) r.v[j] *= ksc[k0 + kq * 16 + j];
        }
#pragma unroll
        for (int rr = 0; rr < 4; ++rr) {
            u32x4 w0, w1;
#pragma unroll
            for (int j = 0; j < 4; ++j) { w0[j] = pk2(r.v[2 * j][rr], r.v[2 * j + 1][rr]); w1[j] = pk2(r.v[8 + 2 * j][rr], r.v[8 + 2 * j + 1][rr]); }
            bf16_t* d = dst + (size_t)rr * K + kq * 16;
            *(u32x4*)d = w0; *(u32x4*)(d + 8) = w1;
        }
    }
}
__device__ __forceinline__ void rms_row_to_h(const float* __restrict__ xr, const float* __restrict__ nw, bf16_t* __restrict__ hr, int lane) {
    f32x4 v[4]; float ss = 0.f;
#pragma unroll
    for (int i = 0; i < 4; ++i) { v[i] = *(const f32x4*)(xr + i * 256 + lane * 4); ss += v[i][0] * v[i][0] + v[i][1] * v[i][1] + v[i][2] * v[i][2] + v[i][3] * v[i][3]; }
    ss = wave_sum(ss);
    const float rs = rsqrtf(ss * (1.0f / 1024.0f) + NORM_EPS);
#pragma unroll
    for (int i = 0; i < 4; ++i) { const f32x4 w = *(const f32x4*)(nw + i * 256 + lane * 4);
        u32x2 o; o.x = pk2(v[i][0] * rs * w[0], v[i][1] * rs * w[1]); o.y = pk2(v[i][2] * rs * w[2], v[i][3] * rs * w[3]);
        *(u32x2*)(hr + i * 256 + lane * 4) = o; }
}
constexpr int CONV_ITEMS = 112 * 16 + 16 * 32 + 16 * 16 + 2 * 4 * 32 + 32 * 32 * 16 + 32 * 16 * 16;
template <int MODE>
__device__ __forceinline__ void conv_one(const Ctx& c, const int l, const int it, ConvR& cr) {
    const int lane = c.lane;
    constexpr int I_IN = 112 * 16, I_O = 16 * 32, I_OUT = 16 * 16, I_C1 = 2 * 4 * 32, I_GU = 32 * 32 * 16;
    constexpr int E1 = I_IN, E2 = E1 + I_O, E3 = E2 + I_OUT, E4 = E3 + I_C1, E5 = E4 + I_GU;
    const int n4 = (lane & 15) * 4, kq = lane >> 4;
    if (it < E1) { const int nb = it / 16, kb = it % 16; const int n = nb * 64 + n4;
        const int col = n < 4912 ? n : (n < 5120 ? -1 : n - 208);
        conv_item<MODE>(c.w_in + (size_t)l * D * IN_TOTAL, IN_TOTAL, col, kb * 64, WSP(bf16_t, WS_WIN) + ((size_t)l * NPROJ + n) * D + kb * 64, D, kq, nullptr, cr);
    } else if (it < E2) { const int r = it - E1, nb = r / 32, kb = r % 32; const int n = nb * 64 + n4;
        const float* src = (kb < 16 ? c.w_o_ret : c.w_o_nsa) + (size_t)l * D * D;
        conv_item<MODE>(src, D, n, (kb & 15) * 64, WSP(bf16_t, WS_WO) + ((size_t)l * D + n) * 2048 + kb * 64, 2048, kq, nullptr, cr);
    } else if (it < E3) { const int r = it - E2, nb = r / 16, kb = r % 16; const int n = nb * 64 + n4;
        conv_item<MODE>(c.w_out + (size_t)l * D * D, D, n, kb * 64, WSP(bf16_t, WS_WOUT) + ((size_t)l * D + n) * D + kb * 64, D, kq, nullptr, cr);
    } else if (it < E4) { const int j = it - E3, lk = l * 2 + j / 128, r = j % 128, nb = r / 32, kb = r % 32; const int n = nb * 64 + n4;
        conv_item<MODE>(c.cmp_w1 + (size_t)lk * 2048 * 256, 256, n, kb * 64, WSP(bf16_t, WS_WC1) + ((size_t)lk * 256 + n) * 2048 + kb * 64, 2048, kq, nullptr, cr);
    } else if (it < E5) { const int j = it - E4, le = l * NEXP + j / 512, r = j % 512, nb = r / 16, kb = r % 16; const int n = nb * 64 + n4;
        const int pn = n >> 8, jj = n & 255; const int col = jj < 128 ? pn * 128 + jj : 1024 + pn * 128 + (jj - 128);
        conv_item<MODE>(c.w_gate_up + (size_t)le * D * 2048, 2048, col, kb * 64, WSP(bf16_t, WS_WGU) + ((size_t)le * 2048 + n) * D + kb * 64, D, kq, c.norm2_w + (size_t)l * D, cr);
    } else { const int j = it - E5, le = l * NEXP + j / 256, r = j % 256, nb = r / 16, kb = r % 16; const int n = nb * 64 + n4;
        conv_item<MODE>(c.w_down + (size_t)le * D * D, D, n, kb * 64, WSP(bf16_t, WS_WD) + ((size_t)le * D + n) * D + kb * 64, D, kq, nullptr, cr);
    }
}
__device__ __forceinline__ void conv_one(const Ctx& c, const int l, const int it) { ConvR cr; conv_one<0>(c, l, it, cr); }
__device__ __forceinline__ bool conv_is_early(const int it) { return it < 112 * 16 || (it >= 112 * 16 + 16 * 32 + 16 * 16 && it < 112 * 16 + 16 * 32 + 16 * 16 + 2 * 4 * 32); }
__device__ __forceinline__ void conv_layer_early(const Ctx& c, const int l, const int widx, const int nw) {
    for (int it = widx; it < 112 * 16; it += nw) conv_one(c, l, it);
    for (int it = 112 * 16 + 16 * 32 + 16 * 16 + widx; it < 112 * 16 + 16 * 32 + 16 * 16 + 2 * 4 * 32; it += nw) conv_one(c, l, it);
}
__device__ __forceinline__ void phase_prologue(const Ctx& c) {
    const int lane = c.lane, gw = c.gw, NW = c.G * NWAVES;
    conv_layer_early(c, 0, gw, NW);
    const int gtid = blockIdx.x * NTHREADS + c.tid, NT = c.G * NTHREADS;
    for (int pos = gw; pos < SEQ; pos += NW) {
#pragma unroll
        for (int pass = 0; pass < 2; ++pass) {
            if (pass == 1 && lane >= 8) break;
            const int j = pass == 0 ? lane : 64 + lane;
            float inv; if (j < 64) inv = powf(10000.0f, -(float)(2 * j) / 128.0f); else inv = powf(500000.0f, -(float)(2 * (j - 64)) / 16.0f);
            const float ang = (float)pos * inv;
            double rev = (double)ang * 0.15915494309189535; rev -= floor(rev);
            const float rv = (float)rev; const float sn = __builtin_amdgcn_sinf(rv), cs = __builtin_amdgcn_cosf(rv);
            if (j < 64) { float* t = WSP(float, WS_ROPER) + ((size_t)pos * 64 + j) * 2; t[0] = cs; t[1] = sn; }
            else { float* t = WSP(float, WS_ROPEN) + ((size_t)pos * 8 + (j - 64)) * 2; t[0] = cs; t[1] = sn; }
        }
    }
    for (int u = blockIdx.x + c.wave * c.G; u < NL * 2 * 16 * 8; u += c.G * NWAVES) {
        const int kh = u & 7, lk = u >> 7, n = ((u >> 3) & 15) * 16 + (lane & 15), k0 = kh * 256 + (lane >> 4) * 64;
        const float* pe = c.cmp_pos + (size_t)lk * 2048 + k0; const float* w1 = c.cmp_w1 + ((size_t)lk * 2048 + k0) * 256 + n;
        float s0 = 0.f, s1 = 0.f, s2 = 0.f, s3 = 0.f;
#pragma unroll 4
        for (int k = 0; k < 64; k += 4) { s0 += pe[k] * w1[(size_t)k * 256]; s1 += pe[k + 1] * w1[(size_t)(k + 1) * 256]; s2 += pe[k + 2] * w1[(size_t)(k + 2) * 256]; s3 += pe[k + 3] * w1[(size_t)(k + 3) * 256]; }
        float s = (s0 + s1) + (s2 + s3);
        s += __shfl_xor(s, 16); s += __shfl_xor(s, 32);
        if (lane < 16) WSP(float, WS_PEB)[kh * (NL * 2 * 256) + lk * 256 + n] = s;
    }
    for (int i = gtid; i < NL * 32 * 2 * 64 * 8; i += NT) {
        const int j = i & 7, ln = (i >> 3) & 63, nt = (i >> 9) & 1, ks = (i >> 10) & 31, l = i >> 15;
        const int fr_ = ln & 15, fq_ = ln >> 4, k = 32 * ks + (j < 4 ? 4 * fq_ + j : 16 + 4 * fq_ + (j - 4)), e = 16 * nt + fr_;
        const float w = c.norm2_w[(size_t)l * D + k] * c.router_w[((size_t)l * D + k) * NEXP + e];
        const unsigned hi = f2bf(w); const float wl = w - __uint_as_float(hi << 16);
        bf16_t* dst = WSP(bf16_t, WS_RWF) + ((((size_t)l * 32 + ks) * 2 + nt) * 2) * 512 + ln * 8 + j;
        dst[0] = (bf16_t)hi; dst[512] = (bf16_t)f2bf(wl);
    }
    for (int tok = gw; tok < NTOK; tok += NW) rms_row_to_h(c.x_in + (size_t)tok * D, c.norm1_w, WSP(bf16_t, WS_H) + (size_t)tok * D, lane);
}

constexpr float SM_SCALE_L2 = 0.125f * 1.4426950408889634f;
__device__ __forceinline__ void phase_prep(const Ctx& c, int l) {
    const int lane = c.lane, gw = c.gw, NW = c.G * NWAVES;
    const bf16_t* proj = WSP(bf16_t, WS_PROJ);
    const float* ropeR = WSP(float, WS_ROPER); const float* ropeN = WSP(float, WS_ROPEN);
    const float* qkw = c.qk_norm_w + (size_t)l * 4 * 64;
    for (int tok = gw; tok < NTOK; tok += NW) {
        const int b = tok / SEQ, s = tok % SEQ; const bf16_t* pr = proj + (size_t)tok * NPROJ;
        {
            const int job = lane >> 3, l8 = lane & 7, isk = job >> 2, h = job & 3;
            const bf16_t* src = pr + (isk ? C_RK : C_RQ) + h * 128 + 8 * l8;
            const u32x4 w1 = *(const u32x4*)src, w2 = *(const u32x4*)(src + 64);
            const f32x4* tb = (const f32x4*)(ropeR + ((size_t)s * 64 + 8 * l8) * 2);
            const float ksc = isk ? 0.08838834764831845f : 1.0f;
            u32x4 o1, o2;
#pragma unroll
            for (int j = 0; j < 4; ++j) { const f32x4 cs = tb[j];
                const float a1 = bflo(w1[j]), a2 = bflo(w2[j]), b1 = bfhi(w1[j]), b2 = bfhi(w2[j]);
                o1[j] = pk2((a1 * cs[0] - a2 * cs[1]) * ksc, (b1 * cs[2] - b2 * cs[3]) * ksc);
                o2[j] = pk2((a1 * cs[1] + a2 * cs[0]) * ksc, (b1 * cs[3] + b2 * cs[2]) * ksc); }
            bf16_t* dst = WSP(bf16_t, isk ? WS_KR : WS_QR) + ((size_t)(b * 4 + h) * SEQ + s) * 128 + 8 * l8;
            *(u32x4*)dst = o1; *(u32x4*)(dst + 64) = o2;
        }
        {
            const int head = lane >> 2, part = lane & 3; const bf16_t* src = pr + C_NQ + head * 64 + part * 16;
            const u32x4 w0 = *(const u32x4*)src, w1 = *(const u32x4*)(src + 8); float v[16];
#pragma unroll
            for (int j = 0; j < 4; ++j) { v[2 * j] = bflo(w0[j]); v[2 * j + 1] = bfhi(w0[j]); v[8 + 2 * j] = bflo(w1[j]); v[8 + 2 * j + 1] = bfhi(w1[j]); }
            float ss = 0.f;
#pragma unroll
            for (int j = 0; j < 16; ++j) ss += v[j] * v[j];
            ss += __shfl_xor(ss, 1); ss += __shfl_xor(ss, 2);
            const float rs = rsqrtf(ss * (1.0f / 64.0f) + NORM_EPS);
#pragma unroll
            for (int j = 0; j < 16; ++j) v[j] = v[j] * (rs * SM_SCALE_L2) * qkw[0 * 64 + part * 16 + j];
            if (part == 0) {
#pragma unroll
                for (int i = 0; i < 8; ++i) { const float cc = ropeN[((size_t)s * 8 + i) * 2], sc = ropeN[((size_t)s * 8 + i) * 2 + 1]; const float x1 = v[i], x2 = v[i + 8]; v[i] = x1 * cc - x2 * sc; v[i + 8] = x1 * sc + x2 * cc; }
            }
            u32x4 o0, o1;
#pragma unroll
            for (int j = 0; j < 4; ++j) { o0[j] = pk2(v[2 * j], v[2 * j + 1]); o1[j] = pk2(v[8 + 2 * j], v[8 + 2 * j + 1]); }
            bf16_t* dst = WSP(bf16_t, WS_QN) + ((size_t)tok * 16 + head) * 64 + part * 16;
            *(u32x4*)dst = o0; *(u32x4*)(dst + 8) = o1;
        }
        if (lane < 16) {
            const int hh = lane >> 2, part = lane & 3, isw = hh >> 1, g = hh & 1;
            const bf16_t* src = pr + (isw ? C_KW : C_KS) + g * 64 + part * 16;
            const u32x4 w0 = *(const u32x4*)src, w1 = *(const u32x4*)(src + 8); float v[16];
#pragma unroll
            for (int j = 0; j < 4; ++j) { v[2 * j] = bflo(w0[j]); v[2 * j + 1] = bfhi(w0[j]); v[8 + 2 * j] = bflo(w1[j]); v[8 + 2 * j + 1] = bfhi(w1[j]); }
            float ss = 0.f;
#pragma unroll
            for (int j = 0; j < 16; ++j) ss += v[j] * v[j];
            ss += __shfl_xor(ss, 1); ss += __shfl_xor(ss, 2);
            const float rs = rsqrtf(ss * (1.0f / 64.0f) + NORM_EPS);
            const float* w = qkw + (isw ? 3 : 2) * 64 + part * 16;
#pragma unroll
            for (int j = 0; j < 16; ++j) v[j] = v[j] * rs * w[j];
            if (part == 0) {
#pragma unroll
                for (int i = 0; i < 8; ++i) { const float cc = ropeN[((size_t)s * 8 + i) * 2], sc = ropeN[((size_t)s * 8 + i) * 2 + 1]; const float x1 = v[i], x2 = v[i + 8]; v[i] = x1 * cc - x2 * sc; v[i + 8] = x1 * sc + x2 * cc; }
            }
            u32x4 o0, o1;
#pragma unroll
            for (int j = 0; j < 4; ++j) { o0[j] = pk2(v[2 * j], v[2 * j + 1]); o1[j] = pk2(v[8 + 2 * j], v[8 + 2 * j + 1]); }
            bf16_t* dst = WSP(bf16_t, isw ? WS_KW : WS_KS) + ((((size_t)(b * 2 + g) * 128 + (s >> 6)) * 4 + ((s >> 4) & 3)) * 2 + (part >> 1)) * 512 + ((2 * (part & 1)) * 16 + (s & 15)) * 8;
            *(u32x4*)dst = o0; *(u32x4*)(dst + 128) = o1;
        } else if (lane < 48) {
            const int q = lane - 16, isv = q >> 4, r = q & 15, g = r >> 3, part = r & 7;
            const u32x4 w = *(const u32x4*)(pr + (isv ? C_VC : C_KC) + g * 64 + part * 8);
            *(u32x4*)(WSP(bf16_t, isv ? WS_VCT : WS_KCT) + ((size_t)(b * 2 + g) * SEQ + s) * 64 + part * 8) = w;
        }
    }
    const float lgam[4] = {log2f(1.0f - 1.0f / 32.0f), log2f(1.0f - 1.0f / 64.0f), log2f(1.0f - 1.0f / 128.0f), log2f(1.0f - 1.0f / 256.0f)};
    LAS bf16_t* tile = (LAS bf16_t*)(c.lds + c.wave * 8192);
    for (int grp = gw; grp < NTOK / 8; grp += NW) {
        const int tok0 = grp * 8, b = tok0 / SEQ, s0 = tok0 % SEQ; const bf16_t* pr = proj + (size_t)tok0 * NPROJ;
#define PREP_LOAD_TILE(col0) do { _Pragma("unroll") for (int _t = 0; _t < 8; ++_t) { const u32x4 _w = *(const u32x4*)(pr + (size_t)_t * NPROJ + (col0) + lane * 8); *(LAS u32x4*)(tile + _t * 512 + lane * 8) = _w; } } while (0)
#define PREP_COL8(cc, w) do { unsigned short _v[8]; _Pragma("unroll") for (int _t = 0; _t < 8; ++_t) _v[_t] = tile[_t * 512 + (cc)]; \
        (w).x = _v[0] | ((unsigned)_v[1] << 16); (w).y = _v[2] | ((unsigned)_v[3] << 16); (w).z = _v[4] | ((unsigned)_v[5] << 16); (w).w = _v[6] | ((unsigned)_v[7] << 16); } while (0)
        PREP_LOAD_TILE(C_RK);
        {
            float cs[8], sn[8], zz[8];
#pragma unroll
            for (int t = 0; t < 8; ++t) { const f32x2 tb = *(const f32x2*)(ropeR + ((size_t)(s0 + t) * 64 + lane) * 2); cs[t] = tb[0]; sn[t] = tb[1]; }
#pragma unroll
            for (int h = 0; h < 4; ++h) { float o1[8], o2[8];
#pragma unroll
                for (int t = 0; t < 8; ++t) { const float k1 = bf2f(tile[t * 512 + h * 128 + lane]), k2 = bf2f(tile[t * 512 + h * 128 + 64 + lane]);
                    const float z = fexp2(lgam[h] * (float)(127 - ((s0 + t) & 127))) * 0.08838834764831845f;
                    o1[t] = (k1 * cs[t] - k2 * sn[t]) * z; o2[t] = (k1 * sn[t] + k2 * cs[t]) * z; }
                u32x4 w1, w2;
#pragma unroll
                for (int j = 0; j < 4; ++j) { w1[j] = pk2(o1[2 * j], o1[2 * j + 1]); w2[j] = pk2(o2[2 * j], o2[2 * j + 1]); }
                { const int tk = s0 & 127, q = tk & 31, fqa = (q & 15) >> 2, jb = q >= 16 ? 4 : 0;
                  bf16_t* base = WSP(bf16_t, WS_KZT) + ((((size_t)(b * 4 + h) * 64 + (s0 >> 7)) * 8) * 4 + (tk >> 5)) * 512 + (fqa * 16 + (lane & 15)) * 8 + jb;
                  bf16_t* d1 = base + (size_t)(lane >> 4) * 2048, *d2 = base + (size_t)(4 + (lane >> 4)) * 2048;
                  u32x2 a; a.x = w1.x; a.y = w1.y; *(u32x2*)d1 = a; a.x = w1.z; a.y = w1.w; *(u32x2*)(d1 + 128) = a;
                  a.x = w2.x; a.y = w2.y; *(u32x2*)d2 = a; a.x = w2.z; a.y = w2.w; *(u32x2*)(d2 + 128) = a; } }
        }
#pragma unroll 1
        for (int hf = 0; hf < 2; ++hf) {
            PREP_LOAD_TILE(C_RV + hf * 512);
#pragma unroll
            for (int i = 0; i < 8; ++i) { const int cc = i * 64 + lane; u32x4 w; PREP_COL8(cc, w);
                { const int ch_ = hf * 512 + cc, hh = ch_ >> 8, dv = ch_ & 255, tk = s0 & 127, q = tk & 31, fqa = (q & 15) >> 2, jb = q >= 16 ? 4 : 0;
                  bf16_t* d = WSP(bf16_t, WS_VT) + (((((size_t)(b * 4 + hh) * 64 + (s0 >> 7)) * 4 + (tk >> 5)) * 16 + (dv >> 4)) * 64 + fqa * 16 + (dv & 15)) * 8 + jb;
                  u32x2 a; a.x = w.x; a.y = w.y; *(u32x2*)d = a; a.x = w.z; a.y = w.w; *(u32x2*)(d + 128) = a; } }
        }
        {
#pragma unroll
            for (int _t = 0; _t < 8; ++_t) { const int piece = lane >> 4, off = (lane & 15) * 8;
                if (lane < 32) { const u32x4 _w = *(const u32x4*)(pr + (size_t)_t * NPROJ + (piece ? C_VW : C_VS) + off); *(LAS u32x4*)(tile + _t * 512 + piece * 128 + off) = _w; } }
#pragma unroll
            for (int i = 0; i < 4; ++i) { const int isw = i >> 1, g = i & 1; u32x4 w; PREP_COL8(isw * 128 + g * 64 + lane, w);
                const int q = s0 & 31; bf16_t* dst = WSP(bf16_t, isw ? WS_VWT : WS_VST) + ((((size_t)(b * 2 + g) * 128 + (s0 >> 6)) * 2 + ((s0 >> 5) & 1)) * 4 + (lane >> 4)) * 512 + ((((q & 15) >> 2)) * 16 + (lane & 15)) * 8 + (q >= 16 ? 4 : 0);
                u32x2 w0, w1; w0.x = w.x; w0.y = w.y; w1.x = w.z; w1.y = w.w; *(u32x2*)dst = w0; *(u32x2*)(dst + 128) = w1; }
        }
#undef PREP_LOAD_TILE
#undef PREP_COL8
    }
}

__device__ __forceinline__ void phase_cmp2(const Ctx& c, int l) {
    const int lane = c.lane, gw = c.gw, NW = c.G * NWAVES;
    const float* ropeN = WSP(float, WS_ROPEN);
    for (int r0 = 0; r0 < 2 * 8 * 512; r0 += c.G * 32) {
        const int rowb = r0 + blockIdx.x * 32 + c.wave * 4; if (rowb >= 2 * 8 * 512) break;
        const int kv = rowb >> 12, bg = (rowb >> 9) & 7;
        const float* w2 = c.cmp_w2 + ((size_t)l * 2 + kv) * 256 * 64 + lane;
        LAS float* hl = (LAS float*)(c.lds + c.wave * 4096);
        { const float* sl = WSP(float, WS_ACT) + (size_t)rowb * 256 + lane * 4; f32x4 pb = *(const f32x4*)(WSP(float, WS_PEB) + (size_t)l * 512 + kv * 256 + lane * 4);
#pragma unroll
          for (int kh = 1; kh < 8; ++kh) pb += *(const f32x4*)(WSP(float, WS_PEB) + (size_t)kh * (NL * 2 * 256) + (size_t)l * 512 + kv * 256 + lane * 4);
#pragma unroll
          for (int rr = 0; rr < 4; ++rr) { f32x4 a = pb;
#pragma unroll
              for (int q = 0; q < 8; ++q) a += *(const f32x4*)(sl + (size_t)q * 8192 * 256 + rr * 256);
#pragma unroll
              for (int j = 0; j < 4; ++j) { const float x = a[j]; const float t = 0.7978845608028654f * (x + 0.044715f * x * x * x);
                  const float th = 1.0f - 2.0f * frcp(1.0f + fexp2(2.8853900817779268f * t)); a[j] = 0.5f * x * (1.0f + th); }
              *(LAS f32x4*)(hl + rr * 256 + lane * 4) = a; } }
        float acc4[4] = {0.f, 0.f, 0.f, 0.f};
#pragma unroll 4
        for (int k = 0; k < 256; k += 2) { const float wa = w2[(size_t)k * 64], wb = w2[(size_t)(k + 1) * 64];
#pragma unroll
            for (int rr = 0; rr < 4; ++rr) { const f32x2 hw = *(const LAS f32x2*)(hl + rr * 256 + k); acc4[rr] += hw[0] * wa + hw[1] * wb; } }
#pragma unroll
        for (int rr = 0; rr < 4; ++rr) {
            const int n = (rowb + rr) & 511; const float acc = acc4[rr];
            if (kv == 0) {
                const float ss = wave_sum(acc * acc); float v = acc * rsqrtf(ss * (1.0f / 64.0f) + NORM_EPS) * c.qk_norm_w[(size_t)l * 256 + 64 + lane];
                const float other = __shfl_xor(v, 8);
                int pos = 16 * n + 31; if (pos > SEQ - 1) pos = SEQ - 1;
                if (lane < 16) { const int i = lane & 7; const float cc = ropeN[((size_t)pos * 8 + i) * 2], sc = ropeN[((size_t)pos * 8 + i) * 2 + 1];
                    v = lane < 8 ? v * cc - other * sc : other * sc + v * cc; }
                WSP(bf16_t, WS_KCMP)[((((size_t)bg * 8 + (n >> 6)) * 4 + ((n >> 4) & 3)) * 2 + (lane >> 5)) * 512 + (((lane >> 3) & 3) * 16 + (n & 15)) * 8 + (lane & 7)] = (bf16_t)f2bf(v);
            } else {
                const int q = n & 31; WSP(bf16_t, WS_VCMPT)[((((size_t)bg * 8 + (n >> 6)) * 2 + ((n >> 5) & 1)) * 4 + (lane >> 4)) * 512 + (((q & 15) >> 2) * 16 + (lane & 15)) * 8 + (q >= 16 ? 4 : 0) + (q & 3)] = (bf16_t)(n < 511 ? f2bf(acc) : 0u);
            }
        }
    }
}

__device__ __forceinline__ void phase_scan(const Ctx& c) {
    const int lane = c.lane, w = c.wave, fr = lane & 15, fq = lane >> 4;
    for (int it0 = blockIdx.x; it0 < 256; it0 += c.G) {
        const int it = (c.G == 256) ? ((it0 & 7) * 32 + (it0 >> 3)) : it0;
        const int bh = it >> 4, dvs = it & 15, h = bh & 3;
        const float cdec = fexp2(log2f(1.0f - fexp2(-5.0f - (float)h)) * 128.0f);
        const bf16_t* kz = WSP(bf16_t, WS_KZT) + ((size_t)bh * 64 * 8 + w) * 2048 + lane * 8;
        const bf16_t* vt = WSP(bf16_t, WS_VT) + ((size_t)bh * 64 * 64 + dvs) * 512 + lane * 8;
        bf16_t* rt = WSP(bf16_t, WS_RT) + ((((size_t)bh * 64) * 16 + dvs) * 4 + (w >> 1)) * 512 + ((2 * (w & 1) + (fq >> 1)) * 16 + fr) * 8 + 4 * (fq & 1);
        f32x4 acc = {0.f, 0.f, 0.f, 0.f};
        bf16x8 kf[2][4], vf[2][4];
        u32x2 st[64];
#pragma unroll
        for (int u = 0; u < 2; ++u)
#pragma unroll
            for (int ks = 0; ks < 4; ++ks) { kf[u][ks] = ld8(kz + (size_t)u * 16384 + ks * 512); vf[u][ks] = ld8(vt + (size_t)u * 32768 + ks * 8192); }
#pragma unroll
        for (int ch = 0; ch < 64; ++ch) {
            const int u = ch & 1;
            st[ch].x = pk2(acc[0], acc[1]); st[ch].y = pk2(acc[2], acc[3]);
            acc *= cdec;
#pragma unroll
            for (int ks = 0; ks < 4; ++ks) acc = mfma16(kf[u][ks], vf[u][ks], acc);
            if (ch + 2 < 64) {
#pragma unroll
                for (int ks = 0; ks < 4; ++ks) { kf[u][ks] = ld8(kz + (size_t)(ch + 2) * 16384 + ks * 512); vf[u][ks] = ld8(vt + (size_t)(ch + 2) * 32768 + ks * 8192); }
            }
        }
        MFMA_FENCE();
#pragma unroll
        for (int ch = 0; ch < 64; ++ch) *(u32x2*)(rt + (size_t)ch * 32768) = st[ch];
    }
}

#define SH_BAR() do { asm volatile("" ::: "memory"); __builtin_amdgcn_s_barrier(); asm volatile("" ::: "memory"); } while (0)
#define SH_WAIT_BAR() do { asm volatile("s_waitcnt vmcnt(0)" ::: "memory"); __builtin_amdgcn_s_barrier(); asm volatile("" ::: "memory"); } while (0)
constexpr int RET_CONV = 1024 * NWAVES;
__device__ __forceinline__ void phase_retout(const Ctx& c, int l, const int lconv, const bool late0) {
    const int lane = c.lane, wave = c.wave, fr = lane & 15, fq = lane >> 4;
    const bf16_t* proj = WSP(bf16_t, WS_PROJ);
    LAS unsigned char* lv = c.lds;
    LAS unsigned char* lr = c.lds + 65536;
    for (int u = blockIdx.x; u < 16 * 64; u += c.G) {
        const int qt = wave, ch = u & 63, bh = u >> 6, b = bh >> 2, h = bh & 3;
        const float lg = log2f(1.0f - fexp2(-5.0f - (float)h));
        const bf16_t* Q = WSP(bf16_t, WS_QR) + ((size_t)bh * SEQ + ch * 128) * 128;
        const bf16_t* Kp = WSP(bf16_t, WS_KR) + ((size_t)bh * SEQ + ch * 128) * 128;
        const bf16_t* VTp = WSP(bf16_t, WS_VT) + ((size_t)(bh * 64 + ch)) * 32768;
        const bf16_t* RTp = WSP(bf16_t, WS_RT) + ((size_t)(bh * 64 + ch)) * 32768;
        ConvR cvr;
#define RET_CONV_CALL(MODE) do { const int _tot = (lconv >= 0 ? CONV_ITEMS : 0) + (late0 ? CONV_ITEMS : 0); if (_tot > 0) { const int _it = _tot - 1 - (u * NWAVES + wave); \
            const bool _nx = lconv >= 0 && _it < CONV_ITEMS; conv_one<MODE>(c, _nx ? lconv : 0, _nx ? _it : _it - (lconv >= 0 ? CONV_ITEMS : 0), cvr); } } while (0)
        SH_BAR();
        RET_CONV_CALL(1);
#pragma unroll
        for (int i = 0; i < 8; ++i) {
            __builtin_amdgcn_global_load_lds((const unsigned*)(VTp + (size_t)(wave * 8 + i) * 512 + lane * 8), (LAS unsigned*)(lv + (wave * 8 + i) * 1024), 16, 0, 0);
            __builtin_amdgcn_global_load_lds((const unsigned*)(RTp + (size_t)(wave * 8 + i) * 512 + lane * 8), (LAS unsigned*)(lr + (wave * 8 + i) * 1024), 16, 0, 0);
        }
        const int n = 16 * qt + fr;
        bf16x8 qf[4], qs[4];
        const float xi = fexp2(lg * (float)(n + 1));
#pragma unroll
        for (int ks = 0; ks < 4; ++ks) { const u32x4 w = *(const u32x4*)(Q + (size_t)n * 128 + 32 * ks + 8 * fq); qf[ks] = mk8(w);
            u32x4 s;
#pragma unroll
            for (int j = 0; j < 4; ++j) s[j] = pk2(bflo(w[j]) * xi, bfhi(w[j]) * xi);
            qs[ks] = mk8(s); }
        const size_t tok = (size_t)b * SEQ + ch * 128 + n;
        const bf16_t* gp = proj + tok * NPROJ + C_RG + h * 256 + 4 * fq; const float* gw_ = c.ret_gn_w + (size_t)l * 1024 + h * 256 + 4 * fq;
        bf16x8 kk[8];
#pragma unroll
        for (int ks = 0; ks < 4; ++ks) { kk[ks] = ld8(Kp + (size_t)fr * 128 + 32 * ks + 8 * fq); kk[4 + ks] = ld8(Kp + (size_t)((qt >= 1 ? 16 : 0) + fr) * 128 + 32 * ks + 8 * fq); }
        SH_WAIT_BAR();
        RET_CONV_CALL(2);
#undef RET_CONV_CALL
        u32x2 gv[16];
#pragma unroll
        for (int dt = 0; dt < 16; ++dt) gv[dt] = *(const u32x2*)(gp + 16 * dt);
        f32x4 o[16];
#pragma unroll
        for (int dt = 0; dt < 16; ++dt) o[dt] = (f32x4){0.f, 0.f, 0.f, 0.f};
        for (int p = 0; p <= (qt >> 1); ++p) {
            f32x4 s0 = {0.f, 0.f, 0.f, 0.f}, s1 = {0.f, 0.f, 0.f, 0.f};
            const bool two = (2 * p + 1 <= qt);
#pragma unroll
            for (int ks = 0; ks < 4; ++ks) s0 = mfma16(kk[ks], qf[ks], s0);
#pragma unroll
            for (int ks = 0; ks < 4; ++ks) s1 = mfma16(kk[4 + ks], qf[ks], s1);
            MFMA_FENCE();
            if (p + 1 <= (qt >> 1)) {
                const bool two_n = (2 * (p + 1) + 1 <= qt);
#pragma unroll
                for (int ks = 0; ks < 4; ++ks) { kk[ks] = ld8(Kp + (size_t)(32 * (p + 1) + fr) * 128 + 32 * ks + 8 * fq); kk[4 + ks] = ld8(Kp + (size_t)(32 * (p + 1) + (two_n ? 16 : 0) + fr) * 128 + 32 * ks + 8 * fq); }
            }
#pragma unroll
            for (int r = 0; r < 4; ++r) { const int d0 = n - (32 * p + 4 * fq + r), d1 = d0 - 16;
                s0[r] = d0 >= 0 ? s0[r] * fexp2(lg * (float)d0) : 0.f; s1[r] = (two && d1 >= 0) ? s1[r] * fexp2(lg * (float)d1) : 0.f; }
            u32x4 pw; pw.x = pk2(s0[0], s0[1]); pw.y = pk2(s0[2], s0[3]); pw.z = pk2(s1[0], s1[1]); pw.w = pk2(s1[2], s1[3]);
            const bf16x8 pb = mk8(pw);
#pragma unroll
            for (int dt = 0; dt < 16; ++dt) o[dt] = mfma16(*(const LAS bf16x8*)(lv + (p * 16 + dt) * 1024 + lane * 16), pb, o[dt]);
            MFMA_FENCE();
        }
#pragma unroll
        for (int dt = 0; dt < 16; ++dt)
#pragma unroll
            for (int ks = 0; ks < 4; ++ks) o[dt] = mfma16(*(const LAS bf16x8*)(lr + (dt * 4 + ks) * 1024 + lane * 16), qs[ks], o[dt]);
        float s = 0.f;
#pragma unroll
        for (int dt = 0; dt < 16; ++dt) s += (o[dt][0] + o[dt][1]) + (o[dt][2] + o[dt][3]);
        s += __shfl_xor(s, 16); s += __shfl_xor(s, 32);
        const float mu = s * (1.0f / 256.0f); float q = 0.f;
#pragma unroll
        for (int dt = 0; dt < 16; ++dt)
#pragma unroll
            for (int r = 0; r < 4; ++r) { const float d = o[dt][r] - mu; q += d * d; }
        q += __shfl_xor(q, 16); q += __shfl_xor(q, 32);
        const float rstd = rsqrtf(q * (1.0f / 256.0f) + NORM_EPS);
        bf16_t* op = WSP(bf16_t, WS_RA) + tok * 2048 + h * 256 + 4 * fq;
#pragma unroll
        for (int dt = 0; dt < 16; ++dt) { const f32x4 wv = *(const f32x4*)(gw_ + 16 * dt);
            float g[4] = {bflo(gv[dt].x), bfhi(gv[dt].x), bflo(gv[dt].y), bfhi(gv[dt].y)}; float r_[4];
#pragma unroll
            for (int r = 0; r < 4; ++r) r_[r] = (o[dt][r] - mu) * rstd * wv[r] * g[r] * sigmoidf_(g[r]);
            u32x2 ov; ov.x = pk2(r_[0], r_[1]); ov.y = pk2(r_[2], r_[3]); *(u32x2*)(op + 16 * dt) = ov; }
    }
    SH_BAR();
}

__device__ __forceinline__ void attn_step_lds(const LAS unsigned char* slot, const bf16x8 (&qf)[2], const int key0, const int hiK, const int loK, const bool colok, const bool allok, const bool full,
                                              f32x4 (&O)[4], float& lsum, const int lane, const int fq) {
    bf16x8 kv[8];
#pragma unroll
    for (int i = 0; i < 8; ++i) kv[i] = *(const LAS bf16x8*)(slot + i * 1024 + lane * 16);
    f32x4 s[4];
    __builtin_amdgcn_s_setprio(1);
#pragma unroll
    for (int kt = 0; kt < 4; ++kt) { s[kt] = (f32x4){0.f, 0.f, 0.f, 0.f};
#pragma unroll
        for (int ks = 0; ks < 2; ++ks) s[kt] = mfma16(kv[kt * 2 + ks], qf[ks], s[kt]); }
    __builtin_amdgcn_s_setprio(0);
#pragma unroll
    for (int i = 0; i < 8; ++i) kv[i] = *(const LAS bf16x8*)(slot + 8192 + i * 1024 + lane * 16);
    float ps = 0.f;
    if (full) {
        if (allok) {
#pragma unroll
            for (int kt = 0; kt < 4; ++kt)
#pragma unroll
                for (int r = 0; r < 4; ++r) { const float p = fexp2(s[kt][r]); s[kt][r] = p; ps += p; }
        } else {
#pragma unroll
            for (int kt = 0; kt < 4; ++kt)
#pragma unroll
                for (int r = 0; r < 4; ++r) { const float p = colok ? fexp2(s[kt][r]) : 0.f; s[kt][r] = p; ps += p; }
        }
    } else {
#pragma unroll
        for (int kt = 0; kt < 4; ++kt)
#pragma unroll
            for (int r = 0; r < 4; ++r) { const int key = key0 + 16 * kt + 4 * fq + r; const bool ok = colok && (key <= hiK) && (key > loK);
                const float p = ok ? fexp2(s[kt][r]) : 0.f; s[kt][r] = p; ps += p; }
    }
    lsum += ps;
#pragma unroll
    for (int p2 = 0; p2 < 2; ++p2) {
        u32x4 pw; pw.x = pk2(s[2 * p2][0], s[2 * p2][1]); pw.y = pk2(s[2 * p2][2], s[2 * p2][3]); pw.z = pk2(s[2 * p2 + 1][0], s[2 * p2 + 1][1]); pw.w = pk2(s[2 * p2 + 1][2], s[2 * p2 + 1][3]);
        const bf16x8 pb = mk8(pw);
        __builtin_amdgcn_s_setprio(1);
#pragma unroll
        for (int dt = 0; dt < 4; ++dt) O[dt] = mfma16(kv[p2 * 4 + dt], pb, O[dt]);
        __builtin_amdgcn_s_setprio(0);
    }
    MFMA_FENCE();
}
__device__ __forceinline__ int sel_pop(unsigned long long& lo, unsigned long long& hi) {
    if (lo) { const int j = __builtin_ctzll(lo); lo &= lo - 1ull; return j; }
    if (hi) { const int j = 64 + __builtin_ctzll(hi); hi &= hi - 1ull; return j; }
    return -1;
}
#define SH_SLOT(s) (shb + (s) * 16384)
#define SH_ISSUE(kbase, vbase, blk, slot, withv) do { \
        __builtin_amdgcn_global_load_lds((const unsigned*)((kbase) + (size_t)(blk) * 4096 + (wave * 64 + lane) * 8), (LAS unsigned*)(SH_SLOT(slot) + wave * 1024), 16, 0, 0); \
        if (withv) __builtin_amdgcn_global_load_lds((const unsigned*)((vbase) + (size_t)(blk) * 4096 + (wave * 64 + lane) * 8), (LAS unsigned*)(SH_SLOT(slot) + 8192 + wave * 1024), 16, 0, 0); } while (0)
#define SH_READ_K(slot) do { _Pragma("unroll") for (int _i = 0; _i < 8; ++_i) kf[_i] = *(const LAS bf16x8*)(SH_SLOT(slot) + _i * 1024 + lane * 16); } while (0)
#define SH_READ_V(slot) do { _Pragma("unroll") for (int _i = 0; _i < 8; ++_i) vf[_i] = *(const LAS bf16x8*)(SH_SLOT(slot) + 8192 + _i * 1024 + lane * 16); } while (0)
__device__ __forceinline__ void phase_nsa(const Ctx& c, const int layer, const int lconv  , const bool late0  ) {
    const int lane = c.lane, wave = c.wave, fr = lane & 15, fq = lane >> 4;
    const bf16_t* proj = WSP(bf16_t, WS_PROJ);
    volatile LAS float* imp = (volatile LAS float*)(c.lds + 131072 + wave * 2304);
    LAS unsigned char* shb = c.lds;
    const int cntot0 = (lconv >= 0 ? CONV_ITEMS : 0) + (late0 ? CONV_ITEMS : 0), cntot = cntot0 > 0 ? cntot0 - RET_CONV : 0, crounds = (cntot + c.G * NWAVES - 1) / (c.G * NWAVES);
    const int cntl = (2048 + c.G - 1) / c.G, crpt = (crounds + cntl - 1) / cntl;
    volatile LAS int* qs = (volatile LAS int*)(c.lds + LDS_CTL_OFF + 256);
#define NSA_QCTR (WSP(unsigned, WS_CTL + 16384) + layer * 64)
    if (c.tid == 0) { qs[0] = (int)__hip_atomic_fetch_add(NSA_QCTR, 1u, __ATOMIC_RELAXED, __HIP_MEMORY_SCOPE_AGENT); asm volatile("s_waitcnt lgkmcnt(0)" ::: "memory"); }
    int kk = 0;
    for (;; ++kk) {
        SH_BAR();
        const int U = __builtin_amdgcn_readfirstlane(qs[kk & 1]);
        if (U >= 2048) break;
        const int bg = U >> 8; const int tl = 255 - (U & 255);
        const int b = bg >> 1, g = bg & 1, T0 = 32 * tl, curW = T0 >> 6;
        int t0[2], tcol[2]; bf16x8 qf[2][2]; float g0[2], g1[2], g2[2]; size_t tokc[2];
        const int head = g * 8 + (fr & 7);
#pragma unroll
        for (int pr = 0; pr < 2; ++pr) {
            t0[pr] = T0 + 4 * wave + 2 * pr; tcol[pr] = t0[pr] + (fr >> 3); tokc[pr] = (size_t)b * SEQ + tcol[pr];
#pragma unroll
            for (int ks = 0; ks < 2; ++ks) qf[pr][ks] = ld8(WSP(bf16_t, WS_QN) + (tokc[pr] * 16 + head) * 64 + 32 * ks + 8 * fq);
            const bf16_t* gp = proj + tokc[pr] * NPROJ + C_NG + head * 3;
            g0[pr] = sigmoidf_(bf2f(gp[0])); g1[pr] = sigmoidf_(bf2f(gp[1])); g2[pr] = sigmoidf_(bf2f(gp[2]));
        }
        f32x4 out[2][4], O[2][4]; float lsum[2];
        bf16x8 kf[8];
#define NSA_ZERO_O() do { _Pragma("unroll") for (int _p = 0; _p < 2; ++_p) { lsum[_p] = 0.f; _Pragma("unroll") for (int _d = 0; _d < 4; ++_d) O[_p][_d] = (f32x4){0.f, 0.f, 0.f, 0.f}; } } while (0)
        int nbc[2];
#pragma unroll
        for (int pr = 0; pr < 2; ++pr) { const int nv = (t0[pr] + 1 >= 31) ? ((t0[pr] + 1 - 31) >> 4) + 1 : 0; nbc[pr] = (nv + 63) >> 6; }
        const int nvW = (T0 + 31 >= 31) ? ((T0 + 31 - 31) >> 4) + 1 : 0, nbcW = (nvW + 63) >> 6;
        const bf16_t* Kc = WSP(bf16_t, WS_KCMP) + (size_t)bg * 8 * 4096; const bf16_t* Vc = WSP(bf16_t, WS_VCMPT) + (size_t)bg * 8 * 4096;
        NSA_ZERO_O();
        SH_BAR();
        int nq = 0; if (c.tid == 0) nq = (int)__hip_atomic_fetch_add(NSA_QCTR, 1u, __ATOMIC_RELAXED, __HIP_MEMORY_SCOPE_AGENT);
        for (int kb = 0; kb < nbcW; ++kb) SH_ISSUE(Kc, Vc, kb, kb, true);
        SH_WAIT_BAR();
        if (c.tid == 0) { qs[(kk + 1) & 1] = nq; asm volatile("s_waitcnt lgkmcnt(0)" ::: "memory"); }
        for (int kb = 0; kb < nbcW; ++kb) {
#pragma unroll
            for (int pr = 0; pr < 2; ++pr) if (kb < nbc[pr])
                attn_step_lds(SH_SLOT(kb), qf[pr], kb * 64, (tcol[pr] - 31) >> 4, -1, true, true, 16 * (kb * 64 + 63) + 31 <= t0[pr], O[pr], lsum[pr], lane, fq);
        }
        float il[2];
#pragma unroll
        for (int pr = 0; pr < 2; ++pr) { float l = lsum[pr]; l += __shfl_xor(l, 16); l += __shfl_xor(l, 32); il[pr] = l > 0.f ? 1.0f / l : 0.f;
#pragma unroll
            for (int dt = 0; dt < 4; ++dt) out[pr][dt] = O[pr][dt] * (g0[pr] * il[pr]); }
        for (int i = lane; i < 4 * 136; i += 64) imp[i] = 0.f;
        for (int kb = 0; kb < nbcW; ++kb) {
            if (kb < nbc[1]) {
                SH_READ_K(kb);
#pragma unroll
                for (int pr = 0; pr < 2; ++pr) if (kb < nbc[pr]) {
                    f32x4 s4[4];
#pragma unroll
                    for (int kt = 0; kt < 4; ++kt) { s4[kt] = (f32x4){0.f, 0.f, 0.f, 0.f};
#pragma unroll
                        for (int ks = 0; ks < 2; ++ks) s4[kt] = mfma16(kf[kt * 2 + ks], qf[pr][ks], s4[kt]); }
                    MFMA_FENCE();
#pragma unroll
                    for (int kt = 0; kt < 4; ++kt) {
                        float pa = 0.f, p3 = 0.f;
#pragma unroll
                        for (int r = 0; r < 4; ++r) { const int key = kb * 64 + 16 * kt + 4 * fq + r; const bool ok = (16 * key + 31 <= tcol[pr]);
                            const float p = ok ? fexp2(s4[kt][r]) * il[pr] : 0.f; pa += p; if (r == 3) p3 = p; }
                        pa = sum8(pa); p3 = sum8(p3);
                        const int jb = 4 * (4 * kb + kt) + fq, tk = pr * 2 + (fr >> 3);
                        if ((fr & 7) == 0) { (void)__hip_atomic_fetch_add((LAS float*)imp + tk * 136 + jb, pa, __ATOMIC_RELAXED, __HIP_MEMORY_SCOPE_WORKGROUP);
                            (void)__hip_atomic_fetch_add((LAS float*)imp + tk * 136 + jb + 1, p3, __ATOMIC_RELAXED, __HIP_MEMORY_SCOPE_WORKGROUP); }
                    }
                }
            }
        }
        unsigned long long msk[2][2][2];
        {
            bool vl[4], vh[4]; unsigned ul[4], uh[4], T[4];
#pragma unroll
            for (int tk = 0; tk < 4; ++tk) {
                const int t = T0 + 4 * wave + tk, cur = t >> 6; const int jl = lane, jh = lane + 64;
                vl[tk] = jl <= cur; vh[tk] = jh <= cur;
                const bool fl = (jl == 0) || (jl == cur) || (jl == cur - 1), fh = (jh == cur) || (jh == cur - 1);
                ul[tk] = fl ? 0x7f800000u : __float_as_uint(imp[tk * 136 + jl]); uh[tk] = fh ? 0x7f800000u : __float_as_uint(imp[tk * 136 + jh]); T[tk] = 0u;
            }
            int cT[4];
#pragma unroll
            for (int tk = 0; tk < 4; ++tk) cT[tk] = __popcll(__ballot(vl[tk])) + __popcll(__ballot(vh[tk]));
#pragma unroll 1
            for (int bit = 30; bit >= 0; --bit) {
#pragma unroll
                for (int tk = 0; tk < 4; ++tk) { const unsigned cand = T[tk] | (1u << bit);
                    const int cnt = __popcll(__ballot(vl[tk] && ul[tk] >= cand)) + __popcll(__ballot(vh[tk] && uh[tk] >= cand));
                    if (cnt >= 16) { T[tk] = cand; cT[tk] = cnt; } }
                if (cT[0] <= 16 && cT[1] <= 16 && cT[2] <= 16 && cT[3] <= 16) break;
            }
#pragma unroll
            for (int tk = 0; tk < 4; ++tk) {
                const unsigned long long gtl = __ballot(vl[tk] && ul[tk] > T[tk]), gth = __ballot(vh[tk] && uh[tk] > T[tk]);
                const unsigned long long eql = __ballot(vl[tk] && ul[tk] == T[tk]), eqh = __ballot(vh[tk] && uh[tk] == T[tk]);
                const int need = 16 - (__popcll(gtl) + __popcll(gth));
                const unsigned long long lm = (1ull << lane) - 1ull;
                const int rl = __popcll(eql & lm), rh = __popcll(eql) + __popcll(eqh & lm);
                msk[tk >> 1][tk & 1][0] = gtl | __ballot(vl[tk] && ul[tk] == T[tk] && rl < need); msk[tk >> 1][tk & 1][1] = gth | __ballot(vh[tk] && uh[tk] == T[tk] && rh < need);
            }
        }
        const bf16_t* Kw = WSP(bf16_t, WS_KW) + (size_t)bg * 128 * 4096; const bf16_t* Vw = WSP(bf16_t, WS_VWT) + (size_t)bg * 128 * 4096;
        const int loW = T0 - 511 > 0 ? T0 - 511 : 0; const int jb0W = loW >> 6, jb1W = (T0 + 31) >> 6;
        const int wbase = (((curW >> 2) + 1) & 1) * 4;
        {
            const bf16_t* Ks = WSP(bf16_t, WS_KS) + (size_t)bg * 128 * 4096; const bf16_t* Vs = WSP(bf16_t, WS_VST) + (size_t)bg * 128 * 4096;
            NSA_ZERO_O();
            unsigned long long any[2][2], mine[2][2], both[2][2];
#pragma unroll
            for (int pr = 0; pr < 2; ++pr)
#pragma unroll
                for (int h = 0; h < 2; ++h) { any[pr][h] = msk[pr][0][h] | msk[pr][1][h]; both[pr][h] = msk[pr][0][h] & msk[pr][1][h]; mine[pr][h] = (fr >> 3) ? msk[pr][1][h] : msk[pr][0][h]; }
            const int ng = (curW >> 2) + 1;
            SH_BAR();
#pragma unroll
            for (int bb = 0; bb < 4; ++bb) if (bb <= curW) SH_ISSUE(Ks, Vs, bb, bb, true);
            for (int gi = 0; gi < ng; ++gi) {
                SH_WAIT_BAR();
                if (gi + 1 < ng) {
#pragma unroll
                    for (int bb = 0; bb < 4; ++bb) if (4 * (gi + 1) + bb <= curW) SH_ISSUE(Ks, Vs, 4 * (gi + 1) + bb, ((gi + 1) & 1) * 4 + bb, true);
                } else SH_ISSUE(Kw, Vw, jb0W, ((gi + 1) & 1) * 4, true);
#pragma unroll 1
                for (int bb = 0; bb < 4; ++bb) {
                    const int j = 4 * gi + bb; if (j > curW) break;
                    const int slot = (gi & 1) * 4 + bb;
                    const bool a0 = ((j < 64 ? (any[0][0] >> j) : (any[0][1] >> (j - 64))) & 1ull) != 0ull, a1 = ((j < 64 ? (any[1][0] >> j) : (any[1][1] >> (j - 64))) & 1ull) != 0ull;
#pragma unroll
                    for (int pr = 0; pr < 2; ++pr) if (pr == 0 ? a0 : a1) {
                        const bool colok = ((j < 64 ? (mine[pr][0] >> j) : (mine[pr][1] >> (j - 64))) & 1ull) != 0ull;
                        const bool bothsel = ((j < 64 ? (both[pr][0] >> j) : (both[pr][1] >> (j - 64))) & 1ull) != 0ull;
                        attn_step_lds(SH_SLOT(slot), qf[pr], j * 64, tcol[pr], -1, colok, bothsel, j * 64 + 63 <= t0[pr], O[pr], lsum[pr], lane, fq); }
                }
            }
#pragma unroll
            for (int pr = 0; pr < 2; ++pr) { float l = lsum[pr]; l += __shfl_xor(l, 16); l += __shfl_xor(l, 32); const float sc = l > 0.f ? g1[pr] / l : 0.f;
#pragma unroll
                for (int dt = 0; dt < 4; ++dt) out[pr][dt] += O[pr][dt] * sc; }
        }
        {
            NSA_ZERO_O();
            for (int jb = jb0W; jb <= jb1W; ++jb) {
                const int slot = wbase + ((jb - jb0W) & 1);
                SH_WAIT_BAR();
                if (jb < jb1W) SH_ISSUE(Kw, Vw, jb + 1, wbase + ((jb + 1 - jb0W) & 1), true);
#pragma unroll
                for (int pr = 0; pr < 2; ++pr) { const int lo = t0[pr] - 511 > 0 ? t0[pr] - 511 : 0;
                    if (jb >= (lo >> 6) && jb <= ((t0[pr] + 1) >> 6))
                        attn_step_lds(SH_SLOT(slot), qf[pr], jb * 64, tcol[pr], tcol[pr] - 512, true, true, jb * 64 > t0[pr] + 1 - 512 && jb * 64 + 63 <= t0[pr], O[pr], lsum[pr], lane, fq); }
            }
#pragma unroll
            for (int pr = 0; pr < 2; ++pr) { float l = lsum[pr]; l += __shfl_xor(l, 16); l += __shfl_xor(l, 32); const float sc = l > 0.f ? g2[pr] / l : 0.f;
#pragma unroll
                for (int dt = 0; dt < 4; ++dt) out[pr][dt] += O[pr][dt] * sc; }
        }
#pragma unroll
        for (int pr = 0; pr < 2; ++pr) { bf16_t* op = WSP(bf16_t, WS_RA) + tokc[pr] * 2048 + 1024 + head * 64 + 4 * fq;
#pragma unroll
            for (int dt = 0; dt < 4; ++dt) { u32x2 ov; ov.x = pk2(out[pr][dt][0], out[pr][dt][1]); ov.y = pk2(out[pr][dt][2], out[pr][dt][3]); *(u32x2*)(op + 16 * dt) = ov; } }
#undef NSA_ZERO_O
        {
#pragma unroll 1
            for (int r = kk * crpt; r < (kk + 1) * crpt && r < crounds; ++r) { const int item = c.gw + r * (c.G * NWAVES);
                if (item < cntot) { const bool nx = lconv >= 0 && item < CONV_ITEMS; const int i0 = nx ? item : item - (lconv >= 0 ? CONV_ITEMS : 0);
                    if (nx || !conv_is_early(i0)) conv_one(c, nx ? lconv : 0, i0); } }
        }
    }
#pragma unroll 1
    for (int r = kk * crpt; r < crounds; ++r) { const int item = c.gw + r * (c.G * NWAVES);
        if (item < cntot) { const bool nx = lconv >= 0 && item < CONV_ITEMS; const int i0 = nx ? item : item - (lconv >= 0 ? CONV_ITEMS : 0);
            if (nx || !conv_is_early(i0)) conv_one(c, nx ? lconv : 0, i0); } }
    SH_BAR();
#undef NSA_QCTR
}

__device__ __forceinline__ void phase_route(const Ctx& c, int l) {
    const int lane = c.lane, gw = c.gw, NW = c.G * NWAVES, fr = lane & 15, fq = lane >> 4;
    LAS int* cnt = (LAS int*)(c.lds + LDS_CTL_OFF + 64);
    if (c.tid < 32) cnt[c.tid] = 0;
    for (int i = blockIdx.x * NTHREADS + c.tid; i < XROWS; i += c.G * NTHREADS) WSP(int, WS_ROWTOK)[i] = 0;
    __syncthreads();
    const bf16_t* rwf = WSP(bf16_t, WS_RWF) + (size_t)l * 32 * 2 * 2 * 512 + lane * 8;
    const float b0 = c.router_b[(size_t)l * NEXP + fr], b1 = c.router_b[(size_t)l * NEXP + 16 + fr];
    for (int tile = gw; tile < NTOK / 16; tile += NW) {
        const int tok0 = tile * 16; const float* xr = (l == 0 ? c.x_in : (const float*)c.out) + (size_t)(tok0 + fr) * D + 4 * fq;
        const bf16_t* dr = WSP(bf16_t, WS_PROJ) + (size_t)(tok0 + fr) * D + 4 * fq;
        bf16_t* hrow = WSP(bf16_t, WS_H) + (size_t)(tok0 + fr) * D + 4 * fq;
        f32x4 acc0 = {0.f, 0.f, 0.f, 0.f}, acc1 = {0.f, 0.f, 0.f, 0.f}; float ss = 0.f;
#pragma unroll 1
        for (int kg = 0; kg < 8; ++kg) {
            f32x4 xa[4], xb[4]; u32x2 da[4], db[4]; bf16x8 wv[4][4];
#pragma unroll
            for (int u = 0; u < 4; ++u) { const int ks = kg * 4 + u; xa[u] = *(const f32x4*)(xr + 32 * ks); xb[u] = *(const f32x4*)(xr + 32 * ks + 16);
                da[u] = *(const u32x2*)(dr + 32 * ks); db[u] = *(const u32x2*)(dr + 32 * ks + 16);
#pragma unroll
                for (int q = 0; q < 4; ++q) wv[u][q] = ld8(rwf + ((size_t)ks * 4 + q) * 512); }
            __builtin_amdgcn_sched_barrier(0);
#pragma unroll
            for (int u = 0; u < 4; ++u) {
                float v[8] = {xa[u][0] + bflo(da[u].x), xa[u][1] + bfhi(da[u].x), xa[u][2] + bflo(da[u].y), xa[u][3] + bfhi(da[u].y),
                              xb[u][0] + bflo(db[u].x), xb[u][1] + bfhi(db[u].x), xb[u][2] + bflo(db[u].y), xb[u][3] + bfhi(db[u].y)}; float lo[8]; u32x4 hw, lw;
#pragma unroll
                for (int j = 0; j < 8; ++j) ss += v[j] * v[j];
#pragma unroll
                for (int j = 0; j < 4; ++j) { hw[j] = pk2(v[2 * j], v[2 * j + 1]); lo[2 * j] = v[2 * j] - bflo(hw[j]); lo[2 * j + 1] = v[2 * j + 1] - bfhi(hw[j]); }
#pragma unroll
                for (int j = 0; j < 4; ++j) lw[j] = pk2(lo[2 * j], lo[2 * j + 1]);
                const bf16x8 ah = mk8(hw), al = mk8(lw);
                { bf16_t* hp = hrow + 32 * (kg * 4 + u); u32x2 h0, h1; h0.x = hw[0]; h0.y = hw[1]; h1.x = hw[2]; h1.y = hw[3]; *(u32x2*)hp = h0; *(u32x2*)(hp + 16) = h1; }
                acc0 = mfma16(ah, wv[u][0], acc0); acc1 = mfma16(ah, wv[u][2], acc1);
                acc0 = mfma16(ah, wv[u][1], acc0); acc1 = mfma16(ah, wv[u][3], acc1);
                acc0 = mfma16(al, wv[u][0], acc0); acc1 = mfma16(al, wv[u][2], acc1);
            }
            MFMA_FENCE();
        }
        ss += __shfl_xor(ss, 16); ss += __shfl_xor(ss, 32);
        const float rs = rsqrtf(ss * (1.0f / 1024.0f) + NORM_EPS);
        if (fq == 0) WSP(float, WS_RSTD)[tok0 + fr] = rs;
#pragma unroll
        for (int r = 0; r < 4; ++r) {
            const float rt = __shfl(rs, 4 * fq + r);
            float v0 = acc0[r] * rt + b0, v1 = acc1[r] * rt + b1; float tv[4]; int te[4];
#pragma unroll
            for (int k = 0; k < 4; ++k) { float bv = v0; int be = fr; if (v1 > bv) { bv = v1; be = 16 + fr; }
#pragma unroll
                for (int o = 8; o >= 1; o >>= 1) { const float ov = __shfl_xor(bv, o); const int oe = __shfl_xor(be, o); if (ov > bv || (ov == bv && oe < be)) { bv = ov; be = oe; } }
                tv[k] = bv; te[k] = be; if (be == fr) v0 = -INFINITY; if (be == 16 + fr) v1 = -INFINITY; }
            const float e1 = expf(tv[1] - tv[0]), e2 = expf(tv[2] - tv[0]), e3 = expf(tv[3] - tv[0]); const float inv = 1.0f / (1.0f + e1 + e2 + e3);
            if (fr < 4) { const int e = fr == 0 ? te[0] : fr == 1 ? te[1] : fr == 2 ? te[2] : te[3]; const float wv_ = (fr == 0 ? 1.0f : fr == 1 ? e1 : fr == 2 ? e2 : e3) * inv;
                const int rk = atomicAdd((int*)&cnt[e], 1); const size_t o = (size_t)(tok0 + 4 * fq + r) * 4 + fr;
                WSP(int, WS_TE)[o] = e; WSP(float, WS_TW)[o] = wv_; WSP(int, WS_RANK)[o] = rk; }
        }
    }
    __syncthreads();
    if (c.tid < 32) WSP(int, WS_HIST)[blockIdx.x * 32 + c.tid] = cnt[c.tid];
    __syncthreads();
}

__device__ __forceinline__ void phase_scatter(const Ctx& c, int l) {
    const int lane = c.lane, gw = c.gw, NW = c.G * NWAVES;
    LAS int* hist = (LAS int*)c.lds;
    LAS int* part = (LAS int*)(c.lds + 65536);
    LAS int* base = part + 1024;
    LAS int* pst = base + 32;
    LAS int* nblk = pst + 40;
    for (int i = c.tid; i < c.G * 32; i += NTHREADS) hist[i] = WSP(int, WS_HIST)[i];
    __syncthreads();
    { const int e = c.tid & 31, p = c.tid >> 5, per = (c.G + 15) >> 4; const int w1 = (p + 1) * per < c.G ? (p + 1) * per : c.G; int before = 0, tot = 0;
      for (int w = p * per; w < w1; ++w) { const int v = hist[w * 32 + e]; if (w < (int)blockIdx.x) before += v; tot += v; }
      part[(p * 32 + e) * 2] = before; part[(p * 32 + e) * 2 + 1] = tot; }
    __syncthreads();
    if (c.tid < 32) { int before = 0, tot = 0;
#pragma unroll
        for (int p = 0; p < 16; ++p) { before += part[(p * 32 + c.tid) * 2]; tot += part[(p * 32 + c.tid) * 2 + 1]; }
        base[c.tid] = before; const int padded = (tot + 255) & ~255; int incl = padded;
#pragma unroll
        for (int o = 1; o < 32; o <<= 1) { const int t = __shfl_up(incl, o); if (c.tid >= o) incl += t; }
        pst[c.tid] = incl - padded; if (c.tid == 31) pst[32] = incl; nblk[c.tid] = padded >> 8; }
    __syncthreads();
    if (blockIdx.x == 0 && c.tid < 32) {
        int* meta = WSP(int, WS_META); const int e = c.tid, x = e & 7; int off = 0;
        for (int e2 = x; e2 < e; e2 += 8) off += nblk[e2];
        const int rb0 = pst[e] >> 8, nb = nblk[e];
        for (int i = 0; i < nb; ++i) { meta[64 + rb0 + i] = e; meta[1024 + 640 * x + off + i] = rb0 + i; }
        if (e >= 24) meta[16 + x] = off + nb;
        if (e == 0) meta[0] = pst[32] >> 8; }
    for (int tile = gw; tile < NTOK / 16; tile += NW) {
        const int o = tile * 64 + lane, tok = o >> 2;
        const int e = WSP(int, WS_TE)[o], rk = WSP(int, WS_RANK)[o];
        const int dst = pst[e] + base[e] + rk;
        WSP(int, WS_ROWTOK)[dst] = tok; WSP(float, WS_RSROW)[dst] = WSP(float, WS_RSTD)[tok]; WSP(int, WS_SLOT)[o] = dst;
    }
}

__device__ __forceinline__ void phase_combine(const Ctx& c, int l) {
    const int lane = c.lane, gw = c.gw, NW = c.G * NWAVES;
    for (int tok = gw; tok < NTOK; tok += NW) {
        float* xr = c.out + (size_t)tok * D; const bf16_t* hs = WSP(bf16_t, WS_H) + (size_t)tok * D;
        const u32x4 sl = *(const u32x4*)(WSP(int, WS_SLOT) + (size_t)tok * 4); const f32x4 tw = *(const f32x4*)(WSP(float, WS_TW) + (size_t)tok * 4);
        f32x4 v[4];
#pragma unroll
        for (int i = 0; i < 4; ++i) { const u32x2 d = *(const u32x2*)(hs + i * 256 + lane * 4); v[i][0] = bflo(d.x); v[i][1] = bfhi(d.x); v[i][2] = bflo(d.y); v[i][3] = bfhi(d.y); }
#pragma unroll
        for (int k = 0; k < 4; ++k) { const bf16_t* yr = WSP(bf16_t, WS_XBUF) + (size_t)sl[k] * D; const float w = tw[k];
#pragma unroll
            for (int i = 0; i < 4; ++i) { const u32x2 y = *(const u32x2*)(yr + i * 256 + lane * 4);
                v[i][0] += w * bflo(y.x); v[i][1] += w * bfhi(y.x); v[i][2] += w * bflo(y.y); v[i][3] += w * bfhi(y.y); } }
        float ss = 0.f;
#pragma unroll
        for (int i = 0; i < 4; ++i) { *(f32x4*)(xr + i * 256 + lane * 4) = v[i]; ss += v[i][0] * v[i][0] + v[i][1] * v[i][1] + v[i][2] * v[i][2] + v[i][3] * v[i][3]; }
        if (l + 1 < NL) {
            ss = wave_sum(ss); const float rs = rsqrtf(ss * (1.0f / 1024.0f) + NORM_EPS);
            const float* nw = c.norm1_w + (size_t)(l + 1) * D; bf16_t* hr = WSP(bf16_t, WS_H) + (size_t)tok * D;
#pragma unroll
            for (int i = 0; i < 4; ++i) { const f32x4 w = *(const f32x4*)(nw + i * 256 + lane * 4);
                u32x2 o; o.x = pk2(v[i][0] * rs * w[0], v[i][1] * rs * w[1]); o.y = pk2(v[i][2] * rs * w[2], v[i][3] * rs * w[3]); *(u32x2*)(hr + i * 256 + lane * 4) = o; }
        }
    }
}

constexpr int PH_PER_LAYER = 14, N_PHASES = 1 + NL * PH_PER_LAYER;
#ifndef PH_MASK
#define PH_MASK 0xffff
#endif
#define IN(k) (lo <= (k) && (k) < hi)
#define INL(j) (((PH_MASK >> ((j) + 1)) & 1) && IN(pb + (j)))
#define FRESH() do { int _t = (c.wave0 << 6) | (int)__builtin_amdgcn_mbcnt_hi(~0u, __builtin_amdgcn_mbcnt_lo(~0u, 0u)); asm volatile("" : "+v"(_t)); c.tid = _t; c.lane = _t & 63; c.wave = c.wave0; c.gw = blockIdx.x * NWAVES + c.wave; } while (0)
#define SEAM(k) do { if (IN((k) + 1) || IN((k) + 2)) xcd_barrier(bar); else __syncthreads(); } while (0)

template <int l>
__device__ __forceinline__ void run_layer(Ctx& c, const XcdBarrier& bar, const int lo, const int hi) {
        const int pb = 1 + l * PH_PER_LAYER;
        if (INL(0)) { FRESH();
            g8::SchedPlain S{(const char*)WSP(bf16_t, WS_H), (const char*)(WSP(bf16_t, WS_WIN) + (size_t)l * NPROJ * D), (size_t)256 * D * 2, (size_t)256 * D * 2, NTOK / 256, NPROJ / 256, (NTOK / 256) * (NPROJ / 256), c.G, (int)blockIdx.x};
            g8::EpiBf16 E{WSP(bf16_t, WS_PROJ), NPROJ};
            g8::gemm_phase(c.lds, c.tid, D, D * 2, D * 2, S, E);
            SEAM(pb + 0);
        }
        if (INL(1)) { FRESH(); phase_prep(c, l); SEAM(pb + 1); }
        if (INL(2)) { FRESH();
            g8::SchedCmp S{(const char*)WSP(bf16_t, WS_KCT), (const char*)WSP(bf16_t, WS_VCT), (const char*)(WSP(bf16_t, WS_WC1) + (size_t)l * 2 * 256 * 2048), c.G, (int)blockIdx.x};
            g8::EpiSlab E{WSP(float, WS_ACT)};
            g8::gemm_phase(c.lds, c.tid, 256, 1024 * 2, 2048 * 2, S, E);
            SEAM(pb + 2);
        }
        if (INL(3)) { FRESH(); phase_cmp2(c, l); FRESH(); phase_scan(c); SEAM(pb + 3); }
        if (INL(5)) { FRESH(); phase_retout(c, l, l + 1 < NL ? l + 1 : -1, l == 0); FRESH(); phase_nsa(c, l, l + 1 < NL ? l + 1 : -1, l == 0); SEAM(pb + 5); }
        if (INL(7)) { FRESH();
            {
                g8::SchedPlain S{(const char*)WSP(bf16_t, WS_RA), (const char*)(WSP(bf16_t, WS_WO) + (size_t)l * D * 2048), (size_t)256 * 2048 * 2, (size_t)256 * 2048 * 2, NTOK / 256, D / 256, (NTOK / 256) * (D / 256), c.G, (int)blockIdx.x};
                g8::EpiGate E{WSP(bf16_t, WS_MIX), WSP(bf16_t, WS_PROJ), 0};
                g8::gemm_phase(c.lds, c.tid, D, 2048 * 2, 2048 * 2, S, E);
            }
            asm volatile("s_waitcnt vmcnt(0)" ::: "memory"); __syncthreads();
            {
                g8::SchedPlain S{(const char*)(WSP(bf16_t, WS_RA) + 1024), (const char*)(WSP(bf16_t, WS_WO) + (size_t)l * D * 2048 + 1024), (size_t)256 * 2048 * 2, (size_t)256 * 2048 * 2, NTOK / 256, D / 256, (NTOK / 256) * (D / 256), c.G, (int)blockIdx.x};
                g8::EpiGate E{WSP(bf16_t, WS_MIX), WSP(bf16_t, WS_PROJ), 1};
                g8::gemm_phase(c.lds, c.tid, D, 2048 * 2, 2048 * 2, S, E);
            }
            SEAM(pb + 7);
        }
        if (INL(8)) { FRESH();
            g8::SchedPlain S{(const char*)WSP(bf16_t, WS_MIX), (const char*)(WSP(bf16_t, WS_WOUT) + (size_t)l * D * D), (size_t)256 * D * 2, (size_t)256 * D * 2, NTOK / 256, D / 256, (NTOK / 256) * (D / 256), c.G, (int)blockIdx.x};
            g8::EpiBf16 E{WSP(bf16_t, WS_PROJ), D};
            g8::gemm_phase(c.lds, c.tid, D, D * 2, D * 2, S, E);
            SEAM(pb + 8);
        }
        if (INL(9)) { FRESH(); phase_route(c, l); SEAM(pb + 9); }
        if (INL(10)) { FRESH(); phase_scatter(c, l); SEAM(pb + 10); }
        if (INL(11)) { FRESH();
            LAS int* tab = (LAS int*)(c.lds + 131072); g8::moe_units(tab, WSP(int, WS_META), 8, c.G, (int)blockIdx.x, c.tid);
            g8::SchedMoeG S{(const char*)WSP(bf16_t, WS_H), (const char*)(WSP(bf16_t, WS_WGU) + (size_t)l * NEXP * 2048 * D), tab, 8, (size_t)2048 * D * 2, WSP(int, WS_ROWTOK)};
            g8::EpiSwiglu E{WSP(bf16_t, WS_ACT), c.b_gate_up + (size_t)l * NEXP * 2048, WSP(float, WS_RSROW), c.lds + 131072 + 8192};
            g8::gemm_phase(c.lds, c.tid, D, D * 2, D * 2, S, E);
            SEAM(pb + 11);
        }
        if (INL(12)) { FRESH();
            LAS int* tab = (LAS int*)(c.lds + 131072); g8::moe_units(tab, WSP(int, WS_META), 4, c.G, (int)blockIdx.x, c.tid);
            g8::SchedMoe S{(const char*)WSP(bf16_t, WS_ACT), (const char*)(WSP(bf16_t, WS_WD) + (size_t)l * NEXP * D * D), tab, 4, (size_t)D * D * 2};
            g8::EpiDown E{WSP(bf16_t, WS_XBUF), c.b_down + (size_t)l * NEXP * D};
            g8::gemm_phase(c.lds, c.tid, D, D * 2, D * 2, S, E);
            SEAM(pb + 12);
        }
        if (INL(13)) { FRESH(); phase_combine(c, l); SEAM(pb + 13); }
    }
__global__ void __launch_bounds__(NTHREADS, 2) mk_fwd(Args args) {
    extern __shared__ __attribute__((aligned(16))) unsigned char lds_raw[];
    Ctx c;
    c.x_in = args.in[0]; c.norm1_w = args.in[1]; c.w_in = args.in[2]; c.ret_gn_w = args.in[3]; c.qk_norm_w = args.in[4]; c.cmp_pos = args.in[5]; c.cmp_w1 = args.in[6]; c.cmp_w2 = args.in[7];
    c.w_o_ret = args.in[8]; c.w_o_nsa = args.in[9]; c.w_out = args.in[10]; c.norm2_w = args.in[11]; c.router_w = args.in[12]; c.router_b = args.in[13]; c.w_gate_up = args.in[14]; c.b_gate_up = args.in[15];
    c.w_down = args.in[16]; c.b_down = args.in[17];
    c.out = args.out; c.ws = args.ws; c.lds = (LAS unsigned char*)lds_raw;
    c.tid = threadIdx.x; c.lane = c.tid & 63; c.wave = __builtin_amdgcn_readfirstlane(c.tid >> 6); c.G = gridDim.x; c.gw = blockIdx.x * NWAVES + c.wave; c.wave0 = c.wave;
    volatile LAS unsigned* lctl = (volatile LAS unsigned*)(c.lds + LDS_CTL_OFF);
    if (c.tid < 16) lctl[c.tid] = 0u;
    __syncthreads();
    const int lo = args.ph_lo, hi = args.ph_hi;
    XcdBarrier bar; bar.bar = WSP(unsigned, WS_CTL); bar.x = 0; bar.st = lctl;
    if (hi - lo > 1) bar = xcd_barrier_post(WSP(unsigned, WS_CTL), lctl);
    if ((PH_MASK & 1) && IN(0)) { FRESH(); phase_prologue(c); SEAM(0); }

    run_layer<0>(c, bar, lo, hi); run_layer<1>(c, bar, lo, hi); run_layer<2>(c, bar, lo, hi); run_layer<3>(c, bar, lo, hi);
#undef IN
#undef INL
#undef SEAM
}


extern "C" void kernel_launch(void* const* d_in, const int* in_sizes, int n_in, void* d_out, int out_size, void* d_ws, size_t ws_size, hipStream_t stream) {
    static int grid = 0;
    if (grid == 0) {
        if (n_in != 18 || out_size != NTOK * D || ws_size < WS_END) { fprintf(stderr, "kernel_launch: unexpected shapes (n_in %d out %d ws %zu need %zu)\n", n_in, out_size, ws_size, (size_t)WS_END); grid = -1; return; }
        int dev = 0, cus = 0;
        if (hipGetDevice(&dev) != hipSuccess || hipDeviceGetAttribute(&cus, hipDeviceAttributeMultiprocessorCount, dev) != hipSuccess) { grid = -1; return; }
        if (hipFuncSetAttribute((const void*)mk_fwd, hipFuncAttributeMaxDynamicSharedMemorySize, LDS_BYTES) != hipSuccess) { fprintf(stderr, "kernel_launch: hipFuncSetAttribute failed\n"); grid = -1; return; }
        int per_cu = 0;
        if (hipOccupancyMaxActiveBlocksPerMultiprocessor(&per_cu, (const void*)mk_fwd, NTHREADS, LDS_BYTES) != hipSuccess || per_cu < 1) fprintf(stderr, "kernel_launch: occupancy query says %d\n", per_cu);
        (void)hipGetLastError();
        grid = cus;
    }
    if (grid < 0) return;
    (void)hipMemsetAsync((char*)d_ws + WS_CTL, 0, CTL_BYTES, stream);
    Args a{};
    for (int i = 0; i < 18; ++i) a.in[i] = (const float*)d_in[i];
    a.out = (float*)d_out; a.ws = (unsigned char*)d_ws;
#if MK_ONE_LAUNCH
    a.ph_lo = 0; a.ph_hi = N_PHASES;
    hipLaunchKernelGGL(mk_fwd, dim3(grid), dim3(NTHREADS), LDS_BYTES, stream, a);
#else
    for (int p = 0; p < N_PHASES; ++p) { a.ph_lo = p; a.ph_hi = p + 1; hipLaunchKernelGGL(mk_fwd, dim3(grid), dim3(NTHREADS), LDS_BYTES, stream, a); }
#endif
}
```

```cpp
#include <hip/hip_runtime.h>
#include <stdint.h>
#include <stdio.h>

#ifndef MK_ONE_LAUNCH
#define MK_ONE_LAUNCH 1
#endif

#define LAS __attribute__((address_space(3)))
typedef unsigned short bf16_t;
typedef short bf16x8 __attribute__((ext_vector_type(8)));
typedef float f32x4 __attribute__((ext_vector_type(4)));
typedef float f32x2 __attribute__((ext_vector_type(2)));
typedef unsigned u32x4 __attribute__((ext_vector_type(4)));
typedef unsigned u32x2 __attribute__((ext_vector_type(2)));

constexpr int D = 1024, NB = 4, SEQ = 8192, NTOK = NB * SEQ, NL = 4;
constexpr int NPROJ = 7168, IN_TOTAL = 6960;
constexpr int C_RQ = 0, C_RK = 512, C_RV = 1024, C_RG = 2048, C_NQ = 3072, C_KC = 4096, C_VC = 4224, C_KS = 4352, C_VS = 4480, C_KW = 4608, C_VW = 4736, C_NG = 4864, C_MG = 5120;
constexpr int NEXP = 32, XROWS = 139264;
constexpr int NWAVES = 8, NTHREADS = 512;
constexpr float NORM_EPS = 1e-6f;

constexpr size_t al256(size_t x) { return (x + 255) & ~(size_t)255; }
constexpr size_t WS_CTL = 0, CTL_BYTES = 65536;
constexpr size_t WS_HIST = WS_CTL + CTL_BYTES;
constexpr size_t WS_META = WS_HIST + 1024 * 32 * 4;
constexpr size_t WS_ROPER = WS_META + 32768;
constexpr size_t WS_ROPEN = WS_ROPER + (size_t)SEQ * 64 * 2 * 4;
constexpr size_t WS_PEB = WS_ROPEN + (size_t)SEQ * 8 * 2 * 4;
constexpr size_t WS_RWF = al256(WS_PEB + 8 * NL * 2 * 256 * 4);
constexpr size_t WS_RSTD = WS_RWF + (size_t)NL * 32 * 2 * 2 * 512 * 2;
constexpr size_t WS_WIN = al256(WS_RSTD + (size_t)NTOK * 4);
constexpr size_t WS_WO = WS_WIN + (size_t)NL * NPROJ * D * 2;
constexpr size_t WS_WOUT = WS_WO + (size_t)NL * D * 2048 * 2;
constexpr size_t WS_WC1 = WS_WOUT + (size_t)NL * D * D * 2;
constexpr size_t WS_WGU = WS_WC1 + (size_t)NL * 2 * 256 * 2048 * 2;
constexpr size_t WS_WD = WS_WGU + (size_t)NL * NEXP * 2048 * D * 2;
constexpr size_t WS_H = WS_WD + (size_t)NL * NEXP * D * D * 2;
constexpr size_t WS_PROJ = WS_H + (size_t)NTOK * D * 2;
constexpr size_t WS_QR = WS_PROJ + (size_t)NTOK * NPROJ * 2;
constexpr size_t WS_KR = WS_QR + (size_t)NTOK * 512 * 2;
constexpr size_t WS_KZT = WS_KR + (size_t)NTOK * 512 * 2;
constexpr size_t WS_VT = WS_KZT + (size_t)NTOK * 512 * 2;
constexpr size_t WS_RT = WS_VT + (size_t)NTOK * 1024 * 2;
constexpr size_t WS_QN = WS_RT + (size_t)16 * 64 * 256 * 128 * 2;
constexpr size_t WS_KS = WS_QN + (size_t)NTOK * 1024 * 2;
constexpr size_t WS_VST = WS_KS + (size_t)NTOK * 128 * 2;
constexpr size_t WS_KW = WS_VST + (size_t)NTOK * 128 * 2;
constexpr size_t WS_VWT = WS_KW + (size_t)NTOK * 128 * 2;
constexpr size_t WS_KCT = WS_VWT + (size_t)NTOK * 128 * 2;
constexpr size_t WS_VCT = WS_KCT + (size_t)NTOK * 128 * 2 + 4096;
constexpr size_t WS_HID = WS_VCT + (size_t)NTOK * 128 * 2 + 4096;
constexpr size_t WS_KCMP = WS_HID + (size_t)2 * 8 * 512 * 256 * 2;
constexpr size_t WS_VCMPT = WS_KCMP + (size_t)8 * 512 * 64 * 2;
constexpr size_t WS_RA = WS_VCMPT + (size_t)8 * 512 * 64 * 2;
constexpr size_t WS_MIX = WS_RA + (size_t)NTOK * 2048 * 2;
constexpr size_t WS_TE = WS_MIX + (size_t)NTOK * D * 2;
constexpr size_t WS_TW = WS_TE + (size_t)NTOK * 16;
constexpr size_t WS_RANK = WS_TW + (size_t)NTOK * 16;
constexpr size_t WS_SLOT = WS_RANK + (size_t)NTOK * 16;
constexpr size_t WS_ROWTOK = WS_SLOT + (size_t)NTOK * 16;
constexpr size_t WS_RSROW = WS_ROWTOK + (size_t)XROWS * 4;
constexpr size_t WS_XBUF = al256(WS_RSROW + (size_t)XROWS * 4);
constexpr size_t WS_ACT = WS_XBUF + (size_t)XROWS * D * 2;
constexpr size_t WS_END = WS_ACT + (size_t)XROWS * D * 2;

constexpr int LDS_SCRATCH = 149504;
constexpr int LDS_CTL_OFF = LDS_SCRATCH;
constexpr int LDS_BYTES = LDS_SCRATCH + 1024;

__device__ __forceinline__ float bf2f(bf16_t v) { return __uint_as_float(((unsigned)v) << 16); }
__device__ __forceinline__ float bflo(unsigned w) { return __uint_as_float(w << 16); }
__device__ __forceinline__ float bfhi(unsigned w) { return __uint_as_float(w & 0xffff0000u); }
__device__ __forceinline__ unsigned f2bf(float f) { unsigned u = __float_as_uint(f); return (u + 0x7fffu + ((u >> 16) & 1u)) >> 16; }
typedef __bf16 bf16x2_t __attribute__((ext_vector_type(2)));
__device__ __forceinline__ unsigned pk2(float lo, float hi) { const f32x2 v = {lo, hi}; const bf16x2_t r = __builtin_convertvector(v, bf16x2_t); return __builtin_bit_cast(unsigned, r); }
__device__ __forceinline__ float fexp2(float x) { return __builtin_amdgcn_exp2f(x); }
__device__ __forceinline__ float frcp(float x) { return __builtin_amdgcn_rcpf(x); }
__device__ __forceinline__ float sigmoidf_(float x) { return frcp(1.0f + fexp2(-1.4426950408889634f * x)); }
__device__ __forceinline__ bf16x8 mk8(u32x4 v) { return __builtin_bit_cast(bf16x8, v); }
__device__ __forceinline__ bf16x8 ld8(const bf16_t* p) { return __builtin_bit_cast(bf16x8, *(const u32x4*)p); }
__device__ __forceinline__ f32x4 mfma16(bf16x8 a, bf16x8 b, f32x4 c) { return __builtin_amdgcn_mfma_f32_16x16x32_bf16(a, b, c, 0, 0, 0); }
#define MFMA_FENCE() do { __builtin_amdgcn_sched_barrier(0); asm volatile("s_nop 7\n\ts_nop 7" ::: "memory"); __builtin_amdgcn_sched_barrier(0); } while (0)
__device__ __forceinline__ float sum8(float v) { v += __int_as_float(__builtin_amdgcn_update_dpp(0, __float_as_int(v), 0xB1, 0xf, 0xf, true));
    v += __int_as_float(__builtin_amdgcn_update_dpp(0, __float_as_int(v), 0x4E, 0xf, 0xf, true)); v += __int_as_float(__builtin_amdgcn_update_dpp(0, __float_as_int(v), 0x141, 0xf, 0xf, true)); return v; }
__device__ __forceinline__ float wave_sum(float v) {
#pragma unroll
    for (int o = 32; o >= 1; o >>= 1) v += __shfl_xor(v, o);
    return v;
}

#define XB_TMO      128
#define XB_XCNT(j)  (256  + 64 * (j))
#define XB_XSUB(j)  (1280 + 64 * (j))
#define XB_XGEN(j)  (2304 + 64 * (j))
#define XB_TOP      3328
#define XB_TOPGEN   3392
#define XCD_BAR_WORDS 3456
#define XB_SPIN_CAP (1u << 18)
__device__ __forceinline__ unsigned xb_ld(unsigned* p)              { return __hip_atomic_load(p, __ATOMIC_RELAXED, __HIP_MEMORY_SCOPE_AGENT); }
__device__ __forceinline__ unsigned xb_add(unsigned* p, unsigned v) { return __hip_atomic_fetch_add(p, v, __ATOMIC_RELAXED, __HIP_MEMORY_SCOPE_AGENT); }
__device__ __forceinline__ unsigned xb_xcc_id() { return (unsigned)__builtin_amdgcn_s_getreg((3 << 11) | 20) & 0xFu; }
#define XB_SPIN(cond, bar) do { unsigned _sp = 0; while (cond) { __builtin_amdgcn_s_sleep(1); \
    if ((++_sp & 255u) == 0u) { if (xb_ld(&(bar)[XB_TMO])) break; if (_sp > XB_SPIN_CAP) { atomicAdd(&(bar)[XB_TMO], 1u); break; } } } } while (0)
struct XcdBarrier { unsigned* bar; unsigned x; volatile LAS unsigned* st; };
__device__ __forceinline__ XcdBarrier xcd_barrier_post(unsigned* bar, volatile LAS unsigned* st) {
    XcdBarrier b; b.bar = bar; b.x = xb_xcc_id(); b.st = st;
    if (threadIdx.x == 0) (void)xb_add(&bar[XB_XCNT(b.x)], 1u);
    return b;
}
__device__ __forceinline__ void xcd_barrier_complete(unsigned* bar, unsigned x, unsigned& nloc, unsigned& nx) {
    const unsigned G = gridDim.x * gridDim.y * gridDim.z;
    unsigned sum, cnt, mine, sp = 0u;
    for (;;) {
        sum = 0u; cnt = 0u; mine = 0u;
#pragma unroll
        for (unsigned j = 0; j < 16; ++j) { const unsigned c = xb_ld(&bar[XB_XCNT(j)]); sum += c; cnt += (c > 0u) ? 1u : 0u; mine = (j == x) ? c : mine; }
        if (sum == G) break;
        __builtin_amdgcn_s_sleep(1);
        if ((++sp & 255u) == 0u) { if (xb_ld(&bar[XB_TMO])) break; if (sp > XB_SPIN_CAP) { atomicAdd(&bar[XB_TMO], 1u); break; } }
    }
    nloc = mine > 0u ? mine : 1u; nx = cnt > 0u ? cnt : 1u;
}
__device__ __forceinline__ void xcd_barrier(const XcdBarrier& b) {
    asm volatile("s_waitcnt vmcnt(0)" ::: "memory");
    __syncthreads();
    if (threadIdx.x == 0) {
        unsigned* bar = b.bar;
        __builtin_amdgcn_s_waitcnt(0);
        unsigned nloc = b.st[0], nx = b.st[1];
        if (nloc == 0u) { xcd_barrier_complete(bar, b.x, nloc, nx); b.st[0] = nloc; b.st[1] = nx; }
        const unsigned old = xb_add(&bar[XB_XSUB(b.x)], 1u);
        const unsigned gen = old / nloc;
        if (old + 1u == (gen + 1u) * nloc) {
            __builtin_amdgcn_fence(__ATOMIC_RELEASE, "agent");
            asm volatile("s_waitcnt vmcnt(0)" ::: "memory");
            const unsigned og = xb_add(&bar[XB_TOP], 1u);
            const unsigned tg = og / nx;
            if (og + 1u == (tg + 1u) * nx) xb_add(&bar[XB_TOPGEN], 1u);
            else XB_SPIN(xb_ld(&bar[XB_TOPGEN]) == tg, bar);
            __builtin_amdgcn_fence(__ATOMIC_ACQUIRE, "agent");
            xb_add(&bar[XB_XGEN(b.x)], 1u);
            asm volatile("s_waitcnt vmcnt(0)" ::: "memory");
        } else {
            XB_SPIN(xb_ld(&bar[XB_XGEN(b.x)]) == gen, bar);
            __builtin_amdgcn_fence(__ATOMIC_ACQUIRE, "agent");
            asm volatile("s_waitcnt vmcnt(0)" ::: "memory");
        }
    }
    __syncthreads();
}

struct Args { const float* in[18]; float* out; unsigned char* ws; int ph_lo, ph_hi; };
struct Ctx {
    const float *x_in, *norm1_w, *w_in, *ret_gn_w, *qk_norm_w, *cmp_pos, *cmp_w1, *cmp_w2, *w_o_ret, *w_o_nsa, *w_out, *norm2_w, *router_w, *router_b, *w_gate_up, *b_gate_up, *w_down, *b_down;
    float* out; unsigned char* ws; LAS unsigned char* lds;
    int tid, lane, wave, gw, G;
};
#define WSP(T, off) ((T*)(c.ws + (off)))

namespace g8 {
constexpr int BM = 256, BK = 64, HALF = 128, HTB = HALF * BK * 2, STAGE_BYTES = 8 * HTB, NXCD = 8, WGM = 8;
__device__ __forceinline__ int lds_byte(int r, int c) { const int st = (r >> 4) * 2 + (c >> 5), rr = r & 15, cc = c & 31, ob = rr * 64 + cc * 2; return st * 1024 + (ob ^ (((ob >> 9) & 1) << 5)); }
__device__ __forceinline__ void stage_rc(int b, int& R, int& C) { const int st = b / 1024, sb = b % 1024, swz = sb ^ (((sb >> 9) & 1) << 5); R = (st >> 1) * 16 + swz / 64; C = (st & 1) * 32 + (swz % 64) / 2; }
__device__ __forceinline__ int perm32(int rho) { const int n = rho >> 4, i = rho & 15; return 8 * (i >> 2) + 4 * n + (i & 3); }

struct Unit { const char* A; const char* B; int pm, pn, e; };

struct SchedPlain {
    static constexpr bool GATHER = false;
    const char* A; const char* B; size_t tA, tB; int nM, nN, nwg, G, c;
    __device__ __forceinline__ bool next(int i, Unit& u) const {
        const long L = (long)i * G + c; if (L >= nwg) return false;
        int wgid = (int)L; { const int q = nwg / NXCD, r = nwg % NXCD, xcd = wgid % NXCD, off = wgid / NXCD; wgid = (xcd < r ? xcd * (q + 1) : r * (q + 1) + (xcd - r) * q) + off; }
        const int nig = WGM * nN, gid = wgid / nig, fm = gid * WGM, gsz = (nM - fm) < WGM ? (nM - fm) : WGM;
        u.pm = fm + ((wgid % nig) % gsz); u.pn = (wgid % nig) / gsz; u.e = 0;
        u.A = A + (size_t)u.pm * tA; u.B = B + (size_t)u.pn * tB; return true;
    }
};
struct SchedCmp {         static constexpr bool GATHER = false;
    const char* KCT; const char* VCT; const char* W; int G, c;
    __device__ __forceinline__ bool next(int i, Unit& u) const {
        const int idx = i * G + c; if (idx >= 256) return false;
        const int ksl = idx & 7, r = idx >> 3, kv = r >> 4, bg = (r >> 1) & 7, half = r & 1;
        u.A = (kv ? VCT : KCT) + ((size_t)bg * SEQ * 64 + (size_t)half * 256 * 1024 + (size_t)ksl * 256) * 2;
        u.B = W + ((size_t)kv * 256 * 2048 + (size_t)ksl * 256) * 2; u.pm = (kv * 8 + bg) * 2 + half; u.pn = 0; u.e = ksl; return true;
    }
};
struct SchedMoe {
    static constexpr bool GATHER = false;
    const char* A; const char* W; const LAS int* tab; int NT; size_t wstride;
    __device__ __forceinline__ bool next(int i, Unit& u) const {
        const int v = __builtin_amdgcn_readfirstlane(tab[i]); if (v < 0) return false;
        const int rb = v & 0xfff, pn = (v >> 12) & 0xf, e = v >> 16;
        u.A = A + (size_t)rb * 256 * 1024 * 2; u.B = W + (size_t)e * wstride + (size_t)pn * 256 * 1024 * 2; u.pm = rb; u.pn = pn; u.e = e; return true;
    }
};
struct SchedMoeG {
    static constexpr bool GATHER = true;
    const char* A; const char* W; const LAS int* tab; int NT; size_t wstride; const int* rowtok;
    __device__ __forceinline__ bool next(int i, Unit& u) const {
        const int v = __builtin_amdgcn_readfirstlane(tab[i]); if (v < 0) return false;
        const int rb = v & 0xfff, pn = (v >> 12) & 0xf, e = v >> 16;
        u.A = A; u.B = W + (size_t)e * wstride + (size_t)pn * 256 * 1024 * 2; u.pm = rb; u.pn = pn; u.e = e; return true;
    }
};
__device__ __forceinline__ void moe_units(LAS int* tab, const int* meta, const int NT, const int G, const int c, const int tid) {
    if (tid < 256) {
        int v = -1; const int i = tid;
        if ((G & 7) == 0) { const int x = c & 7, q = i * (G >> 3) + (c >> 3); const int nb = meta[16 + x];
            if (q < nb * NT) { const int rbi = q / NT, pn = q - rbi * NT, rb = meta[1024 + 640 * x + rbi]; v = rb | (pn << 12) | (meta[64 + rb] << 16); } }
        else { const int idx = i * G + c; const int nblk = meta[0]; if (idx < nblk * NT) { const int rb = idx / NT, pn = idx - rb * NT; v = rb | (pn << 12) | (meta[64 + rb] << 16); } }
        tab[i] = v;
    }
    __syncthreads();
}

typedef f32x4 Acc[2][2][4][2];

struct EpiBf16 {
    struct Pre {}; __device__ __forceinline__ void pre(Pre&, const Unit&, int, int, int, int) const {}
    static constexpr bool PERM = true;
    bf16_t* O; int ldc;
    __device__ __forceinline__ void operator()(const Acc& acc, const Unit& u, int wr, int wc, int fr, int fq, const Pre&) const {
        const int row0 = u.pm * BM + wr * 64 + fr, col0 = u.pn * BM + wc * 32 + 8 * fq;
#pragma unroll
        for (int ai = 0; ai < 2; ++ai)
#pragma unroll
            for (int m = 0; m < 4; ++m) { bf16_t* rowp = O + (size_t)(row0 + ai * HALF + m * 16) * ldc + col0;
#pragma unroll
                for (int bj = 0; bj < 2; ++bj) { const f32x4 v0 = acc[ai][bj][m][0], v1 = acc[ai][bj][m][1];
                    u32x4 w; w.x = pk2(v0[0], v0[1]); w.y = pk2(v0[2], v0[3]); w.z = pk2(v1[0], v1[1]); w.w = pk2(v1[2], v1[3]);
                    *(u32x4*)(rowp + bj * HALF) = w; } }
    }
};
struct EpiSlab {
    struct Pre {}; __device__ __forceinline__ void pre(Pre&, const Unit&, int, int, int, int) const {}
    static constexpr bool PERM = false;
    float* O;
    __device__ __forceinline__ void operator()(const Acc& acc, const Unit& u, int wr, int wc, int fr, int fq, const Pre&) const {
        const int row0 = u.pm * BM + wr * 64 + fr, col0 = wc * 32 + 4 * fq;
        float* base = O + (size_t)u.e * 8192 * 256;
#pragma unroll
        for (int ai = 0; ai < 2; ++ai)
#pragma unroll
            for (int m = 0; m < 4; ++m) { const size_t off = (size_t)(row0 + ai * HALF + m * 16) * 256 + col0;
#pragma unroll
                for (int bj = 0; bj < 2; ++bj)
#pragma unroll
                    for (int n = 0; n < 2; ++n) *(f32x4*)(base + off + bj * HALF + n * 16) = acc[ai][bj][m][n]; }
    }
};
struct EpiGate {
    struct Pre {}; __device__ __forceinline__ void pre(Pre&, const Unit&, int, int, int, int) const {}
    static constexpr bool PERM = true;
    bf16_t* O; const bf16_t* proj; int second;
    __device__ __forceinline__ void operator()(const Acc& acc, const Unit& u, int wr, int wc, int fr, int fq, const Pre&) const {
        const int row0 = u.pm * BM + wr * 64 + fr, col0 = u.pn * BM + wc * 32 + 8 * fq;
#pragma unroll
        for (int ai = 0; ai < 2; ++ai)
#pragma unroll
            for (int m = 0; m < 4; ++m) { const size_t row = (size_t)(row0 + ai * HALF + m * 16); const bf16_t* rp = proj + row * NPROJ + C_MG + (second ? 1024 : 0) + col0;
#pragma unroll
                for (int bj = 0; bj < 2; ++bj) { const u32x4 wb = *(const u32x4*)(rp + bj * HALF); u32x4 prev = {0u, 0u, 0u, 0u};
                    if (second) prev = *(const u32x4*)(O + row * D + col0 + bj * HALF);
                    float o[8];
#pragma unroll
                    for (int j = 0; j < 8; ++j) { const unsigned ub = wb[j >> 1], up = prev[j >> 1]; const float b = (j & 1) ? bfhi(ub) : bflo(ub), pv = (j & 1) ? bfhi(up) : bflo(up);
                        o[j] = pv + (j < 4 ? acc[ai][bj][m][0][j] : acc[ai][bj][m][1][j - 4]) * sigmoidf_(b); }
                    u32x4 w; w.x = pk2(o[0], o[1]); w.y = pk2(o[2], o[3]); w.z = pk2(o[4], o[5]); w.w = pk2(o[6], o[7]);
                    *(u32x4*)(O + row * D + col0 + bj * HALF) = w; } }
    }
};
struct EpiSwiglu {
    static constexpr bool PERM = true;
    bf16_t* O; const float* bgu;
    const float* rsrow;
    LAS unsigned char* rsl;
    struct Pre {};
    __device__ __forceinline__ void pre(Pre&, const Unit& u, int wc, int fq, int wid, int lane) const {
        LAS unsigned char* my = rsl + wid * 768;
        const float* rp = rsrow + u.pm * BM + (wid >> 2) * 64 + lane;
        __builtin_amdgcn_global_load_lds((const unsigned*)rp, (LAS unsigned*)my, 4, 0, 0);
        __builtin_amdgcn_global_load_lds((const unsigned*)(rp + HALF), (LAS unsigned*)(my + 256), 4, 0, 0);
        const float* bp = bgu + (size_t)u.e * 2048 + u.pn * 128 + wc * 32 + (lane & 31) + (lane >> 5) * 1024;
        __builtin_amdgcn_global_load_lds((const unsigned*)bp, (LAS unsigned*)(my + 512), 4, 0, 0); }
    __device__ __forceinline__ void operator()(const Acc& acc, const Unit& u, int wr, int wc, int fr, int fq, const Pre&) const {
        const int row0 = u.pm * BM + wr * 64 + fr, col0 = u.pn * 128 + wc * 32 + 8 * fq;
        const LAS unsigned char* my = rsl + (wr * 4 + wc) * 768;
        const f32x4 g0 = *(const LAS f32x4*)(my + 512 + 32 * fq), g1 = *(const LAS f32x4*)(my + 512 + 32 * fq + 16), u0 = *(const LAS f32x4*)(my + 640 + 32 * fq), u1 = *(const LAS f32x4*)(my + 640 + 32 * fq + 16);
#pragma unroll
        for (int ai = 0; ai < 2; ++ai)
#pragma unroll
            for (int m = 0; m < 4; ++m) { float o[8]; const float rs = *(const LAS float*)(my + ai * 256 + (m * 16 + fr) * 4);
#pragma unroll
                for (int j = 0; j < 8; ++j) {
                    float gv = (j < 4 ? acc[ai][0][m][0][j] * rs + g0[j] : acc[ai][0][m][1][j - 4] * rs + g1[j - 4]);
                    float uv = (j < 4 ? acc[ai][1][m][0][j] * rs + u0[j] : acc[ai][1][m][1][j - 4] * rs + u1[j - 4]);
                    gv = fminf(gv, 7.0f); uv = fminf(fmaxf(uv, -7.0f), 7.0f);
                    const float glu = gv * frcp(1.0f + fexp2(-1.702f * 1.4426950408889634f * gv)); o[j] = (uv + 1.0f) * glu; }
                u32x4 w; w.x = pk2(o[0], o[1]); w.y = pk2(o[2], o[3]); w.z = pk2(o[4], o[5]); w.w = pk2(o[6], o[7]);
                *(u32x4*)(O + (size_t)(row0 + ai * HALF + m * 16) * D + col0) = w; }
    }
};
struct EpiDown {
    static constexpr bool PERM = true;
    bf16_t* O; const float* bd;
    struct Pre { f32x4 b[2][2]; };
    __device__ __forceinline__ void pre(Pre& p, const Unit& u, int wc, int fq, int wid, int lane) const { const float* bp = bd + (size_t)u.e * D + u.pn * BM + wc * 32 + 8 * fq;
#pragma unroll
        for (int bj = 0; bj < 2; ++bj) { p.b[bj][0] = *(const f32x4*)(bp + bj * HALF); p.b[bj][1] = *(const f32x4*)(bp + bj * HALF + 4); } }
    __device__ __forceinline__ void operator()(const Acc& acc, const Unit& u, int wr, int wc, int fr, int fq, const Pre& p) const {
        const int row0 = u.pm * BM + wr * 64 + fr, col0 = u.pn * BM + wc * 32 + 8 * fq;
#pragma unroll
        for (int bj = 0; bj < 2; ++bj) { const f32x4 b0 = p.b[bj][0], b1 = p.b[bj][1];
#pragma unroll
            for (int ai = 0; ai < 2; ++ai)
#pragma unroll
                for (int m = 0; m < 4; ++m) { const f32x4 v0 = acc[ai][bj][m][0] + b0, v1 = acc[ai][bj][m][1] + b1;
                    u32x4 w; w.x = pk2(v0[0], v0[1]); w.y = pk2(v0[2], v0[3]); w.z = pk2(v1[0], v1[1]); w.w = pk2(v1[2], v1[3]);
                    *(u32x4*)(O + (size_t)(row0 + ai * HALF + m * 16) * D + col0 + bj * HALF) = w; } }
    }
};

template <class Epi, class Sched>
__device__ __forceinline__ void gemm_phase(LAS unsigned char* lds, const int tid, const int K, const unsigned lda, const unsigned ldb, const Sched& S, const Epi& E) {
    const int wid = __builtin_amdgcn_readfirstlane(tid >> 6), lane = tid & 63, wr = wid >> 2, wc = wid & 3, fr = lane & 15, fq = lane >> 4;
    const int nt = K / BK;
    unsigned voffA[2], voffB[2]; int Rs[2];
#pragma unroll
    for (int i = 0; i < 2; ++i) { int R, C; stage_rc(tid * 16 + i * 8192, R, C); const int Rb = Epi::PERM ? ((R & ~31) + perm32(R & 31)) : R; Rs[i] = R;
        voffA[i] = Sched::GATHER ? (unsigned)C * 2u : (unsigned)R * lda + (unsigned)C * 2u; voffB[i] = (unsigned)Rb * ldb + (unsigned)C * 2u; }
    unsigned offc[2][2] = {{0u, 0u}, {0u, 0u}}, offn[2][2] = {{0u, 0u}, {0u, 0u}};
    const size_t kstep = (size_t)(BK * 2);
    const size_t hstepA = (size_t)HALF * lda, hstepB = (size_t)HALF * ldb;
    const unsigned ldsw = (unsigned)wid * 1024u;
    const int aoff = lds_byte(wr * 64 + fr, fq * 8), boff = lds_byte(wc * 32 + fr, fq * 8);
#define G8_SA(b, h) (((b) * 2 + (h)) * HTB)
#define G8_SB(b, h) ((4 + (b) * 2 + (h)) * HTB)
#define G8_STAGE(bufoff, gbase, voff) do { _Pragma("unroll") for (int _i = 0; _i < 2; ++_i) \
        __builtin_amdgcn_global_load_lds((const unsigned*)((const char*)(gbase) + (voff)[_i]), (LAS unsigned*)(lds + (bufoff) + ldsw + _i * 8192), 16, 0, 0); } while (0)
#define G8_STAGEA(bufoff, kt, h, nx) do { _Pragma("unroll") for (int _i = 0; _i < 2; ++_i) { \
        const char* _g = Sched::GATHER ? (cA + (size_t)(kt) * kstep + ((nx) ? offn[h][_i] : offc[h][_i]) + voffA[_i]) : (((nx) ? nA : cA) + (size_t)(kt) * kstep + (size_t)(h) * hstepA + voffA[_i]); \
        __builtin_amdgcn_global_load_lds((const unsigned*)_g, (LAS unsigned*)(lds + (bufoff) + ldsw + _i * 8192), 16, 0, 0); } } while (0)
#define G8_LOADOFF(dst, un) do { if constexpr (Sched::GATHER) { _Pragma("unroll") for (int _h = 0; _h < 2; ++_h) _Pragma("unroll") for (int _i = 0; _i < 2; ++_i) \
        dst[_h][_i] = (unsigned)S.rowtok[(un).pm * 256 + _h * 128 + Rs[_i]] * (unsigned)(D * 2); } } while (0)
#define G8_LDA(dst, b, h) do { _Pragma("unroll") for (int m = 0; m < 4; ++m) _Pragma("unroll") for (int k = 0; k < 2; ++k) dst[m][k] = *(const LAS bf16x8*)(lds + G8_SA(b, h) + aoff + m * 2048 + k * 1024); } while (0)
#define G8_LDB(dst, b, h) do { _Pragma("unroll") for (int n = 0; n < 2; ++n) _Pragma("unroll") for (int k = 0; k < 2; ++k) dst[n][k] = *(const LAS bf16x8*)(lds + G8_SB(b, h) + boff + n * 2048 + k * 1024); } while (0)
#define G8_MMA(ai, bj, At, Bt) do { __builtin_amdgcn_s_setprio(1); _Pragma("unroll") for (int m = 0; m < 4; ++m) _Pragma("unroll") for (int n = 0; n < 2; ++n) _Pragma("unroll") for (int k = 0; k < 2; ++k) \
        acc[ai][bj][m][n] = __builtin_amdgcn_mfma_f32_16x16x32_bf16(Bt[n][k], At[m][k], acc[ai][bj][m][n], 0, 0, 0); __builtin_amdgcn_s_setprio(0); } while (0)
#define G8_WAIT_V(n) asm volatile("s_waitcnt vmcnt(" #n ")" ::: "memory")
#define G8_WAIT_L(n) asm volatile("s_waitcnt lgkmcnt(" #n ")" ::: "memory")
#define G8_BAR __builtin_amdgcn_s_barrier()
#define G8_SCHED __builtin_amdgcn_sched_barrier(0)
    Unit cur, nxt; int ui = 0;
    if (!S.next(0, cur)) return;
    Acc acc;
#pragma unroll
    for (int a = 0; a < 2; ++a)
#pragma unroll
        for (int b = 0; b < 2; ++b)
#pragma unroll
            for (int m = 0; m < 4; ++m)
#pragma unroll
                for (int n = 0; n < 2; ++n) acc[a][b][m][n] = (f32x4){0.f, 0.f, 0.f, 0.f};
    bf16x8 At[4][2], B0[2][2], B1[2][2];
    const char* cA = cur.A; const char* cB = cur.B; const char* nA = cA;
    typename Epi::Pre epre; E.pre(epre, cur, wc, fq, wid, lane);
    G8_LOADOFF(offc, cur);
    if constexpr (Sched::GATHER) asm volatile("s_waitcnt vmcnt(0)" ::: "memory");
    G8_STAGE(G8_SB(0, 0), cB, voffB); G8_STAGEA(G8_SA(0, 0), 0, 0, false); G8_STAGE(G8_SB(0, 1), cB + hstepB, voffB); G8_STAGEA(G8_SA(0, 1), 0, 1, false);
    if (wr == 1) G8_BAR;
    G8_WAIT_V(4); G8_BAR;
    G8_STAGE(G8_SB(1, 0), cB + kstep, voffB); G8_STAGEA(G8_SA(1, 0), 1, 0, false); G8_STAGE(G8_SB(1, 1), cB + hstepB + kstep, voffB);
    G8_WAIT_V(6); G8_BAR;
    for (;;) {
        const bool has_next = S.next(ui + 1, nxt);
        nA = has_next ? nxt.A : cA; const char* nB = has_next ? nxt.B : cB;
        if (has_next) G8_LOADOFF(offn, nxt);
        else { _Pragma("unroll") for (int _h = 0; _h < 2; ++_h) _Pragma("unroll") for (int _i = 0; _i < 2; ++_i) offn[_h][_i] = offc[_h][_i]; }
        for (int t = 0; t < nt; t += 2) {
            const bool last = (t == nt - 2);
            const char* b2 = last ? nB : cB + (size_t)(t + 2) * kstep;
            const char* b3 = b2 + kstep;
            const int k2 = last ? 0 : t + 2, k3 = last ? 1 : t + 3;
            G8_LDB(B0, 0, 0); G8_SCHED; G8_LDA(At, 0, 0); G8_STAGEA(G8_SA(1, 1), t + 1, 1, false);
            G8_WAIT_L(8); G8_BAR; G8_WAIT_L(0); G8_MMA(0, 0, At, B0); G8_BAR; G8_SCHED;
            G8_LDB(B1, 0, 1); G8_STAGE(G8_SB(0, 0), b2, voffB);
            G8_BAR; G8_WAIT_L(0); G8_MMA(0, 1, At, B1); G8_BAR;
            G8_LDA(At, 0, 1); G8_STAGEA(G8_SA(0, 0), k2, 0, last);
            G8_BAR; G8_WAIT_L(0); G8_MMA(1, 0, At, B0); G8_BAR; G8_SCHED;
            G8_STAGE(G8_SB(0, 1), b2 + hstepB, voffB);
            G8_WAIT_V(6); G8_BAR; G8_MMA(1, 1, At, B1); G8_BAR;
            G8_LDB(B0, 1, 0); G8_SCHED; G8_LDA(At, 1, 0); G8_STAGEA(G8_SA(0, 1), k2, 1, last);
            G8_WAIT_L(8); G8_BAR; G8_WAIT_L(0); G8_MMA(0, 0, At, B0); G8_BAR; G8_SCHED;
            G8_LDB(B1, 1, 1); G8_STAGE(G8_SB(1, 0), b3, voffB);
            G8_BAR; G8_WAIT_L(0); G8_MMA(0, 1, At, B1); G8_BAR;
            G8_LDA(At, 1, 1); G8_STAGEA(G8_SA(1, 0), k3, 0, last);
            G8_BAR; G8_WAIT_L(0); G8_MMA(1, 0, At, B0); G8_BAR; G8_SCHED;
            G8_STAGE(G8_SB(1, 1), b3 + hstepB, voffB);
            G8_WAIT_V(6); G8_BAR; G8_MMA(1, 1, At, B1); G8_BAR;
        }
        MFMA_FENCE();
        E(acc, cur, wr, wc, fr, fq, epre);
        if (!has_next) break;
#pragma unroll
        for (int a = 0; a < 2; ++a)
#pragma unroll
            for (int b = 0; b < 2; ++b)
#pragma unroll
                for (int m = 0; m < 4; ++m)
#pragma unroll
                    for (int n = 0; n < 2; ++n) acc[a][b][m][n] = (f32x4){0.f, 0.f, 0.f, 0.f};
        cur = nxt; cA = nA; cB = nB; ++ui;
        { _Pragma("unroll") for (int _h = 0; _h < 2; ++_h) _Pragma("unroll") for (int _i = 0; _i < 2; ++_i) offc[_h][_i] = offn[_h][_i]; }
        E.pre(epre, cur, wc, fq, wid, lane);
    }
    G8_WAIT_V(0);
    if (wr == 0) G8_BAR;
    G8_BAR;
#undef G8_SA
#undef G8_SB
#undef G8_STAGE
#undef G8_LDA
#undef G8_STAGEA
#undef G8_LOADOFF
#undef G8_LDB
#undef G8_MMA
#undef G8_WAIT_V
#undef G8_WAIT_L
#undef G8_BAR
#undef G8_SCHED
}
}

__device__ __forceinline__ void conv_item(const float* __restrict__ src, int ldS, int col4  , int k0, bf16_t* __restrict__ dst  , int K, int kq, const float* __restrict__ ksc = nullptr  ) {
    f32x4 v[16];
#pragma unroll
    for (int j = 0; j < 16; ++j) v[j] = col4 >= 0 ? *(const f32x4*)(src + (size_t)(k0 + kq * 16 + j) * ldS + col4) : (f32x4){0.f, 0.f, 0.f, 0.f};
    if (ksc) {
#pragma unroll
        for (int j = 0; j < 16; ++j) v[j] *= ksc[k0 + kq * 16 + j];
    }
#pragma unroll
    for (int r = 0; r < 4; ++r) {
        u32x4 w0, w1;
#pragma unroll
        for (int j = 0; j < 4; ++j) { w0[j] = pk2(v[2 * j][r], v[2 * j + 1][r]); w1[j] = pk2(v[8 + 2 * j][r], v[8 + 2 * j + 1][r]); }
        bf16_t* d = dst + (size_t)r * K + kq * 16;
        *(u32x4*)d = w0; *(u32x4*)(d + 8) = w1;
    }
}
__device__ __forceinline__ void rms_row_to_h(const float* __restrict__ xr, const float* __restrict__ nw, bf16_t* __restrict__ hr, int lane) {
    f32x4 v[4]; float ss = 0.f;
#pragma unroll
    for (int i = 0; i < 4; ++i) { v[i] = *(const f32x4*)(xr + i * 256 + lane * 4); ss += v[i][0] * v[i][0] + v[i][1] * v[i][1] + v[i][2] * v[i][2] + v[i][3] * v[i][3]; }
    ss = wave_sum(ss);
    const float rs = rsqrtf(ss * (1.0f / 1024.0f) + NORM_EPS);
#pragma unroll
    for (int i = 0; i < 4; ++i) { const f32x4 w = *(const f32x4*)(nw + i * 256 + lane * 4);
        u32x2 o; o.x = pk2(v[i][0] * rs * w[0], v[i][1] * rs * w[1]); o.y = pk2(v[i][2] * rs * w[2], v[i][3] * rs * w[3]);
        *(u32x2*)(hr + i * 256 + lane * 4) = o; }
}
constexpr int CONV_ITEMS = 112 * 16 + 16 * 32 + 16 * 16 + 2 * 4 * 32 + 32 * 32 * 16 + 32 * 16 * 16;
__device__ __forceinline__ void conv_one(const Ctx& c, const int l, const int it) {
    const int lane = c.lane;
    constexpr int I_IN = 112 * 16, I_O = 16 * 32, I_OUT = 16 * 16, I_C1 = 2 * 4 * 32, I_GU = 32 * 32 * 16;
    constexpr int E1 = I_IN, E2 = E1 + I_O, E3 = E2 + I_OUT, E4 = E3 + I_C1, E5 = E4 + I_GU;
    const int n4 = (lane & 15) * 4, kq = lane >> 4;
    if (it < E1) { const int nb = it / 16, kb = it % 16; const int n = nb * 64 + n4;
        const int col = n < 4912 ? n : (n < 5120 ? -1 : n - 208);
        conv_item(c.w_in + (size_t)l * D * IN_TOTAL, IN_TOTAL, col, kb * 64, WSP(bf16_t, WS_WIN) + ((size_t)l * NPROJ + n) * D + kb * 64, D, kq);
    } else if (it < E2) { const int r = it - E1, nb = r / 32, kb = r % 32; const int n = nb * 64 + n4;
        const float* src = (kb < 16 ? c.w_o_ret : c.w_o_nsa) + (size_t)l * D * D;
        conv_item(src, D, n, (kb & 15) * 64, WSP(bf16_t, WS_WO) + ((size_t)l * D + n) * 2048 + kb * 64, 2048, kq);
    } else if (it < E3) { const int r = it - E2, nb = r / 16, kb = r % 16; const int n = nb * 64 + n4;
        conv_item(c.w_out + (size_t)l * D * D, D, n, kb * 64, WSP(bf16_t, WS_WOUT) + ((size_t)l * D + n) * D + kb * 64, D, kq);
    } else if (it < E4) { const int j = it - E3, lk = l * 2 + j / 128, r = j % 128, nb = r / 32, kb = r % 32; const int n = nb * 64 + n4;
        conv_item(c.cmp_w1 + (size_t)lk * 2048 * 256, 256, n, kb * 64, WSP(bf16_t, WS_WC1) + ((size_t)lk * 256 + n) * 2048 + kb * 64, 2048, kq);
    } else if (it < E5) { const int j = it - E4, le = l * NEXP + j / 512, r = j % 512, nb = r / 16, kb = r % 16; const int n = nb * 64 + n4;
        const int pn = n >> 8, jj = n & 255; const int col = jj < 128 ? pn * 128 + jj : 1024 + pn * 128 + (jj - 128);
        conv_item(c.w_gate_up + (size_t)le * D * 2048, 2048, col, kb * 64, WSP(bf16_t, WS_WGU) + ((size_t)le * 2048 + n) * D + kb * 64, D, kq, c.norm2_w + (size_t)l * D);
    } else { const int j = it - E5, le = l * NEXP + j / 256, r = j % 256, nb = r / 16, kb = r % 16; const int n = nb * 64 + n4;
        conv_item(c.w_down + (size_t)le * D * D, D, n, kb * 64, WSP(bf16_t, WS_WD) + ((size_t)le * D + n) * D + kb * 64, D, kq);
    }
}
__device__ __forceinline__ bool conv_is_early(const int it) { return it < 112 * 16 || (it >= 112 * 16 + 16 * 32 + 16 * 16 && it < 112 * 16 + 16 * 32 + 16 * 16 + 2 * 4 * 32); }
__device__ __forceinline__ void conv_layer_early(const Ctx& c, const int l, const int widx, const int nw) {
    for (int it = widx; it < 112 * 16; it += nw) conv_one(c, l, it);
    for (int it = 112 * 16 + 16 * 32 + 16 * 16 + widx; it < 112 * 16 + 16 * 32 + 16 * 16 + 2 * 4 * 32; it += nw) conv_one(c, l, it);
}
__device__ __forceinline__ void phase_prologue(const Ctx& c) {
    const int lane = c.lane, gw = c.gw, NW = c.G * NWAVES;
    conv_layer_early(c, 0, gw, NW);
    const int gtid = blockIdx.x * NTHREADS + c.tid, NT = c.G * NTHREADS;
    for (int pos = gw; pos < SEQ; pos += NW) {
#pragma unroll
        for (int pass = 0; pass < 2; ++pass) {
            if (pass == 1 && lane >= 8) break;
            const int j = pass == 0 ? lane : 64 + lane;
            float inv; if (j < 64) inv = powf(10000.0f, -(float)(2 * j) / 128.0f); else inv = powf(500000.0f, -(float)(2 * (j - 64)) / 16.0f);
            const float ang = (float)pos * inv;
            double rev = (double)ang * 0.15915494309189535; rev -= floor(rev);
            const float rv = (float)rev; const float sn = __builtin_amdgcn_sinf(rv), cs = __builtin_amdgcn_cosf(rv);
            if (j < 64) { float* t = WSP(float, WS_ROPER) + ((size_t)pos * 64 + j) * 2; t[0] = cs; t[1] = sn; }
            else { float* t = WSP(float, WS_ROPEN) + ((size_t)pos * 8 + (j - 64)) * 2; t[0] = cs; t[1] = sn; }
        }
    }
    for (int u = blockIdx.x + c.wave * c.G; u < NL * 2 * 16 * 8; u += c.G * NWAVES) {
        const int kh = u & 7, lk = u >> 7, n = ((u >> 3) & 15) * 16 + (lane & 15), k0 = kh * 256 + (lane >> 4) * 64;
        const float* pe = c.cmp_pos + (size_t)lk * 2048 + k0; const float* w1 = c.cmp_w1 + ((size_t)lk * 2048 + k0) * 256 + n;
        float s0 = 0.f, s1 = 0.f, s2 = 0.f, s3 = 0.f;
#pragma unroll 4
        for (int k = 0; k < 64; k += 4) { s0 += pe[k] * w1[(size_t)k * 256]; s1 += pe[k + 1] * w1[(size_t)(k + 1) * 256]; s2 += pe[k + 2] * w1[(size_t)(k + 2) * 256]; s3 += pe[k + 3] * w1[(size_t)(k + 3) * 256]; }
        float s = (s0 + s1) + (s2 + s3);
        s += __shfl_xor(s, 16); s += __shfl_xor(s, 32);
        if (lane < 16) WSP(float, WS_PEB)[kh * (NL * 2 * 256) + lk * 256 + n] = s;
    }
    for (int i = gtid; i < NL * 32 * 2 * 64 * 8; i += NT) {
        const int j = i & 7, ln = (i >> 3) & 63, nt = (i >> 9) & 1, ks = (i >> 10) & 31, l = i >> 15;
        const int fr_ = ln & 15, fq_ = ln >> 4, k = 32 * ks + (j < 4 ? 4 * fq_ + j : 16 + 4 * fq_ + (j - 4)), e = 16 * nt + fr_;
        const float w = c.norm2_w[(size_t)l * D + k] * c.router_w[((size_t)l * D + k) * NEXP + e];
        const unsigned hi = f2bf(w); const float wl = w - __uint_as_float(hi << 16);
        bf16_t* dst = WSP(bf16_t, WS_RWF) + ((((size_t)l * 32 + ks) * 2 + nt) * 2) * 512 + ln * 8 + j;
        dst[0] = (bf16_t)hi; dst[512] = (bf16_t)f2bf(wl);
    }
    for (int tok = gw; tok < NTOK; tok += NW) rms_row_to_h(c.x_in + (size_t)tok * D, c.norm1_w, WSP(bf16_t, WS_H) + (size_t)tok * D, lane);
}

constexpr float SM_SCALE_L2 = 0.125f * 1.4426950408889634f;
__device__ __forceinline__ void phase_prep(const Ctx& c, int l) {
    const int lane = c.lane, gw = c.gw, NW = c.G * NWAVES;
    const bf16_t* proj = WSP(bf16_t, WS_PROJ);
    const float* ropeR = WSP(float, WS_ROPER); const float* ropeN = WSP(float, WS_ROPEN);
    const float* qkw = c.qk_norm_w + (size_t)l * 4 * 64;
    for (int tok = gw; tok < NTOK; tok += NW) {
        const int b = tok / SEQ, s = tok % SEQ; const bf16_t* pr = proj + (size_t)tok * NPROJ;
        {
            const int job = lane >> 3, l8 = lane & 7, isk = job >> 2, h = job & 3;
            const bf16_t* src = pr + (isk ? C_RK : C_RQ) + h * 128 + 8 * l8;
            const u32x4 w1 = *(const u32x4*)src, w2 = *(const u32x4*)(src + 64);
            const f32x4* tb = (const f32x4*)(ropeR + ((size_t)s * 64 + 8 * l8) * 2);
            const float ksc = isk ? 0.08838834764831845f : 1.0f;
            u32x4 o1, o2;
#pragma unroll
            for (int j = 0; j < 4; ++j) { const f32x4 cs = tb[j];
                const float a1 = bflo(w1[j]), a2 = bflo(w2[j]), b1 = bfhi(w1[j]), b2 = bfhi(w2[j]);
                o1[j] = pk2((a1 * cs[0] - a2 * cs[1]) * ksc, (b1 * cs[2] - b2 * cs[3]) * ksc);
                o2[j] = pk2((a1 * cs[1] + a2 * cs[0]) * ksc, (b1 * cs[3] + b2 * cs[2]) * ksc); }
            bf16_t* dst = WSP(bf16_t, isk ? WS_KR : WS_QR) + ((size_t)(b * 4 + h) * SEQ + s) * 128 + 8 * l8;
            *(u32x4*)dst = o1; *(u32x4*)(dst + 64) = o2;
        }
        {
            const int head = lane >> 2, part = lane & 3; const bf16_t* src = pr + C_NQ + head * 64 + part * 16;
            const u32x4 w0 = *(const u32x4*)src, w1 = *(const u32x4*)(src + 8); float v[16];
#pragma unroll
            for (int j = 0; j < 4; ++j) { v[2 * j] = bflo(w0[j]); v[2 * j + 1] = bfhi(w0[j]); v[8 + 2 * j] = bflo(w1[j]); v[8 + 2 * j + 1] = bfhi(w1[j]); }
            float ss = 0.f;
#pragma unroll
            for (int j = 0; j < 16; ++j) ss += v[j] * v[j];
            ss += __shfl_xor(ss, 1); ss += __shfl_xor(ss, 2);
            const float rs = rsqrtf(ss * (1.0f / 64.0f) + NORM_EPS);
#pragma unroll
            for (int j = 0; j < 16; ++j) v[j] = v[j] * (rs * SM_SCALE_L2) * qkw[0 * 64 + part * 16 + j];
            if (part == 0) {
#pragma unroll
                for (int i = 0; i < 8; ++i) { const float cc = ropeN[((size_t)s * 8 + i) * 2], sc = ropeN[((size_t)s * 8 + i) * 2 + 1]; const float x1 = v[i], x2 = v[i + 8]; v[i] = x1 * cc - x2 * sc; v[i + 8] = x1 * sc + x2 * cc; }
            }
            u32x4 o0, o1;
#pragma unroll
            for (int j = 0; j < 4; ++j) { o0[j] = pk2(v[2 * j], v[2 * j + 1]); o1[j] = pk2(v[8 + 2 * j], v[8 + 2 * j + 1]); }
            bf16_t* dst = WSP(bf16_t, WS_QN) + ((size_t)tok * 16 + head) * 64 + part * 16;
            *(u32x4*)dst = o0; *(u32x4*)(dst + 8) = o1;
        }
        if (lane < 16) {
            const int hh = lane >> 2, part = lane & 3, isw = hh >> 1, g = hh & 1;
            const bf16_t* src = pr + (isw ? C_KW : C_KS) + g * 64 + part * 16;
            const u32x4 w0 = *(const u32x4*)src, w1 = *(const u32x4*)(src + 8); float v[16];
#pragma unroll
            for (int j = 0; j < 4; ++j) { v[2 * j] = bflo(w0[j]); v[2 * j + 1] = bfhi(w0[j]); v[8 + 2 * j] = bflo(w1[j]); v[8 + 2 * j + 1] = bfhi(w1[j]); }
            float ss = 0.f;
#pragma unroll
            for (int j = 0; j < 16; ++j) ss += v[j] * v[j];
            ss += __shfl_xor(ss, 1); ss += __shfl_xor(ss, 2);
            const float rs = rsqrtf(ss * (1.0f / 64.0f) + NORM_EPS);
            const float* w = qkw + (isw ? 3 : 2) * 64 + part * 16;
#pragma unroll
            for (int j = 0; j < 16; ++j) v[j] = v[j] * rs * w[j];
            if (part == 0) {
#pragma unroll
                for (int i = 0; i < 8; ++i) { const float cc = ropeN[((size_t)s * 8 + i) * 2], sc = ropeN[((size_t)s * 8 + i) * 2 + 1]; const float x1 = v[i], x2 = v[i + 8]; v[i] = x1 * cc - x2 * sc; v[i + 8] = x1 * sc + x2 * cc; }
            }
            u32x4 o0, o1;
#pragma unroll
            for (int j = 0; j < 4; ++j) { o0[j] = pk2(v[2 * j], v[2 * j + 1]); o1[j] = pk2(v[8 + 2 * j], v[8 + 2 * j + 1]); }
            bf16_t* dst = WSP(bf16_t, isw ? WS_KW : WS_KS) + ((((size_t)(b * 2 + g) * 128 + (s >> 6)) * 4 + ((s >> 4) & 3)) * 2 + (part >> 1)) * 512 + ((2 * (part & 1)) * 16 + (s & 15)) * 8;
            *(u32x4*)dst = o0; *(u32x4*)(dst + 128) = o1;
        } else if (lane < 48) {
            const int q = lane - 16, isv = q >> 4, r = q & 15, g = r >> 3, part = r & 7;
            const u32x4 w = *(const u32x4*)(pr + (isv ? C_VC : C_KC) + g * 64 + part * 8);
            *(u32x4*)(WSP(bf16_t, isv ? WS_VCT : WS_KCT) + ((size_t)(b * 2 + g) * SEQ + s) * 64 + part * 8) = w;
        }
    }
    const float lgam[4] = {log2f(1.0f - 1.0f / 32.0f), log2f(1.0f - 1.0f / 64.0f), log2f(1.0f - 1.0f / 128.0f), log2f(1.0f - 1.0f / 256.0f)};
    LAS bf16_t* tile = (LAS bf16_t*)(c.lds + c.wave * 8192);
    for (int grp = gw; grp < NTOK / 8; grp += NW) {
        const int tok0 = grp * 8, b = tok0 / SEQ, s0 = tok0 % SEQ; const bf16_t* pr = proj + (size_t)tok0 * NPROJ;
#define PREP_LOAD_TILE(col0) do { _Pragma("unroll") for (int _t = 0; _t < 8; ++_t) { const u32x4 _w = *(const u32x4*)(pr + (size_t)_t * NPROJ + (col0) + lane * 8); *(LAS u32x4*)(tile + _t * 512 + lane * 8) = _w; } } while (0)
#define PREP_COL8(cc, w) do { unsigned short _v[8]; _Pragma("unroll") for (int _t = 0; _t < 8; ++_t) _v[_t] = tile[_t * 512 + (cc)]; \
        (w).x = _v[0] | ((unsigned)_v[1] << 16); (w).y = _v[2] | ((unsigned)_v[3] << 16); (w).z = _v[4] | ((unsigned)_v[5] << 16); (w).w = _v[6] | ((unsigned)_v[7] << 16); } while (0)
        PREP_LOAD_TILE(C_RK);
        {
            float cs[8], sn[8], zz[8];
#pragma unroll
            for (int t = 0; t < 8; ++t) { const f32x2 tb = *(const f32x2*)(ropeR + ((size_t)(s0 + t) * 64 + lane) * 2); cs[t] = tb[0]; sn[t] = tb[1]; }
#pragma unroll
            for (int h = 0; h < 4; ++h) { float o1[8], o2[8];
#pragma unroll
                for (int t = 0; t < 8; ++t) { const float k1 = bf2f(tile[t * 512 + h * 128 + lane]), k2 = bf2f(tile[t * 512 + h * 128 + 64 + lane]);
                    const float z = fexp2(lgam[h] * (float)(127 - ((s0 + t) & 127))) * 0.08838834764831845f;
                    o1[t] = (k1 * cs[t] - k2 * sn[t]) * z; o2[t] = (k1 * sn[t] + k2 * cs[t]) * z; }
                u32x4 w1, w2;
#pragma unroll
                for (int j = 0; j < 4; ++j) { w1[j] = pk2(o1[2 * j], o1[2 * j + 1]); w2[j] = pk2(o2[2 * j], o2[2 * j + 1]); }
                { const int tk = s0 & 127, q = tk & 31, fqa = (q & 15) >> 2, jb = q >= 16 ? 4 : 0;
                  bf16_t* base = WSP(bf16_t, WS_KZT) + ((((size_t)(b * 4 + h) * 64 + (s0 >> 7)) * 8) * 4 + (tk >> 5)) * 512 + (fqa * 16 + (lane & 15)) * 8 + jb;
                  bf16_t* d1 = base + (size_t)(lane >> 4) * 2048, *d2 = base + (size_t)(4 + (lane >> 4)) * 2048;
                  u32x2 a; a.x = w1.x; a.y = w1.y; *(u32x2*)d1 = a; a.x = w1.z; a.y = w1.w; *(u32x2*)(d1 + 128) = a;
                  a.x = w2.x; a.y = w2.y; *(u32x2*)d2 = a; a.x = w2.z; a.y = w2.w; *(u32x2*)(d2 + 128) = a; } }
        }
#pragma unroll 1
        for (int hf = 0; hf < 2; ++hf) {
            PREP_LOAD_TILE(C_RV + hf * 512);
#pragma unroll
            for (int i = 0; i < 8; ++i) { const int cc = i * 64 + lane; u32x4 w; PREP_COL8(cc, w);
                { const int ch_ = hf * 512 + cc, hh = ch_ >> 8, dv = ch_ & 255, tk = s0 & 127, q = tk & 31, fqa = (q & 15) >> 2, jb = q >= 16 ? 4 : 0;
                  bf16_t* d = WSP(bf16_t, WS_VT) + (((((size_t)(b * 4 + hh) * 64 + (s0 >> 7)) * 4 + (tk >> 5)) * 16 + (dv >> 4)) * 64 + fqa * 16 + (dv & 15)) * 8 + jb;
                  u32x2 a; a.x = w.x; a.y = w.y; *(u32x2*)d = a; a.x = w.z; a.y = w.w; *(u32x2*)(d + 128) = a; } }
        }
        {
#pragma unroll
            for (int _t = 0; _t < 8; ++_t) { const int piece = lane >> 4, off = (lane & 15) * 8;
                if (lane < 32) { const u32x4 _w = *(const u32x4*)(pr + (size_t)_t * NPROJ + (piece ? C_VW : C_VS) + off); *(LAS u32x4*)(tile + _t * 512 + piece * 128 + off) = _w; } }
#pragma unroll
            for (int i = 0; i < 4; ++i) { const int isw = i >> 1, g = i & 1; u32x4 w; PREP_COL8(isw * 128 + g * 64 + lane, w);
                const int q = s0 & 31; bf16_t* dst = WSP(bf16_t, isw ? WS_VWT : WS_VST) + ((((size_t)(b * 2 + g) * 128 + (s0 >> 6)) * 2 + ((s0 >> 5) & 1)) * 4 + (lane >> 4)) * 512 + ((((q & 15) >> 2)) * 16 + (lane & 15)) * 8 + (q >= 16 ? 4 : 0);
                u32x2 w0, w1; w0.x = w.x; w0.y = w.y; w1.x = w.z; w1.y = w.w; *(u32x2*)dst = w0; *(u32x2*)(dst + 128) = w1; }
        }
#undef PREP_LOAD_TILE
#undef PREP_COL8
    }
}

__device__ __forceinline__ void phase_cmp2(const Ctx& c, int l) {
    const int lane = c.lane, gw = c.gw, NW = c.G * NWAVES;
    const float* ropeN = WSP(float, WS_ROPEN);
    for (int r0 = 0; r0 < 2 * 8 * 512; r0 += c.G * 32) {
        const int rowb = r0 + blockIdx.x * 32 + c.wave * 4; if (rowb >= 2 * 8 * 512) break;
        const int kv = rowb >> 12, bg = (rowb >> 9) & 7;
        const float* w2 = c.cmp_w2 + ((size_t)l * 2 + kv) * 256 * 64 + lane;
        LAS float* hl = (LAS float*)(c.lds + c.wave * 4096);
        { const float* sl = WSP(float, WS_ACT) + (size_t)rowb * 256 + lane * 4; f32x4 pb = *(const f32x4*)(WSP(float, WS_PEB) + (size_t)l * 512 + kv * 256 + lane * 4);
#pragma unroll
          for (int kh = 1; kh < 8; ++kh) pb += *(const f32x4*)(WSP(float, WS_PEB) + (size_t)kh * (NL * 2 * 256) + (size_t)l * 512 + kv * 256 + lane * 4);
#pragma unroll
          for (int rr = 0; rr < 4; ++rr) { f32x4 a = pb;
#pragma unroll
              for (int q = 0; q < 8; ++q) a += *(const f32x4*)(sl + (size_t)q * 8192 * 256 + rr * 256);
#pragma unroll
              for (int j = 0; j < 4; ++j) { const float x = a[j]; const float t = 0.7978845608028654f * (x + 0.044715f * x * x * x);
                  const float th = 1.0f - 2.0f * frcp(1.0f + fexp2(2.8853900817779268f * t)); a[j] = 0.5f * x * (1.0f + th); }
              *(LAS f32x4*)(hl + rr * 256 + lane * 4) = a; } }
        float acc4[4] = {0.f, 0.f, 0.f, 0.f};
#pragma unroll 1
        for (int k0 = 0; k0 < 256; k0 += 32) {
            float wv[32];
#pragma unroll
            for (int i = 0; i < 32; ++i) wv[i] = w2[(size_t)(k0 + i) * 64];
#pragma unroll
            for (int i = 0; i < 32; i += 2) {
#pragma unroll
                for (int rr = 0; rr < 4; ++rr) { const f32x2 hw = *(const LAS f32x2*)(hl + rr * 256 + k0 + i); acc4[rr] += hw[0] * wv[i] + hw[1] * wv[i + 1]; } }
        }
#pragma unroll
        for (int rr = 0; rr < 4; ++rr) {
            const int n = (rowb + rr) & 511; const float acc = acc4[rr];
            if (kv == 0) {
                const float ss = wave_sum(acc * acc); float v = acc * rsqrtf(ss * (1.0f / 64.0f) + NORM_EPS) * c.qk_norm_w[(size_t)l * 256 + 64 + lane];
                const float other = __shfl_xor(v, 8);
                int pos = 16 * n + 31; if (pos > SEQ - 1) pos = SEQ - 1;
                if (lane < 16) { const int i = lane & 7; const float cc = ropeN[((size_t)pos * 8 + i) * 2], sc = ropeN[((size_t)pos * 8 + i) * 2 + 1];
                    v = lane < 8 ? v * cc - other * sc : other * sc + v * cc; }
                WSP(bf16_t, WS_KCMP)[((((size_t)bg * 8 + (n >> 6)) * 4 + ((n >> 4) & 3)) * 2 + (lane >> 5)) * 512 + (((lane >> 3) & 3) * 16 + (n & 15)) * 8 + (lane & 7)] = (bf16_t)f2bf(v);
            } else {
                const int q = n & 31; WSP(bf16_t, WS_VCMPT)[((((size_t)bg * 8 + (n >> 6)) * 2 + ((n >> 5) & 1)) * 4 + (lane >> 4)) * 512 + (((q & 15) >> 2) * 16 + (lane & 15)) * 8 + (q >= 16 ? 4 : 0) + (q & 3)] = (bf16_t)(n < 511 ? f2bf(acc) : 0u);
            }
        }
    }
}

__device__ __forceinline__ void phase_scan(const Ctx& c) {
    const int lane = c.lane, w = c.wave, fr = lane & 15, fq = lane >> 4;
    for (int it0 = blockIdx.x; it0 < 256; it0 += c.G) {
        const int it = (c.G == 256) ? ((it0 & 7) * 32 + (it0 >> 3)) : it0;
        const int bh = it >> 4, dvs = it & 15, h = bh & 3;
        const float cdec = fexp2(log2f(1.0f - fexp2(-5.0f - (float)h)) * 128.0f);
        const bf16_t* kz = WSP(bf16_t, WS_KZT) + ((size_t)bh * 64 * 8 + w) * 2048 + lane * 8;
        const bf16_t* vt = WSP(bf16_t, WS_VT) + ((size_t)bh * 64 * 64 + dvs) * 512 + lane * 8;
        bf16_t* rt = WSP(bf16_t, WS_RT) + ((((size_t)bh * 64) * 16 + dvs) * 4 + (w >> 1)) * 512 + ((2 * (w & 1) + (fq >> 1)) * 16 + fr) * 8 + 4 * (fq & 1);
        f32x4 acc = {0.f, 0.f, 0.f, 0.f};
        bf16x8 kf[2][4], vf[2][4];
        u32x2 st[64];
#pragma unroll
        for (int u = 0; u < 2; ++u)
#pragma unroll
            for (int ks = 0; ks < 4; ++ks) { kf[u][ks] = ld8(kz + (size_t)u * 16384 + ks * 512); vf[u][ks] = ld8(vt + (size_t)u * 32768 + ks * 8192); }
#pragma unroll
        for (int ch = 0; ch < 64; ++ch) {
            const int u = ch & 1;
            st[ch].x = pk2(acc[0], acc[1]); st[ch].y = pk2(acc[2], acc[3]);
            acc *= cdec;
#pragma unroll
            for (int ks = 0; ks < 4; ++ks) acc = mfma16(kf[u][ks], vf[u][ks], acc);
            if (ch + 2 < 64) {
#pragma unroll
                for (int ks = 0; ks < 4; ++ks) { kf[u][ks] = ld8(kz + (size_t)(ch + 2) * 16384 + ks * 512); vf[u][ks] = ld8(vt + (size_t)(ch + 2) * 32768 + ks * 8192); }
            }
        }
        MFMA_FENCE();
#pragma unroll
        for (int ch = 0; ch < 64; ++ch) *(u32x2*)(rt + (size_t)ch * 32768) = st[ch];
    }
}

#define SH_BAR() do { asm volatile("" ::: "memory"); __builtin_amdgcn_s_barrier(); asm volatile("" ::: "memory"); } while (0)
#define SH_WAIT_BAR() do { asm volatile("s_waitcnt vmcnt(0)" ::: "memory"); __builtin_amdgcn_s_barrier(); asm volatile("" ::: "memory"); } while (0)
__device__ __forceinline__ void phase_retout(const Ctx& c, int l) {
    const int lane = c.lane, wave = c.wave, fr = lane & 15, fq = lane >> 4;
    const bf16_t* proj = WSP(bf16_t, WS_PROJ);
    LAS unsigned char* lv = c.lds;
    LAS unsigned char* lr = c.lds + 65536;
    for (int u = blockIdx.x; u < 16 * 64; u += c.G) {
        const int qt = wave, ch = u & 63, bh = u >> 6, b = bh >> 2, h = bh & 3;
        const float lg = log2f(1.0f - fexp2(-5.0f - (float)h));
        const bf16_t* Q = WSP(bf16_t, WS_QR) + ((size_t)bh * SEQ + ch * 128) * 128;
        const bf16_t* Kp = WSP(bf16_t, WS_KR) + ((size_t)bh * SEQ + ch * 128) * 128;
        const bf16_t* VTp = WSP(bf16_t, WS_VT) + ((size_t)(bh * 64 + ch)) * 32768;
        const bf16_t* RTp = WSP(bf16_t, WS_RT) + ((size_t)(bh * 64 + ch)) * 32768;
        SH_BAR();
#pragma unroll
        for (int i = 0; i < 8; ++i) {
            __builtin_amdgcn_global_load_lds((const unsigned*)(VTp + (size_t)(wave * 8 + i) * 512 + lane * 8), (LAS unsigned*)(lv + (wave * 8 + i) * 1024), 16, 0, 0);
            __builtin_amdgcn_global_load_lds((const unsigned*)(RTp + (size_t)(wave * 8 + i) * 512 + lane * 8), (LAS unsigned*)(lr + (wave * 8 + i) * 1024), 16, 0, 0);
        }
        const int n = 16 * qt + fr;
        bf16x8 qf[4], qs[4];
        const float xi = fexp2(lg * (float)(n + 1));
#pragma unroll
        for (int ks = 0; ks < 4; ++ks) { const u32x4 w = *(const u32x4*)(Q + (size_t)n * 128 + 32 * ks + 8 * fq); qf[ks] = mk8(w);
            u32x4 s;
#pragma unroll
            for (int j = 0; j < 4; ++j) s[j] = pk2(bflo(w[j]) * xi, bfhi(w[j]) * xi);
            qs[ks] = mk8(s); }
        const size_t tok = (size_t)b * SEQ + ch * 128 + n;
        const bf16_t* gp = proj + tok * NPROJ + C_RG + h * 256 + 4 * fq; const float* gw_ = c.ret_gn_w + (size_t)l * 1024 + h * 256 + 4 * fq;
        u32x2 gv[16];
#pragma unroll
        for (int dt = 0; dt < 16; ++dt) gv[dt] = *(const u32x2*)(gp + 16 * dt);
        bf16x8 kk[8];
#pragma unroll
        for (int ks = 0; ks < 4; ++ks) { kk[ks] = ld8(Kp + (size_t)fr * 128 + 32 * ks + 8 * fq); kk[4 + ks] = ld8(Kp + (size_t)((qt >= 1 ? 16 : 0) + fr) * 128 + 32 * ks + 8 * fq); }
        f32x4 o[16];
#pragma unroll
        for (int dt = 0; dt < 16; ++dt) o[dt] = (f32x4){0.f, 0.f, 0.f, 0.f};
        SH_WAIT_BAR();
        for (int p = 0; p <= (qt >> 1); ++p) {
            f32x4 s0 = {0.f, 0.f, 0.f, 0.f}, s1 = {0.f, 0.f, 0.f, 0.f};
            const bool two = (2 * p + 1 <= qt);
#pragma unroll
            for (int ks = 0; ks < 4; ++ks) s0 = mfma16(kk[ks], qf[ks], s0);
#pragma unroll
            for (int ks = 0; ks < 4; ++ks) s1 = mfma16(kk[4 + ks], qf[ks], s1);
            MFMA_FENCE();
            if (p + 1 <= (qt >> 1)) {
                const bool two_n = (2 * (p + 1) + 1 <= qt);
#pragma unroll
                for (int ks = 0; ks < 4; ++ks) { kk[ks] = ld8(Kp + (size_t)(32 * (p + 1) + fr) * 128 + 32 * ks + 8 * fq); kk[4 + ks] = ld8(Kp + (size_t)(32 * (p + 1) + (two_n ? 16 : 0) + fr) * 128 + 32 * ks + 8 * fq); }
            }
#pragma unroll
            for (int r = 0; r < 4; ++r) { const int d0 = n - (32 * p + 4 * fq + r), d1 = d0 - 16;
                s0[r] = d0 >= 0 ? s0[r] * fexp2(lg * (float)d0) : 0.f; s1[r] = (two && d1 >= 0) ? s1[r] * fexp2(lg * (float)d1) : 0.f; }
            u32x4 pw; pw.x = pk2(s0[0], s0[1]); pw.y = pk2(s0[2], s0[3]); pw.z = pk2(s1[0], s1[1]); pw.w = pk2(s1[2], s1[3]);
            const bf16x8 pb = mk8(pw);
#pragma unroll
            for (int dt = 0; dt < 16; ++dt) o[dt] = mfma16(*(const LAS bf16x8*)(lv + (p * 16 + dt) * 1024 + lane * 16), pb, o[dt]);
            MFMA_FENCE();
        }
#pragma unroll
        for (int dt = 0; dt < 16; ++dt)
#pragma unroll
            for (int ks = 0; ks < 4; ++ks) o[dt] = mfma16(*(const LAS bf16x8*)(lr + (dt * 4 + ks) * 1024 + lane * 16), qs[ks], o[dt]);
        float s = 0.f;
#pragma unroll
        for (int dt = 0; dt < 16; ++dt) s += (o[dt][0] + o[dt][1]) + (o[dt][2] + o[dt][3]);
        s += __shfl_xor(s, 16); s += __shfl_xor(s, 32);
        const float mu = s * (1.0f / 256.0f); float q = 0.f;
#pragma unroll
        for (int dt = 0; dt < 16; ++dt)
#pragma unroll
            for (int r = 0; r < 4; ++r) { const float d = o[dt][r] - mu; q += d * d; }
        q += __shfl_xor(q, 16); q += __shfl_xor(q, 32);
        const float rstd = rsqrtf(q * (1.0f / 256.0f) + NORM_EPS);
        bf16_t* op = WSP(bf16_t, WS_RA) + tok * 2048 + h * 256 + 4 * fq;
#pragma unroll
        for (int dt = 0; dt < 16; ++dt) { const f32x4 wv = *(const f32x4*)(gw_ + 16 * dt);
            float g[4] = {bflo(gv[dt].x), bfhi(gv[dt].x), bflo(gv[dt].y), bfhi(gv[dt].y)}; float r_[4];
#pragma unroll
            for (int r = 0; r < 4; ++r) r_[r] = (o[dt][r] - mu) * rstd * wv[r] * g[r] * sigmoidf_(g[r]);
            u32x2 ov; ov.x = pk2(r_[0], r_[1]); ov.y = pk2(r_[2], r_[3]); *(u32x2*)(op + 16 * dt) = ov; }
    }
    SH_BAR();
}

__device__ __forceinline__ void attn_step_lds(const LAS unsigned char* slot, const bf16x8 (&qf)[2], const int key0, const int hiK, const int loK, const bool colok, const bool allok, const bool full,
                                              f32x4 (&O)[4], float& lsum, const int lane, const int fq) {
    bf16x8 kv[8];
#pragma unroll
    for (int i = 0; i < 8; ++i) kv[i] = *(const LAS bf16x8*)(slot + i * 1024 + lane * 16);
    f32x4 s[4];
    __builtin_amdgcn_s_setprio(1);
#pragma unroll
    for (int kt = 0; kt < 4; ++kt) { s[kt] = (f32x4){0.f, 0.f, 0.f, 0.f};
#pragma unroll
        for (int ks = 0; ks < 2; ++ks) s[kt] = mfma16(kv[kt * 2 + ks], qf[ks], s[kt]); }
    __builtin_amdgcn_s_setprio(0);
#pragma unroll
    for (int i = 0; i < 8; ++i) kv[i] = *(const LAS bf16x8*)(slot + 8192 + i * 1024 + lane * 16);
    float ps = 0.f;
    if (full) {
        if (allok) {
#pragma unroll
            for (int kt = 0; kt < 4; ++kt)
#pragma unroll
                for (int r = 0; r < 4; ++r) { const float p = fexp2(s[kt][r]); s[kt][r] = p; ps += p; }
        } else {
#pragma unroll
            for (int kt = 0; kt < 4; ++kt)
#pragma unroll
                for (int r = 0; r < 4; ++r) { const float p = colok ? fexp2(s[kt][r]) : 0.f; s[kt][r] = p; ps += p; }
        }
    } else {
#pragma unroll
        for (int kt = 0; kt < 4; ++kt)
#pragma unroll
            for (int r = 0; r < 4; ++r) { const int key = key0 + 16 * kt + 4 * fq + r; const bool ok = colok && (key <= hiK) && (key > loK);
                const float p = ok ? fexp2(s[kt][r]) : 0.f; s[kt][r] = p; ps += p; }
    }
    lsum += ps;
#pragma unroll
    for (int p2 = 0; p2 < 2; ++p2) {
        u32x4 pw; pw.x = pk2(s[2 * p2][0], s[2 * p2][1]); pw.y = pk2(s[2 * p2][2], s[2 * p2][3]); pw.z = pk2(s[2 * p2 + 1][0], s[2 * p2 + 1][1]); pw.w = pk2(s[2 * p2 + 1][2], s[2 * p2 + 1][3]);
        const bf16x8 pb = mk8(pw);
        __builtin_amdgcn_s_setprio(1);
#pragma unroll
        for (int dt = 0; dt < 4; ++dt) O[dt] = mfma16(kv[p2 * 4 + dt], pb, O[dt]);
        __builtin_amdgcn_s_setprio(0);
    }
    MFMA_FENCE();
}
__device__ __forceinline__ int sel_pop(unsigned long long& lo, unsigned long long& hi) {
    if (lo) { const int j = __builtin_ctzll(lo); lo &= lo - 1ull; return j; }
    if (hi) { const int j = 64 + __builtin_ctzll(hi); hi &= hi - 1ull; return j; }
    return -1;
}
#define SH_SLOT(s) (shb + (s) * 16384)
#define SH_ISSUE(kbase, vbase, blk, slot, withv) do { \
        __builtin_amdgcn_global_load_lds((const unsigned*)((kbase) + (size_t)(blk) * 4096 + (wave * 64 + lane) * 8), (LAS unsigned*)(SH_SLOT(slot) + wave * 1024), 16, 0, 0); \
        if (withv) __builtin_amdgcn_global_load_lds((const unsigned*)((vbase) + (size_t)(blk) * 4096 + (wave * 64 + lane) * 8), (LAS unsigned*)(SH_SLOT(slot) + 8192 + wave * 1024), 16, 0, 0); } while (0)
#define SH_READ_K(slot) do { _Pragma("unroll") for (int _i = 0; _i < 8; ++_i) kf[_i] = *(const LAS bf16x8*)(SH_SLOT(slot) + _i * 1024 + lane * 16); } while (0)
#define SH_READ_V(slot) do { _Pragma("unroll") for (int _i = 0; _i < 8; ++_i) vf[_i] = *(const LAS bf16x8*)(SH_SLOT(slot) + 8192 + _i * 1024 + lane * 16); } while (0)
__device__ __forceinline__ void phase_nsa(const Ctx& c, const int layer, const int lconv  , const bool late0  ) {
    const int lane = c.lane, wave = c.wave, fr = lane & 15, fq = lane >> 4;
    const bf16_t* proj = WSP(bf16_t, WS_PROJ);
    volatile LAS float* imp = (volatile LAS float*)(c.lds + 131072 + wave * 2304);
    LAS unsigned char* shb = c.lds;
    const int cntot = (lconv >= 0 ? CONV_ITEMS : 0) + (late0 ? CONV_ITEMS : 0), crounds = (cntot + c.G * NWAVES - 1) / (c.G * NWAVES);
    const int cntl = (2048 + c.G - 1) / c.G, crpt = (crounds + cntl - 1) / cntl;
    volatile LAS int* qs = (volatile LAS int*)(c.lds + LDS_CTL_OFF + 256);
#define NSA_QCTR (WSP(unsigned, WS_CTL + 16384) + layer * 64)
    if (c.tid == 0) { qs[0] = (int)__hip_atomic_fetch_add(NSA_QCTR, 1u, __ATOMIC_RELAXED, __HIP_MEMORY_SCOPE_AGENT); asm volatile("s_waitcnt lgkmcnt(0)" ::: "memory"); }
    int kk = 0;
    for (;; ++kk) {
        SH_BAR();
        const int U = __builtin_amdgcn_readfirstlane(qs[kk & 1]);
        if (U >= 2048) break;
        const int bg = U >> 8; const int tl = 255 - (U & 255);
        const int b = bg >> 1, g = bg & 1, T0 = 32 * tl, curW = T0 >> 6;
        int t0[2], tcol[2]; bf16x8 qf[2][2]; float g0[2], g1[2], g2[2]; size_t tokc[2];
        const int head = g * 8 + (fr & 7);
#pragma unroll
        for (int pr = 0; pr < 2; ++pr) {
            t0[pr] = T0 + 4 * wave + 2 * pr; tcol[pr] = t0[pr] + (fr >> 3); tokc[pr] = (size_t)b * SEQ + tcol[pr];
#pragma unroll
            for (int ks = 0; ks < 2; ++ks) qf[pr][ks] = ld8(WSP(bf16_t, WS_QN) + (tokc[pr] * 16 + head) * 64 + 32 * ks + 8 * fq);
            const bf16_t* gp = proj + tokc[pr] * NPROJ + C_NG + head * 3;
            g0[pr] = sigmoidf_(bf2f(gp[0])); g1[pr] = sigmoidf_(bf2f(gp[1])); g2[pr] = sigmoidf_(bf2f(gp[2]));
        }
        f32x4 out[2][4], O[2][4]; float lsum[2];
        bf16x8 kf[8];
#define NSA_ZERO_O() do { _Pragma("unroll") for (int _p = 0; _p < 2; ++_p) { lsum[_p] = 0.f; _Pragma("unroll") for (int _d = 0; _d < 4; ++_d) O[_p][_d] = (f32x4){0.f, 0.f, 0.f, 0.f}; } } while (0)
        int nbc[2];
#pragma unroll
        for (int pr = 0; pr < 2; ++pr) { const int nv = (t0[pr] + 1 >= 31) ? ((t0[pr] + 1 - 31) >> 4) + 1 : 0; nbc[pr] = (nv + 63) >> 6; }
        const int nvW = (T0 + 31 >= 31) ? ((T0 + 31 - 31) >> 4) + 1 : 0, nbcW = (nvW + 63) >> 6;
        const bf16_t* Kc = WSP(bf16_t, WS_KCMP) + (size_t)bg * 8 * 4096; const bf16_t* Vc = WSP(bf16_t, WS_VCMPT) + (size_t)bg * 8 * 4096;
        NSA_ZERO_O();
        SH_BAR();
        int nq = 0; if (c.tid == 0) nq = (int)__hip_atomic_fetch_add(NSA_QCTR, 1u, __ATOMIC_RELAXED, __HIP_MEMORY_SCOPE_AGENT);
        for (int kb = 0; kb < nbcW; ++kb) SH_ISSUE(Kc, Vc, kb, kb, true);
        SH_WAIT_BAR();
        if (c.tid == 0) { qs[(kk + 1) & 1] = nq; asm volatile("s_waitcnt lgkmcnt(0)" ::: "memory"); }
        for (int kb = 0; kb < nbcW; ++kb) {
#pragma unroll
            for (int pr = 0; pr < 2; ++pr) if (kb < nbc[pr])
                attn_step_lds(SH_SLOT(kb), qf[pr], kb * 64, (tcol[pr] - 31) >> 4, -1, true, true, 16 * (kb * 64 + 63) + 31 <= t0[pr], O[pr], lsum[pr], lane, fq);
        }
        float il[2];
#pragma unroll
        for (int pr = 0; pr < 2; ++pr) { float l = lsum[pr]; l += __shfl_xor(l, 16); l += __shfl_xor(l, 32); il[pr] = l > 0.f ? 1.0f / l : 0.f;
#pragma unroll
            for (int dt = 0; dt < 4; ++dt) out[pr][dt] = O[pr][dt] * (g0[pr] * il[pr]); }
        for (int i = lane; i < 4 * 136; i += 64) imp[i] = 0.f;
        for (int kb = 0; kb < nbcW; ++kb) {
            if (kb < nbc[1]) {
                SH_READ_K(kb);
#pragma unroll
                for (int pr = 0; pr < 2; ++pr) if (kb < nbc[pr]) {
                    f32x4 s4[4];
#pragma unroll
                    for (int kt = 0; kt < 4; ++kt) { s4[kt] = (f32x4){0.f, 0.f, 0.f, 0.f};
#pragma unroll
                        for (int ks = 0; ks < 2; ++ks) s4[kt] = mfma16(kf[kt * 2 + ks], qf[pr][ks], s4[kt]); }
                    MFMA_FENCE();
#pragma unroll
                    for (int kt = 0; kt < 4; ++kt) {
                        float pa = 0.f, p3 = 0.f;
#pragma unroll
                        for (int r = 0; r < 4; ++r) { const int key = kb * 64 + 16 * kt + 4 * fq + r; const bool ok = (16 * key + 31 <= tcol[pr]);
                            const float p = ok ? fexp2(s4[kt][r]) * il[pr] : 0.f; pa += p; if (r == 3) p3 = p; }
                        pa = sum8(pa); p3 = sum8(p3);
                        const int jb = 4 * (4 * kb + kt) + fq, tk = pr * 2 + (fr >> 3);
                        if ((fr & 7) == 0) { (void)__hip_atomic_fetch_add((LAS float*)imp + tk * 136 + jb, pa, __ATOMIC_RELAXED, __HIP_MEMORY_SCOPE_WORKGROUP);
                            (void)__hip_atomic_fetch_add((LAS float*)imp + tk * 136 + jb + 1, p3, __ATOMIC_RELAXED, __HIP_MEMORY_SCOPE_WORKGROUP); }
                    }
                }
            }
        }
        unsigned long long msk[2][2][2];
        {
            bool vl[4], vh[4]; unsigned ul[4], uh[4], T[4];
#pragma unroll
            for (int tk = 0; tk < 4; ++tk) {
                const int t = T0 + 4 * wave + tk, cur = t >> 6; const int jl = lane, jh = lane + 64;
                vl[tk] = jl <= cur; vh[tk] = jh <= cur;
                const bool fl = (jl == 0) || (jl == cur) || (jl == cur - 1), fh = (jh == cur) || (jh == cur - 1);
                ul[tk] = fl ? 0x7f800000u : __float_as_uint(imp[tk * 136 + jl]); uh[tk] = fh ? 0x7f800000u : __float_as_uint(imp[tk * 136 + jh]); T[tk] = 0u;
            }
            int cT[4];
#pragma unroll
            for (int tk = 0; tk < 4; ++tk) cT[tk] = __popcll(__ballot(vl[tk])) + __popcll(__ballot(vh[tk]));
#pragma unroll 1
            for (int bit = 30; bit >= 0; --bit) {
#pragma unroll
                for (int tk = 0; tk < 4; ++tk) { const unsigned cand = T[tk] | (1u << bit);
                    const int cnt = __popcll(__ballot(vl[tk] && ul[tk] >= cand)) + __popcll(__ballot(vh[tk] && uh[tk] >= cand));
                    if (cnt >= 16) { T[tk] = cand; cT[tk] = cnt; } }
                if (cT[0] <= 16 && cT[1] <= 16 && cT[2] <= 16 && cT[3] <= 16) break;
            }
#pragma unroll
            for (int tk = 0; tk < 4; ++tk) {
                const unsigned long long gtl = __ballot(vl[tk] && ul[tk] > T[tk]), gth = __ballot(vh[tk] && uh[tk] > T[tk]);
                const unsigned long long eql = __ballot(vl[tk] && ul[tk] == T[tk]), eqh = __ballot(vh[tk] && uh[tk] == T[tk]);
                const int need = 16 - (__popcll(gtl) + __popcll(gth));
                const unsigned long long lm = (1ull << lane) - 1ull;
                const int rl = __popcll(eql & lm), rh = __popcll(eql) + __popcll(eqh & lm);
                msk[tk >> 1][tk & 1][0] = gtl | __ballot(vl[tk] && ul[tk] == T[tk] && rl < need); msk[tk >> 1][tk & 1][1] = gth | __ballot(vh[tk] && uh[tk] == T[tk] && rh < need);
            }
        }
        const bf16_t* Kw = WSP(bf16_t, WS_KW) + (size_t)bg * 128 * 4096; const bf16_t* Vw = WSP(bf16_t, WS_VWT) + (size_t)bg * 128 * 4096;
        const int loW = T0 - 511 > 0 ? T0 - 511 : 0; const int jb0W = loW >> 6, jb1W = (T0 + 31) >> 6;
        const int wbase = (((curW >> 2) + 1) & 1) * 4;
        {
            const bf16_t* Ks = WSP(bf16_t, WS_KS) + (size_t)bg * 128 * 4096; const bf16_t* Vs = WSP(bf16_t, WS_VST) + (size_t)bg * 128 * 4096;
            NSA_ZERO_O();
            unsigned long long any[2][2], mine[2][2], both[2][2];
#pragma unroll
            for (int pr = 0; pr < 2; ++pr)
#pragma unroll
                for (int h = 0; h < 2; ++h) { any[pr][h] = msk[pr][0][h] | msk[pr][1][h]; both[pr][h] = msk[pr][0][h] & msk[pr][1][h]; mine[pr][h] = (fr >> 3) ? msk[pr][1][h] : msk[pr][0][h]; }
            const int ng = (curW >> 2) + 1;
            SH_BAR();
#pragma unroll
            for (int bb = 0; bb < 4; ++bb) if (bb <= curW) SH_ISSUE(Ks, Vs, bb, bb, true);
            for (int gi = 0; gi < ng; ++gi) {
                SH_WAIT_BAR();
                if (gi + 1 < ng) {
#pragma unroll
                    for (int bb = 0; bb < 4; ++bb) if (4 * (gi + 1) + bb <= curW) SH_ISSUE(Ks, Vs, 4 * (gi + 1) + bb, ((gi + 1) & 1) * 4 + bb, true);
                } else SH_ISSUE(Kw, Vw, jb0W, ((gi + 1) & 1) * 4, true);
#pragma unroll 1
                for (int bb = 0; bb < 4; ++bb) {
                    const int j = 4 * gi + bb; if (j > curW) break;
                    const int slot = (gi & 1) * 4 + bb;
                    const bool a0 = ((j < 64 ? (any[0][0] >> j) : (any[0][1] >> (j - 64))) & 1ull) != 0ull, a1 = ((j < 64 ? (any[1][0] >> j) : (any[1][1] >> (j - 64))) & 1ull) != 0ull;
#pragma unroll
                    for (int pr = 0; pr < 2; ++pr) if (pr == 0 ? a0 : a1) {
                        const bool colok = ((j < 64 ? (mine[pr][0] >> j) : (mine[pr][1] >> (j - 64))) & 1ull) != 0ull;
                        const bool bothsel = ((j < 64 ? (both[pr][0] >> j) : (both[pr][1] >> (j - 64))) & 1ull) != 0ull;
                        attn_step_lds(SH_SLOT(slot), qf[pr], j * 64, tcol[pr], -1, colok, bothsel, j * 64 + 63 <= t0[pr], O[pr], lsum[pr], lane, fq); }
                }
            }
#pragma unroll
            for (int pr = 0; pr < 2; ++pr) { float l = lsum[pr]; l += __shfl_xor(l, 16); l += __shfl_xor(l, 32); const float sc = l > 0.f ? g1[pr] / l : 0.f;
#pragma unroll
                for (int dt = 0; dt < 4; ++dt) out[pr][dt] += O[pr][dt] * sc; }
        }
        {
            NSA_ZERO_O();
            for (int jb = jb0W; jb <= jb1W; ++jb) {
                const int slot = wbase + ((jb - jb0W) & 1);
                SH_WAIT_BAR();
                if (jb < jb1W) SH_ISSUE(Kw, Vw, jb + 1, wbase + ((jb + 1 - jb0W) & 1), true);
#pragma unroll
                for (int pr = 0; pr < 2; ++pr) { const int lo = t0[pr] - 511 > 0 ? t0[pr] - 511 : 0;
                    if (jb >= (lo >> 6) && jb <= ((t0[pr] + 1) >> 6))
                        attn_step_lds(SH_SLOT(slot), qf[pr], jb * 64, tcol[pr], tcol[pr] - 512, true, true, jb * 64 > t0[pr] + 1 - 512 && jb * 64 + 63 <= t0[pr], O[pr], lsum[pr], lane, fq); }
            }
#pragma unroll
            for (int pr = 0; pr < 2; ++pr) { float l = lsum[pr]; l += __shfl_xor(l, 16); l += __shfl_xor(l, 32); const float sc = l > 0.f ? g2[pr] / l : 0.f;
#pragma unroll
                for (int dt = 0; dt < 4; ++dt) out[pr][dt] += O[pr][dt] * sc; }
        }
#pragma unroll
        for (int pr = 0; pr < 2; ++pr) { bf16_t* op = WSP(bf16_t, WS_RA) + tokc[pr] * 2048 + 1024 + head * 64 + 4 * fq;
#pragma unroll
            for (int dt = 0; dt < 4; ++dt) { u32x2 ov; ov.x = pk2(out[pr][dt][0], out[pr][dt][1]); ov.y = pk2(out[pr][dt][2], out[pr][dt][3]); *(u32x2*)(op + 16 * dt) = ov; } }
#undef NSA_ZERO_O
        {
#pragma unroll 1
            for (int r = kk * crpt; r < (kk + 1) * crpt && r < crounds; ++r) { const int item = c.gw + r * (c.G * NWAVES);
                if (item < cntot) { const bool nx = lconv >= 0 && item < CONV_ITEMS; const int i0 = nx ? item : item - (lconv >= 0 ? CONV_ITEMS : 0);
                    if (nx || !conv_is_early(i0)) conv_one(c, nx ? lconv : 0, i0); } }
        }
    }
#pragma unroll 1
    for (int r = kk * crpt; r < crounds; ++r) { const int item = c.gw + r * (c.G * NWAVES);
        if (item < cntot) { const bool nx = lconv >= 0 && item < CONV_ITEMS; const int i0 = nx ? item : item - (lconv >= 0 ? CONV_ITEMS : 0);
            if (nx || !conv_is_early(i0)) conv_one(c, nx ? lconv : 0, i0); } }
    SH_BAR();
#undef NSA_QCTR
}

__device__ __forceinline__ void phase_route(const Ctx& c, int l) {
    const int lane = c.lane, gw = c.gw, NW = c.G * NWAVES, fr = lane & 15, fq = lane >> 4;
    LAS int* cnt = (LAS int*)(c.lds + LDS_CTL_OFF + 64);
    if (c.tid < 32) cnt[c.tid] = 0;
    for (int i = blockIdx.x * NTHREADS + c.tid; i < XROWS; i += c.G * NTHREADS) WSP(int, WS_ROWTOK)[i] = 0;
    __syncthreads();
    const bf16_t* rwf = WSP(bf16_t, WS_RWF) + (size_t)l * 32 * 2 * 2 * 512 + lane * 8;
    const float b0 = c.router_b[(size_t)l * NEXP + fr], b1 = c.router_b[(size_t)l * NEXP + 16 + fr];
    for (int tile = gw; tile < NTOK / 16; tile += NW) {
        const int tok0 = tile * 16; const float* xr = (l == 0 ? c.x_in : (const float*)c.out) + (size_t)(tok0 + fr) * D + 4 * fq;
        const bf16_t* dr = WSP(bf16_t, WS_PROJ) + (size_t)(tok0 + fr) * D + 4 * fq;
        bf16_t* hrow = WSP(bf16_t, WS_H) + (size_t)(tok0 + fr) * D + 4 * fq;
        f32x4 acc0 = {0.f, 0.f, 0.f, 0.f}, acc1 = {0.f, 0.f, 0.f, 0.f}; float ss = 0.f;
#pragma unroll 1
        for (int kg = 0; kg < 8; ++kg) {
            f32x4 xa[4], xb[4]; u32x2 da[4], db[4]; bf16x8 wv[4][4];
#pragma unroll
            for (int u = 0; u < 4; ++u) { const int ks = kg * 4 + u; xa[u] = *(const f32x4*)(xr + 32 * ks); xb[u] = *(const f32x4*)(xr + 32 * ks + 16);
                da[u] = *(const u32x2*)(dr + 32 * ks); db[u] = *(const u32x2*)(dr + 32 * ks + 16);
#pragma unroll
                for (int q = 0; q < 4; ++q) wv[u][q] = ld8(rwf + ((size_t)ks * 4 + q) * 512); }
            __builtin_amdgcn_sched_barrier(0);
#pragma unroll
            for (int u = 0; u < 4; ++u) {
                float v[8] = {xa[u][0] + bflo(da[u].x), xa[u][1] + bfhi(da[u].x), xa[u][2] + bflo(da[u].y), xa[u][3] + bfhi(da[u].y),
                              xb[u][0] + bflo(db[u].x), xb[u][1] + bfhi(db[u].x), xb[u][2] + bflo(db[u].y), xb[u][3] + bfhi(db[u].y)}; float lo[8]; u32x4 hw, lw;
#pragma unroll
                for (int j = 0; j < 8; ++j) ss += v[j] * v[j];
#pragma unroll
                for (int j = 0; j < 4; ++j) { hw[j] = pk2(v[2 * j], v[2 * j + 1]); lo[2 * j] = v[2 * j] - bflo(hw[j]); lo[2 * j + 1] = v[2 * j + 1] - bfhi(hw[j]); }
#pragma unroll
                for (int j = 0; j < 4; ++j) lw[j] = pk2(lo[2 * j], lo[2 * j + 1]);
                const bf16x8 ah = mk8(hw), al = mk8(lw);
                { bf16_t* hp = hrow + 32 * (kg * 4 + u); u32x2 h0, h1; h0.x = hw[0]; h0.y = hw[1]; h1.x = hw[2]; h1.y = hw[3]; *(u32x2*)hp = h0; *(u32x2*)(hp + 16) = h1; }
                acc0 = mfma16(ah, wv[u][0], acc0); acc1 = mfma16(ah, wv[u][2], acc1);
                acc0 = mfma16(ah, wv[u][1], acc0); acc1 = mfma16(ah, wv[u][3], acc1);
                acc0 = mfma16(al, wv[u][0], acc0); acc1 = mfma16(al, wv[u][2], acc1);
            }
            MFMA_FENCE();
        }
        ss += __shfl_xor(ss, 16); ss += __shfl_xor(ss, 32);
        const float rs = rsqrtf(ss * (1.0f / 1024.0f) + NORM_EPS);
        if (fq == 0) WSP(float, WS_RSTD)[tok0 + fr] = rs;
#pragma unroll
        for (int r = 0; r < 4; ++r) {
            const float rt = __shfl(rs, 4 * fq + r);
            float v0 = acc0[r] * rt + b0, v1 = acc1[r] * rt + b1; float tv[4]; int te[4];
#pragma unroll
            for (int k = 0; k < 4; ++k) { float bv = v0; int be = fr; if (v1 > bv) { bv = v1; be = 16 + fr; }
#pragma unroll
                for (int o = 8; o >= 1; o >>= 1) { const float ov = __shfl_xor(bv, o); const int oe = __shfl_xor(be, o); if (ov > bv || (ov == bv && oe < be)) { bv = ov; be = oe; } }
                tv[k] = bv; te[k] = be; if (be == fr) v0 = -INFINITY; if (be == 16 + fr) v1 = -INFINITY; }
            const float e1 = expf(tv[1] - tv[0]), e2 = expf(tv[2] - tv[0]), e3 = expf(tv[3] - tv[0]); const float inv = 1.0f / (1.0f + e1 + e2 + e3);
            if (fr < 4) { const int e = fr == 0 ? te[0] : fr == 1 ? te[1] : fr == 2 ? te[2] : te[3]; const float wv_ = (fr == 0 ? 1.0f : fr == 1 ? e1 : fr == 2 ? e2 : e3) * inv;
                const int rk = atomicAdd((int*)&cnt[e], 1); const size_t o = (size_t)(tok0 + 4 * fq + r) * 4 + fr;
                WSP(int, WS_TE)[o] = e; WSP(float, WS_TW)[o] = wv_; WSP(int, WS_RANK)[o] = rk; }
        }
    }
    __syncthreads();
    if (c.tid < 32) WSP(int, WS_HIST)[blockIdx.x * 32 + c.tid] = cnt[c.tid];
    __syncthreads();
}

__device__ __forceinline__ void phase_scatter(const Ctx& c, int l) {
    const int lane = c.lane, gw = c.gw, NW = c.G * NWAVES;
    LAS int* hist = (LAS int*)c.lds;
    LAS int* part = (LAS int*)(c.lds + 65536);
    LAS int* base = part + 1024;
    LAS int* pst = base + 32;
    LAS int* nblk = pst + 40;
    for (int i = c.tid; i < c.G * 32; i += NTHREADS) hist[i] = WSP(int, WS_HIST)[i];
    __syncthreads();
    { const int e = c.tid & 31, p = c.tid >> 5, per = (c.G + 15) >> 4; const int w1 = (p + 1) * per < c.G ? (p + 1) * per : c.G; int before = 0, tot = 0;
      for (int w = p * per; w < w1; ++w) { const int v = hist[w * 32 + e]; if (w < (int)blockIdx.x) before += v; tot += v; }
      part[(p * 32 + e) * 2] = before; part[(p * 32 + e) * 2 + 1] = tot; }
    __syncthreads();
    if (c.tid < 32) { int before = 0, tot = 0;
#pragma unroll
        for (int p = 0; p < 16; ++p) { before += part[(p * 32 + c.tid) * 2]; tot += part[(p * 32 + c.tid) * 2 + 1]; }
        base[c.tid] = before; const int padded = (tot + 255) & ~255; int incl = padded;
#pragma unroll
        for (int o = 1; o < 32; o <<= 1) { const int t = __shfl_up(incl, o); if (c.tid >= o) incl += t; }
        pst[c.tid] = incl - padded; if (c.tid == 31) pst[32] = incl; nblk[c.tid] = padded >> 8; }
    __syncthreads();
    if (blockIdx.x == 0 && c.tid < 32) {
        int* meta = WSP(int, WS_META); const int e = c.tid, x = e & 7; int off = 0;
        for (int e2 = x; e2 < e; e2 += 8) off += nblk[e2];
        const int rb0 = pst[e] >> 8, nb = nblk[e];
        for (int i = 0; i < nb; ++i) { meta[64 + rb0 + i] = e; meta[1024 + 640 * x + off + i] = rb0 + i; }
        if (e >= 24) meta[16 + x] = off + nb;
        if (e == 0) meta[0] = pst[32] >> 8; }
    for (int tile = gw; tile < NTOK / 16; tile += NW) {
        const int o = tile * 64 + lane, tok = o >> 2;
        const int e = WSP(int, WS_TE)[o], rk = WSP(int, WS_RANK)[o];
        const int dst = pst[e] + base[e] + rk;
        WSP(int, WS_ROWTOK)[dst] = tok; WSP(float, WS_RSROW)[dst] = WSP(float, WS_RSTD)[tok]; WSP(int, WS_SLOT)[o] = dst;
    }
}

__device__ __forceinline__ void phase_combine(const Ctx& c, int l) {
    const int lane = c.lane, gw = c.gw, NW = c.G * NWAVES;
    for (int tok = gw; tok < NTOK; tok += NW) {
        float* xr = c.out + (size_t)tok * D; const bf16_t* hs = WSP(bf16_t, WS_H) + (size_t)tok * D;
        const u32x4 sl = *(const u32x4*)(WSP(int, WS_SLOT) + (size_t)tok * 4); const f32x4 tw = *(const f32x4*)(WSP(float, WS_TW) + (size_t)tok * 4);
        f32x4 v[4];
#pragma unroll
        for (int i = 0; i < 4; ++i) { const u32x2 d = *(const u32x2*)(hs + i * 256 + lane * 4); v[i][0] = bflo(d.x); v[i][1] = bfhi(d.x); v[i][2] = bflo(d.y); v[i][3] = bfhi(d.y); }
#pragma unroll
        for (int k = 0; k < 4; ++k) { const bf16_t* yr = WSP(bf16_t, WS_XBUF) + (size_t)sl[k] * D; const float w = tw[k];
#pragma unroll
            for (int i = 0; i < 4; ++i) { const u32x2 y = *(const u32x2*)(yr + i * 256 + lane * 4);
                v[i][0] += w * bflo(y.x); v[i][1] += w * bfhi(y.x); v[i][2] += w * bflo(y.y); v[i][3] += w * bfhi(y.y); } }
        float ss = 0.f;
#pragma unroll
        for (int i = 0; i < 4; ++i) { *(f32x4*)(xr + i * 256 + lane * 4) = v[i]; ss += v[i][0] * v[i][0] + v[i][1] * v[i][1] + v[i][2] * v[i][2] + v[i][3] * v[i][3]; }
        if (l + 1 < NL) {
            ss = wave_sum(ss); const float rs = rsqrtf(ss * (1.0f / 1024.0f) + NORM_EPS);
            const float* nw = c.norm1_w + (size_t)(l + 1) * D; bf16_t* hr = WSP(bf16_t, WS_H) + (size_t)tok * D;
#pragma unroll
            for (int i = 0; i < 4; ++i) { const f32x4 w = *(const f32x4*)(nw + i * 256 + lane * 4);
                u32x2 o; o.x = pk2(v[i][0] * rs * w[0], v[i][1] * rs * w[1]); o.y = pk2(v[i][2] * rs * w[2], v[i][3] * rs * w[3]); *(u32x2*)(hr + i * 256 + lane * 4) = o; }
        }
    }
}

constexpr int PH_PER_LAYER = 14, N_PHASES = 1 + NL * PH_PER_LAYER;
#ifndef PH_MASK
#define PH_MASK 0xffff
#endif
#define IN(k) (lo <= (k) && (k) < hi)
#define INL(j) (((PH_MASK >> ((j) + 1)) & 1) && IN(pb + (j)))
#define FRESH() do { int _t = threadIdx.x; asm volatile("" : "+v"(_t)); c.tid = _t; c.lane = _t & 63; c.wave = __builtin_amdgcn_readfirstlane(_t >> 6); c.gw = blockIdx.x * NWAVES + c.wave; } while (0)
#define SEAM(k) do { if (IN((k) + 1) || IN((k) + 2)) xcd_barrier(bar); else __syncthreads(); } while (0)

template <int l>
__device__ __forceinline__ void run_layer(Ctx& c, const XcdBarrier& bar, const int lo, const int hi) {
        const int pb = 1 + l * PH_PER_LAYER;
        if (INL(0)) { FRESH();
            g8::SchedPlain S{(const char*)WSP(bf16_t, WS_H), (const char*)(WSP(bf16_t, WS_WIN) + (size_t)l * NPROJ * D), (size_t)256 * D * 2, (size_t)256 * D * 2, NTOK / 256, NPROJ / 256, (NTOK / 256) * (NPROJ / 256), c.G, (int)blockIdx.x};
            g8::EpiBf16 E{WSP(bf16_t, WS_PROJ), NPROJ};
            g8::gemm_phase(c.lds, c.tid, D, D * 2, D * 2, S, E);
            SEAM(pb + 0);
        }
        if (INL(1)) { FRESH(); phase_prep(c, l); SEAM(pb + 1); }
        if (INL(2)) { FRESH();
            g8::SchedCmp S{(const char*)WSP(bf16_t, WS_KCT), (const char*)WSP(bf16_t, WS_VCT), (const char*)(WSP(bf16_t, WS_WC1) + (size_t)l * 2 * 256 * 2048), c.G, (int)blockIdx.x};
            g8::EpiSlab E{WSP(float, WS_ACT)};
            g8::gemm_phase(c.lds, c.tid, 256, 1024 * 2, 2048 * 2, S, E);
            SEAM(pb + 2);
        }
        if (INL(3)) { FRESH(); phase_cmp2(c, l); FRESH(); phase_scan(c); SEAM(pb + 3); }
        if (INL(5)) { FRESH(); phase_retout(c, l); FRESH(); phase_nsa(c, l, l + 1 < NL ? l + 1 : -1, l == 0); SEAM(pb + 5); }
        if (INL(7)) { FRESH();
            {
                g8::SchedPlain S{(const char*)WSP(bf16_t, WS_RA), (const char*)(WSP(bf16_t, WS_WO) + (size_t)l * D * 2048), (size_t)256 * 2048 * 2, (size_t)256 * 2048 * 2, NTOK / 256, D / 256, (NTOK / 256) * (D / 256), c.G, (int)blockIdx.x};
                g8::EpiGate E{WSP(bf16_t, WS_MIX), WSP(bf16_t, WS_PROJ), 0};
                g8::gemm_phase(c.lds, c.tid, D, 2048 * 2, 2048 * 2, S, E);
            }
            asm volatile("s_waitcnt vmcnt(0)" ::: "memory"); __syncthreads();
            {
                g8::SchedPlain S{(const char*)(WSP(bf16_t, WS_RA) + 1024), (const char*)(WSP(bf16_t, WS_WO) + (size_t)l * D * 2048 + 1024), (size_t)256 * 2048 * 2, (size_t)256 * 2048 * 2, NTOK / 256, D / 256, (NTOK / 256) * (D / 256), c.G, (int)blockIdx.x};
                g8::EpiGate E{WSP(bf16_t, WS_MIX), WSP(bf16_t, WS_PROJ), 1};
                g8::gemm_phase(c.lds, c.tid, D, 2048 * 2, 2048 * 2, S, E);
            }
            SEAM(pb + 7);
        }
        if (INL(8)) { FRESH();
            g8::SchedPlain S{(const char*)WSP(bf16_t, WS_MIX), (const char*)(WSP(bf16_t, WS_WOUT) + (size_t)l * D * D), (size_t)256 * D * 2, (size_t)256 * D * 2, NTOK / 256, D / 256, (NTOK / 256) * (D / 256), c.G, (int)blockIdx.x};
            g8::EpiBf16 E{WSP(bf16_t, WS_PROJ), D};
            g8::gemm_phase(c.lds, c.tid, D, D * 2, D * 2, S, E);
            SEAM(pb + 8);
        }
        if (INL(9)) { FRESH(); phase_route(c, l); SEAM(pb + 9); }
        if (INL(10)) { FRESH(); phase_scatter(c, l); SEAM(pb + 10); }
        if (INL(11)) { FRESH();
            LAS int* tab = (LAS int*)(c.lds + 131072); g8::moe_units(tab, WSP(int, WS_META), 8, c.G, (int)blockIdx.x, c.tid);
            g8::SchedMoeG S{(const char*)WSP(bf16_t, WS_H), (const char*)(WSP(bf16_t, WS_WGU) + (size_t)l * NEXP * 2048 * D), tab, 8, (size_t)2048 * D * 2, WSP(int, WS_ROWTOK)};
            g8::EpiSwiglu E{WSP(bf16_t, WS_ACT), c.b_gate_up + (size_t)l * NEXP * 2048, WSP(float, WS_RSROW), c.lds + 131072 + 8192};
            g8::gemm_phase(c.lds, c.tid, D, D * 2, D * 2, S, E);
            SEAM(pb + 11);
        }
        if (INL(12)) { FRESH();
            LAS int* tab = (LAS int*)(c.lds + 131072); g8::moe_units(tab, WSP(int, WS_META), 4, c.G, (int)blockIdx.x, c.tid);
            g8::SchedMoe S{(const char*)WSP(bf16_t, WS_ACT), (const char*)(WSP(bf16_t, WS_WD) + (size_t)l * NEXP * D * D), tab, 4, (size_t)D * D * 2};
            g8::EpiDown E{WSP(bf16_t, WS_XBUF), c.b_down + (size_t)l * NEXP * D};
            g8::gemm_phase(c.lds, c.tid, D, D * 2, D * 2, S, E);
            SEAM(pb + 12);
        }
        if (INL(13)) { FRESH(); phase_combine(c, l); SEAM(pb + 13); }
    }
__global__ void __launch_bounds__(NTHREADS, 2) mk_fwd(Args args) {
    extern __shared__ __attribute__((aligned(16))) unsigned char lds_raw[];
    Ctx c;
    c.x_in = args.in[0]; c.norm1_w = args.in[1]; c.w_in = args.in[2]; c.ret_gn_w = args.in[3]; c.qk_norm_w = args.in[4]; c.cmp_pos = args.in[5]; c.cmp_w1 = args.in[6]; c.cmp_w2 = args.in[7];
    c.w_o_ret = args.in[8]; c.w_o_nsa = args.in[9]; c.w_out = args.in[10]; c.norm2_w = args.in[11]; c.router_w = args.in[12]; c.router_b = args.in[13]; c.w_gate_up = args.in[14]; c.b_gate_up = args.in[15];
    c.w_down = args.in[16]; c.b_down = args.in[17];
    c.out = args.out; c.ws = args.ws; c.lds = (LAS unsigned char*)lds_raw;
    c.tid = threadIdx.x; c.lane = c.tid & 63; c.wave = __builtin_amdgcn_readfirstlane(c.tid >> 6); c.G = gridDim.x; c.gw = blockIdx.x * NWAVES + c.wave;
    volatile LAS unsigned* lctl = (volatile LAS unsigned*)(c.lds + LDS_CTL_OFF);
    if (c.tid < 16) lctl[c.tid] = 0u;
    __syncthreads();
    const int lo = args.ph_lo, hi = args.ph_hi;
    XcdBarrier bar; bar.bar = WSP(unsigned, WS_CTL); bar.x = 0; bar.st = lctl;
    if (hi - lo > 1) bar = xcd_barrier_post(WSP(unsigned, WS_CTL), lctl);
    if ((PH_MASK & 1) && IN(0)) { FRESH(); phase_prologue(c); SEAM(0); }

    run_layer<0>(c, bar, lo, hi); run_layer<1>(c, bar, lo, hi); run_layer<2>(c, bar, lo, hi); run_layer<3>(c, bar, lo, hi);
#undef IN
#undef INL
#undef SEAM
}


extern "C" void kernel_launch(void* const* d_in, const int* in_sizes, int n_in, void* d_out, int out_size, void* d_ws, size_t ws_size, hipStream_t stream) {
    static int grid = 0;
    if (grid == 0) {
        if (n_in != 18 || out_size != NTOK * D || ws_size < WS_END) { fprintf(stderr, "kernel_launch: unexpected shapes (n_in %d out %d ws %zu need %zu)\n", n_in, out_size, ws_size, (size_t)WS_END); grid = -1; return; }
        int dev = 0, cus = 0;
        if (hipGetDevice(&dev) != hipSuccess || hipDeviceGetAttribute(&cus, hipDeviceAttributeMultiprocessorCount, dev) != hipSuccess) { grid = -1; return; }
        if (hipFuncSetAttribute((const void*)mk_fwd, hipFuncAttributeMaxDynamicSharedMemorySize, LDS_BYTES) != hipSuccess) { fprintf(stderr, "kernel_launch: hipFuncSetAttribute failed\n"); grid = -1; return; }
        int per_cu = 0;
        if (hipOccupancyMaxActiveBlocksPerMultiprocessor(&per_cu, (const void*)mk_fwd, NTHREADS, LDS_BYTES) != hipSuccess || per_cu < 1) fprintf(stderr, "kernel_launch: occupancy query says %d\n", per_cu);
        (void)hipGetLastError();
        grid = cus;
    }
    if (grid < 0) return;
    (void)hipMemsetAsync((char*)d_ws + WS_CTL, 0, CTL_BYTES, stream);
    Args a{};
    for (int i = 0; i < 18; ++i) a.in[i] = (const float*)d_in[i];
    a.out = (float*)d_out; a.ws = (unsigned char*)d_ws;
#if MK_ONE_LAUNCH
    a.ph_lo = 0; a.ph_hi = N_PHASES;
    hipLaunchKernelGGL(mk_fwd, dim3(grid), dim3(NTHREADS), LDS_BYTES, stream, a);
#else
    for (int p = 0; p < N_PHASES; ++p) { a.ph_lo = p; a.ph_hi = p + 1; hipLaunchKernelGGL(mk_fwd, dim3(grid), dim3(NTHREADS), LDS_BYTES, stream, a); }
#endif
}
```

```cpp
#include <hip/hip_runtime.h>
#include <stdint.h>
#include <stdio.h>

#ifndef MK_ONE_LAUNCH
#define MK_ONE_LAUNCH 1
#endif

#define LAS __attribute__((address_space(3)))
typedef unsigned short bf16_t;
typedef short bf16x8 __attribute__((ext_vector_type(8)));
typedef float f32x4 __attribute__((ext_vector_type(4)));
typedef float f32x2 __attribute__((ext_vector_type(2)));
typedef unsigned u32x4 __attribute__((ext_vector_type(4)));
typedef unsigned u32x2 __attribute__((ext_vector_type(2)));

constexpr int D = 1024, NB = 4, SEQ = 8192, NTOK = NB * SEQ, NL = 4;
constexpr int NPROJ = 7168, IN_TOTAL = 6960;
constexpr int C_RQ = 0, C_RK = 512, C_RV = 1024, C_RG = 2048, C_NQ = 3072, C_KC = 4096, C_VC = 4224, C_KS = 4352, C_VS = 4480, C_KW = 4608, C_VW = 4736, C_NG = 4864, C_MG = 5120;
constexpr int NEXP = 32, XROWS = 139264;
constexpr int NWAVES = 8, NTHREADS = 512;
constexpr float NORM_EPS = 1e-6f;

constexpr size_t al256(size_t x) { return (x + 255) & ~(size_t)255; }
constexpr size_t WS_CTL = 0, CTL_BYTES = 65536;
constexpr size_t WS_HIST = WS_CTL + CTL_BYTES;
constexpr size_t WS_META = WS_HIST + 1024 * 32 * 4;
constexpr size_t WS_ROPER = WS_META + 32768;
constexpr size_t WS_ROPEN = WS_ROPER + (size_t)SEQ * 64 * 2 * 4;
constexpr size_t WS_PEB = WS_ROPEN + (size_t)SEQ * 8 * 2 * 4;
constexpr size_t WS_RWF = al256(WS_PEB + 8 * NL * 2 * 256 * 4);
constexpr size_t WS_RSTD = WS_RWF + (size_t)NL * 32 * 2 * 2 * 512 * 2;
constexpr size_t WS_WIN = al256(WS_RSTD + (size_t)NTOK * 4);
constexpr size_t WS_WO = WS_WIN + (size_t)NL * NPROJ * D * 2;
constexpr size_t WS_WOUT = WS_WO + (size_t)NL * D * 2048 * 2;
constexpr size_t WS_WC1 = WS_WOUT + (size_t)NL * D * D * 2;
constexpr size_t WS_WGU = WS_WC1 + (size_t)NL * 2 * 256 * 2048 * 2;
constexpr size_t WS_WD = WS_WGU + (size_t)NL * NEXP * 2048 * D * 2;
constexpr size_t WS_H = WS_WD + (size_t)NL * NEXP * D * D * 2;
constexpr size_t WS_PROJ = WS_H + (size_t)NTOK * D * 2;
constexpr size_t WS_QR = WS_PROJ + (size_t)NTOK * NPROJ * 2;
constexpr size_t WS_KR = WS_QR + (size_t)NTOK * 512 * 2;
constexpr size_t WS_KZT = WS_KR + (size_t)NTOK * 512 * 2;
constexpr size_t WS_VT = WS_KZT + (size_t)NTOK * 512 * 2;
constexpr size_t WS_RT = WS_VT + (size_t)NTOK * 1024 * 2;
constexpr size_t WS_QN = WS_RT + (size_t)16 * 64 * 256 * 128 * 2;
constexpr size_t WS_KS = WS_QN + (size_t)NTOK * 1024 * 2;
constexpr size_t WS_VST = WS_KS + (size_t)NTOK * 128 * 2;
constexpr size_t WS_KW = WS_VST + (size_t)NTOK * 128 * 2;
constexpr size_t WS_VWT = WS_KW + (size_t)NTOK * 128 * 2;
constexpr size_t WS_KCT = WS_VWT + (size_t)NTOK * 128 * 2;
constexpr size_t WS_VCT = WS_KCT + (size_t)NTOK * 128 * 2 + 4096;
constexpr size_t WS_HID = WS_VCT + (size_t)NTOK * 128 * 2 + 4096;
constexpr size_t WS_KCMP = WS_HID + (size_t)2 * 8 * 512 * 256 * 2;
constexpr size_t WS_VCMPT = WS_KCMP + (size_t)8 * 512 * 64 * 2;
constexpr size_t WS_RA = WS_VCMPT + (size_t)8 * 512 * 64 * 2;
constexpr size_t WS_MIX = WS_RA + (size_t)NTOK * 2048 * 2;
constexpr size_t WS_TE = WS_MIX + (size_t)NTOK * D * 2;
constexpr size_t WS_TW = WS_TE + (size_t)NTOK * 16;
constexpr size_t WS_RANK = WS_TW + (size_t)NTOK * 16;
constexpr size_t WS_SLOT = WS_RANK + (size_t)NTOK * 16;
constexpr size_t WS_ROWTOK = WS_SLOT + (size_t)NTOK * 16;
constexpr size_t WS_RSROW = WS_ROWTOK + (size_t)XROWS * 4;
constexpr size_t WS_XBUF = al256(WS_RSROW + (size_t)XROWS * 4);
constexpr size_t WS_ACT = WS_XBUF + (size_t)XROWS * D * 2;
constexpr size_t WS_END = WS_ACT + (size_t)XROWS * D * 2;

constexpr int LDS_SCRATCH = 149504;
constexpr int LDS_CTL_OFF = LDS_SCRATCH;
constexpr int LDS_BYTES = LDS_SCRATCH + 1024;

__device__ __forceinline__ float bf2f(bf16_t v) { return __uint_as_float(((unsigned)v) << 16); }
__device__ __forceinline__ float bflo(unsigned w) { return __uint_as_float(w << 16); }
__device__ __forceinline__ float bfhi(unsigned w) { return __uint_as_float(w & 0xffff0000u); }
__device__ __forceinline__ unsigned f2bf(float f) { unsigned u = __float_as_uint(f); return (u + 0x7fffu + ((u >> 16) & 1u)) >> 16; }
typedef __bf16 bf16x2_t __attribute__((ext_vector_type(2)));
__device__ __forceinline__ unsigned pk2(float lo, float hi) { const f32x2 v = {lo, hi}; const bf16x2_t r = __builtin_convertvector(v, bf16x2_t); return __builtin_bit_cast(unsigned, r); }
__device__ __forceinline__ float fexp2(float x) { return __builtin_amdgcn_exp2f(x); }
__device__ __forceinline__ float frcp(float x) { return __builtin_amdgcn_rcpf(x); }
__device__ __forceinline__ float sigmoidf_(float x) { return frcp(1.0f + fexp2(-1.4426950408889634f * x)); }
__device__ __forceinline__ bf16x8 mk8(u32x4 v) { return __builtin_bit_cast(bf16x8, v); }
__device__ __forceinline__ bf16x8 ld8(const bf16_t* p) { return __builtin_bit_cast(bf16x8, *(const u32x4*)p); }
__device__ __forceinline__ f32x4 mfma16(bf16x8 a, bf16x8 b, f32x4 c) { return __builtin_amdgcn_mfma_f32_16x16x32_bf16(a, b, c, 0, 0, 0); }
#define MFMA_FENCE() do { __builtin_amdgcn_sched_barrier(0); asm volatile("s_nop 7\n\ts_nop 7" ::: "memory"); __builtin_amdgcn_sched_barrier(0); } while (0)
__device__ __forceinline__ float sum8(float v) { v += __int_as_float(__builtin_amdgcn_update_dpp(0, __float_as_int(v), 0xB1, 0xf, 0xf, true));
    v += __int_as_float(__builtin_amdgcn_update_dpp(0, __float_as_int(v), 0x4E, 0xf, 0xf, true)); v += __int_as_float(__builtin_amdgcn_update_dpp(0, __float_as_int(v), 0x141, 0xf, 0xf, true)); return v; }
__device__ __forceinline__ float wave_sum(float v) {
#pragma unroll
    for (int o = 32; o >= 1; o >>= 1) v += __shfl_xor(v, o);
    return v;
}

#define XB_TMO      128
#define XB_XCNT(j)  (256  + 64 * (j))
#define XB_XSUB(j)  (1280 + 64 * (j))
#define XB_XGEN(j)  (2304 + 64 * (j))
#define XB_TOP      3328
#define XB_TOPGEN   3392
#define XCD_BAR_WORDS 3456
#define XB_SPIN_CAP (1u << 18)
__device__ __forceinline__ unsigned xb_ld(unsigned* p)              { return __hip_atomic_load(p, __ATOMIC_RELAXED, __HIP_MEMORY_SCOPE_AGENT); }
__device__ __forceinline__ unsigned xb_add(unsigned* p, unsigned v) { return __hip_atomic_fetch_add(p, v, __ATOMIC_RELAXED, __HIP_MEMORY_SCOPE_AGENT); }
__device__ __forceinline__ unsigned xb_xcc_id() { return (unsigned)__builtin_amdgcn_s_getreg((3 << 11) | 20) & 0xFu; }
#define XB_SPIN(cond, bar) do { unsigned _sp = 0; while (cond) { __builtin_amdgcn_s_sleep(1); \
    if ((++_sp & 255u) == 0u) { if (xb_ld(&(bar)[XB_TMO])) break; if (_sp > XB_SPIN_CAP) { atomicAdd(&(bar)[XB_TMO], 1u); break; } } } } while (0)
struct XcdBarrier { unsigned* bar; unsigned x; volatile LAS unsigned* st; };
__device__ __forceinline__ XcdBarrier xcd_barrier_post(unsigned* bar, volatile LAS unsigned* st) {
    XcdBarrier b; b.bar = bar; b.x = xb_xcc_id(); b.st = st;
    if (threadIdx.x == 0) (void)xb_add(&bar[XB_XCNT(b.x)], 1u);
    return b;
}
__device__ __forceinline__ void xcd_barrier_complete(unsigned* bar, unsigned x, unsigned& nloc, unsigned& nx) {
    const unsigned G = gridDim.x * gridDim.y * gridDim.z;
    unsigned sum, cnt, mine, sp = 0u;
    for (;;) {
        sum = 0u; cnt = 0u; mine = 0u;
#pragma unroll
        for (unsigned j = 0; j < 16; ++j) { const unsigned c = xb_ld(&bar[XB_XCNT(j)]); sum += c; cnt += (c > 0u) ? 1u : 0u; mine = (j == x) ? c : mine; }
        if (sum == G) break;
        __builtin_amdgcn_s_sleep(1);
        if ((++sp & 255u) == 0u) { if (xb_ld(&bar[XB_TMO])) break; if (sp > XB_SPIN_CAP) { atomicAdd(&bar[XB_TMO], 1u); break; } }
    }
    nloc = mine > 0u ? mine : 1u; nx = cnt > 0u ? cnt : 1u;
}
__device__ __forceinline__ void xcd_barrier(const XcdBarrier& b) {
    asm volatile("s_waitcnt vmcnt(0)" ::: "memory");
    __syncthreads();
    if (threadIdx.x == 0) {
        unsigned* bar = b.bar;
        __builtin_amdgcn_s_waitcnt(0);
        unsigned nloc = b.st[0], nx = b.st[1];
        if (nloc == 0u) { xcd_barrier_complete(bar, b.x, nloc, nx); b.st[0] = nloc; b.st[1] = nx; }
        const unsigned old = xb_add(&bar[XB_XSUB(b.x)], 1u);
        const unsigned gen = old / nloc;
        if (old + 1u == (gen + 1u) * nloc) {
            __builtin_amdgcn_fence(__ATOMIC_RELEASE, "agent");
            asm volatile("s_waitcnt vmcnt(0)" ::: "memory");
            const unsigned og = xb_add(&bar[XB_TOP], 1u);
            const unsigned tg = og / nx;
            if (og + 1u == (tg + 1u) * nx) xb_add(&bar[XB_TOPGEN], 1u);
            else XB_SPIN(xb_ld(&bar[XB_TOPGEN]) == tg, bar);
            __builtin_amdgcn_fence(__ATOMIC_ACQUIRE, "agent");
            xb_add(&bar[XB_XGEN(b.x)], 1u);
            asm volatile("s_waitcnt vmcnt(0)" ::: "memory");
        } else {
            XB_SPIN(xb_ld(&bar[XB_XGEN(b.x)]) == gen, bar);
            __builtin_amdgcn_fence(__ATOMIC_ACQUIRE, "agent");
            asm volatile("s_waitcnt vmcnt(0)" ::: "memory");
        }
    }
    __syncthreads();
}

struct Args { const float* in[18]; float* out; unsigned char* ws; int ph_lo, ph_hi; };
struct Ctx {
    const float *x_in, *norm1_w, *w_in, *ret_gn_w, *qk_norm_w, *cmp_pos, *cmp_w1, *cmp_w2, *w_o_ret, *w_o_nsa, *w_out, *norm2_w, *router_w, *router_b, *w_gate_up, *b_gate_up, *w_down, *b_down;
    float* out; unsigned char* ws; LAS unsigned char* lds;
    int tid, lane, wave, gw, G;
};
#define WSP(T, off) ((T*)(c.ws + (off)))

namespace g8 {
constexpr int BM = 256, BK = 64, HALF = 128, HTB = HALF * BK * 2, STAGE_BYTES = 8 * HTB, NXCD = 8, WGM = 8;
__device__ __forceinline__ int lds_byte(int r, int c) { const int st = (r >> 4) * 2 + (c >> 5), rr = r & 15, cc = c & 31, ob = rr * 64 + cc * 2; return st * 1024 + (ob ^ (((ob >> 9) & 1) << 5)); }
__device__ __forceinline__ void stage_rc(int b, int& R, int& C) { const int st = b / 1024, sb = b % 1024, swz = sb ^ (((sb >> 9) & 1) << 5); R = (st >> 1) * 16 + swz / 64; C = (st & 1) * 32 + (swz % 64) / 2; }
__device__ __forceinline__ int perm32(int rho) { const int n = rho >> 4, i = rho & 15; return 8 * (i >> 2) + 4 * n + (i & 3); }

struct Unit { const char* A; const char* B; int pm, pn, e; };

struct SchedPlain {
    static constexpr bool GATHER = false;
    const char* A; const char* B; size_t tA, tB; int nM, nN, nwg, G, c;
    __device__ __forceinline__ bool next(int i, Unit& u) const {
        const long L = (long)i * G + c; if (L >= nwg) return false;
        int wgid = (int)L; { const int q = nwg / NXCD, r = nwg % NXCD, xcd = wgid % NXCD, off = wgid / NXCD; wgid = (xcd < r ? xcd * (q + 1) : r * (q + 1) + (xcd - r) * q) + off; }
        const int nig = WGM * nN, gid = wgid / nig, fm = gid * WGM, gsz = (nM - fm) < WGM ? (nM - fm) : WGM;
        u.pm = fm + ((wgid % nig) % gsz); u.pn = (wgid % nig) / gsz; u.e = 0;
        u.A = A + (size_t)u.pm * tA; u.B = B + (size_t)u.pn * tB; return true;
    }
};
struct SchedCmp {         static constexpr bool GATHER = false;
    const char* KCT; const char* VCT; const char* W; int G, c;
    __device__ __forceinline__ bool next(int i, Unit& u) const {
        const int idx = i * G + c; if (idx >= 256) return false;
        const int ksl = idx & 7, r = idx >> 3, kv = r >> 4, bg = (r >> 1) & 7, half = r & 1;
        u.A = (kv ? VCT : KCT) + ((size_t)bg * SEQ * 64 + (size_t)half * 256 * 1024 + (size_t)ksl * 256) * 2;
        u.B = W + ((size_t)kv * 256 * 2048 + (size_t)ksl * 256) * 2; u.pm = (kv * 8 + bg) * 2 + half; u.pn = 0; u.e = ksl; return true;
    }
};
struct SchedMoe {
    static constexpr bool GATHER = false;
    const char* A; const char* W; const LAS int* tab; int NT; size_t wstride;
    __device__ __forceinline__ bool next(int i, Unit& u) const {
        const int v = __builtin_amdgcn_readfirstlane(tab[i]); if (v < 0) return false;
        const int rb = v & 0xfff, pn = (v >> 12) & 0xf, e = v >> 16;
        u.A = A + (size_t)rb * 256 * 1024 * 2; u.B = W + (size_t)e * wstride + (size_t)pn * 256 * 1024 * 2; u.pm = rb; u.pn = pn; u.e = e; return true;
    }
};
struct SchedMoeG {
    static constexpr bool GATHER = true;
    const char* A; const char* W; const LAS int* tab; int NT; size_t wstride; const int* rowtok;
    __device__ __forceinline__ bool next(int i, Unit& u) const {
        const int v = __builtin_amdgcn_readfirstlane(tab[i]); if (v < 0) return false;
        const int rb = v & 0xfff, pn = (v >> 12) & 0xf, e = v >> 16;
        u.A = A; u.B = W + (size_t)e * wstride + (size_t)pn * 256 * 1024 * 2; u.pm = rb; u.pn = pn; u.e = e; return true;
    }
};
__device__ __forceinline__ void moe_units(LAS int* tab, const int* meta, const int NT, const int G, const int c, const int tid) {
    if (tid < 256) {
        int v = -1; const int i = tid;
        if ((G & 7) == 0) { const int x = c & 7, q = i * (G >> 3) + (c >> 3); const int nb = meta[16 + x];
            if (q < nb * NT) { const int rbi = q / NT, pn = q - rbi * NT, rb = meta[1024 + 640 * x + rbi]; v = rb | (pn << 12) | (meta[64 + rb] << 16); } }
        else { const int idx = i * G + c; const int nblk = meta[0]; if (idx < nblk * NT) { const int rb = idx / NT, pn = idx - rb * NT; v = rb | (pn << 12) | (meta[64 + rb] << 16); } }
        tab[i] = v;
    }
    __syncthreads();
}

typedef f32x4 Acc[2][2][4][2];

struct EpiBf16 {
    struct Pre {}; __device__ __forceinline__ void pre(Pre&, const Unit&, int, int, int, int) const {}
    static constexpr bool PERM = true;
    bf16_t* O; int ldc;
    __device__ __forceinline__ void operator()(const Acc& acc, const Unit& u, int wr, int wc, int fr, int fq, const Pre&) const {
        const int row0 = u.pm * BM + wr * 64 + fr, col0 = u.pn * BM + wc * 32 + 8 * fq;
#pragma unroll
        for (int ai = 0; ai < 2; ++ai)
#pragma unroll
            for (int m = 0; m < 4; ++m) { bf16_t* rowp = O + (size_t)(row0 + ai * HALF + m * 16) * ldc + col0;
#pragma unroll
                for (int bj = 0; bj < 2; ++bj) { const f32x4 v0 = acc[ai][bj][m][0], v1 = acc[ai][bj][m][1];
                    u32x4 w; w.x = pk2(v0[0], v0[1]); w.y = pk2(v0[2], v0[3]); w.z = pk2(v1[0], v1[1]); w.w = pk2(v1[2], v1[3]);
                    *(u32x4*)(rowp + bj * HALF) = w; } }
    }
};
struct EpiSlab {
    struct Pre {}; __device__ __forceinline__ void pre(Pre&, const Unit&, int, int, int, int) const {}
    static constexpr bool PERM = false;
    float* O;
    __device__ __forceinline__ void operator()(const Acc& acc, const Unit& u, int wr, int wc, int fr, int fq, const Pre&) const {
        const int row0 = u.pm * BM + wr * 64 + fr, col0 = wc * 32 + 4 * fq;
        float* base = O + (size_t)u.e * 8192 * 256;
#pragma unroll
        for (int ai = 0; ai < 2; ++ai)
#pragma unroll
            for (int m = 0; m < 4; ++m) { const size_t off = (size_t)(row0 + ai * HALF + m * 16) * 256 + col0;
#pragma unroll
                for (int bj = 0; bj < 2; ++bj)
#pragma unroll
                    for (int n = 0; n < 2; ++n) *(f32x4*)(base + off + bj * HALF + n * 16) = acc[ai][bj][m][n]; }
    }
};
struct EpiGate {
    struct Pre {}; __device__ __forceinline__ void pre(Pre&, const Unit&, int, int, int, int) const {}
    static constexpr bool PERM = true;
    bf16_t* O; const bf16_t* proj; int second;
    __device__ __forceinline__ void operator()(const Acc& acc, const Unit& u, int wr, int wc, int fr, int fq, const Pre&) const {
        const int row0 = u.pm * BM + wr * 64 + fr, col0 = u.pn * BM + wc * 32 + 8 * fq;
#pragma unroll
        for (int ai = 0; ai < 2; ++ai)
#pragma unroll
            for (int m = 0; m < 4; ++m) { const size_t row = (size_t)(row0 + ai * HALF + m * 16); const bf16_t* rp = proj + row * NPROJ + C_MG + (second ? 1024 : 0) + col0;
#pragma unroll
                for (int bj = 0; bj < 2; ++bj) { const u32x4 wb = *(const u32x4*)(rp + bj * HALF); u32x4 prev = {0u, 0u, 0u, 0u};
                    if (second) prev = *(const u32x4*)(O + row * D + col0 + bj * HALF);
                    float o[8];
#pragma unroll
                    for (int j = 0; j < 8; ++j) { const unsigned ub = wb[j >> 1], up = prev[j >> 1]; const float b = (j & 1) ? bfhi(ub) : bflo(ub), pv = (j & 1) ? bfhi(up) : bflo(up);
                        o[j] = pv + (j < 4 ? acc[ai][bj][m][0][j] : acc[ai][bj][m][1][j - 4]) * sigmoidf_(b); }
                    u32x4 w; w.x = pk2(o[0], o[1]); w.y = pk2(o[2], o[3]); w.z = pk2(o[4], o[5]); w.w = pk2(o[6], o[7]);
                    *(u32x4*)(O + row * D + col0 + bj * HALF) = w; } }
    }
};
struct EpiSwiglu {
    static constexpr bool PERM = true;
    bf16_t* O; const float* bgu;
    const float* rsrow;
    LAS unsigned char* rsl;
    struct Pre {};
    __device__ __forceinline__ void pre(Pre&, const Unit& u, int wc, int fq, int wid, int lane) const {
        LAS unsigned char* my = rsl + wid * 768;
        const float* rp = rsrow + u.pm * BM + (wid >> 2) * 64 + lane;
        __builtin_amdgcn_global_load_lds((const unsigned*)rp, (LAS unsigned*)my, 4, 0, 0);
        __builtin_amdgcn_global_load_lds((const unsigned*)(rp + HALF), (LAS unsigned*)(my + 256), 4, 0, 0);
        const float* bp = bgu + (size_t)u.e * 2048 + u.pn * 128 + wc * 32 + (lane & 31) + (lane >> 5) * 1024;
        __builtin_amdgcn_global_load_lds((const unsigned*)bp, (LAS unsigned*)(my + 512), 4, 0, 0); }
    __device__ __forceinline__ void operator()(const Acc& acc, const Unit& u, int wr, int wc, int fr, int fq, const Pre&) const {
        const int row0 = u.pm * BM + wr * 64 + fr, col0 = u.pn * 128 + wc * 32 + 8 * fq;
        const LAS unsigned char* my = rsl + (wr * 4 + wc) * 768;
        const f32x4 g0 = *(const LAS f32x4*)(my + 512 + 32 * fq), g1 = *(const LAS f32x4*)(my + 512 + 32 * fq + 16), u0 = *(const LAS f32x4*)(my + 640 + 32 * fq), u1 = *(const LAS f32x4*)(my + 640 + 32 * fq + 16);
#pragma unroll
        for (int ai = 0; ai < 2; ++ai)
#pragma unroll
            for (int m = 0; m < 4; ++m) { float o[8]; const float rs = *(const LAS float*)(my + ai * 256 + (m * 16 + fr) * 4);
#pragma unroll
                for (int j = 0; j < 8; ++j) {
                    float gv = (j < 4 ? acc[ai][0][m][0][j] * rs + g0[j] : acc[ai][0][m][1][j - 4] * rs + g1[j - 4]);
                    float uv = (j < 4 ? acc[ai][1][m][0][j] * rs + u0[j] : acc[ai][1][m][1][j - 4] * rs + u1[j - 4]);
                    gv = fminf(gv, 7.0f); uv = fminf(fmaxf(uv, -7.0f), 7.0f);
                    const float glu = gv * frcp(1.0f + fexp2(-1.702f * 1.4426950408889634f * gv)); o[j] = (uv + 1.0f) * glu; }
                u32x4 w; w.x = pk2(o[0], o[1]); w.y = pk2(o[2], o[3]); w.z = pk2(o[4], o[5]); w.w = pk2(o[6], o[7]);
                *(u32x4*)(O + (size_t)(row0 + ai * HALF + m * 16) * D + col0) = w; }
    }
};
struct EpiDown {
    static constexpr bool PERM = true;
    bf16_t* O; const float* bd;
    struct Pre { f32x4 b[2][2]; };
    __device__ __forceinline__ void pre(Pre& p, const Unit& u, int wc, int fq, int wid, int lane) const { const float* bp = bd + (size_t)u.e * D + u.pn * BM + wc * 32 + 8 * fq;
#pragma unroll
        for (int bj = 0; bj < 2; ++bj) { p.b[bj][0] = *(const f32x4*)(bp + bj * HALF); p.b[bj][1] = *(const f32x4*)(bp + bj * HALF + 4); } }
    __device__ __forceinline__ void operator()(const Acc& acc, const Unit& u, int wr, int wc, int fr, int fq, const Pre& p) const {
        const int row0 = u.pm * BM + wr * 64 + fr, col0 = u.pn * BM + wc * 32 + 8 * fq;
#pragma unroll
        for (int bj = 0; bj < 2; ++bj) { const f32x4 b0 = p.b[bj][0], b1 = p.b[bj][1];
#pragma unroll
            for (int ai = 0; ai < 2; ++ai)
#pragma unroll
                for (int m = 0; m < 4; ++m) { const f32x4 v0 = acc[ai][bj][m][0] + b0, v1 = acc[ai][bj][m][1] + b1;
                    u32x4 w; w.x = pk2(v0[0], v0[1]); w.y = pk2(v0[2], v0[3]); w.z = pk2(v1[0], v1[1]); w.w = pk2(v1[2], v1[3]);
                    *(u32x4*)(O + (size_t)(row0 + ai * HALF + m * 16) * D + col0 + bj * HALF) = w; } }
    }
};

template <class Epi, class Sched>
__device__ __forceinline__ void gemm_phase(LAS unsigned char* lds, const int tid, const int K, const unsigned lda, const unsigned ldb, const Sched& S, const Epi& E) {
    const int wid = __builtin_amdgcn_readfirstlane(tid >> 6), lane = tid & 63, wr = wid >> 2, wc = wid & 3, fr = lane & 15, fq = lane >> 4;
    const int nt = K / BK;
    unsigned voffA[2], voffB[2]; int Rs[2];
#pragma unroll
    for (int i = 0; i < 2; ++i) { int R, C; stage_rc(tid * 16 + i * 8192, R, C); const int Rb = Epi::PERM ? ((R & ~31) + perm32(R & 31)) : R; Rs[i] = R;
        voffA[i] = Sched::GATHER ? (unsigned)C * 2u : (unsigned)R * lda + (unsigned)C * 2u; voffB[i] = (unsigned)Rb * ldb + (unsigned)C * 2u; }
    unsigned offc[2][2] = {{0u, 0u}, {0u, 0u}}, offn[2][2] = {{0u, 0u}, {0u, 0u}};
    const size_t kstep = (size_t)(BK * 2);
    const size_t hstepA = (size_t)HALF * lda, hstepB = (size_t)HALF * ldb;
    const unsigned ldsw = (unsigned)wid * 1024u;
    const int aoff = lds_byte(wr * 64 + fr, fq * 8), boff = lds_byte(wc * 32 + fr, fq * 8);
#define G8_SA(b, h) (((b) * 2 + (h)) * HTB)
#define G8_SB(b, h) ((4 + (b) * 2 + (h)) * HTB)
#define G8_STAGE(bufoff, gbase, voff) do { _Pragma("unroll") for (int _i = 0; _i < 2; ++_i) \
        __builtin_amdgcn_global_load_lds((const unsigned*)((const char*)(gbase) + (voff)[_i]), (LAS unsigned*)(lds + (bufoff) + ldsw + _i * 8192), 16, 0, 0); } while (0)
#define G8_STAGEA(bufoff, kt, h, nx) do { _Pragma("unroll") for (int _i = 0; _i < 2; ++_i) { \
        const char* _g = Sched::GATHER ? (cA + (size_t)(kt) * kstep + ((nx) ? offn[h][_i] : offc[h][_i]) + voffA[_i]) : (((nx) ? nA : cA) + (size_t)(kt) * kstep + (size_t)(h) * hstepA + voffA[_i]); \
        __builtin_amdgcn_global_load_lds((const unsigned*)_g, (LAS unsigned*)(lds + (bufoff) + ldsw + _i * 8192), 16, 0, 0); } } while (0)
#define G8_LOADOFF(dst, un) do { if constexpr (Sched::GATHER) { _Pragma("unroll") for (int _h = 0; _h < 2; ++_h) _Pragma("unroll") for (int _i = 0; _i < 2; ++_i) \
        dst[_h][_i] = (unsigned)S.rowtok[(un).pm * 256 + _h * 128 + Rs[_i]] * (unsigned)(D * 2); } } while (0)
#define G8_LDA(dst, b, h) do { _Pragma("unroll") for (int m = 0; m < 4; ++m) _Pragma("unroll") for (int k = 0; k < 2; ++k) dst[m][k] = *(const LAS bf16x8*)(lds + G8_SA(b, h) + aoff + m * 2048 + k * 1024); } while (0)
#define G8_LDB(dst, b, h) do { _Pragma("unroll") for (int n = 0; n < 2; ++n) _Pragma("unroll") for (int k = 0; k < 2; ++k) dst[n][k] = *(const LAS bf16x8*)(lds + G8_SB(b, h) + boff + n * 2048 + k * 1024); } while (0)
#define G8_MMA(ai, bj, At, Bt) do { __builtin_amdgcn_s_setprio(1); _Pragma("unroll") for (int m = 0; m < 4; ++m) _Pragma("unroll") for (int n = 0; n < 2; ++n) _Pragma("unroll") for (int k = 0; k < 2; ++k) \
        acc[ai][bj][m][n] = __builtin_amdgcn_mfma_f32_16x16x32_bf16(Bt[n][k], At[m][k], acc[ai][bj][m][n], 0, 0, 0); __builtin_amdgcn_s_setprio(0); } while (0)
#define G8_WAIT_V(n) asm volatile("s_waitcnt vmcnt(" #n ")" ::: "memory")
#define G8_WAIT_L(n) asm volatile("s_waitcnt lgkmcnt(" #n ")" ::: "memory")
#define G8_BAR __builtin_amdgcn_s_barrier()
#define G8_SCHED __builtin_amdgcn_sched_barrier(0)
    Unit cur, nxt; int ui = 0;
    if (!S.next(0, cur)) return;
    Acc acc;
#pragma unroll
    for (int a = 0; a < 2; ++a)
#pragma unroll
        for (int b = 0; b < 2; ++b)
#pragma unroll
            for (int m = 0; m < 4; ++m)
#pragma unroll
                for (int n = 0; n < 2; ++n) acc[a][b][m][n] = (f32x4){0.f, 0.f, 0.f, 0.f};
    bf16x8 At[4][2], B0[2][2], B1[2][2];
    const char* cA = cur.A; const char* cB = cur.B; const char* nA = cA;
    typename Epi::Pre epre; E.pre(epre, cur, wc, fq, wid, lane);
    G8_LOADOFF(offc, cur);
    if constexpr (Sched::GATHER) asm volatile("s_waitcnt vmcnt(0)" ::: "memory");
    G8_STAGE(G8_SB(0, 0), cB, voffB); G8_STAGEA(G8_SA(0, 0), 0, 0, false); G8_STAGE(G8_SB(0, 1), cB + hstepB, voffB); G8_STAGEA(G8_SA(0, 1), 0, 1, false);
    if (wr == 1) G8_BAR;
    G8_WAIT_V(4); G8_BAR;
    G8_STAGE(G8_SB(1, 0), cB + kstep, voffB); G8_STAGEA(G8_SA(1, 0), 1, 0, false); G8_STAGE(G8_SB(1, 1), cB + hstepB + kstep, voffB);
    G8_WAIT_V(6); G8_BAR;
    for (;;) {
        const bool has_next = S.next(ui + 1, nxt);
        nA = has_next ? nxt.A : cA; const char* nB = has_next ? nxt.B : cB;
        if (has_next) G8_LOADOFF(offn, nxt);
        else { _Pragma("unroll") for (int _h = 0; _h < 2; ++_h) _Pragma("unroll") for (int _i = 0; _i < 2; ++_i) offn[_h][_i] = offc[_h][_i]; }
        for (int t = 0; t < nt; t += 2) {
            const bool last = (t == nt - 2);
            const char* b2 = last ? nB : cB + (size_t)(t + 2) * kstep;
            const char* b3 = b2 + kstep;
            const int k2 = last ? 0 : t + 2, k3 = last ? 1 : t + 3;
            G8_LDB(B0, 0, 0); G8_SCHED; G8_LDA(At, 0, 0); G8_STAGEA(G8_SA(1, 1), t + 1, 1, false);
            G8_WAIT_L(8); G8_BAR; G8_WAIT_L(0); G8_MMA(0, 0, At, B0); G8_BAR; G8_SCHED;
            G8_LDB(B1, 0, 1); G8_STAGE(G8_SB(0, 0), b2, voffB);
            G8_BAR; G8_WAIT_L(0); G8_MMA(0, 1, At, B1); G8_BAR;
            G8_LDA(At, 0, 1); G8_STAGEA(G8_SA(0, 0), k2, 0, last);
            G8_BAR; G8_WAIT_L(0); G8_MMA(1, 0, At, B0); G8_BAR; G8_SCHED;
            G8_STAGE(G8_SB(0, 1), b2 + hstepB, voffB);
            G8_WAIT_V(6); G8_BAR; G8_MMA(1, 1, At, B1); G8_BAR;
            G8_LDB(B0, 1, 0); G8_SCHED; G8_LDA(At, 1, 0); G8_STAGEA(G8_SA(0, 1), k2, 1, last);
            G8_WAIT_L(8); G8_BAR; G8_WAIT_L(0); G8_MMA(0, 0, At, B0); G8_BAR; G8_SCHED;
            G8_LDB(B1, 1, 1); G8_STAGE(G8_SB(1, 0), b3, voffB);
            G8_BAR; G8_WAIT_L(0); G8_MMA(0, 1, At, B1); G8_BAR;
            G8_LDA(At, 1, 1); G8_STAGEA(G8_SA(1, 0), k3, 0, last);
            G8_BAR; G8_WAIT_L(0); G8_MMA(1, 0, At, B0); G8_BAR; G8_SCHED;
            G8_STAGE(G8_SB(1, 1), b3 + hstepB, voffB);
            G8_WAIT_V(6); G8_BAR; G8_MMA(1, 1, At, B1); G8_BAR;
        }
        MFMA_FENCE();
        E(acc, cur, wr, wc, fr, fq, epre);
        if (!has_next) break;
#pragma unroll
        for (int a = 0; a < 2; ++a)
#pragma unroll
            for (int b = 0; b < 2; ++b)
#pragma unroll
                for (int m = 0; m < 4; ++m)
#pragma unroll
                    for (int n = 0; n < 2; ++n) acc[a][b][m][n] = (f32x4){0.f, 0.f, 0.f, 0.f};
        cur = nxt; cA = nA; cB = nB; ++ui;
        { _Pragma("unroll") for (int _h = 0; _h < 2; ++_h) _Pragma("unroll") for (int _i = 0; _i < 2; ++_i) offc[_h][_i] = offn[_h][_i]; }
        E.pre(epre, cur, wc, fq, wid, lane);
    }
    G8_WAIT_V(0);
    if (wr == 0) G8_BAR;
    G8_BAR;
#undef G8_SA
#undef G8_SB
#undef G8_STAGE
#undef G8_LDA
#undef G8_STAGEA
#undef G8_LOADOFF
#undef G8_LDB
#undef G8_MMA
#undef G8_WAIT_V
#undef G8_WAIT_L
#undef G8_BAR
#undef G8_SCHED
}
}

__device__ __forceinline__ void conv_item(const float* __restrict__ src, int ldS, int col4  , int k0, bf16_t* __restrict__ dst  , int K, int kq, const float* __restrict__ ksc = nullptr  ) {
    f32x4 v[16];
#pragma unroll
    for (int j = 0; j < 16; ++j) v[j] = col4 >= 0 ? *(const f32x4*)(src + (size_t)(k0 + kq * 16 + j) * ldS + col4) : (f32x4){0.f, 0.f, 0.f, 0.f};
    if (ksc) {
#pragma unroll
        for (int j = 0; j < 16; ++j) v[j] *= ksc[k0 + kq * 16 + j];
    }
#pragma unroll
    for (int r = 0; r < 4; ++r) {
        u32x4 w0, w1;
#pragma unroll
        for (int j = 0; j < 4; ++j) { w0[j] = pk2(v[2 * j][r], v[2 * j + 1][r]); w1[j] = pk2(v[8 + 2 * j][r], v[8 + 2 * j + 1][r]); }
        bf16_t* d = dst + (size_t)r * K + kq * 16;
        *(u32x4*)d = w0; *(u32x4*)(d + 8) = w1;
    }
}
__device__ __forceinline__ void rms_row_to_h(const float* __restrict__ xr, const float* __restrict__ nw, bf16_t* __restrict__ hr, int lane) {
    f32x4 v[4]; float ss = 0.f;
#pragma unroll
    for (int i = 0; i < 4; ++i) { v[i] = *(const f32x4*)(xr + i * 256 + lane * 4); ss += v[i][0] * v[i][0] + v[i][1] * v[i][1] + v[i][2] * v[i][2] + v[i][3] * v[i][3]; }
    ss = wave_sum(ss);
    const float rs = rsqrtf(ss * (1.0f / 1024.0f) + NORM_EPS);
#pragma unroll
    for (int i = 0; i < 4; ++i) { const f32x4 w = *(const f32x4*)(nw + i * 256 + lane * 4);
        u32x2 o; o.x = pk2(v[i][0] * rs * w[0], v[i][1] * rs * w[1]); o.y = pk2(v[i][2] * rs * w[2], v[i][3] * rs * w[3]);
        *(u32x2*)(hr + i * 256 + lane * 4) = o; }
}
constexpr int CONV_ITEMS = 112 * 16 + 16 * 32 + 16 * 16 + 2 * 4 * 32 + 32 * 32 * 16 + 32 * 16 * 16;
__device__ __forceinline__ void conv_one(const Ctx& c, const int l, const int it) {
    const int lane = c.lane;
    constexpr int I_IN = 112 * 16, I_O = 16 * 32, I_OUT = 16 * 16, I_C1 = 2 * 4 * 32, I_GU = 32 * 32 * 16;
    constexpr int E1 = I_IN, E2 = E1 + I_O, E3 = E2 + I_OUT, E4 = E3 + I_C1, E5 = E4 + I_GU;
    const int n4 = (lane & 15) * 4, kq = lane >> 4;
    if (it < E1) { const int nb = it / 16, kb = it % 16; const int n = nb * 64 + n4;
        const int col = n < 4912 ? n : (n < 5120 ? -1 : n - 208);
        conv_item(c.w_in + (size_t)l * D * IN_TOTAL, IN_TOTAL, col, kb * 64, WSP(bf16_t, WS_WIN) + ((size_t)l * NPROJ + n) * D + kb * 64, D, kq);
    } else if (it < E2) { const int r = it - E1, nb = r / 32, kb = r % 32; const int n = nb * 64 + n4;
        const float* src = (kb < 16 ? c.w_o_ret : c.w_o_nsa) + (size_t)l * D * D;
        conv_item(src, D, n, (kb & 15) * 64, WSP(bf16_t, WS_WO) + ((size_t)l * D + n) * 2048 + kb * 64, 2048, kq);
    } else if (it < E3) { const int r = it - E2, nb = r / 16, kb = r % 16; const int n = nb * 64 + n4;
        conv_item(c.w_out + (size_t)l * D * D, D, n, kb * 64, WSP(bf16_t, WS_WOUT) + ((size_t)l * D + n) * D + kb * 64, D, kq);
    } else if (it < E4) { const int j = it - E3, lk = l * 2 + j / 128, r = j % 128, nb = r / 32, kb = r % 32; const int n = nb * 64 + n4;
        conv_item(c.cmp_w1 + (size_t)lk * 2048 * 256, 256, n, kb * 64, WSP(bf16_t, WS_WC1) + ((size_t)lk * 256 + n) * 2048 + kb * 64, 2048, kq);
    } else if (it < E5) { const int j = it - E4, le = l * NEXP + j / 512, r = j % 512, nb = r / 16, kb = r % 16; const int n = nb * 64 + n4;
        const int pn = n >> 8, jj = n & 255; const int col = jj < 128 ? pn * 128 + jj : 1024 + pn * 128 + (jj - 128);
        conv_item(c.w_gate_up + (size_t)le * D * 2048, 2048, col, kb * 64, WSP(bf16_t, WS_WGU) + ((size_t)le * 2048 + n) * D + kb * 64, D, kq, c.norm2_w + (size_t)l * D);
    } else { const int j = it - E5, le = l * NEXP + j / 256, r = j % 256, nb = r / 16, kb = r % 16; const int n = nb * 64 + n4;
        conv_item(c.w_down + (size_t)le * D * D, D, n, kb * 64, WSP(bf16_t, WS_WD) + ((size_t)le * D + n) * D + kb * 64, D, kq);
    }
}
__device__ __forceinline__ bool conv_is_early(const int it) { return it < 112 * 16 || (it >= 112 * 16 + 16 * 32 + 16 * 16 && it < 112 * 16 + 16 * 32 + 16 * 16 + 2 * 4 * 32); }
__device__ __forceinline__ void conv_layer_early(const Ctx& c, const int l, const int widx, const int nw) {
    for (int it = widx; it < 112 * 16; it += nw) conv_one(c, l, it);
    for (int it = 112 * 16 + 16 * 32 + 16 * 16 + widx; it < 112 * 16 + 16 * 32 + 16 * 16 + 2 * 4 * 32; it += nw) conv_one(c, l, it);
}
__device__ __forceinline__ void phase_prologue(const Ctx& c) {
    const int lane = c.lane, gw = c.gw, NW = c.G * NWAVES;
    conv_layer_early(c, 0, gw, NW);
    const int gtid = blockIdx.x * NTHREADS + c.tid, NT = c.G * NTHREADS;
    for (int pos = gw; pos < SEQ; pos += NW) {
#pragma unroll
        for (int pass = 0; pass < 2; ++pass) {
            if (pass == 1 && lane >= 8) break;
            const int j = pass == 0 ? lane : 64 + lane;
            float inv; if (j < 64) inv = powf(10000.0f, -(float)(2 * j) / 128.0f); else inv = powf(500000.0f, -(float)(2 * (j - 64)) / 16.0f);
            const float ang = (float)pos * inv;
            double rev = (double)ang * 0.15915494309189535; rev -= floor(rev);
            const float rv = (float)rev; const float sn = __builtin_amdgcn_sinf(rv), cs = __builtin_amdgcn_cosf(rv);
            if (j < 64) { float* t = WSP(float, WS_ROPER) + ((size_t)pos * 64 + j) * 2; t[0] = cs; t[1] = sn; }
            else { float* t = WSP(float, WS_ROPEN) + ((size_t)pos * 8 + (j - 64)) * 2; t[0] = cs; t[1] = sn; }
        }
    }
    for (int u = blockIdx.x + c.wave * c.G; u < NL * 2 * 16 * 8; u += c.G * NWAVES) {
        const int kh = u & 7, lk = u >> 7, n = ((u >> 3) & 15) * 16 + (lane & 15), k0 = kh * 256 + (lane >> 4) * 64;
        const float* pe = c.cmp_pos + (size_t)lk * 2048 + k0; const float* w1 = c.cmp_w1 + ((size_t)lk * 2048 + k0) * 256 + n;
        float s0 = 0.f, s1 = 0.f, s2 = 0.f, s3 = 0.f;
#pragma unroll 4
        for (int k = 0; k < 64; k += 4) { s0 += pe[k] * w1[(size_t)k * 256]; s1 += pe[k + 1] * w1[(size_t)(k + 1) * 256]; s2 += pe[k + 2] * w1[(size_t)(k + 2) * 256]; s3 += pe[k + 3] * w1[(size_t)(k + 3) * 256]; }
        float s = (s0 + s1) + (s2 + s3);
        s += __shfl_xor(s, 16); s += __shfl_xor(s, 32);
        if (lane < 16) WSP(float, WS_PEB)[kh * (NL * 2 * 256) + lk * 256 + n] = s;
    }
    for (int i = gtid; i < NL * 32 * 2 * 64 * 8; i += NT) {
        const int j = i & 7, ln = (i >> 3) & 63, nt = (i >> 9) & 1, ks = (i >> 10) & 31, l = i >> 15;
        const int fr_ = ln & 15, fq_ = ln >> 4, k = 32 * ks + (j < 4 ? 4 * fq_ + j : 16 + 4 * fq_ + (j - 4)), e = 16 * nt + fr_;
        const float w = c.norm2_w[(size_t)l * D + k] * c.router_w[((size_t)l * D + k) * NEXP + e];
        const unsigned hi = f2bf(w); const float wl = w - __uint_as_float(hi << 16);
        bf16_t* dst = WSP(bf16_t, WS_RWF) + ((((size_t)l * 32 + ks) * 2 + nt) * 2) * 512 + ln * 8 + j;
        dst[0] = (bf16_t)hi; dst[512] = (bf16_t)f2bf(wl);
    }
    for (int tok = gw; tok < NTOK; tok += NW) rms_row_to_h(c.x_in + (size_t)tok * D, c.norm1_w, WSP(bf16_t, WS_H) + (size_t)tok * D, lane);
}

constexpr float SM_SCALE_L2 = 0.125f * 1.4426950408889634f;
__device__ __forceinline__ void phase_prep(const Ctx& c, int l) {
    const int lane = c.lane, gw = c.gw, NW = c.G * NWAVES;
    const bf16_t* proj = WSP(bf16_t, WS_PROJ);
    const float* ropeR = WSP(float, WS_ROPER); const float* ropeN = WSP(float, WS_ROPEN);
    const float* qkw = c.qk_norm_w + (size_t)l * 4 * 64;
    for (int tok = gw; tok < NTOK; tok += NW) {
        const int b = tok / SEQ, s = tok % SEQ; const bf16_t* pr = proj + (size_t)tok * NPROJ;
        {
            const int job = lane >> 3, l8 = lane & 7, isk = job >> 2, h = job & 3;
            const bf16_t* src = pr + (isk ? C_RK : C_RQ) + h * 128 + 8 * l8;
            const u32x4 w1 = *(const u32x4*)src, w2 = *(const u32x4*)(src + 64);
            const f32x4* tb = (const f32x4*)(ropeR + ((size_t)s * 64 + 8 * l8) * 2);
            const float ksc = isk ? 0.08838834764831845f : 1.0f;
            u32x4 o1, o2;
#pragma unroll
            for (int j = 0; j < 4; ++j) { const f32x4 cs = tb[j];
                const float a1 = bflo(w1[j]), a2 = bflo(w2[j]), b1 = bfhi(w1[j]), b2 = bfhi(w2[j]);
                o1[j] = pk2((a1 * cs[0] - a2 * cs[1]) * ksc, (b1 * cs[2] - b2 * cs[3]) * ksc);
                o2[j] = pk2((a1 * cs[1] + a2 * cs[0]) * ksc, (b1 * cs[3] + b2 * cs[2]) * ksc); }
            bf16_t* dst = WSP(bf16_t, isk ? WS_KR : WS_QR) + ((size_t)(b * 4 + h) * SEQ + s) * 128 + 8 * l8;
            *(u32x4*)dst = o1; *(u32x4*)(dst + 64) = o2;
        }
        {
            const int head = lane >> 2, part = lane & 3; const bf16_t* src = pr + C_NQ + head * 64 + part * 16;
            const u32x4 w0 = *(const u32x4*)src, w1 = *(const u32x4*)(src + 8); float v[16];
#pragma unroll
            for (int j = 0; j < 4; ++j) { v[2 * j] = bflo(w0[j]); v[2 * j + 1] = bfhi(w0[j]); v[8 + 2 * j] = bflo(w1[j]); v[8 + 2 * j + 1] = bfhi(w1[j]); }
            float ss = 0.f;
#pragma unroll
            for (int j = 0; j < 16; ++j) ss += v[j] * v[j];
            ss += __shfl_xor(ss, 1); ss += __shfl_xor(ss, 2);
            const float rs = rsqrtf(ss * (1.0f / 64.0f) + NORM_EPS);
#pragma unroll
            for (int j = 0; j < 16; ++j) v[j] = v[j] * (rs * SM_SCALE_L2) * qkw[0 * 64 + part * 16 + j];
            if (part == 0) {
#pragma unroll
                for (int i = 0; i < 8; ++i) { const float cc = ropeN[((size_t)s * 8 + i) * 2], sc = ropeN[((size_t)s * 8 + i) * 2 + 1]; const float x1 = v[i], x2 = v[i + 8]; v[i] = x1 * cc - x2 * sc; v[i + 8] = x1 * sc + x2 * cc; }
            }
            u32x4 o0, o1;
#pragma unroll
            for (int j = 0; j < 4; ++j) { o0[j] = pk2(v[2 * j], v[2 * j + 1]); o1[j] = pk2(v[8 + 2 * j], v[8 + 2 * j + 1]); }
            bf16_t* dst = WSP(bf16_t, WS_QN) + ((size_t)tok * 16 + head) * 64 + part * 16;
            *(u32x4*)dst = o0; *(u32x4*)(dst + 8) = o1;
        }
        if (lane < 16) {
            const int hh = lane >> 2, part = lane & 3, isw = hh >> 1, g = hh & 1;
            const bf16_t* src = pr + (isw ? C_KW : C_KS) + g * 64 + part * 16;
            const u32x4 w0 = *(const u32x4*)src, w1 = *(const u32x4*)(src + 8); float v[16];
#pragma unroll
            for (int j = 0; j < 4; ++j) { v[2 * j] = bflo(w0[j]); v[2 * j + 1] = bfhi(w0[j]); v[8 + 2 * j] = bflo(w1[j]); v[8 + 2 * j + 1] = bfhi(w1[j]); }
            float ss = 0.f;
#pragma unroll
            for (int j = 0; j < 16; ++j) ss += v[j] * v[j];
            ss += __shfl_xor(ss, 1); ss += __shfl_xor(ss, 2);
            const float rs = rsqrtf(ss * (1.0f / 64.0f) + NORM_EPS);
            const float* w = qkw + (isw ? 3 : 2) * 64 + part * 16;
#pragma unroll
            for (int j = 0; j < 16; ++j) v[j] = v[j] * rs * w[j];
            if (part == 0) {
#pragma unroll
                for (int i = 0; i < 8; ++i) { const float cc = ropeN[((size_t)s * 8 + i) * 2], sc = ropeN[((size_t)s * 8 + i) * 2 + 1]; const float x1 = v[i], x2 = v[i + 8]; v[i] = x1 * cc - x2 * sc; v[i + 8] = x1 * sc + x2 * cc; }
            }
            u32x4 o0, o1;
#pragma unroll
            for (int j = 0; j < 4; ++j) { o0[j] = pk2(v[2 * j], v[2 * j + 1]); o1[j] = pk2(v[8 + 2 * j], v[8 + 2 * j + 1]); }
            bf16_t* dst = WSP(bf16_t, isw ? WS_KW : WS_KS) + ((((size_t)(b * 2 + g) * 128 + (s >> 6)) * 4 + ((s >> 4) & 3)) * 2 + (part >> 1)) * 512 + ((2 * (part & 1)) * 16 + (s & 15)) * 8;
            *(u32x4*)dst = o0; *(u32x4*)(dst + 128) = o1;
        } else if (lane < 48) {
            const int q = lane - 16, isv = q >> 4, r = q & 15, g = r >> 3, part = r & 7;
            const u32x4 w = *(const u32x4*)(pr + (isv ? C_VC : C_KC) + g * 64 + part * 8);
            *(u32x4*)(WSP(bf16_t, isv ? WS_VCT : WS_KCT) + ((size_t)(b * 2 + g) * SEQ + s) * 64 + part * 8) = w;
        }
    }
    const float lgam[4] = {log2f(1.0f - 1.0f / 32.0f), log2f(1.0f - 1.0f / 64.0f), log2f(1.0f - 1.0f / 128.0f), log2f(1.0f - 1.0f / 256.0f)};
    LAS bf16_t* tile = (LAS bf16_t*)(c.lds + c.wave * 8192);
    for (int grp = gw; grp < NTOK / 8; grp += NW) {
        const int tok0 = grp * 8, b = tok0 / SEQ, s0 = tok0 % SEQ; const bf16_t* pr = proj + (size_t)tok0 * NPROJ;
#define PREP_LOAD_TILE(col0) do { _Pragma("unroll") for (int _t = 0; _t < 8; ++_t) { const u32x4 _w = *(const u32x4*)(pr + (size_t)_t * NPROJ + (col0) + lane * 8); *(LAS u32x4*)(tile + _t * 512 + lane * 8) = _w; } } while (0)
#define PREP_COL8(cc, w) do { unsigned short _v[8]; _Pragma("unroll") for (int _t = 0; _t < 8; ++_t) _v[_t] = tile[_t * 512 + (cc)]; \
        (w).x = _v[0] | ((unsigned)_v[1] << 16); (w).y = _v[2] | ((unsigned)_v[3] << 16); (w).z = _v[4] | ((unsigned)_v[5] << 16); (w).w = _v[6] | ((unsigned)_v[7] << 16); } while (0)
        PREP_LOAD_TILE(C_RK);
        {
            float cs[8], sn[8], zz[8];
#pragma unroll
            for (int t = 0; t < 8; ++t) { const f32x2 tb = *(const f32x2*)(ropeR + ((size_t)(s0 + t) * 64 + lane) * 2); cs[t] = tb[0]; sn[t] = tb[1]; }
#pragma unroll
            for (int h = 0; h < 4; ++h) { float o1[8], o2[8];
#pragma unroll
                for (int t = 0; t < 8; ++t) { const float k1 = bf2f(tile[t * 512 + h * 128 + lane]), k2 = bf2f(tile[t * 512 + h * 128 + 64 + lane]);
                    const float z = fexp2(lgam[h] * (float)(127 - ((s0 + t) & 127))) * 0.08838834764831845f;
                    o1[t] = (k1 * cs[t] - k2 * sn[t]) * z; o2[t] = (k1 * sn[t] + k2 * cs[t]) * z; }
                u32x4 w1, w2;
#pragma unroll
                for (int j = 0; j < 4; ++j) { w1[j] = pk2(o1[2 * j], o1[2 * j + 1]); w2[j] = pk2(o2[2 * j], o2[2 * j + 1]); }
                { const int tk = s0 & 127, q = tk & 31, fqa = (q & 15) >> 2, jb = q >= 16 ? 4 : 0;
                  bf16_t* base = WSP(bf16_t, WS_KZT) + ((((size_t)(b * 4 + h) * 64 + (s0 >> 7)) * 8) * 4 + (tk >> 5)) * 512 + (fqa * 16 + (lane & 15)) * 8 + jb;
                  bf16_t* d1 = base + (size_t)(lane >> 4) * 2048, *d2 = base + (size_t)(4 + (lane >> 4)) * 2048;
                  u32x2 a; a.x = w1.x; a.y = w1.y; *(u32x2*)d1 = a; a.x = w1.z; a.y = w1.w; *(u32x2*)(d1 + 128) = a;
                  a.x = w2.x; a.y = w2.y; *(u32x2*)d2 = a; a.x = w2.z; a.y = w2.w; *(u32x2*)(d2 + 128) = a; } }
        }
#pragma unroll 1
        for (int hf = 0; hf < 2; ++hf) {
            PREP_LOAD_TILE(C_RV + hf * 512);
#pragma unroll
            for (int i = 0; i < 8; ++i) { const int cc = i * 64 + lane; u32x4 w; PREP_COL8(cc, w);
                { const int ch_ = hf * 512 + cc, hh = ch_ >> 8, dv = ch_ & 255, tk = s0 & 127, q = tk & 31, fqa = (q & 15) >> 2, jb = q >= 16 ? 4 : 0;
                  bf16_t* d = WSP(bf16_t, WS_VT) + (((((size_t)(b * 4 + hh) * 64 + (s0 >> 7)) * 4 + (tk >> 5)) * 16 + (dv >> 4)) * 64 + fqa * 16 + (dv & 15)) * 8 + jb;
                  u32x2 a; a.x = w.x; a.y = w.y; *(u32x2*)d = a; a.x = w.z; a.y = w.w; *(u32x2*)(d + 128) = a; } }
        }
        {
#pragma unroll
            for (int _t = 0; _t < 8; ++_t) { const int piece = lane >> 4, off = (lane & 15) * 8;
                if (lane < 32) { const u32x4 _w = *(const u32x4*)(pr + (size_t)_t * NPROJ + (piece ? C_VW : C_VS) + off); *(LAS u32x4*)(tile + _t * 512 + piece * 128 + off) = _w; } }
#pragma unroll
            for (int i = 0; i < 4; ++i) { const int isw = i >> 1, g = i & 1; u32x4 w; PREP_COL8(isw * 128 + g * 64 + lane, w);
                const int q = s0 & 31; bf16_t* dst = WSP(bf16_t, isw ? WS_VWT : WS_VST) + ((((size_t)(b * 2 + g) * 128 + (s0 >> 6)) * 2 + ((s0 >> 5) & 1)) * 4 + (lane >> 4)) * 512 + ((((q & 15) >> 2)) * 16 + (lane & 15)) * 8 + (q >= 16 ? 4 : 0);
                u32x2 w0, w1; w0.x = w.x; w0.y = w.y; w1.x = w.z; w1.y = w.w; *(u32x2*)dst = w0; *(u32x2*)(dst + 128) = w1; }
        }
#undef PREP_LOAD_TILE
#undef PREP_COL8
    }
}

__device__ __forceinline__ void phase_cmp2(const Ctx& c, int l) {
    const int lane = c.lane, gw = c.gw, NW = c.G * NWAVES;
    const float* ropeN = WSP(float, WS_ROPEN);
    for (int r0 = 0; r0 < 2 * 8 * 512; r0 += c.G * 32) {
        const int rowb = r0 + blockIdx.x * 32 + c.wave * 4; if (rowb >= 2 * 8 * 512) break;
        const int kv = rowb >> 12, bg = (rowb >> 9) & 7;
        const float* w2 = c.cmp_w2 + ((size_t)l * 2 + kv) * 256 * 64 + lane;
        LAS float* hl = (LAS float*)(c.lds + c.wave * 4096);
        { const float* sl = WSP(float, WS_ACT) + (size_t)rowb * 256 + lane * 4; f32x4 pb = *(const f32x4*)(WSP(float, WS_PEB) + (size_t)l * 512 + kv * 256 + lane * 4);
#pragma unroll
          for (int kh = 1; kh < 8; ++kh) pb += *(const f32x4*)(WSP(float, WS_PEB) + (size_t)kh * (NL * 2 * 256) + (size_t)l * 512 + kv * 256 + lane * 4);
#pragma unroll
          for (int rr = 0; rr < 4; ++rr) { f32x4 a = pb;
#pragma unroll
              for (int q = 0; q < 8; ++q) a += *(const f32x4*)(sl + (size_t)q * 8192 * 256 + rr * 256);
#pragma unroll
              for (int j = 0; j < 4; ++j) { const float x = a[j]; const float t = 0.7978845608028654f * (x + 0.044715f * x * x * x);
                  const float th = 1.0f - 2.0f * frcp(1.0f + fexp2(2.8853900817779268f * t)); a[j] = 0.5f * x * (1.0f + th); }
              *(LAS f32x4*)(hl + rr * 256 + lane * 4) = a; } }
        float acc4[4] = {0.f, 0.f, 0.f, 0.f};
#pragma unroll 1
        for (int k0 = 0; k0 < 256; k0 += 32) {
            float wv[32];
#pragma unroll
            for (int i = 0; i < 32; ++i) wv[i] = w2[(size_t)(k0 + i) * 64];
#pragma unroll
            for (int i = 0; i < 32; i += 2) {
#pragma unroll
                for (int rr = 0; rr < 4; ++rr) { const f32x2 hw = *(const LAS f32x2*)(hl + rr * 256 + k0 + i); acc4[rr] += hw[0] * wv[i] + hw[1] * wv[i + 1]; } }
        }
#pragma unroll
        for (int rr = 0; rr < 4; ++rr) {
            const int n = (rowb + rr) & 511; const float acc = acc4[rr];
            if (kv == 0) {
                const float ss = wave_sum(acc * acc); float v = acc * rsqrtf(ss * (1.0f / 64.0f) + NORM_EPS) * c.qk_norm_w[(size_t)l * 256 + 64 + lane];
                const float other = __shfl_xor(v, 8);
                int pos = 16 * n + 31; if (pos > SEQ - 1) pos = SEQ - 1;
                if (lane < 16) { const int i = lane & 7; const float cc = ropeN[((size_t)pos * 8 + i) * 2], sc = ropeN[((size_t)pos * 8 + i) * 2 + 1];
                    v = lane < 8 ? v * cc - other * sc : other * sc + v * cc; }
                WSP(bf16_t, WS_KCMP)[((((size_t)bg * 8 + (n >> 6)) * 4 + ((n >> 4) & 3)) * 2 + (lane >> 5)) * 512 + (((lane >> 3) & 3) * 16 + (n & 15)) * 8 + (lane & 7)] = (bf16_t)f2bf(v);
            } else {
                const int q = n & 31; WSP(bf16_t, WS_VCMPT)[((((size_t)bg * 8 + (n >> 6)) * 2 + ((n >> 5) & 1)) * 4 + (lane >> 4)) * 512 + (((q & 15) >> 2) * 16 + (lane & 15)) * 8 + (q >= 16 ? 4 : 0) + (q & 3)] = (bf16_t)(n < 511 ? f2bf(acc) : 0u);
            }
        }
    }
}

__device__ __forceinline__ void phase_scan(const Ctx& c) {
    const int lane = c.lane, w = c.wave, fr = lane & 15, fq = lane >> 4;
    for (int it0 = blockIdx.x; it0 < 256; it0 += c.G) {
        const int it = (c.G == 256) ? ((it0 & 7) * 32 + (it0 >> 3)) : it0;
        const int bh = it >> 4, dvs = it & 15, h = bh & 3;
        const float cdec = fexp2(log2f(1.0f - fexp2(-5.0f - (float)h)) * 128.0f);
        const bf16_t* kz = WSP(bf16_t, WS_KZT) + ((size_t)bh * 64 * 8 + w) * 2048 + lane * 8;
        const bf16_t* vt = WSP(bf16_t, WS_VT) + ((size_t)bh * 64 * 64 + dvs) * 512 + lane * 8;
        bf16_t* rt = WSP(bf16_t, WS_RT) + ((((size_t)bh * 64) * 16 + dvs) * 4 + (w >> 1)) * 512 + ((2 * (w & 1) + (fq >> 1)) * 16 + fr) * 8 + 4 * (fq & 1);
        f32x4 acc = {0.f, 0.f, 0.f, 0.f};
        bf16x8 kf[2][4];
        u32x2 st[64];
        const bf16_t* vt0 = WSP(bf16_t, WS_VT) + ((size_t)bh * 64 * 64 + dvs) * 512 + lane * 8;
#define SCAN_VBATCH(b) do { _Pragma("unroll") for (int _i = 0; _i < 8; ++_i) { const int _blk = w * 8 + _i; \
            __builtin_amdgcn_global_load_lds((const unsigned*)(vt0 + (size_t)(16 * (b) + (_blk >> 2)) * 32768 + (_blk & 3) * 8192), (LAS unsigned*)(c.lds + ((b) & 1) * 65536 + _blk * 1024), 16, 0, 0); } } while (0)
        SCAN_VBATCH(0);
#pragma unroll
        for (int u = 0; u < 2; ++u)
#pragma unroll
            for (int ks = 0; ks < 4; ++ks) kf[u][ks] = ld8(kz + (size_t)u * 16384 + ks * 512);
#pragma unroll
        for (int ch = 0; ch < 64; ++ch) {
            const int u = ch & 1;
            if ((ch & 15) == 0) { asm volatile("s_waitcnt vmcnt(0)" ::: "memory"); __builtin_amdgcn_s_barrier(); asm volatile("" ::: "memory");
                if (ch + 16 < 64) SCAN_VBATCH((ch >> 4) + 1); }
            st[ch].x = pk2(acc[0], acc[1]); st[ch].y = pk2(acc[2], acc[3]);
            acc *= cdec;
            const LAS unsigned char* vb = c.lds + ((ch >> 4) & 1) * 65536 + (ch & 15) * 4096 + lane * 16;
#pragma unroll
            for (int ks = 0; ks < 4; ++ks) acc = mfma16(kf[u][ks], *(const LAS bf16x8*)(vb + ks * 1024), acc);
            if (ch + 2 < 64) {
#pragma unroll
                for (int ks = 0; ks < 4; ++ks) kf[u][ks] = ld8(kz + (size_t)(ch + 2) * 16384 + ks * 512);
            }
        }
#undef SCAN_VBATCH
        MFMA_FENCE();
#pragma unroll
        for (int ch = 0; ch < 64; ++ch) *(u32x2*)(rt + (size_t)ch * 32768) = st[ch];
    }
}

#define SH_BAR() do { asm volatile("" ::: "memory"); __builtin_amdgcn_s_barrier(); asm volatile("" ::: "memory"); } while (0)
#define SH_WAIT_BAR() do { asm volatile("s_waitcnt vmcnt(0)" ::: "memory"); __builtin_amdgcn_s_barrier(); asm volatile("" ::: "memory"); } while (0)
__device__ __forceinline__ void phase_retout(const Ctx& c, int l) {
    const int lane = c.lane, wave = c.wave, fr = lane & 15, fq = lane >> 4;
    const bf16_t* proj = WSP(bf16_t, WS_PROJ);
    LAS unsigned char* lv = c.lds;
    LAS unsigned char* lr = c.lds + 65536;
    for (int u = blockIdx.x; u < 16 * 64; u += c.G) {
        const int qt = wave, ch = u & 63, bh = u >> 6, b = bh >> 2, h = bh & 3;
        const float lg = log2f(1.0f - fexp2(-5.0f - (float)h));
        const bf16_t* Q = WSP(bf16_t, WS_QR) + ((size_t)bh * SEQ + ch * 128) * 128;
        const bf16_t* Kp = WSP(bf16_t, WS_KR) + ((size_t)bh * SEQ + ch * 128) * 128;
        const bf16_t* VTp = WSP(bf16_t, WS_VT) + ((size_t)(bh * 64 + ch)) * 32768;
        const bf16_t* RTp = WSP(bf16_t, WS_RT) + ((size_t)(bh * 64 + ch)) * 32768;
        SH_BAR();
#pragma unroll
        for (int i = 0; i < 8; ++i) {
            __builtin_amdgcn_global_load_lds((const unsigned*)(VTp + (size_t)(wave * 8 + i) * 512 + lane * 8), (LAS unsigned*)(lv + (wave * 8 + i) * 1024), 16, 0, 0);
            __builtin_amdgcn_global_load_lds((const unsigned*)(RTp + (size_t)(wave * 8 + i) * 512 + lane * 8), (LAS unsigned*)(lr + (wave * 8 + i) * 1024), 16, 0, 0);
        }
        const int n = 16 * qt + fr;
        bf16x8 qf[4], qs[4];
        const float xi = fexp2(lg * (float)(n + 1));
#pragma unroll
        for (int ks = 0; ks < 4; ++ks) { const u32x4 w = *(const u32x4*)(Q + (size_t)n * 128 + 32 * ks + 8 * fq); qf[ks] = mk8(w);
            u32x4 s;
#pragma unroll
            for (int j = 0; j < 4; ++j) s[j] = pk2(bflo(w[j]) * xi, bfhi(w[j]) * xi);
            qs[ks] = mk8(s); }
        const size_t tok = (size_t)b * SEQ + ch * 128 + n;
        const bf16_t* gp = proj + tok * NPROJ + C_RG + h * 256 + 4 * fq; const float* gw_ = c.ret_gn_w + (size_t)l * 1024 + h * 256 + 4 * fq;
        u32x2 gv[16];
#pragma unroll
        for (int dt = 0; dt < 16; ++dt) gv[dt] = *(const u32x2*)(gp + 16 * dt);
        bf16x8 kk[8];
#pragma unroll
        for (int ks = 0; ks < 4; ++ks) { kk[ks] = ld8(Kp + (size_t)fr * 128 + 32 * ks + 8 * fq); kk[4 + ks] = ld8(Kp + (size_t)((qt >= 1 ? 16 : 0) + fr) * 128 + 32 * ks + 8 * fq); }
        f32x4 o[16];
#pragma unroll
        for (int dt = 0; dt < 16; ++dt) o[dt] = (f32x4){0.f, 0.f, 0.f, 0.f};
        SH_WAIT_BAR();
        for (int p = 0; p <= (qt >> 1); ++p) {
            f32x4 s0 = {0.f, 0.f, 0.f, 0.f}, s1 = {0.f, 0.f, 0.f, 0.f};
            const bool two = (2 * p + 1 <= qt);
#pragma unroll
            for (int ks = 0; ks < 4; ++ks) s0 = mfma16(kk[ks], qf[ks], s0);
#pragma unroll
            for (int ks = 0; ks < 4; ++ks) s1 = mfma16(kk[4 + ks], qf[ks], s1);
            MFMA_FENCE();
            if (p + 1 <= (qt >> 1)) {
                const bool two_n = (2 * (p + 1) + 1 <= qt);
#pragma unroll
                for (int ks = 0; ks < 4; ++ks) { kk[ks] = ld8(Kp + (size_t)(32 * (p + 1) + fr) * 128 + 32 * ks + 8 * fq); kk[4 + ks] = ld8(Kp + (size_t)(32 * (p + 1) + (two_n ? 16 : 0) + fr) * 128 + 32 * ks + 8 * fq); }
            }
#pragma unroll
            for (int r = 0; r < 4; ++r) { const int d0 = n - (32 * p + 4 * fq + r), d1 = d0 - 16;
                s0[r] = d0 >= 0 ? s0[r] * fexp2(lg * (float)d0) : 0.f; s1[r] = (two && d1 >= 0) ? s1[r] * fexp2(lg * (float)d1) : 0.f; }
            u32x4 pw; pw.x = pk2(s0[0], s0[1]); pw.y = pk2(s0[2], s0[3]); pw.z = pk2(s1[0], s1[1]); pw.w = pk2(s1[2], s1[3]);
            const bf16x8 pb = mk8(pw);
#pragma unroll
            for (int dt = 0; dt < 16; ++dt) o[dt] = mfma16(*(const LAS bf16x8*)(lv + (p * 16 + dt) * 1024 + lane * 16), pb, o[dt]);
            MFMA_FENCE();
        }
#pragma unroll
        for (int dt = 0; dt < 16; ++dt)
#pragma unroll
            for (int ks = 0; ks < 4; ++ks) o[dt] = mfma16(*(const LAS bf16x8*)(lr + (dt * 4 + ks) * 1024 + lane * 16), qs[ks], o[dt]);
        float s = 0.f;
#pragma unroll
        for (int dt = 0; dt < 16; ++dt) s += (o[dt][0] + o[dt][1]) + (o[dt][2] + o[dt][3]);
        s += __shfl_xor(s, 16); s += __shfl_xor(s, 32);
        const float mu = s * (1.0f / 256.0f); float q = 0.f;
#pragma unroll
        for (int dt = 0; dt < 16; ++dt)
#pragma unroll
            for (int r = 0; r < 4; ++r) { const float d = o[dt][r] - mu; q += d * d; }
        q += __shfl_xor(q, 16); q += __shfl_xor(q, 32);
        const float rstd = rsqrtf(q * (1.0f / 256.0f) + NORM_EPS);
        bf16_t* op = WSP(bf16_t, WS_RA) + tok * 2048 + h * 256 + 4 * fq;
#pragma unroll
        for (int dt = 0; dt < 16; ++dt) { const f32x4 wv = *(const f32x4*)(gw_ + 16 * dt);
            float g[4] = {bflo(gv[dt].x), bfhi(gv[dt].x), bflo(gv[dt].y), bfhi(gv[dt].y)}; float r_[4];
#pragma unroll
            for (int r = 0; r < 4; ++r) r_[r] = (o[dt][r] - mu) * rstd * wv[r] * g[r] * sigmoidf_(g[r]);
            u32x2 ov; ov.x = pk2(r_[0], r_[1]); ov.y = pk2(r_[2], r_[3]); *(u32x2*)(op + 16 * dt) = ov; }
    }
    SH_BAR();
}

__device__ __forceinline__ void attn_step_lds(const LAS unsigned char* slot, const bf16x8 (&qf)[2], const int key0, const int hiK, const int loK, const bool colok, const bool allok, const bool full,
                                              f32x4 (&O)[4], float& lsum, const int lane, const int fq) {
    bf16x8 kv[8];
#pragma unroll
    for (int i = 0; i < 8; ++i) kv[i] = *(const LAS bf16x8*)(slot + i * 1024 + lane * 16);
    f32x4 s[4];
    __builtin_amdgcn_s_setprio(1);
#pragma unroll
    for (int kt = 0; kt < 4; ++kt) { s[kt] = (f32x4){0.f, 0.f, 0.f, 0.f};
#pragma unroll
        for (int ks = 0; ks < 2; ++ks) s[kt] = mfma16(kv[kt * 2 + ks], qf[ks], s[kt]); }
    __builtin_amdgcn_s_setprio(0);
#pragma unroll
    for (int i = 0; i < 8; ++i) kv[i] = *(const LAS bf16x8*)(slot + 8192 + i * 1024 + lane * 16);
    float ps = 0.f;
    if (full) {
        if (allok) {
#pragma unroll
            for (int kt = 0; kt < 4; ++kt)
#pragma unroll
                for (int r = 0; r < 4; ++r) { const float p = fexp2(s[kt][r]); s[kt][r] = p; ps += p; }
        } else {
#pragma unroll
            for (int kt = 0; kt < 4; ++kt)
#pragma unroll
                for (int r = 0; r < 4; ++r) { const float p = colok ? fexp2(s[kt][r]) : 0.f; s[kt][r] = p; ps += p; }
        }
    } else {
#pragma unroll
        for (int kt = 0; kt < 4; ++kt)
#pragma unroll
            for (int r = 0; r < 4; ++r) { const int key = key0 + 16 * kt + 4 * fq + r; const bool ok = colok && (key <= hiK) && (key > loK);
                const float p = ok ? fexp2(s[kt][r]) : 0.f; s[kt][r] = p; ps += p; }
    }
    lsum += ps;
#pragma unroll
    for (int p2 = 0; p2 < 2; ++p2) {
        u32x4 pw; pw.x = pk2(s[2 * p2][0], s[2 * p2][1]); pw.y = pk2(s[2 * p2][2], s[2 * p2][3]); pw.z = pk2(s[2 * p2 + 1][0], s[2 * p2 + 1][1]); pw.w = pk2(s[2 * p2 + 1][2], s[2 * p2 + 1][3]);
        const bf16x8 pb = mk8(pw);
        __builtin_amdgcn_s_setprio(1);
#pragma unroll
        for (int dt = 0; dt < 4; ++dt) O[dt] = mfma16(kv[p2 * 4 + dt], pb, O[dt]);
        __builtin_amdgcn_s_setprio(0);
    }
    MFMA_FENCE();
}
__device__ __forceinline__ int sel_pop(unsigned long long& lo, unsigned long long& hi) {
    if (lo) { const int j = __builtin_ctzll(lo); lo &= lo - 1ull; return j; }
    if (hi) { const int j = 64 + __builtin_ctzll(hi); hi &= hi - 1ull; return j; }
    return -1;
}
#define SH_SLOT(s) (shb + (s) * 16384)
#define SH_ISSUE(kbase, vbase, blk, slot, withv) do { \
        __builtin_amdgcn_global_load_lds((const unsigned*)((kbase) + (size_t)(blk) * 4096 + (wave * 64 + lane) * 8), (LAS unsigned*)(SH_SLOT(slot) + wave * 1024), 16, 0, 0); \
        if (withv) __builtin_amdgcn_global_load_lds((const unsigned*)((vbase) + (size_t)(blk) * 4096 + (wave * 64 + lane) * 8), (LAS unsigned*)(SH_SLOT(slot) + 8192 + wave * 1024), 16, 0, 0); } while (0)
#define SH_READ_K(slot) do { _Pragma("unroll") for (int _i = 0; _i < 8; ++_i) kf[_i] = *(const LAS bf16x8*)(SH_SLOT(slot) + _i * 1024 + lane * 16); } while (0)
#define SH_READ_V(slot) do { _Pragma("unroll") for (int _i = 0; _i < 8; ++_i) vf[_i] = *(const LAS bf16x8*)(SH_SLOT(slot) + 8192 + _i * 1024 + lane * 16); } while (0)
__device__ __forceinline__ void phase_nsa(const Ctx& c, const int layer, const int lconv  , const bool late0  ) {
    const int lane = c.lane, wave = c.wave, fr = lane & 15, fq = lane >> 4;
    const bf16_t* proj = WSP(bf16_t, WS_PROJ);
    volatile LAS float* imp = (volatile LAS float*)(c.lds + 131072 + wave * 2304);
    LAS unsigned char* shb = c.lds;
    const int cntot = (lconv >= 0 ? CONV_ITEMS : 0) + (late0 ? CONV_ITEMS : 0), crounds = (cntot + c.G * NWAVES - 1) / (c.G * NWAVES);
    const int cntl = (2048 + c.G - 1) / c.G, crpt = (crounds + cntl - 1) / cntl;
    volatile LAS int* qs = (volatile LAS int*)(c.lds + LDS_CTL_OFF + 256);
#define NSA_QCTR (WSP(unsigned, WS_CTL + 16384) + layer * 64)
    if (c.tid == 0) { qs[0] = (int)__hip_atomic_fetch_add(NSA_QCTR, 1u, __ATOMIC_RELAXED, __HIP_MEMORY_SCOPE_AGENT); asm volatile("s_waitcnt lgkmcnt(0)" ::: "memory"); }
    int kk = 0;
    for (;; ++kk) {
        SH_BAR();
        const int U = __builtin_amdgcn_readfirstlane(qs[kk & 1]);
        if (U >= 2048) break;
        const int bg = U >> 8; const int tl = 255 - (U & 255);
        const int b = bg >> 1, g = bg & 1, T0 = 32 * tl, curW = T0 >> 6;
        int t0[2], tcol[2]; bf16x8 qf[2][2]; float g0[2], g1[2], g2[2]; size_t tokc[2];
        const int head = g * 8 + (fr & 7);
#pragma unroll
        for (int pr = 0; pr < 2; ++pr) {
            t0[pr] = T0 + 4 * wave + 2 * pr; tcol[pr] = t0[pr] + (fr >> 3); tokc[pr] = (size_t)b * SEQ + tcol[pr];
#pragma unroll
            for (int ks = 0; ks < 2; ++ks) qf[pr][ks] = ld8(WSP(bf16_t, WS_QN) + (tokc[pr] * 16 + head) * 64 + 32 * ks + 8 * fq);
            const bf16_t* gp = proj + tokc[pr] * NPROJ + C_NG + head * 3;
            g0[pr] = sigmoidf_(bf2f(gp[0])); g1[pr] = sigmoidf_(bf2f(gp[1])); g2[pr] = sigmoidf_(bf2f(gp[2]));
        }
        f32x4 out[2][4], O[2][4]; float lsum[2];
        bf16x8 kf[8];
#define NSA_ZERO_O() do { _Pragma("unroll") for (int _p = 0; _p < 2; ++_p) { lsum[_p] = 0.f; _Pragma("unroll") for (int _d = 0; _d < 4; ++_d) O[_p][_d] = (f32x4){0.f, 0.f, 0.f, 0.f}; } } while (0)
        int nbc[2];
#pragma unroll
        for (int pr = 0; pr < 2; ++pr) { const int nv = (t0[pr] + 1 >= 31) ? ((t0[pr] + 1 - 31) >> 4) + 1 : 0; nbc[pr] = (nv + 63) >> 6; }
        const int nvW = (T0 + 31 >= 31) ? ((T0 + 31 - 31) >> 4) + 1 : 0, nbcW = (nvW + 63) >> 6;
        const bf16_t* Kc = WSP(bf16_t, WS_KCMP) + (size_t)bg * 8 * 4096; const bf16_t* Vc = WSP(bf16_t, WS_VCMPT) + (size_t)bg * 8 * 4096;
        NSA_ZERO_O();
        SH_BAR();
        int nq = 0; if (c.tid == 0) nq = (int)__hip_atomic_fetch_add(NSA_QCTR, 1u, __ATOMIC_RELAXED, __HIP_MEMORY_SCOPE_AGENT);
        for (int kb = 0; kb < nbcW; ++kb) SH_ISSUE(Kc, Vc, kb, kb, true);
        SH_WAIT_BAR();
        if (c.tid == 0) { qs[(kk + 1) & 1] = nq; asm volatile("s_waitcnt lgkmcnt(0)" ::: "memory"); }
        for (int kb = 0; kb < nbcW; ++kb) {
#pragma unroll
            for (int pr = 0; pr < 2; ++pr) if (kb < nbc[pr])
                attn_step_lds(SH_SLOT(kb), qf[pr], kb * 64, (tcol[pr] - 31) >> 4, -1, true, true, 16 * (kb * 64 + 63) + 31 <= t0[pr], O[pr], lsum[pr], lane, fq);
        }
        float il[2];
#pragma unroll
        for (int pr = 0; pr < 2; ++pr) { float l = lsum[pr]; l += __shfl_xor(l, 16); l += __shfl_xor(l, 32); il[pr] = l > 0.f ? 1.0f / l : 0.f;
#pragma unroll
            for (int dt = 0; dt < 4; ++dt) out[pr][dt] = O[pr][dt] * (g0[pr] * il[pr]); }
        for (int i = lane; i < 4 * 136; i += 64) imp[i] = 0.f;
        for (int kb = 0; kb < nbcW; ++kb) {
            if (kb < nbc[1]) {
                SH_READ_K(kb);
#pragma unroll
                for (int pr = 0; pr < 2; ++pr) if (kb < nbc[pr]) {
                    f32x4 s4[4];
#pragma unroll
                    for (int kt = 0; kt < 4; ++kt) { s4[kt] = (f32x4){0.f, 0.f, 0.f, 0.f};
#pragma unroll
                        for (int ks = 0; ks < 2; ++ks) s4[kt] = mfma16(kf[kt * 2 + ks], qf[pr][ks], s4[kt]); }
                    MFMA_FENCE();
#pragma unroll
                    for (int kt = 0; kt < 4; ++kt) {
                        float pa = 0.f, p3 = 0.f;
#pragma unroll
                        for (int r = 0; r < 4; ++r) { const int key = kb * 64 + 16 * kt + 4 * fq + r; const bool ok = (16 * key + 31 <= tcol[pr]);
                            const float p = ok ? fexp2(s4[kt][r]) * il[pr] : 0.f; pa += p; if (r == 3) p3 = p; }
                        pa = sum8(pa); p3 = sum8(p3);
                        const int jb = 4 * (4 * kb + kt) + fq, tk = pr * 2 + (fr >> 3);
                        if ((fr & 7) == 0) { (void)__hip_atomic_fetch_add((LAS float*)imp + tk * 136 + jb, pa, __ATOMIC_RELAXED, __HIP_MEMORY_SCOPE_WORKGROUP);
                            (void)__hip_atomic_fetch_add((LAS float*)imp + tk * 136 + jb + 1, p3, __ATOMIC_RELAXED, __HIP_MEMORY_SCOPE_WORKGROUP); }
                    }
                }
            }
        }
        unsigned long long msk[2][2][2];
        {
            bool vl[4], vh[4]; unsigned ul[4], uh[4], T[4];
#pragma unroll
            for (int tk = 0; tk < 4; ++tk) {
                const int t = T0 + 4 * wave + tk, cur = t >> 6; const int jl = lane, jh = lane + 64;
                vl[tk] = jl <= cur; vh[tk] = jh <= cur;
                const bool fl = (jl == 0) || (jl == cur) || (jl == cur - 1), fh = (jh == cur) || (jh == cur - 1);
                ul[tk] = fl ? 0x7f800000u : __float_as_uint(imp[tk * 136 + jl]); uh[tk] = fh ? 0x7f800000u : __float_as_uint(imp[tk * 136 + jh]); T[tk] = 0u;
            }
            int cT[4];
#pragma unroll
            for (int tk = 0; tk < 4; ++tk) cT[tk] = __popcll(__ballot(vl[tk])) + __popcll(__ballot(vh[tk]));
#pragma unroll 1
            for (int bit = 30; bit >= 0; --bit) {
#pragma unroll
                for (int tk = 0; tk < 4; ++tk) { const unsigned cand = T[tk] | (1u << bit);
                    const int cnt = __popcll(__ballot(vl[tk] && ul[tk] >= cand)) + __popcll(__ballot(vh[tk] && uh[tk] >= cand));
                    if (cnt >= 16) { T[tk] = cand; cT[tk] = cnt; } }
                if (cT[0] <= 16 && cT[1] <= 16 && cT[2] <= 16 && cT[3] <= 16) break;
            }
#pragma unroll
            for (int tk = 0; tk < 4; ++tk) {
                const unsigned long long gtl = __ballot(vl[tk] && ul[tk] > T[tk]), gth = __ballot(vh[tk] && uh[tk] > T[tk]);
                const unsigned long long eql = __ballot(vl[tk] && ul[tk] == T[tk]), eqh = __ballot(vh[tk] && uh[tk] == T[tk]);
                const int need = 16 - (__popcll(gtl) + __popcll(gth));
                const unsigned long long lm = (1ull << lane) - 1ull;
                const int rl = __popcll(eql & lm), rh = __popcll(eql) + __popcll(eqh & lm);
                msk[tk >> 1][tk & 1][0] = gtl | __ballot(vl[tk] && ul[tk] == T[tk] && rl < need); msk[tk >> 1][tk & 1][1] = gth | __ballot(vh[tk] && uh[tk] == T[tk] && rh < need);
            }
        }
        const bf16_t* Kw = WSP(bf16_t, WS_KW) + (size_t)bg * 128 * 4096; const bf16_t* Vw = WSP(bf16_t, WS_VWT) + (size_t)bg * 128 * 4096;
        const int loW = T0 - 511 > 0 ? T0 - 511 : 0; const int jb0W = loW >> 6, jb1W = (T0 + 31) >> 6;
        const int wbase = (((curW >> 2) + 1) & 1) * 4;
        {
            const bf16_t* Ks = WSP(bf16_t, WS_KS) + (size_t)bg * 128 * 4096; const bf16_t* Vs = WSP(bf16_t, WS_VST) + (size_t)bg * 128 * 4096;
            NSA_ZERO_O();
            unsigned long long any[2][2], mine[2][2], both[2][2];
#pragma unroll
            for (int pr = 0; pr < 2; ++pr)
#pragma unroll
                for (int h = 0; h < 2; ++h) { any[pr][h] = msk[pr][0][h] | msk[pr][1][h]; both[pr][h] = msk[pr][0][h] & msk[pr][1][h]; mine[pr][h] = (fr >> 3) ? msk[pr][1][h] : msk[pr][0][h]; }
            const int ng = (curW >> 2) + 1;
            SH_BAR();
#pragma unroll
            for (int bb = 0; bb < 4; ++bb) if (bb <= curW) SH_ISSUE(Ks, Vs, bb, bb, true);
            for (int gi = 0; gi < ng; ++gi) {
                SH_WAIT_BAR();
                if (gi + 1 < ng) {
#pragma unroll
                    for (int bb = 0; bb < 4; ++bb) if (4 * (gi + 1) + bb <= curW) SH_ISSUE(Ks, Vs, 4 * (gi + 1) + bb, ((gi + 1) & 1) * 4 + bb, true);
                } else SH_ISSUE(Kw, Vw, jb0W, ((gi + 1) & 1) * 4, true);
#pragma unroll 1
                for (int bb = 0; bb < 4; ++bb) {
                    const int j = 4 * gi + bb; if (j > curW) break;
                    const int slot = (gi & 1) * 4 + bb;
                    const bool a0 = ((j < 64 ? (any[0][0] >> j) : (any[0][1] >> (j - 64))) & 1ull) != 0ull, a1 = ((j < 64 ? (any[1][0] >> j) : (any[1][1] >> (j - 64))) & 1ull) != 0ull;
#pragma unroll
                    for (int pr = 0; pr < 2; ++pr) if (pr == 0 ? a0 : a1) {
                        const bool colok = ((j < 64 ? (mine[pr][0] >> j) : (mine[pr][1] >> (j - 64))) & 1ull) != 0ull;
                        const bool bothsel = ((j < 64 ? (both[pr][0] >> j) : (both[pr][1] >> (j - 64))) & 1ull) != 0ull;
                        attn_step_lds(SH_SLOT(slot), qf[pr], j * 64, tcol[pr], -1, colok, bothsel, j * 64 + 63 <= t0[pr], O[pr], lsum[pr], lane, fq); }
                }
            }
#pragma unroll
            for (int pr = 0; pr < 2; ++pr) { float l = lsum[pr]; l += __shfl_xor(l, 16); l += __shfl_xor(l, 32); const float sc = l > 0.f ? g1[pr] / l : 0.f;
#pragma unroll
                for (int dt = 0; dt < 4; ++dt) out[pr][dt] += O[pr][dt] * sc; }
        }
        {
            NSA_ZERO_O();
            for (int jb = jb0W; jb <= jb1W; ++jb) {
                const int slot = wbase + ((jb - jb0W) & 1);
                SH_WAIT_BAR();
                if (jb < jb1W) SH_ISSUE(Kw, Vw, jb + 1, wbase + ((jb + 1 - jb0W) & 1), true);
#pragma unroll
                for (int pr = 0; pr < 2; ++pr) { const int lo = t0[pr] - 511 > 0 ? t0[pr] - 511 : 0;
                    if (jb >= (lo >> 6) && jb <= ((t0[pr] + 1) >> 6))
                        attn_step_lds(SH_SLOT(slot), qf[pr], jb * 64, tcol[pr], tcol[pr] - 512, true, true, jb * 64 > t0[pr] + 1 - 512 && jb * 64 + 63 <= t0[pr], O[pr], lsum[pr], lane, fq); }
            }
#pragma unroll
            for (int pr = 0; pr < 2; ++pr) { float l = lsum[pr]; l += __shfl_xor(l, 16); l += __shfl_xor(l, 32); const float sc = l > 0.f ? g2[pr] / l : 0.f;
#pragma unroll
                for (int dt = 0; dt < 4; ++dt) out[pr][dt] += O[pr][dt] * sc; }
        }
#pragma unroll
        for (int pr = 0; pr < 2; ++pr) { bf16_t* op = WSP(bf16_t, WS_RA) + tokc[pr] * 2048 + 1024 + head * 64 + 4 * fq;
#pragma unroll
            for (int dt = 0; dt < 4; ++dt) { u32x2 ov; ov.x = pk2(out[pr][dt][0], out[pr][dt][1]); ov.y = pk2(out[pr][dt][2], out[pr][dt][3]); *(u32x2*)(op + 16 * dt) = ov; } }
#undef NSA_ZERO_O
        {
#pragma unroll 1
            for (int r = kk * crpt; r < (kk + 1) * crpt && r < crounds; ++r) { const int item = c.gw + r * (c.G * NWAVES);
                if (item < cntot) { const bool nx = lconv >= 0 && item < CONV_ITEMS; const int i0 = nx ? item : item - (lconv >= 0 ? CONV_ITEMS : 0);
                    if (nx || !conv_is_early(i0)) conv_one(c, nx ? lconv : 0, i0); } }
        }
    }
#pragma unroll 1
    for (int r = kk * crpt; r < crounds; ++r) { const int item = c.gw + r * (c.G * NWAVES);
        if (item < cntot) { const bool nx = lconv >= 0 && item < CONV_ITEMS; const int i0 = nx ? item : item - (lconv >= 0 ? CONV_ITEMS : 0);
            if (nx || !conv_is_early(i0)) conv_one(c, nx ? lconv : 0, i0); } }
    SH_BAR();
#undef NSA_QCTR
}

__device__ __forceinline__ void phase_route(const Ctx& c, int l) {
    const int lane = c.lane, gw = c.gw, NW = c.G * NWAVES, fr = lane & 15, fq = lane >> 4;
    LAS int* cnt = (LAS int*)(c.lds + LDS_CTL_OFF + 64);
    if (c.tid < 32) cnt[c.tid] = 0;
    for (int i = blockIdx.x * NTHREADS + c.tid; i < XROWS; i += c.G * NTHREADS) WSP(int, WS_ROWTOK)[i] = 0;
    __syncthreads();
    const bf16_t* rwf = WSP(bf16_t, WS_RWF) + (size_t)l * 32 * 2 * 2 * 512 + lane * 8;
    const float b0 = c.router_b[(size_t)l * NEXP + fr], b1 = c.router_b[(size_t)l * NEXP + 16 + fr];
    for (int tile = gw; tile < NTOK / 16; tile += NW) {
        const int tok0 = tile * 16; const float* xr = (l == 0 ? c.x_in : (const float*)c.out) + (size_t)(tok0 + fr) * D + 4 * fq;
        const bf16_t* dr = WSP(bf16_t, WS_PROJ) + (size_t)(tok0 + fr) * D + 4 * fq;
        bf16_t* hrow = WSP(bf16_t, WS_H) + (size_t)(tok0 + fr) * D + 4 * fq;
        f32x4 acc0 = {0.f, 0.f, 0.f, 0.f}, acc1 = {0.f, 0.f, 0.f, 0.f}; float ss = 0.f;
#pragma unroll 1
        for (int kg = 0; kg < 8; ++kg) {
            f32x4 xa[4], xb[4]; u32x2 da[4], db[4]; bf16x8 wv[4][4];
#pragma unroll
            for (int u = 0; u < 4; ++u) { const int ks = kg * 4 + u; xa[u] = *(const f32x4*)(xr + 32 * ks); xb[u] = *(const f32x4*)(xr + 32 * ks + 16);
                da[u] = *(const u32x2*)(dr + 32 * ks); db[u] = *(const u32x2*)(dr + 32 * ks + 16);
#pragma unroll
                for (int q = 0; q < 4; ++q) wv[u][q] = ld8(rwf + ((size_t)ks * 4 + q) * 512); }
            __builtin_amdgcn_sched_barrier(0);
#pragma unroll
            for (int u = 0; u < 4; ++u) {
                float v[8] = {xa[u][0] + bflo(da[u].x), xa[u][1] + bfhi(da[u].x), xa[u][2] + bflo(da[u].y), xa[u][3] + bfhi(da[u].y),
                              xb[u][0] + bflo(db[u].x), xb[u][1] + bfhi(db[u].x), xb[u][2] + bflo(db[u].y), xb[u][3] + bfhi(db[u].y)}; float lo[8]; u32x4 hw, lw;
#pragma unroll
                for (int j = 0; j < 8; ++j) ss += v[j] * v[j];
#pragma unroll
                for (int j = 0; j < 4; ++j) { hw[j] = pk2(v[2 * j], v[2 * j + 1]); lo[2 * j] = v[2 * j] - bflo(hw[j]); lo[2 * j + 1] = v[2 * j + 1] - bfhi(hw[j]); }
#pragma unroll
                for (int j = 0; j < 4; ++j) lw[j] = pk2(lo[2 * j], lo[2 * j + 1]);
                const bf16x8 ah = mk8(hw), al = mk8(lw);
                { bf16_t* hp = hrow + 32 * (kg * 4 + u); u32x2 h0, h1; h0.x = hw[0]; h0.y = hw[1]; h1.x = hw[2]; h1.y = hw[3]; *(u32x2*)hp = h0; *(u32x2*)(hp + 16) = h1; }
                acc0 = mfma16(ah, wv[u][0], acc0); acc1 = mfma16(ah, wv[u][2], acc1);
                acc0 = mfma16(ah, wv[u][1], acc0); acc1 = mfma16(ah, wv[u][3], acc1);
                acc0 = mfma16(al, wv[u][0], acc0); acc1 = mfma16(al, wv[u][2], acc1);
            }
            MFMA_FENCE();
        }
        ss += __shfl_xor(ss, 16); ss += __shfl_xor(ss, 32);
        const float rs = rsqrtf(ss * (1.0f / 1024.0f) + NORM_EPS);
        if (fq == 0) WSP(float, WS_RSTD)[tok0 + fr] = rs;
#pragma unroll
        for (int r = 0; r < 4; ++r) {
            const float rt = __shfl(rs, 4 * fq + r);
            float v0 = acc0[r] * rt + b0, v1 = acc1[r] * rt + b1; float tv[4]; int te[4];
#pragma unroll
            for (int k = 0; k < 4; ++k) { float bv = v0; int be = fr; if (v1 > bv) { bv = v1; be = 16 + fr; }
#pragma unroll
                for (int o = 8; o >= 1; o >>= 1) { const float ov = __shfl_xor(bv, o); const int oe = __shfl_xor(be, o); if (ov > bv || (ov == bv && oe < be)) { bv = ov; be = oe; } }
                tv[k] = bv; te[k] = be; if (be == fr) v0 = -INFINITY; if (be == 16 + fr) v1 = -INFINITY; }
            const float e1 = expf(tv[1] - tv[0]), e2 = expf(tv[2] - tv[0]), e3 = expf(tv[3] - tv[0]); const float inv = 1.0f / (1.0f + e1 + e2 + e3);
            if (fr < 4) { const int e = fr == 0 ? te[0] : fr == 1 ? te[1] : fr == 2 ? te[2] : te[3]; const float wv_ = (fr == 0 ? 1.0f : fr == 1 ? e1 : fr == 2 ? e2 : e3) * inv;
                const int rk = atomicAdd((int*)&cnt[e], 1); const size_t o = (size_t)(tok0 + 4 * fq + r) * 4 + fr;
                WSP(int, WS_TE)[o] = e; WSP(float, WS_TW)[o] = wv_; WSP(int, WS_RANK)[o] = rk; }
        }
    }
    __syncthreads();
    if (c.tid < 32) WSP(int, WS_HIST)[blockIdx.x * 32 + c.tid] = cnt[c.tid];
    __syncthreads();
}

__device__ __forceinline__ void phase_scatter(const Ctx& c, int l) {
    const int lane = c.lane, gw = c.gw, NW = c.G * NWAVES;
    LAS int* hist = (LAS int*)c.lds;
    LAS int* part = (LAS int*)(c.lds + 65536);
    LAS int* base = part + 1024;
    LAS int* pst = base + 32;
    LAS int* nblk = pst + 40;
    for (int i = c.tid; i < c.G * 32; i += NTHREADS) hist[i] = WSP(int, WS_HIST)[i];
    __syncthreads();
    { const int e = c.tid & 31, p = c.tid >> 5, per = (c.G + 15) >> 4; const int w1 = (p + 1) * per < c.G ? (p + 1) * per : c.G; int before = 0, tot = 0;
      for (int w = p * per; w < w1; ++w) { const int v = hist[w * 32 + e]; if (w < (int)blockIdx.x) before += v; tot += v; }
      part[(p * 32 + e) * 2] = before; part[(p * 32 + e) * 2 + 1] = tot; }
    __syncthreads();
    if (c.tid < 32) { int before = 0, tot = 0;
#pragma unroll
        for (int p = 0; p < 16; ++p) { before += part[(p * 32 + c.tid) * 2]; tot += part[(p * 32 + c.tid) * 2 + 1]; }
        base[c.tid] = before; const int padded = (tot + 255) & ~255; int incl = padded;
#pragma unroll
        for (int o = 1; o < 32; o <<= 1) { const int t = __shfl_up(incl, o); if (c.tid >= o) incl += t; }
        pst[c.tid] = incl - padded; if (c.tid == 31) pst[32] = incl; nblk[c.tid] = padded >> 8; }
    __syncthreads();
    if (blockIdx.x == 0 && c.tid < 32) {
        int* meta = WSP(int, WS_META); const int e = c.tid, x = e & 7; int off = 0;
        for (int e2 = x; e2 < e; e2 += 8) off += nblk[e2];
        const int rb0 = pst[e] >> 8, nb = nblk[e];
        for (int i = 0; i < nb; ++i) { meta[64 + rb0 + i] = e; meta[1024 + 640 * x + off + i] = rb0 + i; }
        if (e >= 24) meta[16 + x] = off + nb;
        if (e == 0) meta[0] = pst[32] >> 8; }
    for (int tile = gw; tile < NTOK / 16; tile += NW) {
        const int o = tile * 64 + lane, tok = o >> 2;
        const int e = WSP(int, WS_TE)[o], rk = WSP(int, WS_RANK)[o];
        const int dst = pst[e] + base[e] + rk;
        WSP(int, WS_ROWTOK)[dst] = tok; WSP(float, WS_RSROW)[dst] = WSP(float, WS_RSTD)[tok]; WSP(int, WS_SLOT)[o] = dst;
    }
}

__device__ __forceinline__ void phase_combine(const Ctx& c, int l) {
    const int lane = c.lane, gw = c.gw, NW = c.G * NWAVES;
    for (int tok = gw; tok < NTOK; tok += NW) {
        float* xr = c.out + (size_t)tok * D; const bf16_t* hs = WSP(bf16_t, WS_H) + (size_t)tok * D;
        const u32x4 sl = *(const u32x4*)(WSP(int, WS_SLOT) + (size_t)tok * 4); const f32x4 tw = *(const f32x4*)(WSP(float, WS_TW) + (size_t)tok * 4);
        f32x4 v[4];
#pragma unroll
        for (int i = 0; i < 4; ++i) { const u32x2 d = *(const u32x2*)(hs + i * 256 + lane * 4); v[i][0] = bflo(d.x); v[i][1] = bfhi(d.x); v[i][2] = bflo(d.y); v[i][3] = bfhi(d.y); }
#pragma unroll
        for (int k = 0; k < 4; ++k) { const bf16_t* yr = WSP(bf16_t, WS_XBUF) + (size_t)sl[k] * D; const float w = tw[k];
#pragma unroll
            for (int i = 0; i < 4; ++i) { const u32x2 y = *(const u32x2*)(yr + i * 256 + lane * 4);
                v[i][0] += w * bflo(y.x); v[i][1] += w * bfhi(y.x); v[i][2] += w * bflo(y.y); v[i][3] += w * bfhi(y.y); } }
        float ss = 0.f;
#pragma unroll
        for (int i = 0; i < 4; ++i) { *(f32x4*)(xr + i * 256 + lane * 4) = v[i]; ss += v[i][0] * v[i][0] + v[i][1] * v[i][1] + v[i][2] * v[i][2] + v[i][3] * v[i][3]; }
        if (l + 1 < NL) {
            ss = wave_sum(ss); const float rs = rsqrtf(ss * (1.0f / 1024.0f) + NORM_EPS);
            const float* nw = c.norm1_w + (size_t)(l + 1) * D; bf16_t* hr = WSP(bf16_t, WS_H) + (size_t)tok * D;
#pragma unroll
            for (int i = 0; i < 4; ++i) { const f32x4 w = *(const f32x4*)(nw + i * 256 + lane * 4);
                u32x2 o; o.x = pk2(v[i][0] * rs * w[0], v[i][1] * rs * w[1]); o.y = pk2(v[i][2] * rs * w[2], v[i][3] * rs * w[3]); *(u32x2*)(hr + i * 256 + lane * 4) = o; }
        }
    }
}

constexpr int PH_PER_LAYER = 14, N_PHASES = 1 + NL * PH_PER_LAYER;
#ifndef PH_MASK
#define PH_MASK 0xffff
#endif
#define IN(k) (lo <= (k) && (k) < hi)
#define INL(j) (((PH_MASK >> ((j) + 1)) & 1) && IN(pb + (j)))
#define FRESH() do { int _t = threadIdx.x; asm volatile("" : "+v"(_t)); c.tid = _t; c.lane = _t & 63; c.wave = __builtin_amdgcn_readfirstlane(_t >> 6); c.gw = blockIdx.x * NWAVES + c.wave; } while (0)
#define SEAM(k) do { if (IN((k) + 1) || IN((k) + 2)) xcd_barrier(bar); else __syncthreads(); } while (0)

template <int l>
__device__ __forceinline__ void run_layer(Ctx& c, const XcdBarrier& bar, const int lo, const int hi) {
        const int pb = 1 + l * PH_PER_LAYER;
        if (INL(0)) { FRESH();
            g8::SchedPlain S{(const char*)WSP(bf16_t, WS_H), (const char*)(WSP(bf16_t, WS_WIN) + (size_t)l * NPROJ * D), (size_t)256 * D * 2, (size_t)256 * D * 2, NTOK / 256, NPROJ / 256, (NTOK / 256) * (NPROJ / 256), c.G, (int)blockIdx.x};
            g8::EpiBf16 E{WSP(bf16_t, WS_PROJ), NPROJ};
            g8::gemm_phase(c.lds, c.tid, D, D * 2, D * 2, S, E);
            SEAM(pb + 0);
        }
        if (INL(1)) { FRESH(); phase_prep(c, l); SEAM(pb + 1); }
        if (INL(2)) { FRESH();
            g8::SchedCmp S{(const char*)WSP(bf16_t, WS_KCT), (const char*)WSP(bf16_t, WS_VCT), (const char*)(WSP(bf16_t, WS_WC1) + (size_t)l * 2 * 256 * 2048), c.G, (int)blockIdx.x};
            g8::EpiSlab E{WSP(float, WS_ACT)};
            g8::gemm_phase(c.lds, c.tid, 256, 1024 * 2, 2048 * 2, S, E);
            SEAM(pb + 2);
        }
        if (INL(3)) { FRESH(); phase_cmp2(c, l); __syncthreads(); FRESH(); phase_scan(c); SEAM(pb + 3); }
        if (INL(5)) { FRESH(); phase_retout(c, l); FRESH(); phase_nsa(c, l, l + 1 < NL ? l + 1 : -1, l == 0); SEAM(pb + 5); }
        if (INL(7)) { FRESH();
            {
                g8::SchedPlain S{(const char*)WSP(bf16_t, WS_RA), (const char*)(WSP(bf16_t, WS_WO) + (size_t)l * D * 2048), (size_t)256 * 2048 * 2, (size_t)256 * 2048 * 2, NTOK / 256, D / 256, (NTOK / 256) * (D / 256), c.G, (int)blockIdx.x};
                g8::EpiGate E{WSP(bf16_t, WS_MIX), WSP(bf16_t, WS_PROJ), 0};
                g8::gemm_phase(c.lds, c.tid, D, 2048 * 2, 2048 * 2, S, E);
            }
            asm volatile("s_waitcnt vmcnt(0)" ::: "memory"); __syncthreads();
            {
                g8::SchedPlain S{(const char*)(WSP(bf16_t, WS_RA) + 1024), (const char*)(WSP(bf16_t, WS_WO) + (size_t)l * D * 2048 + 1024), (size_t)256 * 2048 * 2, (size_t)256 * 2048 * 2, NTOK / 256, D / 256, (NTOK / 256) * (D / 256), c.G, (int)blockIdx.x};
                g8::EpiGate E{WSP(bf16_t, WS_MIX), WSP(bf16_t, WS_PROJ), 1};
                g8::gemm_phase(c.lds, c.tid, D, 2048 * 2, 2048 * 2, S, E);
            }
            SEAM(pb + 7);
        }
        if (INL(8)) { FRESH();
            g8::SchedPlain S{(const char*)WSP(bf16_t, WS_MIX), (const char*)(WSP(bf16_t, WS_WOUT) + (size_t)l * D * D), (size_t)256 * D * 2, (size_t)256 * D * 2, NTOK / 256, D / 256, (NTOK / 256) * (D / 256), c.G, (int)blockIdx.x};
            g8::EpiBf16 E{WSP(bf16_t, WS_PROJ), D};
            g8::gemm_phase(c.lds, c.tid, D, D * 2, D * 2, S, E);
            SEAM(pb + 8);
        }
        if (INL(9)) { FRESH(); phase_route(c, l); SEAM(pb + 9); }
        if (INL(10)) { FRESH(); phase_scatter(c, l); SEAM(pb + 10); }
        if (INL(11)) { FRESH();
            LAS int* tab = (LAS int*)(c.lds + 131072); g8::moe_units(tab, WSP(int, WS_META), 8, c.G, (int)blockIdx.x, c.tid);
            g8::SchedMoeG S{(const char*)WSP(bf16_t, WS_H), (const char*)(WSP(bf16_t, WS_WGU) + (size_t)l * NEXP * 2048 * D), tab, 8, (size_t)2048 * D * 2, WSP(int, WS_ROWTOK)};
            g8::EpiSwiglu E{WSP(bf16_t, WS_ACT), c.b_gate_up + (size_t)l * NEXP * 2048, WSP(float, WS_RSROW), c.lds + 131072 + 8192};
            g8::gemm_phase(c.lds, c.tid, D, D * 2, D * 2, S, E);
            SEAM(pb + 11);
        }
        if (INL(12)) { FRESH();
            LAS int* tab = (LAS int*)(c.lds + 131072); g8::moe_units(tab, WSP(int, WS_META), 4, c.G, (int)blockIdx.x, c.tid);
            g8::SchedMoe S{(const char*)WSP(bf16_t, WS_ACT), (const char*)(WSP(bf16_t, WS_WD) + (size_t)l * NEXP * D * D), tab, 4, (size_t)D * D * 2};
            g8::EpiDown E{WSP(bf16_t, WS_XBUF), c.b_down + (size_t)l * NEXP * D};
            g8::gemm_phase(c.lds, c.tid, D, D * 2, D * 2, S, E);
            SEAM(pb + 12);
        }
        if (INL(13)) { FRESH(); phase_combine(c, l); SEAM(pb + 13); }
    }
__global__ void __launch_bounds__(NTHREADS, 2) mk_fwd(Args args) {
    extern __shared__ __attribute__((aligned(16))) unsigned char lds_raw[];
    Ctx c;
    c.x_in = args.in[0]; c.norm1_w = args.in[1]; c.w_in = args.in[2]; c.ret_gn_w = args.in[3]; c.qk_norm_w = args.in[4]; c.cmp_pos = args.in[5]; c.cmp_w1 = args.in[6]; c.cmp_w2 = args.in[7];
    c.w_o_ret = args.in[8]; c.w_o_nsa = args.in[9]; c.w_out = args.in[10]; c.norm2_w = args.in[11]; c.router_w = args.in[12]; c.router_b = args.in[13]; c.w_gate_up = args.in[14]; c.b_gate_up = args.in[15];
    c.w_down = args.in[16]; c.b_down = args.in[17];
    c.out = args.out; c.ws = args.ws; c.lds = (LAS unsigned char*)lds_raw;
    c.tid = threadIdx.x; c.lane = c.tid & 63; c.wave = __builtin_amdgcn_readfirstlane(c.tid >> 6); c.G = gridDim.x; c.gw = blockIdx.x * NWAVES + c.wave;
    volatile LAS unsigned* lctl = (volatile LAS unsigned*)(c.lds + LDS_CTL_OFF);
    if (c.tid < 16) lctl[c.tid] = 0u;
    __syncthreads();
    const int lo = args.ph_lo, hi = args.ph_hi;
    XcdBarrier bar; bar.bar = WSP(unsigned, WS_CTL); bar.x = 0; bar.st = lctl;
    if (hi - lo > 1) bar = xcd_barrier_post(WSP(unsigned, WS_CTL), lctl);
    if ((PH_MASK & 1) && IN(0)) { FRESH(); phase_prologue(c); SEAM(0); }

    run_layer<0>(c, bar, lo, hi); run_layer<1>(c, bar, lo, hi); run_layer<2>(c, bar, lo, hi); run_layer<3>(c, bar, lo, hi);
#undef IN
#undef INL
#undef SEAM
}


extern "C" void kernel_launch(void* const* d_in, const int* in_sizes, int n_in, void* d_out, int out_size, void* d_ws, size_t ws_size, hipStream_t stream) {
    static int grid = 0;
    if (grid == 0) {
        if (n_in != 18 || out_size != NTOK * D || ws_size < WS_END) { fprintf(stderr, "kernel_launch: unexpected shapes (n_in %d out %d ws %zu need %zu)\n", n_in, out_size, ws_size, (size_t)WS_END); grid = -1; return; }
        int dev = 0, cus = 0;
        if (hipGetDevice(&dev) != hipSuccess || hipDeviceGetAttribute(&cus, hipDeviceAttributeMultiprocessorCount, dev) != hipSuccess) { grid = -1; return; }
        if (hipFuncSetAttribute((const void*)mk_fwd, hipFuncAttributeMaxDynamicSharedMemorySize, LDS_BYTES) != hipSuccess) { fprintf(stderr, "kernel_launch: hipFuncSetAttribute failed\n"); grid = -1; return; }
        int per_cu = 0;
        if (hipOccupancyMaxActiveBlocksPerMultiprocessor(&per_cu, (const void*)mk_fwd, NTHREADS, LDS_BYTES) != hipSuccess || per_cu < 1) fprintf(stderr, "kernel_launch: occupancy query says %d\n", per_cu);
        (void)hipGetLastError();
        grid = cus;
    }
    if (grid < 0) return;
    (void)hipMemsetAsync((char*)d_ws + WS_CTL, 0, CTL_BYTES, stream);
    Args a{};
    for (int i = 0; i < 18; ++i) a.in[i] = (const float*)d_in[i];
    a.out = (float*)d_out; a.ws = (unsigned char*)d_ws;
#if MK_ONE_LAUNCH
    a.ph_lo = 0; a.ph_hi = N_PHASES;
    hipLaunchKernelGGL(mk_fwd, dim3(grid), dim3(NTHREADS), LDS_BYTES, stream, a);
#else
    for (int p = 0; p < N_PHASES; ++p) { a.ph_lo = p; a.ph_hi = p + 1; hipLaunchKernelGGL(mk_fwd, dim3(grid), dim3(NTHREADS), LDS_BYTES, stream, a); }
#endif
}
```

```cpp
#include <hip/hip_runtime.h>
#include <stdint.h>
#include <stdio.h>

#ifndef MK_ONE_LAUNCH
#define MK_ONE_LAUNCH 1
#endif

#define LAS __attribute__((address_space(3)))
typedef unsigned short bf16_t;
typedef short bf16x8 __attribute__((ext_vector_type(8)));
typedef float f32x4 __attribute__((ext_vector_type(4)));
typedef float f32x2 __attribute__((ext_vector_type(2)));
typedef unsigned u32x4 __attribute__((ext_vector_type(4)));
typedef unsigned u32x2 __attribute__((ext_vector_type(2)));

constexpr int D = 1024, NB = 4, SEQ = 8192, NTOK = NB * SEQ, NL = 4;
constexpr int NPROJ = 7168, IN_TOTAL = 6960;
constexpr int C_RQ = 0, C_RK = 512, C_RV = 1024, C_RG = 2048, C_NQ = 3072, C_KC = 4096, C_VC = 4224, C_KS = 4352, C_VS = 4480, C_KW = 4608, C_VW = 4736, C_NG = 4864, C_MG = 5120;
constexpr int NEXP = 32, XROWS = 139264;
constexpr int NWAVES = 8, NTHREADS = 512;
constexpr float NORM_EPS = 1e-6f;

constexpr size_t al256(size_t x) { return (x + 255) & ~(size_t)255; }
constexpr size_t WS_CTL = 0, CTL_BYTES = 65536;
constexpr size_t WS_HIST = WS_CTL + CTL_BYTES;
constexpr size_t WS_META = WS_HIST + 1024 * 32 * 4;
constexpr size_t WS_ROPER = WS_META + 32768;
constexpr size_t WS_ROPEN = WS_ROPER + (size_t)SEQ * 64 * 2 * 4;
constexpr size_t WS_PEB = WS_ROPEN + (size_t)SEQ * 8 * 2 * 4;
constexpr size_t WS_RWF = al256(WS_PEB + 8 * NL * 2 * 256 * 4);
constexpr size_t WS_RSTD = WS_RWF + (size_t)NL * 32 * 2 * 2 * 512 * 2;
constexpr size_t WS_WIN = al256(WS_RSTD + (size_t)NTOK * 4);
constexpr size_t WS_WO = WS_WIN + (size_t)NL * NPROJ * D * 2;
constexpr size_t WS_WOUT = WS_WO + (size_t)NL * D * 2048 * 2;
constexpr size_t WS_WC1 = WS_WOUT + (size_t)NL * D * D * 2;
constexpr size_t WS_WGU = WS_WC1 + (size_t)NL * 2 * 256 * 2048 * 2;
constexpr size_t WS_WD = WS_WGU + (size_t)NL * NEXP * 2048 * D * 2;
constexpr size_t WS_H = WS_WD + (size_t)NL * NEXP * D * D * 2;
constexpr size_t WS_PROJ = WS_H + (size_t)NTOK * D * 2;
constexpr size_t WS_QR = WS_PROJ + (size_t)NTOK * NPROJ * 2;
constexpr size_t WS_KR = WS_QR + (size_t)NTOK * 512 * 2;
constexpr size_t WS_KZT = WS_KR + (size_t)NTOK * 512 * 2;
constexpr size_t WS_VT = WS_KZT + (size_t)NTOK * 512 * 2;
constexpr size_t WS_RT = WS_VT + (size_t)NTOK * 1024 * 2;
constexpr size_t WS_QN = WS_RT + (size_t)16 * 64 * 256 * 128 * 2;
constexpr size_t WS_KS = WS_QN + (size_t)NTOK * 1024 * 2;
constexpr size_t WS_VST = WS_KS + (size_t)NTOK * 128 * 2;
constexpr size_t WS_KW = WS_VST + (size_t)NTOK * 128 * 2;
constexpr size_t WS_VWT = WS_KW + (size_t)NTOK * 128 * 2;
constexpr size_t WS_KCT = WS_VWT + (size_t)NTOK * 128 * 2;
constexpr size_t WS_VCT = WS_KCT + (size_t)NTOK * 128 * 2 + 4096;
constexpr size_t WS_HID = WS_VCT + (size_t)NTOK * 128 * 2 + 4096;
constexpr size_t WS_KCMP = WS_HID + (size_t)2 * 8 * 512 * 256 * 2;
constexpr size_t WS_VCMPT = WS_KCMP + (size_t)8 * 512 * 64 * 2;
constexpr size_t WS_RA = WS_VCMPT + (size_t)8 * 512 * 64 * 2;
constexpr size_t WS_MIX = WS_RA + (size_t)NTOK * 2048 * 2;
constexpr size_t WS_TE = WS_MIX + (size_t)NTOK * D * 2;
constexpr size_t WS_TW = WS_TE + (size_t)NTOK * 16;
constexpr size_t WS_RANK = WS_TW + (size_t)NTOK * 16;
constexpr size_t WS_SLOT = WS_RANK + (size_t)NTOK * 16;
constexpr size_t WS_ROWTOK = WS_SLOT + (size_t)NTOK * 16;
constexpr size_t WS_RSROW = WS_ROWTOK + (size_t)XROWS * 4;
constexpr size_t WS_XBUF = al256(WS_RSROW + (size_t)XROWS * 4);
constexpr size_t WS_ACT = WS_XBUF + (size_t)XROWS * D * 2;
constexpr size_t WS_END = WS_ACT + (size_t)XROWS * D * 2;

constexpr int LDS_SCRATCH = 149504;
constexpr int LDS_CTL_OFF = LDS_SCRATCH;
constexpr int LDS_BYTES = LDS_SCRATCH + 1024;

__device__ __forceinline__ float bf2f(bf16_t v) { return __uint_as_float(((unsigned)v) << 16); }
__device__ __forceinline__ float bflo(unsigned w) { return __uint_as_float(w << 16); }
__device__ __forceinline__ float bfhi(unsigned w) { return __uint_as_float(w & 0xffff0000u); }
__device__ __forceinline__ unsigned f2bf(float f) { unsigned u = __float_as_uint(f); return (u + 0x7fffu + ((u >> 16) & 1u)) >> 16; }
typedef __bf16 bf16x2_t __attribute__((ext_vector_type(2)));
__device__ __forceinline__ unsigned pk2(float lo, float hi) { const f32x2 v = {lo, hi}; const bf16x2_t r = __builtin_convertvector(v, bf16x2_t); return __builtin_bit_cast(unsigned, r); }
__device__ __forceinline__ float fexp2(float x) { return __builtin_amdgcn_exp2f(x); }
__device__ __forceinline__ float frcp(float x) { return __builtin_amdgcn_rcpf(x); }
__device__ __forceinline__ float sigmoidf_(float x) { return frcp(1.0f + fexp2(-1.4426950408889634f * x)); }
__device__ __forceinline__ bf16x8 mk8(u32x4 v) { return __builtin_bit_cast(bf16x8, v); }
__device__ __forceinline__ bf16x8 ld8(const bf16_t* p) { return __builtin_bit_cast(bf16x8, *(const u32x4*)p); }
__device__ __forceinline__ f32x4 mfma16(bf16x8 a, bf16x8 b, f32x4 c) { return __builtin_amdgcn_mfma_f32_16x16x32_bf16(a, b, c, 0, 0, 0); }
#define MFMA_FENCE() do { __builtin_amdgcn_sched_barrier(0); asm volatile("s_nop 7\n\ts_nop 7" ::: "memory"); __builtin_amdgcn_sched_barrier(0); } while (0)
__device__ __forceinline__ float sum8(float v) { v += __int_as_float(__builtin_amdgcn_update_dpp(0, __float_as_int(v), 0xB1, 0xf, 0xf, true));
    v += __int_as_float(__builtin_amdgcn_update_dpp(0, __float_as_int(v), 0x4E, 0xf, 0xf, true)); v += __int_as_float(__builtin_amdgcn_update_dpp(0, __float_as_int(v), 0x141, 0xf, 0xf, true)); return v; }
__device__ __forceinline__ float wave_sum(float v) {
#pragma unroll
    for (int o = 32; o >= 1; o >>= 1) v += __shfl_xor(v, o);
    return v;
}

#define XB_TMO      128
#define XB_XCNT(j)  (256  + 64 * (j))
#define XB_XSUB(j)  (1280 + 64 * (j))
#define XB_XGEN(j)  (2304 + 64 * (j))
#define XB_TOP      3328
#define XB_TOPGEN   3392
#define XCD_BAR_WORDS 3456
#define XB_SPIN_CAP (1u << 18)
__device__ __forceinline__ unsigned xb_ld(unsigned* p)              { return __hip_atomic_load(p, __ATOMIC_RELAXED, __HIP_MEMORY_SCOPE_AGENT); }
__device__ __forceinline__ unsigned xb_add(unsigned* p, unsigned v) { return __hip_atomic_fetch_add(p, v, __ATOMIC_RELAXED, __HIP_MEMORY_SCOPE_AGENT); }
__device__ __forceinline__ unsigned xb_xcc_id() { return (unsigned)__builtin_amdgcn_s_getreg((3 << 11) | 20) & 0xFu; }
#define XB_SPIN(cond, bar) do { unsigned _sp = 0; while (cond) { __builtin_amdgcn_s_sleep(1); \
    if ((++_sp & 255u) == 0u) { if (xb_ld(&(bar)[XB_TMO])) break; if (_sp > XB_SPIN_CAP) { atomicAdd(&(bar)[XB_TMO], 1u); break; } } } } while (0)
struct XcdBarrier { unsigned* bar; unsigned x; volatile LAS unsigned* st; };
__device__ __forceinline__ XcdBarrier xcd_barrier_post(unsigned* bar, volatile LAS unsigned* st) {
    XcdBarrier b; b.bar = bar; b.x = xb_xcc_id(); b.st = st;
    if (threadIdx.x == 0) (void)xb_add(&bar[XB_XCNT(b.x)], 1u);
    return b;
}
__device__ __forceinline__ void xcd_barrier_complete(unsigned* bar, unsigned x, unsigned& nloc, unsigned& nx) {
    const unsigned G = gridDim.x * gridDim.y * gridDim.z;
    unsigned sum, cnt, mine, sp = 0u;
    for (;;) {
        sum = 0u; cnt = 0u; mine = 0u;
#pragma unroll
        for (unsigned j = 0; j < 16; ++j) { const unsigned c = xb_ld(&bar[XB_XCNT(j)]); sum += c; cnt += (c > 0u) ? 1u : 0u; mine = (j == x) ? c : mine; }
        if (sum == G) break;
        __builtin_amdgcn_s_sleep(1);
        if ((++sp & 255u) == 0u) { if (xb_ld(&bar[XB_TMO])) break; if (sp > XB_SPIN_CAP) { atomicAdd(&bar[XB_TMO], 1u); break; } }
    }
    nloc = mine > 0u ? mine : 1u; nx = cnt > 0u ? cnt : 1u;
}
__device__ __forceinline__ void xcd_barrier(const XcdBarrier& b) {
    asm volatile("s_waitcnt vmcnt(0)" ::: "memory");
    __syncthreads();
    if (threadIdx.x == 0) {
        unsigned* bar = b.bar;
        __builtin_amdgcn_s_waitcnt(0);
        unsigned nloc = b.st[0], nx = b.st[1];
        if (nloc == 0u) { xcd_barrier_complete(bar, b.x, nloc, nx); b.st[0] = nloc; b.st[1] = nx; }
        const unsigned old = xb_add(&bar[XB_XSUB(b.x)], 1u);
        const unsigned gen = old / nloc;
        if (old + 1u == (gen + 1u) * nloc) {
            __builtin_amdgcn_fence(__ATOMIC_RELEASE, "agent");
            asm volatile("s_waitcnt vmcnt(0)" ::: "memory");
            const unsigned og = xb_add(&bar[XB_TOP], 1u);
            const unsigned tg = og / nx;
            if (og + 1u == (tg + 1u) * nx) xb_add(&bar[XB_TOPGEN], 1u);
            else XB_SPIN(xb_ld(&bar[XB_TOPGEN]) == tg, bar);
            __builtin_amdgcn_fence(__ATOMIC_ACQUIRE, "agent");
            xb_add(&bar[XB_XGEN(b.x)], 1u);
            asm volatile("s_waitcnt vmcnt(0)" ::: "memory");
        } else {
            XB_SPIN(xb_ld(&bar[XB_XGEN(b.x)]) == gen, bar);
            __builtin_amdgcn_fence(__ATOMIC_ACQUIRE, "agent");
            asm volatile("s_waitcnt vmcnt(0)" ::: "memory");
        }
    }
    __syncthreads();
}

struct Args { const float* in[18]; float* out; unsigned char* ws; int ph_lo, ph_hi; };
struct Ctx {
    const float *x_in, *norm1_w, *w_in, *ret_gn_w, *qk_norm_w, *cmp_pos, *cmp_w1, *cmp_w2, *w_o_ret, *w_o_nsa, *w_out, *norm2_w, *router_w, *router_b, *w_gate_up, *b_gate_up, *w_down, *b_down;
    float* out; unsigned char* ws; LAS unsigned char* lds;
    int tid, lane, wave, gw, G;
};
#define WSP(T, off) ((T*)(c.ws + (off)))

namespace g8 {
constexpr int BM = 256, BK = 64, HALF = 128, HTB = HALF * BK * 2, STAGE_BYTES = 8 * HTB, NXCD = 8, WGM = 8;
__device__ __forceinline__ int lds_byte(int r, int c) { const int st = (r >> 4) * 2 + (c >> 5), rr = r & 15, cc = c & 31, ob = rr * 64 + cc * 2; return st * 1024 + (ob ^ (((ob >> 9) & 1) << 5)); }
__device__ __forceinline__ void stage_rc(int b, int& R, int& C) { const int st = b / 1024, sb = b % 1024, swz = sb ^ (((sb >> 9) & 1) << 5); R = (st >> 1) * 16 + swz / 64; C = (st & 1) * 32 + (swz % 64) / 2; }
__device__ __forceinline__ int perm32(int rho) { const int n = rho >> 4, i = rho & 15; return 8 * (i >> 2) + 4 * n + (i & 3); }

struct Unit { const char* A; const char* B; int pm, pn, e; };

struct SchedPlain {
    static constexpr bool GATHER = false;
    const char* A; const char* B; size_t tA, tB; int nM, nN, nwg, G, c;
    __device__ __forceinline__ bool next(int i, Unit& u) const {
        const long L = (long)i * G + c; if (L >= nwg) return false;
        int wgid = (int)L; { const int q = nwg / NXCD, r = nwg % NXCD, xcd = wgid % NXCD, off = wgid / NXCD; wgid = (xcd < r ? xcd * (q + 1) : r * (q + 1) + (xcd - r) * q) + off; }
        const int nig = WGM * nN, gid = wgid / nig, fm = gid * WGM, gsz = (nM - fm) < WGM ? (nM - fm) : WGM;
        u.pm = fm + ((wgid % nig) % gsz); u.pn = (wgid % nig) / gsz; u.e = 0;
        u.A = A + (size_t)u.pm * tA; u.B = B + (size_t)u.pn * tB; return true;
    }
};
struct SchedCmp {         static constexpr bool GATHER = false;
    const char* KCT; const char* VCT; const char* W; int G, c;
    __device__ __forceinline__ bool next(int i, Unit& u) const {
        const int idx = i * G + c; if (idx >= 256) return false;
        const int ksl = idx & 7, r = idx >> 3, kv = r >> 4, bg = (r >> 1) & 7, half = r & 1;
        u.A = (kv ? VCT : KCT) + ((size_t)bg * SEQ * 64 + (size_t)half * 256 * 1024 + (size_t)ksl * 256) * 2;
        u.B = W + ((size_t)kv * 256 * 2048 + (size_t)ksl * 256) * 2; u.pm = (kv * 8 + bg) * 2 + half; u.pn = 0; u.e = ksl; return true;
    }
};
struct SchedMoe {
    static constexpr bool GATHER = false;
    const char* A; const char* W; const LAS int* tab; int NT; size_t wstride;
    __device__ __forceinline__ bool next(int i, Unit& u) const {
        const int v = __builtin_amdgcn_readfirstlane(tab[i]); if (v < 0) return false;
        const int rb = v & 0xfff, pn = (v >> 12) & 0xf, e = v >> 16;
        u.A = A + (size_t)rb * 256 * 1024 * 2; u.B = W + (size_t)e * wstride + (size_t)pn * 256 * 1024 * 2; u.pm = rb; u.pn = pn; u.e = e; return true;
    }
};
struct SchedMoeG {
    static constexpr bool GATHER = true;
    const char* A; const char* W; const LAS int* tab; int NT; size_t wstride; const int* rowtok;
    __device__ __forceinline__ bool next(int i, Unit& u) const {
        const int v = __builtin_amdgcn_readfirstlane(tab[i]); if (v < 0) return false;
        const int rb = v & 0xfff, pn = (v >> 12) & 0xf, e = v >> 16;
        u.A = A; u.B = W + (size_t)e * wstride + (size_t)pn * 256 * 1024 * 2; u.pm = rb; u.pn = pn; u.e = e; return true;
    }
};
__device__ __forceinline__ void moe_units(LAS int* tab, const int* meta, const int NT, const int G, const int c, const int tid) {
    if (tid < 256) {
        int v = -1; const int i = tid;
        if ((G & 7) == 0) { const int x = c & 7, q = i * (G >> 3) + (c >> 3); const int nb = meta[16 + x];
            if (q < nb * NT) { const int rbi = q / NT, pn = q - rbi * NT, rb = meta[1024 + 640 * x + rbi]; v = rb | (pn << 12) | (meta[64 + rb] << 16); } }
        else { const int idx = i * G + c; const int nblk = meta[0]; if (idx < nblk * NT) { const int rb = idx / NT, pn = idx - rb * NT; v = rb | (pn << 12) | (meta[64 + rb] << 16); } }
        tab[i] = v;
    }
    __syncthreads();
}

typedef f32x4 Acc[2][2][4][2];

struct EpiBf16 {
    struct Pre {}; __device__ __forceinline__ void pre(Pre&, const Unit&, int, int, int, int) const {}
    static constexpr bool PERM = true;
    bf16_t* O; int ldc;
    __device__ __forceinline__ void operator()(const Acc& acc, const Unit& u, int wr, int wc, int fr, int fq, const Pre&) const {
        const int row0 = u.pm * BM + wr * 64 + fr, col0 = u.pn * BM + wc * 32 + 8 * fq;
#pragma unroll
        for (int ai = 0; ai < 2; ++ai)
#pragma unroll
            for (int m = 0; m < 4; ++m) { bf16_t* rowp = O + (size_t)(row0 + ai * HALF + m * 16) * ldc + col0;
#pragma unroll
                for (int bj = 0; bj < 2; ++bj) { const f32x4 v0 = acc[ai][bj][m][0], v1 = acc[ai][bj][m][1];
                    u32x4 w; w.x = pk2(v0[0], v0[1]); w.y = pk2(v0[2], v0[3]); w.z = pk2(v1[0], v1[1]); w.w = pk2(v1[2], v1[3]);
                    *(u32x4*)(rowp + bj * HALF) = w; } }
    }
};
struct EpiSlab {
    struct Pre {}; __device__ __forceinline__ void pre(Pre&, const Unit&, int, int, int, int) const {}
    static constexpr bool PERM = false;
    float* O;
    __device__ __forceinline__ void operator()(const Acc& acc, const Unit& u, int wr, int wc, int fr, int fq, const Pre&) const {
        const int row0 = u.pm * BM + wr * 64 + fr, col0 = wc * 32 + 4 * fq;
        float* base = O + (size_t)u.e * 8192 * 256;
#pragma unroll
        for (int ai = 0; ai < 2; ++ai)
#pragma unroll
            for (int m = 0; m < 4; ++m) { const size_t off = (size_t)(row0 + ai * HALF + m * 16) * 256 + col0;
#pragma unroll
                for (int bj = 0; bj < 2; ++bj)
#pragma unroll
                    for (int n = 0; n < 2; ++n) *(f32x4*)(base + off + bj * HALF + n * 16) = acc[ai][bj][m][n]; }
    }
};
struct EpiGate {
    struct Pre {}; __device__ __forceinline__ void pre(Pre&, const Unit&, int, int, int, int) const {}
    static constexpr bool PERM = true;
    bf16_t* O; const bf16_t* proj; int second;
    __device__ __forceinline__ void operator()(const Acc& acc, const Unit& u, int wr, int wc, int fr, int fq, const Pre&) const {
        const int row0 = u.pm * BM + wr * 64 + fr, col0 = u.pn * BM + wc * 32 + 8 * fq;
#pragma unroll
        for (int ai = 0; ai < 2; ++ai)
#pragma unroll
            for (int m = 0; m < 4; ++m) { const size_t row = (size_t)(row0 + ai * HALF + m * 16); const bf16_t* rp = proj + row * NPROJ + C_MG + (second ? 1024 : 0) + col0;
#pragma unroll
                for (int bj = 0; bj < 2; ++bj) { const u32x4 wb = *(const u32x4*)(rp + bj * HALF); u32x4 prev = {0u, 0u, 0u, 0u};
                    if (second) prev = *(const u32x4*)(O + row * D + col0 + bj * HALF);
                    float o[8];
#pragma unroll
                    for (int j = 0; j < 8; ++j) { const unsigned ub = wb[j >> 1], up = prev[j >> 1]; const float b = (j & 1) ? bfhi(ub) : bflo(ub), pv = (j & 1) ? bfhi(up) : bflo(up);
                        o[j] = pv + (j < 4 ? acc[ai][bj][m][0][j] : acc[ai][bj][m][1][j - 4]) * sigmoidf_(b); }
                    u32x4 w; w.x = pk2(o[0], o[1]); w.y = pk2(o[2], o[3]); w.z = pk2(o[4], o[5]); w.w = pk2(o[6], o[7]);
                    *(u32x4*)(O + row * D + col0 + bj * HALF) = w; } }
    }
};
struct EpiSwiglu {
    static constexpr bool PERM = true;
    bf16_t* O; const float* bgu;
    const float* rsrow;
    LAS unsigned char* rsl;
    struct Pre {};
    __device__ __forceinline__ void pre(Pre&, const Unit& u, int wc, int fq, int wid, int lane) const {
        LAS unsigned char* my = rsl + wid * 768;
        const float* rp = rsrow + u.pm * BM + (wid >> 2) * 64 + lane;
        __builtin_amdgcn_global_load_lds((const unsigned*)rp, (LAS unsigned*)my, 4, 0, 0);
        __builtin_amdgcn_global_load_lds((const unsigned*)(rp + HALF), (LAS unsigned*)(my + 256), 4, 0, 0);
        const float* bp = bgu + (size_t)u.e * 2048 + u.pn * 128 + wc * 32 + (lane & 31) + (lane >> 5) * 1024;
        __builtin_amdgcn_global_load_lds((const unsigned*)bp, (LAS unsigned*)(my + 512), 4, 0, 0); }
    __device__ __forceinline__ void operator()(const Acc& acc, const Unit& u, int wr, int wc, int fr, int fq, const Pre&) const {
        const int row0 = u.pm * BM + wr * 64 + fr, col0 = u.pn * 128 + wc * 32 + 8 * fq;
        const LAS unsigned char* my = rsl + (wr * 4 + wc) * 768;
        const f32x4 g0 = *(const LAS f32x4*)(my + 512 + 32 * fq), g1 = *(const LAS f32x4*)(my + 512 + 32 * fq + 16), u0 = *(const LAS f32x4*)(my + 640 + 32 * fq), u1 = *(const LAS f32x4*)(my + 640 + 32 * fq + 16);
#pragma unroll
        for (int ai = 0; ai < 2; ++ai)
#pragma unroll
            for (int m = 0; m < 4; ++m) { float o[8]; const float rs = *(const LAS float*)(my + ai * 256 + (m * 16 + fr) * 4);
#pragma unroll
                for (int j = 0; j < 8; ++j) {
                    float gv = (j < 4 ? acc[ai][0][m][0][j] * rs + g0[j] : acc[ai][0][m][1][j - 4] * rs + g1[j - 4]);
                    float uv = (j < 4 ? acc[ai][1][m][0][j] * rs + u0[j] : acc[ai][1][m][1][j - 4] * rs + u1[j - 4]);
                    gv = fminf(gv, 7.0f); uv = fminf(fmaxf(uv, -7.0f), 7.0f);
                    const float glu = gv * frcp(1.0f + fexp2(-1.702f * 1.4426950408889634f * gv)); o[j] = (uv + 1.0f) * glu; }
                u32x4 w; w.x = pk2(o[0], o[1]); w.y = pk2(o[2], o[3]); w.z = pk2(o[4], o[5]); w.w = pk2(o[6], o[7]);
                *(u32x4*)(O + (size_t)(row0 + ai * HALF + m * 16) * D + col0) = w; }
    }
};
struct EpiDown {
    static constexpr bool PERM = true;
    bf16_t* O; const float* bd;
    struct Pre { f32x4 b[2][2]; };
    __device__ __forceinline__ void pre(Pre& p, const Unit& u, int wc, int fq, int wid, int lane) const { const float* bp = bd + (size_t)u.e * D + u.pn * BM + wc * 32 + 8 * fq;
#pragma unroll
        for (int bj = 0; bj < 2; ++bj) { p.b[bj][0] = *(const f32x4*)(bp + bj * HALF); p.b[bj][1] = *(const f32x4*)(bp + bj * HALF + 4); } }
    __device__ __forceinline__ void operator()(const Acc& acc, const Unit& u, int wr, int wc, int fr, int fq, const Pre& p) const {
        const int row0 = u.pm * BM + wr * 64 + fr, col0 = u.pn * BM + wc * 32 + 8 * fq;
#pragma unroll
        for (int bj = 0; bj < 2; ++bj) { const f32x4 b0 = p.b[bj][0], b1 = p.b[bj][1];
#pragma unroll
            for (int ai = 0; ai < 2; ++ai)
#pragma unroll
                for (int m = 0; m < 4; ++m) { const f32x4 v0 = acc[ai][bj][m][0] + b0, v1 = acc[ai][bj][m][1] + b1;
                    u32x4 w; w.x = pk2(v0[0], v0[1]); w.y = pk2(v0[2], v0[3]); w.z = pk2(v1[0], v1[1]); w.w = pk2(v1[2], v1[3]);
                    *(u32x4*)(O + (size_t)(row0 + ai * HALF + m * 16) * D + col0 + bj * HALF) = w; } }
    }
};

template <class Epi, class Sched>
__device__ __forceinline__ void gemm_phase(LAS unsigned char* lds, const int tid, const int K, const unsigned lda, const unsigned ldb, const Sched& S, const Epi& E) {
    const int wid = __builtin_amdgcn_readfirstlane(tid >> 6), lane = tid & 63, wr = wid >> 2, wc = wid & 3, fr = lane & 15, fq = lane >> 4;
    const int nt = K / BK;
    unsigned voffA[2], voffB[2]; int Rs[2];
#pragma unroll
    for (int i = 0; i < 2; ++i) { int R, C; stage_rc(tid * 16 + i * 8192, R, C); const int Rb = Epi::PERM ? ((R & ~31) + perm32(R & 31)) : R; Rs[i] = R;
        voffA[i] = Sched::GATHER ? (unsigned)C * 2u : (unsigned)R * lda + (unsigned)C * 2u; voffB[i] = (unsigned)Rb * ldb + (unsigned)C * 2u; }
    unsigned offc[2][2] = {{0u, 0u}, {0u, 0u}}, offn[2][2] = {{0u, 0u}, {0u, 0u}};
    const size_t kstep = (size_t)(BK * 2);
    const size_t hstepA = (size_t)HALF * lda, hstepB = (size_t)HALF * ldb;
    const unsigned ldsw = (unsigned)wid * 1024u;
    const int aoff = lds_byte(wr * 64 + fr, fq * 8), boff = lds_byte(wc * 32 + fr, fq * 8);
#define G8_SA(b, h) (((b) * 2 + (h)) * HTB)
#define G8_SB(b, h) ((4 + (b) * 2 + (h)) * HTB)
#define G8_STAGE(bufoff, gbase, voff) do { _Pragma("unroll") for (int _i = 0; _i < 2; ++_i) \
        __builtin_amdgcn_global_load_lds((const unsigned*)((const char*)(gbase) + (voff)[_i]), (LAS unsigned*)(lds + (bufoff) + ldsw + _i * 8192), 16, 0, 0); } while (0)
#define G8_STAGEA(bufoff, kt, h, nx) do { _Pragma("unroll") for (int _i = 0; _i < 2; ++_i) { \
        const char* _g = Sched::GATHER ? (cA + (size_t)(kt) * kstep + ((nx) ? offn[h][_i] : offc[h][_i]) + voffA[_i]) : (((nx) ? nA : cA) + (size_t)(kt) * kstep + (size_t)(h) * hstepA + voffA[_i]); \
        __builtin_amdgcn_global_load_lds((const unsigned*)_g, (LAS unsigned*)(lds + (bufoff) + ldsw + _i * 8192), 16, 0, 0); } } while (0)
#define G8_LOADOFF(dst, un) do { if constexpr (Sched::GATHER) { _Pragma("unroll") for (int _h = 0; _h < 2; ++_h) _Pragma("unroll") for (int _i = 0; _i < 2; ++_i) \
        dst[_h][_i] = (unsigned)S.rowtok[(un).pm * 256 + _h * 128 + Rs[_i]] * (unsigned)(D * 2); } } while (0)
#define G8_LDA(dst, b, h) do { _Pragma("unroll") for (int m = 0; m < 4; ++m) _Pragma("unroll") for (int k = 0; k < 2; ++k) dst[m][k] = *(const LAS bf16x8*)(lds + G8_SA(b, h) + aoff + m * 2048 + k * 1024); } while (0)
#define G8_LDB(dst, b, h) do { _Pragma("unroll") for (int n = 0; n < 2; ++n) _Pragma("unroll") for (int k = 0; k < 2; ++k) dst[n][k] = *(const LAS bf16x8*)(lds + G8_SB(b, h) + boff + n * 2048 + k * 1024); } while (0)
#define G8_MMA(ai, bj, At, Bt) do { __builtin_amdgcn_s_setprio(1); _Pragma("unroll") for (int m = 0; m < 4; ++m) _Pragma("unroll") for (int n = 0; n < 2; ++n) _Pragma("unroll") for (int k = 0; k < 2; ++k) \
        acc[ai][bj][m][n] = __builtin_amdgcn_mfma_f32_16x16x32_bf16(Bt[n][k], At[m][k], acc[ai][bj][m][n], 0, 0, 0); __builtin_amdgcn_s_setprio(0); } while (0)
#define G8_WAIT_V(n) asm volatile("s_waitcnt vmcnt(" #n ")" ::: "memory")
#define G8_WAIT_L(n) asm volatile("s_waitcnt lgkmcnt(" #n ")" ::: "memory")
#define G8_BAR __builtin_amdgcn_s_barrier()
#define G8_SCHED __builtin_amdgcn_sched_barrier(0)
    Unit cur, nxt; int ui = 0;
    if (!S.next(0, cur)) return;
    Acc acc;
#pragma unroll
    for (int a = 0; a < 2; ++a)
#pragma unroll
        for (int b = 0; b < 2; ++b)
#pragma unroll
            for (int m = 0; m < 4; ++m)
#pragma unroll
                for (int n = 0; n < 2; ++n) acc[a][b][m][n] = (f32x4){0.f, 0.f, 0.f, 0.f};
    bf16x8 At[4][2], B0[2][2], B1[2][2];
    const char* cA = cur.A; const char* cB = cur.B; const char* nA = cA;
    typename Epi::Pre epre; E.pre(epre, cur, wc, fq, wid, lane);
    G8_LOADOFF(offc, cur);
    if constexpr (Sched::GATHER) asm volatile("s_waitcnt vmcnt(0)" ::: "memory");
    G8_STAGE(G8_SB(0, 0), cB, voffB); G8_STAGEA(G8_SA(0, 0), 0, 0, false); G8_STAGE(G8_SB(0, 1), cB + hstepB, voffB); G8_STAGEA(G8_SA(0, 1), 0, 1, false);
    if (wr == 1) G8_BAR;
    G8_WAIT_V(4); G8_BAR;
    G8_STAGE(G8_SB(1, 0), cB + kstep, voffB); G8_STAGEA(G8_SA(1, 0), 1, 0, false); G8_STAGE(G8_SB(1, 1), cB + hstepB + kstep, voffB);
    G8_WAIT_V(6); G8_BAR;
    for (;;) {
        const bool has_next = S.next(ui + 1, nxt);
        nA = has_next ? nxt.A : cA; const char* nB = has_next ? nxt.B : cB;
        if (has_next) G8_LOADOFF(offn, nxt);
        else { _Pragma("unroll") for (int _h = 0; _h < 2; ++_h) _Pragma("unroll") for (int _i = 0; _i < 2; ++_i) offn[_h][_i] = offc[_h][_i]; }
        for (int t = 0; t < nt; t += 2) {
            const bool last = (t == nt - 2);
            const char* b2 = last ? nB : cB + (size_t)(t + 2) * kstep;
            const char* b3 = b2 + kstep;
            const int k2 = last ? 0 : t + 2, k3 = last ? 1 : t + 3;
            G8_LDB(B0, 0, 0); G8_SCHED; G8_LDA(At, 0, 0); G8_STAGEA(G8_SA(1, 1), t + 1, 1, false);
            G8_WAIT_L(8); G8_BAR; G8_WAIT_L(0); G8_MMA(0, 0, At, B0); G8_BAR; G8_SCHED;
            G8_LDB(B1, 0, 1); G8_STAGE(G8_SB(0, 0), b2, voffB);
            G8_BAR; G8_WAIT_L(0); G8_MMA(0, 1, At, B1); G8_BAR;
            G8_LDA(At, 0, 1); G8_STAGEA(G8_SA(0, 0), k2, 0, last);
            G8_BAR; G8_WAIT_L(0); G8_MMA(1, 0, At, B0); G8_BAR; G8_SCHED;
            G8_STAGE(G8_SB(0, 1), b2 + hstepB, voffB);
            G8_WAIT_V(6); G8_BAR; G8_MMA(1, 1, At, B1); G8_BAR;
            G8_LDB(B0, 1, 0); G8_SCHED; G8_LDA(At, 1, 0); G8_STAGEA(G8_SA(0, 1), k2, 1, last);
            G8_WAIT_L(8); G8_BAR; G8_WAIT_L(0); G8_MMA(0, 0, At, B0); G8_BAR; G8_SCHED;
            G8_LDB(B1, 1, 1); G8_STAGE(G8_SB(1, 0), b3, voffB);
            G8_BAR; G8_WAIT_L(0); G8_MMA(0, 1, At, B1); G8_BAR;
            G8_LDA(At, 1, 1); G8_STAGEA(G8_SA(1, 0), k3, 0, last);
            G8_BAR; G8_WAIT_L(0); G8_MMA(1, 0, At, B0); G8_BAR; G8_SCHED;
            G8_STAGE(G8_SB(1, 1), b3 + hstepB, voffB);
            G8_WAIT_V(6); G8_BAR; G8_MMA(1, 1, At, B1); G8_BAR;
        }
        MFMA_FENCE();
        E(acc, cur, wr, wc, fr, fq, epre);
        if (!has_next) break;
#pragma unroll
        for (int a = 0; a < 2; ++a)
#pragma unroll
            for (int b = 0; b < 2; ++b)
#pragma unroll
                for (int m = 0; m < 4; ++m)
#pragma unroll
                    for (int n = 0; n < 2; ++n) acc[a][b][m][n] = (f32x4){0.f, 0.f, 0.f, 0.f};
        cur = nxt; cA = nA; cB = nB; ++ui;
        { _Pragma("unroll") for (int _h = 0; _h < 2; ++_h) _Pragma("unroll") for (int _i = 0; _i < 2; ++_i) offc[_h][_i] = offn[_h][_i]; }
        E.pre(epre, cur, wc, fq, wid, lane);
    }
    G8_WAIT_V(0);
    if (wr == 0) G8_BAR;
    G8_BAR;
#undef G8_SA
#undef G8_SB
#undef G8_STAGE
#undef G8_LDA
#undef G8_STAGEA
#undef G8_LOADOFF
#undef G8_LDB
#undef G8_MMA
#undef G8_WAIT_V
#undef G8_WAIT_L
#undef G8_BAR
#undef G8_SCHED
}
}

__device__ __forceinline__ void conv_item(const float* __restrict__ src, int ldS, int col4  , int k0, bf16_t* __restrict__ dst  , int K, int kq, const float* __restrict__ ksc = nullptr  ) {
    f32x4 v[16];
#pragma unroll
    for (int j = 0; j < 16; ++j) v[j] = col4 >= 0 ? *(const f32x4*)(src + (size_t)(k0 + kq * 16 + j) * ldS + col4) : (f32x4){0.f, 0.f, 0.f, 0.f};
    if (ksc) {
#pragma unroll
        for (int j = 0; j < 16; ++j) v[j] *= ksc[k0 + kq * 16 + j];
    }
#pragma unroll
    for (int r = 0; r < 4; ++r) {
        u32x4 w0, w1;
#pragma unroll
        for (int j = 0; j < 4; ++j) { w0[j] = pk2(v[2 * j][r], v[2 * j + 1][r]); w1[j] = pk2(v[8 + 2 * j][r], v[8 + 2 * j + 1][r]); }
        bf16_t* d = dst + (size_t)r * K + kq * 16;
        *(u32x4*)d = w0; *(u32x4*)(d + 8) = w1;
    }
}
__device__ __forceinline__ void rms_row_to_h(const float* __restrict__ xr, const float* __restrict__ nw, bf16_t* __restrict__ hr, int lane) {
    f32x4 v[4]; float ss = 0.f;
#pragma unroll
    for (int i = 0; i < 4; ++i) { v[i] = *(const f32x4*)(xr + i * 256 + lane * 4); ss += v[i][0] * v[i][0] + v[i][1] * v[i][1] + v[i][2] * v[i][2] + v[i][3] * v[i][3]; }
    ss = wave_sum(ss);
    const float rs = rsqrtf(ss * (1.0f / 1024.0f) + NORM_EPS);
#pragma unroll
    for (int i = 0; i < 4; ++i) { const f32x4 w = *(const f32x4*)(nw + i * 256 + lane * 4);
        u32x2 o; o.x = pk2(v[i][0] * rs * w[0], v[i][1] * rs * w[1]); o.y = pk2(v[i][2] * rs * w[2], v[i][3] * rs * w[3]);
        *(u32x2*)(hr + i * 256 + lane * 4) = o; }
}
constexpr int CONV_ITEMS = 112 * 16 + 16 * 32 + 16 * 16 + 2 * 4 * 32 + 32 * 32 * 16 + 32 * 16 * 16;
__device__ __forceinline__ void conv_one(const Ctx& c, const int l, const int it) {
    const int lane = c.lane;
    constexpr int I_IN = 112 * 16, I_O = 16 * 32, I_OUT = 16 * 16, I_C1 = 2 * 4 * 32, I_GU = 32 * 32 * 16;
    constexpr int E1 = I_IN, E2 = E1 + I_O, E3 = E2 + I_OUT, E4 = E3 + I_C1, E5 = E4 + I_GU;
    const int n4 = (lane & 15) * 4, kq = lane >> 4;
    if (it < E1) { const int nb = it / 16, kb = it % 16; const int n = nb * 64 + n4;
        const int col = n < 4912 ? n : (n < 5120 ? -1 : n - 208);
        conv_item(c.w_in + (size_t)l * D * IN_TOTAL, IN_TOTAL, col, kb * 64, WSP(bf16_t, WS_WIN) + ((size_t)l * NPROJ + n) * D + kb * 64, D, kq);
    } else if (it < E2) { const int r = it - E1, nb = r / 32, kb = r % 32; const int n = nb * 64 + n4;
        const float* src = (kb < 16 ? c.w_o_ret : c.w_o_nsa) + (size_t)l * D * D;
        conv_item(src, D, n, (kb & 15) * 64, WSP(bf16_t, WS_WO) + ((size_t)l * D + n) * 2048 + kb * 64, 2048, kq);
    } else if (it < E3) { const int r = it - E2, nb = r / 16, kb = r % 16; const int n = nb * 64 + n4;
        conv_item(c.w_out + (size_t)l * D * D, D, n, kb * 64, WSP(bf16_t, WS_WOUT) + ((size_t)l * D + n) * D + kb * 64, D, kq);
    } else if (it < E4) { const int j = it - E3, lk = l * 2 + j / 128, r = j % 128, nb = r / 32, kb = r % 32; const int n = nb * 64 + n4;
        conv_item(c.cmp_w1 + (size_t)lk * 2048 * 256, 256, n, kb * 64, WSP(bf16_t, WS_WC1) + ((size_t)lk * 256 + n) * 2048 + kb * 64, 2048, kq);
    } else if (it < E5) { const int j = it - E4, le = l * NEXP + j / 512, r = j % 512, nb = r / 16, kb = r % 16; const int n = nb * 64 + n4;
        const int pn = n >> 8, jj = n & 255; const int col = jj < 128 ? pn * 128 + jj : 1024 + pn * 128 + (jj - 128);
        conv_item(c.w_gate_up + (size_t)le * D * 2048, 2048, col, kb * 64, WSP(bf16_t, WS_WGU) + ((size_t)le * 2048 + n) * D + kb * 64, D, kq, c.norm2_w + (size_t)l * D);
    } else { const int j = it - E5, le = l * NEXP + j / 256, r = j % 256, nb = r / 16, kb = r % 16; const int n = nb * 64 + n4;
        conv_item(c.w_down + (size_t)le * D * D, D, n, kb * 64, WSP(bf16_t, WS_WD) + ((size_t)le * D + n) * D + kb * 64, D, kq);
    }
}
__device__ __forceinline__ bool conv_is_early(const int it) { return it < 112 * 16 || (it >= 112 * 16 + 16 * 32 + 16 * 16 && it < 112 * 16 + 16 * 32 + 16 * 16 + 2 * 4 * 32); }
__device__ __forceinline__ void conv_layer_early(const Ctx& c, const int l, const int widx, const int nw) {
    for (int it = widx; it < 112 * 16; it += nw) conv_one(c, l, it);
    for (int it = 112 * 16 + 16 * 32 + 16 * 16 + widx; it < 112 * 16 + 16 * 32 + 16 * 16 + 2 * 4 * 32; it += nw) conv_one(c, l, it);
}
__device__ __forceinline__ void phase_prologue(const Ctx& c) {
    const int lane = c.lane, gw = c.gw, NW = c.G * NWAVES;
    conv_layer_early(c, 0, gw, NW);
    const int gtid = blockIdx.x * NTHREADS + c.tid, NT = c.G * NTHREADS;
    for (int pos = gw; pos < SEQ; pos += NW) {
#pragma unroll
        for (int pass = 0; pass < 2; ++pass) {
            if (pass == 1 && lane >= 8) break;
            const int j = pass == 0 ? lane : 64 + lane;
            float inv; if (j < 64) inv = powf(10000.0f, -(float)(2 * j) / 128.0f); else inv = powf(500000.0f, -(float)(2 * (j - 64)) / 16.0f);
            const float ang = (float)pos * inv;
            double rev = (double)ang * 0.15915494309189535; rev -= floor(rev);
            const float rv = (float)rev; const float sn = __builtin_amdgcn_sinf(rv), cs = __builtin_amdgcn_cosf(rv);
            if (j < 64) { float* t = WSP(float, WS_ROPER) + ((size_t)pos * 64 + j) * 2; t[0] = cs; t[1] = sn; }
            else { float* t = WSP(float, WS_ROPEN) + ((size_t)pos * 8 + (j - 64)) * 2; t[0] = cs; t[1] = sn; }
        }
    }
    for (int u = blockIdx.x + c.wave * c.G; u < NL * 2 * 16 * 8; u += c.G * NWAVES) {
        const int kh = u & 7, lk = u >> 7, n = ((u >> 3) & 15) * 16 + (lane & 15), k0 = kh * 256 + (lane >> 4) * 64;
        const float* pe = c.cmp_pos + (size_t)lk * 2048 + k0; const float* w1 = c.cmp_w1 + ((size_t)lk * 2048 + k0) * 256 + n;
        float s0 = 0.f, s1 = 0.f, s2 = 0.f, s3 = 0.f;
#pragma unroll 4
        for (int k = 0; k < 64; k += 4) { s0 += pe[k] * w1[(size_t)k * 256]; s1 += pe[k + 1] * w1[(size_t)(k + 1) * 256]; s2 += pe[k + 2] * w1[(size_t)(k + 2) * 256]; s3 += pe[k + 3] * w1[(size_t)(k + 3) * 256]; }
        float s = (s0 + s1) + (s2 + s3);
        s += __shfl_xor(s, 16); s += __shfl_xor(s, 32);
        if (lane < 16) WSP(float, WS_PEB)[kh * (NL * 2 * 256) + lk * 256 + n] = s;
    }
    for (int i = gtid; i < NL * 32 * 2 * 64 * 8; i += NT) {
        const int j = i & 7, ln = (i >> 3) & 63, nt = (i >> 9) & 1, ks = (i >> 10) & 31, l = i >> 15;
        const int fr_ = ln & 15, fq_ = ln >> 4, k = 32 * ks + (j < 4 ? 4 * fq_ + j : 16 + 4 * fq_ + (j - 4)), e = 16 * nt + fr_;
        const float w = c.norm2_w[(size_t)l * D + k] * c.router_w[((size_t)l * D + k) * NEXP + e];
        const unsigned hi = f2bf(w); const float wl = w - __uint_as_float(hi << 16);
        bf16_t* dst = WSP(bf16_t, WS_RWF) + ((((size_t)l * 32 + ks) * 2 + nt) * 2) * 512 + ln * 8 + j;
        dst[0] = (bf16_t)hi; dst[512] = (bf16_t)f2bf(wl);
    }
    for (int tok = gw; tok < NTOK; tok += NW) rms_row_to_h(c.x_in + (size_t)tok * D, c.norm1_w, WSP(bf16_t, WS_H) + (size_t)tok * D, lane);
}

constexpr float SM_SCALE_L2 = 0.125f * 1.4426950408889634f;
__device__ __forceinline__ void phase_prep(const Ctx& c, int l) {
    const int lane = c.lane, gw = c.gw, NW = c.G * NWAVES;
    const bf16_t* proj = WSP(bf16_t, WS_PROJ);
    const float* ropeR = WSP(float, WS_ROPER); const float* ropeN = WSP(float, WS_ROPEN);
    const float* qkw = c.qk_norm_w + (size_t)l * 4 * 64;
    for (int tok = gw; tok < NTOK; tok += NW) {
        const int b = tok / SEQ, s = tok % SEQ; const bf16_t* pr = proj + (size_t)tok * NPROJ;
        {
            const int job = lane >> 3, l8 = lane & 7, isk = job >> 2, h = job & 3;
            const bf16_t* src = pr + (isk ? C_RK : C_RQ) + h * 128 + 8 * l8;
            const u32x4 w1 = *(const u32x4*)src, w2 = *(const u32x4*)(src + 64);
            const f32x4* tb = (const f32x4*)(ropeR + ((size_t)s * 64 + 8 * l8) * 2);
            const float ksc = isk ? 0.08838834764831845f : 1.0f;
            u32x4 o1, o2;
#pragma unroll
            for (int j = 0; j < 4; ++j) { const f32x4 cs = tb[j];
                const float a1 = bflo(w1[j]), a2 = bflo(w2[j]), b1 = bfhi(w1[j]), b2 = bfhi(w2[j]);
                o1[j] = pk2((a1 * cs[0] - a2 * cs[1]) * ksc, (b1 * cs[2] - b2 * cs[3]) * ksc);
                o2[j] = pk2((a1 * cs[1] + a2 * cs[0]) * ksc, (b1 * cs[3] + b2 * cs[2]) * ksc); }
            bf16_t* dst = WSP(bf16_t, isk ? WS_KR : WS_QR) + ((size_t)(b * 4 + h) * SEQ + s) * 128 + 8 * l8;
            *(u32x4*)dst = o1; *(u32x4*)(dst + 64) = o2;
        }
        {
            const int head = lane >> 2, part = lane & 3; const bf16_t* src = pr + C_NQ + head * 64 + part * 16;
            const u32x4 w0 = *(const u32x4*)src, w1 = *(const u32x4*)(src + 8); float v[16];
#pragma unroll
            for (int j = 0; j < 4; ++j) { v[2 * j] = bflo(w0[j]); v[2 * j + 1] = bfhi(w0[j]); v[8 + 2 * j] = bflo(w1[j]); v[8 + 2 * j + 1] = bfhi(w1[j]); }
            float ss = 0.f;
#pragma unroll
            for (int j = 0; j < 16; ++j) ss += v[j] * v[j];
            ss += __shfl_xor(ss, 1); ss += __shfl_xor(ss, 2);
            const float rs = rsqrtf(ss * (1.0f / 64.0f) + NORM_EPS);
#pragma unroll
            for (int j = 0; j < 16; ++j) v[j] = v[j] * (rs * SM_SCALE_L2) * qkw[0 * 64 + part * 16 + j];
            if (part == 0) {
#pragma unroll
                for (int i = 0; i < 8; ++i) { const float cc = ropeN[((size_t)s * 8 + i) * 2], sc = ropeN[((size_t)s * 8 + i) * 2 + 1]; const float x1 = v[i], x2 = v[i + 8]; v[i] = x1 * cc - x2 * sc; v[i + 8] = x1 * sc + x2 * cc; }
            }
            u32x4 o0, o1;
#pragma unroll
            for (int j = 0; j < 4; ++j) { o0[j] = pk2(v[2 * j], v[2 * j + 1]); o1[j] = pk2(v[8 + 2 * j], v[8 + 2 * j + 1]); }
            bf16_t* dst = WSP(bf16_t, WS_QN) + ((size_t)tok * 16 + head) * 64 + part * 16;
            *(u32x4*)dst = o0; *(u32x4*)(dst + 8) = o1;
        }
        if (lane < 16) {
            const int hh = lane >> 2, part = lane & 3, isw = hh >> 1, g = hh & 1;
            const bf16_t* src = pr + (isw ? C_KW : C_KS) + g * 64 + part * 16;
            const u32x4 w0 = *(const u32x4*)src, w1 = *(const u32x4*)(src + 8); float v[16];
#pragma unroll
            for (int j = 0; j < 4; ++j) { v[2 * j] = bflo(w0[j]); v[2 * j + 1] = bfhi(w0[j]); v[8 + 2 * j] = bflo(w1[j]); v[8 + 2 * j + 1] = bfhi(w1[j]); }
            float ss = 0.f;
#pragma unroll
            for (int j = 0; j < 16; ++j) ss += v[j] * v[j];
            ss += __shfl_xor(ss, 1); ss += __shfl_xor(ss, 2);
            const float rs = rsqrtf(ss * (1.0f / 64.0f) + NORM_EPS);
            const float* w = qkw + (isw ? 3 : 2) * 64 + part * 16;
#pragma unroll
            for (int j = 0; j < 16; ++j) v[j] = v[j] * rs * w[j];
            if (part == 0) {
#pragma unroll
                for (int i = 0; i < 8; ++i) { const float cc = ropeN[((size_t)s * 8 + i) * 2], sc = ropeN[((size_t)s * 8 + i) * 2 + 1]; const float x1 = v[i], x2 = v[i + 8]; v[i] = x1 * cc - x2 * sc; v[i + 8] = x1 * sc + x2 * cc; }
            }
            u32x4 o0, o1;
#pragma unroll
            for (int j = 0; j < 4; ++j) { o0[j] = pk2(v[2 * j], v[2 * j + 1]); o1[j] = pk2(v[8 + 2 * j], v[8 + 2 * j + 1]); }
            bf16_t* dst = WSP(bf16_t, isw ? WS_KW : WS_KS) + ((((size_t)(b * 2 + g) * 128 + (s >> 6)) * 4 + ((s >> 4) & 3)) * 2 + (part >> 1)) * 512 + ((2 * (part & 1)) * 16 + (s & 15)) * 8;
            *(u32x4*)dst = o0; *(u32x4*)(dst + 128) = o1;
        } else if (lane < 48) {
            const int q = lane - 16, isv = q >> 4, r = q & 15, g = r >> 3, part = r & 7;
            const u32x4 w = *(const u32x4*)(pr + (isv ? C_VC : C_KC) + g * 64 + part * 8);
            *(u32x4*)(WSP(bf16_t, isv ? WS_VCT : WS_KCT) + ((size_t)(b * 2 + g) * SEQ + s) * 64 + part * 8) = w;
        }
    }
    const float lgam[4] = {log2f(1.0f - 1.0f / 32.0f), log2f(1.0f - 1.0f / 64.0f), log2f(1.0f - 1.0f / 128.0f), log2f(1.0f - 1.0f / 256.0f)};
    LAS bf16_t* tile = (LAS bf16_t*)(c.lds + c.wave * 8192);
    for (int grp = gw; grp < NTOK / 8; grp += NW) {
        const int tok0 = grp * 8, b = tok0 / SEQ, s0 = tok0 % SEQ; const bf16_t* pr = proj + (size_t)tok0 * NPROJ;
#define PREP_LOAD_TILE(col0) do { _Pragma("unroll") for (int _t = 0; _t < 8; ++_t) { const u32x4 _w = *(const u32x4*)(pr + (size_t)_t * NPROJ + (col0) + lane * 8); *(LAS u32x4*)(tile + _t * 512 + lane * 8) = _w; } } while (0)
#define PREP_COL8(cc, w) do { unsigned short _v[8]; _Pragma("unroll") for (int _t = 0; _t < 8; ++_t) _v[_t] = tile[_t * 512 + (cc)]; \
        (w).x = _v[0] | ((unsigned)_v[1] << 16); (w).y = _v[2] | ((unsigned)_v[3] << 16); (w).z = _v[4] | ((unsigned)_v[5] << 16); (w).w = _v[6] | ((unsigned)_v[7] << 16); } while (0)
        PREP_LOAD_TILE(C_RK);
        {
            float cs[8], sn[8], zz[8];
#pragma unroll
            for (int t = 0; t < 8; ++t) { const f32x2 tb = *(const f32x2*)(ropeR + ((size_t)(s0 + t) * 64 + lane) * 2); cs[t] = tb[0]; sn[t] = tb[1]; }
#pragma unroll
            for (int h = 0; h < 4; ++h) { float o1[8], o2[8];
#pragma unroll
                for (int t = 0; t < 8; ++t) { const float k1 = bf2f(tile[t * 512 + h * 128 + lane]), k2 = bf2f(tile[t * 512 + h * 128 + 64 + lane]);
                    const float z = fexp2(lgam[h] * (float)(127 - ((s0 + t) & 127))) * 0.08838834764831845f;
                    o1[t] = (k1 * cs[t] - k2 * sn[t]) * z; o2[t] = (k1 * sn[t] + k2 * cs[t]) * z; }
                u32x4 w1, w2;
#pragma unroll
                for (int j = 0; j < 4; ++j) { w1[j] = pk2(o1[2 * j], o1[2 * j + 1]); w2[j] = pk2(o2[2 * j], o2[2 * j + 1]); }
                { const int tk = s0 & 127, q = tk & 31, fqa = (q & 15) >> 2, jb = q >= 16 ? 4 : 0;
                  bf16_t* base = WSP(bf16_t, WS_KZT) + ((((size_t)(b * 4 + h) * 64 + (s0 >> 7)) * 8) * 4 + (tk >> 5)) * 512 + (fqa * 16 + (lane & 15)) * 8 + jb;
                  bf16_t* d1 = base + (size_t)(lane >> 4) * 2048, *d2 = base + (size_t)(4 + (lane >> 4)) * 2048;
                  u32x2 a; a.x = w1.x; a.y = w1.y; *(u32x2*)d1 = a; a.x = w1.z; a.y = w1.w; *(u32x2*)(d1 + 128) = a;
                  a.x = w2.x; a.y = w2.y; *(u32x2*)d2 = a; a.x = w2.z; a.y = w2.w; *(u32x2*)(d2 + 128) = a; } }
        }
#pragma unroll 1
        for (int hf = 0; hf < 2; ++hf) {
            PREP_LOAD_TILE(C_RV + hf * 512);
#pragma unroll
            for (int i = 0; i < 8; ++i) { const int cc = i * 64 + lane; u32x4 w; PREP_COL8(cc, w);
                { const int ch_ = hf * 512 + cc, hh = ch_ >> 8, dv = ch_ & 255, tk = s0 & 127, q = tk & 31, fqa = (q & 15) >> 2, jb = q >= 16 ? 4 : 0;
                  bf16_t* d = WSP(bf16_t, WS_VT) + (((((size_t)(b * 4 + hh) * 64 + (s0 >> 7)) * 4 + (tk >> 5)) * 16 + (dv >> 4)) * 64 + fqa * 16 + (dv & 15)) * 8 + jb;
                  u32x2 a; a.x = w.x; a.y = w.y; *(u32x2*)d = a; a.x = w.z; a.y = w.w; *(u32x2*)(d + 128) = a; } }
        }
        {
#pragma unroll
            for (int _t = 0; _t < 8; ++_t) { const int piece = lane >> 4, off = (lane & 15) * 8;
                if (lane < 32) { const u32x4 _w = *(const u32x4*)(pr + (size_t)_t * NPROJ + (piece ? C_VW : C_VS) + off); *(LAS u32x4*)(tile + _t * 512 + piece * 128 + off) = _w; } }
#pragma unroll
            for (int i = 0; i < 4; ++i) { const int isw = i >> 1, g = i & 1; u32x4 w; PREP_COL8(isw * 128 + g * 64 + lane, w);
                const int q = s0 & 31; bf16_t* dst = WSP(bf16_t, isw ? WS_VWT : WS_VST) + ((((size_t)(b * 2 + g) * 128 + (s0 >> 6)) * 2 + ((s0 >> 5) & 1)) * 4 + (lane >> 4)) * 512 + ((((q & 15) >> 2)) * 16 + (lane & 15)) * 8 + (q >= 16 ? 4 : 0);
                u32x2 w0, w1; w0.x = w.x; w0.y = w.y; w1.x = w.z; w1.y = w.w; *(u32x2*)dst = w0; *(u32x2*)(dst + 128) = w1; }
        }
#undef PREP_LOAD_TILE
#undef PREP_COL8
    }
}

__device__ __forceinline__ void phase_cmp2(const Ctx& c, int l) {
    const int lane = c.lane, gw = c.gw, NW = c.G * NWAVES;
    const float* ropeN = WSP(float, WS_ROPEN);
    for (int r0 = 0; r0 < 2 * 8 * 512; r0 += c.G * 32) {
        const int rowb = r0 + blockIdx.x * 32 + c.wave * 4; if (rowb >= 2 * 8 * 512) break;
        const int kv = rowb >> 12, bg = (rowb >> 9) & 7;
        const float* w2 = c.cmp_w2 + ((size_t)l * 2 + kv) * 256 * 64 + lane;
        LAS float* hl = (LAS float*)(c.lds + c.wave * 4096);
        { const float* sl = WSP(float, WS_ACT) + (size_t)rowb * 256 + lane * 4; f32x4 pb = *(const f32x4*)(WSP(float, WS_PEB) + (size_t)l * 512 + kv * 256 + lane * 4);
#pragma unroll
          for (int kh = 1; kh < 8; ++kh) pb += *(const f32x4*)(WSP(float, WS_PEB) + (size_t)kh * (NL * 2 * 256) + (size_t)l * 512 + kv * 256 + lane * 4);
#pragma unroll
          for (int rr = 0; rr < 4; ++rr) { f32x4 a = pb;
#pragma unroll
              for (int q = 0; q < 8; ++q) a += *(const f32x4*)(sl + (size_t)q * 8192 * 256 + rr * 256);
#pragma unroll
              for (int j = 0; j < 4; ++j) { const float x = a[j]; const float t = 0.7978845608028654f * (x + 0.044715f * x * x * x);
                  const float th = 1.0f - 2.0f * frcp(1.0f + fexp2(2.8853900817779268f * t)); a[j] = 0.5f * x * (1.0f + th); }
              *(LAS f32x4*)(hl + rr * 256 + lane * 4) = a; } }
        float acc4[4] = {0.f, 0.f, 0.f, 0.f};
#pragma unroll 1
        for (int k0 = 0; k0 < 256; k0 += 32) {
            float wv[32];
#pragma unroll
            for (int i = 0; i < 32; ++i) wv[i] = w2[(size_t)(k0 + i) * 64];
#pragma unroll
            for (int i = 0; i < 32; i += 2) {
#pragma unroll
                for (int rr = 0; rr < 4; ++rr) { const f32x2 hw = *(const LAS f32x2*)(hl + rr * 256 + k0 + i); acc4[rr] += hw[0] * wv[i] + hw[1] * wv[i + 1]; } }
        }
#pragma unroll
        for (int rr = 0; rr < 4; ++rr) {
            const int n = (rowb + rr) & 511; const float acc = acc4[rr];
            if (kv == 0) {
                const float ss = wave_sum(acc * acc); float v = acc * rsqrtf(ss * (1.0f / 64.0f) + NORM_EPS) * c.qk_norm_w[(size_t)l * 256 + 64 + lane];
                const float other = __shfl_xor(v, 8);
                int pos = 16 * n + 31; if (pos > SEQ - 1) pos = SEQ - 1;
                if (lane < 16) { const int i = lane & 7; const float cc = ropeN[((size_t)pos * 8 + i) * 2], sc = ropeN[((size_t)pos * 8 + i) * 2 + 1];
                    v = lane < 8 ? v * cc - other * sc : other * sc + v * cc; }
                WSP(bf16_t, WS_KCMP)[((((size_t)bg * 8 + (n >> 6)) * 4 + ((n >> 4) & 3)) * 2 + (lane >> 5)) * 512 + (((lane >> 3) & 3) * 16 + (n & 15)) * 8 + (lane & 7)] = (bf16_t)f2bf(v);
            } else {
                const int q = n & 31; WSP(bf16_t, WS_VCMPT)[((((size_t)bg * 8 + (n >> 6)) * 2 + ((n >> 5) & 1)) * 4 + (lane >> 4)) * 512 + (((q & 15) >> 2) * 16 + (lane & 15)) * 8 + (q >= 16 ? 4 : 0) + (q & 3)] = (bf16_t)(n < 511 ? f2bf(acc) : 0u);
            }
        }
    }
}

__device__ __forceinline__ void phase_scan(const Ctx& c) {
    const int lane = c.lane, w = c.wave, fr = lane & 15, fq = lane >> 4;
    for (int it0 = blockIdx.x; it0 < 256; it0 += c.G) {
        const int it = (c.G == 256) ? ((it0 & 7) * 32 + (it0 >> 3)) : it0;
        const int bh = it >> 4, dvs = it & 15, h = bh & 3;
        const float cdec = fexp2(log2f(1.0f - fexp2(-5.0f - (float)h)) * 128.0f);
        const bf16_t* kz = WSP(bf16_t, WS_KZT) + ((size_t)bh * 64 * 8 + w) * 2048 + lane * 8;
        const bf16_t* vt = WSP(bf16_t, WS_VT) + ((size_t)bh * 64 * 64 + dvs) * 512 + lane * 8;
        bf16_t* rt = WSP(bf16_t, WS_RT) + ((((size_t)bh * 64) * 16 + dvs) * 4 + (w >> 1)) * 512 + ((2 * (w & 1) + (fq >> 1)) * 16 + fr) * 8 + 4 * (fq & 1);
        f32x4 acc = {0.f, 0.f, 0.f, 0.f};
        bf16x8 kf[2][4];
        u32x2 st[64];
        const bf16_t* vt0 = WSP(bf16_t, WS_VT) + ((size_t)bh * 64 * 64 + dvs) * 512 + lane * 8;
#define SCAN_VBATCH(b) do { _Pragma("unroll") for (int _i = 0; _i < 8; ++_i) { const int _blk = w * 8 + _i; \
            __builtin_amdgcn_global_load_lds((const unsigned*)(vt0 + (size_t)(16 * (b) + (_blk >> 2)) * 32768 + (_blk & 3) * 8192), (LAS unsigned*)(c.lds + ((b) & 1) * 65536 + _blk * 1024), 16, 0, 0); } } while (0)
        SCAN_VBATCH(0);
#pragma unroll
        for (int u = 0; u < 2; ++u)
#pragma unroll
            for (int ks = 0; ks < 4; ++ks) kf[u][ks] = ld8(kz + (size_t)u * 16384 + ks * 512);
#pragma unroll
        for (int ch = 0; ch < 64; ++ch) {
            const int u = ch & 1;
            if ((ch & 15) == 0) { asm volatile("s_waitcnt vmcnt(0)" ::: "memory"); __builtin_amdgcn_s_barrier(); asm volatile("" ::: "memory");
                if (ch + 16 < 64) SCAN_VBATCH((ch >> 4) + 1); }
            st[ch].x = pk2(acc[0], acc[1]); st[ch].y = pk2(acc[2], acc[3]);
            acc *= cdec;
            const LAS unsigned char* vb = c.lds + ((ch >> 4) & 1) * 65536 + (ch & 15) * 4096 + lane * 16;
#pragma unroll
            for (int ks = 0; ks < 4; ++ks) acc = mfma16(kf[u][ks], *(const LAS bf16x8*)(vb + ks * 1024), acc);
            if (ch + 2 < 64) {
#pragma unroll
                for (int ks = 0; ks < 4; ++ks) kf[u][ks] = ld8(kz + (size_t)(ch + 2) * 16384 + ks * 512);
            }
        }
#undef SCAN_VBATCH
        MFMA_FENCE();
#pragma unroll
        for (int ch = 0; ch < 64; ++ch) *(u32x2*)(rt + (size_t)ch * 32768) = st[ch];
    }
}

#define SH_BAR() do { asm volatile("" ::: "memory"); __builtin_amdgcn_s_barrier(); asm volatile("" ::: "memory"); } while (0)
#define SH_WAIT_BAR() do { asm volatile("s_waitcnt vmcnt(0)" ::: "memory"); __builtin_amdgcn_s_barrier(); asm volatile("" ::: "memory"); } while (0)
__device__ __forceinline__ void phase_retout(const Ctx& c, int l) {
    const int lane = c.lane, wave = c.wave, fr = lane & 15, fq = lane >> 4;
    const bf16_t* proj = WSP(bf16_t, WS_PROJ);
    LAS unsigned char* lv = c.lds;
    LAS unsigned char* lr = c.lds + 65536;
    for (int u = blockIdx.x; u < 16 * 64; u += c.G) {
        const int qt = wave, ch = u & 63, bh = u >> 6, b = bh >> 2, h = bh & 3;
        const float lg = log2f(1.0f - fexp2(-5.0f - (float)h));
        const bf16_t* Q = WSP(bf16_t, WS_QR) + ((size_t)bh * SEQ + ch * 128) * 128;
        const bf16_t* Kp = WSP(bf16_t, WS_KR) + ((size_t)bh * SEQ + ch * 128) * 128;
        const bf16_t* VTp = WSP(bf16_t, WS_VT) + ((size_t)(bh * 64 + ch)) * 32768;
        const bf16_t* RTp = WSP(bf16_t, WS_RT) + ((size_t)(bh * 64 + ch)) * 32768;
        SH_BAR();
#pragma unroll
        for (int i = 0; i < 8; ++i) {
            __builtin_amdgcn_global_load_lds((const unsigned*)(VTp + (size_t)(wave * 8 + i) * 512 + lane * 8), (LAS unsigned*)(lv + (wave * 8 + i) * 1024), 16, 0, 0);
            __builtin_amdgcn_global_load_lds((const unsigned*)(RTp + (size_t)(wave * 8 + i) * 512 + lane * 8), (LAS unsigned*)(lr + (wave * 8 + i) * 1024), 16, 0, 0);
        }
        const int n = 16 * qt + fr;
        bf16x8 qf[4], qs[4];
        const float xi = fexp2(lg * (float)(n + 1));
#pragma unroll
        for (int ks = 0; ks < 4; ++ks) { const u32x4 w = *(const u32x4*)(Q + (size_t)n * 128 + 32 * ks + 8 * fq); qf[ks] = mk8(w);
            u32x4 s;
#pragma unroll
            for (int j = 0; j < 4; ++j) s[j] = pk2(bflo(w[j]) * xi, bfhi(w[j]) * xi);
            qs[ks] = mk8(s); }
        const size_t tok = (size_t)b * SEQ + ch * 128 + n;
        const bf16_t* gp = proj + tok * NPROJ + C_RG + h * 256 + 4 * fq; const float* gw_ = c.ret_gn_w + (size_t)l * 1024 + h * 256 + 4 * fq;
        u32x2 gv[16];
#pragma unroll
        for (int dt = 0; dt < 16; ++dt) gv[dt] = *(const u32x2*)(gp + 16 * dt);
        bf16x8 kk[8];
#pragma unroll
        for (int ks = 0; ks < 4; ++ks) { kk[ks] = ld8(Kp + (size_t)fr * 128 + 32 * ks + 8 * fq); kk[4 + ks] = ld8(Kp + (size_t)((qt >= 1 ? 16 : 0) + fr) * 128 + 32 * ks + 8 * fq); }
        f32x4 o[16];
#pragma unroll
        for (int dt = 0; dt < 16; ++dt) o[dt] = (f32x4){0.f, 0.f, 0.f, 0.f};
        SH_WAIT_BAR();
        for (int p = 0; p <= (qt >> 1); ++p) {
            f32x4 s0 = {0.f, 0.f, 0.f, 0.f}, s1 = {0.f, 0.f, 0.f, 0.f};
            const bool two = (2 * p + 1 <= qt);
#pragma unroll
            for (int ks = 0; ks < 4; ++ks) s0 = mfma16(kk[ks], qf[ks], s0);
#pragma unroll
            for (int ks = 0; ks < 4; ++ks) s1 = mfma16(kk[4 + ks], qf[ks], s1);
            MFMA_FENCE();
            if (p + 1 <= (qt >> 1)) {
                const bool two_n = (2 * (p + 1) + 1 <= qt);
#pragma unroll
                for (int ks = 0; ks < 4; ++ks) { kk[ks] = ld8(Kp + (size_t)(32 * (p + 1) + fr) * 128 + 32 * ks + 8 * fq); kk[4 + ks] = ld8(Kp + (size_t)(32 * (p + 1) + (two_n ? 16 : 0) + fr) * 128 + 32 * ks + 8 * fq); }
            }
#pragma unroll
            for (int r = 0; r < 4; ++r) { const int d0 = n - (32 * p + 4 * fq + r), d1 = d0 - 16;
                s0[r] = d0 >= 0 ? s0[r] * fexp2(lg * (float)d0) : 0.f; s1[r] = (two && d1 >= 0) ? s1[r] * fexp2(lg * (float)d1) : 0.f; }
            u32x4 pw; pw.x = pk2(s0[0], s0[1]); pw.y = pk2(s0[2], s0[3]); pw.z = pk2(s1[0], s1[1]); pw.w = pk2(s1[2], s1[3]);
            const bf16x8 pb = mk8(pw);
#pragma unroll
            for (int dt = 0; dt < 16; ++dt) o[dt] = mfma16(*(const LAS bf16x8*)(lv + (p * 16 + dt) * 1024 + lane * 16), pb, o[dt]);
            MFMA_FENCE();
        }
#pragma unroll
        for (int dt = 0; dt < 16; ++dt)
#pragma unroll
            for (int ks = 0; ks < 4; ++ks) o[dt] = mfma16(*(const LAS bf16x8*)(lr + (dt * 4 + ks) * 1024 + lane * 16), qs[ks], o[dt]);
        float s = 0.f;
#pragma unroll
        for (int dt = 0; dt < 16; ++dt) s += (o[dt][0] + o[dt][1]) + (o[dt][2] + o[dt][3]);
        s += __shfl_xor(s, 16); s += __shfl_xor(s, 32);
        const float mu = s * (1.0f / 256.0f); float q = 0.f;
#pragma unroll
        for (int dt = 0; dt < 16; ++dt)
#pragma unroll
            for (int r = 0; r < 4; ++r) { const float d = o[dt][r] - mu; q += d * d; }
        q += __shfl_xor(q, 16); q += __shfl_xor(q, 32);
        const float rstd = rsqrtf(q * (1.0f / 256.0f) + NORM_EPS);
        bf16_t* op = WSP(bf16_t, WS_RA) + tok * 2048 + h * 256 + 4 * fq;
#pragma unroll
        for (int dt = 0; dt < 16; ++dt) { const f32x4 wv = *(const f32x4*)(gw_ + 16 * dt);
            float g[4] = {bflo(gv[dt].x), bfhi(gv[dt].x), bflo(gv[dt].y), bfhi(gv[dt].y)}; float r_[4];
#pragma unroll
            for (int r = 0; r < 4; ++r) r_[r] = (o[dt][r] - mu) * rstd * wv[r] * g[r] * sigmoidf_(g[r]);
            u32x2 ov; ov.x = pk2(r_[0], r_[1]); ov.y = pk2(r_[2], r_[3]); *(u32x2*)(op + 16 * dt) = ov; }
    }
    SH_BAR();
}

__device__ __forceinline__ void attn_step_lds(const LAS unsigned char* slot, const bf16x8 (&qf)[2], const int key0, const int hiK, const int loK, const bool colok, const bool allok, const bool full,
                                              f32x4 (&O)[4], float& lsum, const int lane, const int fq) {
    bf16x8 kv[8];
#pragma unroll
    for (int i = 0; i < 8; ++i) kv[i] = *(const LAS bf16x8*)(slot + i * 1024 + lane * 16);
    f32x4 s[4];
    __builtin_amdgcn_s_setprio(1);
#pragma unroll
    for (int kt = 0; kt < 4; ++kt) { s[kt] = (f32x4){0.f, 0.f, 0.f, 0.f};
#pragma unroll
        for (int ks = 0; ks < 2; ++ks) s[kt] = mfma16(kv[kt * 2 + ks], qf[ks], s[kt]); }
    __builtin_amdgcn_s_setprio(0);
#pragma unroll
    for (int i = 0; i < 8; ++i) kv[i] = *(const LAS bf16x8*)(slot + 8192 + i * 1024 + lane * 16);
    float ps = 0.f;
    if (full) {
        if (allok) {
#pragma unroll
            for (int kt = 0; kt < 4; ++kt)
#pragma unroll
                for (int r = 0; r < 4; ++r) { const float p = fexp2(s[kt][r]); s[kt][r] = p; ps += p; }
        } else {
#pragma unroll
            for (int kt = 0; kt < 4; ++kt)
#pragma unroll
                for (int r = 0; r < 4; ++r) { const float p = colok ? fexp2(s[kt][r]) : 0.f; s[kt][r] = p; ps += p; }
        }
    } else {
#pragma unroll
        for (int kt = 0; kt < 4; ++kt)
#pragma unroll
            for (int r = 0; r < 4; ++r) { const int key = key0 + 16 * kt + 4 * fq + r; const bool ok = colok && (key <= hiK) && (key > loK);
                const float p = ok ? fexp2(s[kt][r]) : 0.f; s[kt][r] = p; ps += p; }
    }
    lsum += ps;
#pragma unroll
    for (int p2 = 0; p2 < 2; ++p2) {
        u32x4 pw; pw.x = pk2(s[2 * p2][0], s[2 * p2][1]); pw.y = pk2(s[2 * p2][2], s[2 * p2][3]); pw.z = pk2(s[2 * p2 + 1][0], s[2 * p2 + 1][1]); pw.w = pk2(s[2 * p2 + 1][2], s[2 * p2 + 1][3]);
        const bf16x8 pb = mk8(pw);
        __builtin_amdgcn_s_setprio(1);
#pragma unroll
        for (int dt = 0; dt < 4; ++dt) O[dt] = mfma16(kv[p2 * 4 + dt], pb, O[dt]);
        __builtin_amdgcn_s_setprio(0);
    }
    MFMA_FENCE();
}
__device__ __forceinline__ int sel_pop(unsigned long long& lo, unsigned long long& hi) {
    if (lo) { const int j = __builtin_ctzll(lo); lo &= lo - 1ull; return j; }
    if (hi) { const int j = 64 + __builtin_ctzll(hi); hi &= hi - 1ull; return j; }
    return -1;
}
#define SH_SLOT(s) (shb + (s) * 16384)
#define SH_ISSUE(kbase, vbase, blk, slot, withv) do { \
        __builtin_amdgcn_global_load_lds((const unsigned*)((kbase) + (size_t)(blk) * 4096 + (wave * 64 + lane) * 8), (LAS unsigned*)(SH_SLOT(slot) + wave * 1024), 16, 0, 0); \
        if (withv) __builtin_amdgcn_global_load_lds((const unsigned*)((vbase) + (size_t)(blk) * 4096 + (wave * 64 + lane) * 8), (LAS unsigned*)(SH_SLOT(slot) + 8192 + wave * 1024), 16, 0, 0); } while (0)
#define SH_READ_K(slot) do { _Pragma("unroll") for (int _i = 0; _i < 8; ++_i) kf[_i] = *(const LAS bf16x8*)(SH_SLOT(slot) + _i * 1024 + lane * 16); } while (0)
#define SH_READ_V(slot) do { _Pragma("unroll") for (int _i = 0; _i < 8; ++_i) vf[_i] = *(const LAS bf16x8*)(SH_SLOT(slot) + 8192 + _i * 1024 + lane * 16); } while (0)
__device__ __forceinline__ void phase_nsa(const Ctx& c, const int layer, const int lconv  , const bool late0  ) {
    const int lane = c.lane, wave = c.wave, fr = lane & 15, fq = lane >> 4;
    const bf16_t* proj = WSP(bf16_t, WS_PROJ);
    volatile LAS float* imp = (volatile LAS float*)(c.lds + 131072 + wave * 2304);
    LAS unsigned char* shb = c.lds;
    const int cntot = (lconv >= 0 ? CONV_ITEMS : 0) + (late0 ? CONV_ITEMS : 0), crounds = (cntot + c.G * NWAVES - 1) / (c.G * NWAVES);
    const int cntl = (2048 + c.G - 1) / c.G, crpt = (crounds + cntl - 1) / cntl;
    volatile LAS int* qs = (volatile LAS int*)(c.lds + LDS_CTL_OFF + 256);
#define NSA_QCTR (WSP(unsigned, WS_CTL + 16384) + layer * 64)
    if (c.tid == 0) { qs[0] = (int)__hip_atomic_fetch_add(NSA_QCTR, 1u, __ATOMIC_RELAXED, __HIP_MEMORY_SCOPE_AGENT); asm volatile("s_waitcnt lgkmcnt(0)" ::: "memory"); }
    int kk = 0;
    for (;; ++kk) {
        SH_BAR();
        const int U = __builtin_amdgcn_readfirstlane(qs[kk & 1]);
        if (U >= 2048) break;
        const int bg = U >> 8; const int tl = 255 - (U & 255);
        const int b = bg >> 1, g = bg & 1, T0 = 32 * tl, curW = T0 >> 6;
        int t0[2], tcol[2]; bf16x8 qf[2][2]; float g0[2], g1[2], g2[2]; size_t tokc[2];
        const int head = g * 8 + (fr & 7);
#pragma unroll
        for (int pr = 0; pr < 2; ++pr) {
            t0[pr] = T0 + 4 * wave + 2 * pr; tcol[pr] = t0[pr] + (fr >> 3); tokc[pr] = (size_t)b * SEQ + tcol[pr];
#pragma unroll
            for (int ks = 0; ks < 2; ++ks) qf[pr][ks] = ld8(WSP(bf16_t, WS_QN) + (tokc[pr] * 16 + head) * 64 + 32 * ks + 8 * fq);
            const bf16_t* gp = proj + tokc[pr] * NPROJ + C_NG + head * 3;
            g0[pr] = sigmoidf_(bf2f(gp[0])); g1[pr] = sigmoidf_(bf2f(gp[1])); g2[pr] = sigmoidf_(bf2f(gp[2]));
        }
        f32x4 out[2][4], O[2][4]; float lsum[2];
        bf16x8 kf[8];
#define NSA_ZERO_O() do { _Pragma("unroll") for (int _p = 0; _p < 2; ++_p) { lsum[_p] = 0.f; _Pragma("unroll") for (int _d = 0; _d < 4; ++_d) O[_p][_d] = (f32x4){0.f, 0.f, 0.f, 0.f}; } } while (0)
        int nbc[2];
#pragma unroll
        for (int pr = 0; pr < 2; ++pr) { const int nv = (t0[pr] + 1 >= 31) ? ((t0[pr] + 1 - 31) >> 4) + 1 : 0; nbc[pr] = (nv + 63) >> 6; }
        const int nvW = (T0 + 31 >= 31) ? ((T0 + 31 - 31) >> 4) + 1 : 0, nbcW = (nvW + 63) >> 6;
        const bf16_t* Kc = WSP(bf16_t, WS_KCMP) + (size_t)bg * 8 * 4096; const bf16_t* Vc = WSP(bf16_t, WS_VCMPT) + (size_t)bg * 8 * 4096;
        NSA_ZERO_O();
        SH_BAR();
        int nq = 0; if (c.tid == 0) nq = (int)__hip_atomic_fetch_add(NSA_QCTR, 1u, __ATOMIC_RELAXED, __HIP_MEMORY_SCOPE_AGENT);
        for (int kb = 0; kb < nbcW; ++kb) SH_ISSUE(Kc, Vc, kb, kb, true);
        SH_WAIT_BAR();
        if (c.tid == 0) { qs[(kk + 1) & 1] = nq; asm volatile("s_waitcnt lgkmcnt(0)" ::: "memory"); }
        for (int kb = 0; kb < nbcW; ++kb) {
#pragma unroll
            for (int pr = 0; pr < 2; ++pr) if (kb < nbc[pr])
                attn_step_lds(SH_SLOT(kb), qf[pr], kb * 64, (tcol[pr] - 31) >> 4, -1, true, true, 16 * (kb * 64 + 63) + 31 <= t0[pr], O[pr], lsum[pr], lane, fq);
        }
        float il[2];
#pragma unroll
        for (int pr = 0; pr < 2; ++pr) { float l = lsum[pr]; l += __shfl_xor(l, 16); l += __shfl_xor(l, 32); il[pr] = l > 0.f ? 1.0f / l : 0.f;
#pragma unroll
            for (int dt = 0; dt < 4; ++dt) out[pr][dt] = O[pr][dt] * (g0[pr] * il[pr]); }
        for (int i = lane; i < 4 * 136; i += 64) imp[i] = 0.f;
        for (int kb = 0; kb < nbcW; ++kb) {
            if (kb < nbc[1]) {
                SH_READ_K(kb);
#pragma unroll
                for (int pr = 0; pr < 2; ++pr) if (kb < nbc[pr]) {
                    f32x4 s4[4];
#pragma unroll
                    for (int kt = 0; kt < 4; ++kt) { s4[kt] = (f32x4){0.f, 0.f, 0.f, 0.f};
#pragma unroll
                        for (int ks = 0; ks < 2; ++ks) s4[kt] = mfma16(kf[kt * 2 + ks], qf[pr][ks], s4[kt]); }
                    MFMA_FENCE();
#pragma unroll
                    for (int kt = 0; kt < 4; ++kt) {
                        float pa = 0.f, p3 = 0.f;
#pragma unroll
                        for (int r = 0; r < 4; ++r) { const int key = kb * 64 + 16 * kt + 4 * fq + r; const bool ok = (16 * key + 31 <= tcol[pr]);
                            const float p = ok ? fexp2(s4[kt][r]) * il[pr] : 0.f; pa += p; if (r == 3) p3 = p; }
                        pa = sum8(pa); p3 = sum8(p3);
                        const int jb = 4 * (4 * kb + kt) + fq, tk = pr * 2 + (fr >> 3);
                        if ((fr & 7) == 0) { (void)__hip_atomic_fetch_add((LAS float*)imp + tk * 136 + jb, pa, __ATOMIC_RELAXED, __HIP_MEMORY_SCOPE_WORKGROUP);
                            (void)__hip_atomic_fetch_add((LAS float*)imp + tk * 136 + jb + 1, p3, __ATOMIC_RELAXED, __HIP_MEMORY_SCOPE_WORKGROUP); }
                    }
                }
            }
        }
        unsigned long long msk[2][2][2];
        {
            bool vl[4], vh[4]; unsigned ul[4], uh[4], T[4];
#pragma unroll
            for (int tk = 0; tk < 4; ++tk) {
                const int t = T0 + 4 * wave + tk, cur = t >> 6; const int jl = lane, jh = lane + 64;
                vl[tk] = jl <= cur; vh[tk] = jh <= cur;
                const bool fl = (jl == 0) || (jl == cur) || (jl == cur - 1), fh = (jh == cur) || (jh == cur - 1);
                ul[tk] = fl ? 0x7f800000u : __float_as_uint(imp[tk * 136 + jl]); uh[tk] = fh ? 0x7f800000u : __float_as_uint(imp[tk * 136 + jh]); T[tk] = 0u;
            }
            int cT[4];
#pragma unroll
            for (int tk = 0; tk < 4; ++tk) cT[tk] = __popcll(__ballot(vl[tk])) + __popcll(__ballot(vh[tk]));
#pragma unroll 1
            for (int bit = 30; bit >= 0; --bit) {
#pragma unroll
                for (int tk = 0; tk < 4; ++tk) { const unsigned cand = T[tk] | (1u << bit);
                    const int cnt = __popcll(__ballot(vl[tk] && ul[tk] >= cand)) + __popcll(__ballot(vh[tk] && uh[tk] >= cand));
                    if (cnt >= 16) { T[tk] = cand; cT[tk] = cnt; } }
                if (cT[0] <= 16 && cT[1] <= 16 && cT[2] <= 16 && cT[3] <= 16) break;
            }
#pragma unroll
            for (int tk = 0; tk < 4; ++tk) {
                const unsigned long long gtl = __ballot(vl[tk] && ul[tk] > T[tk]), gth = __ballot(vh[tk] && uh[tk] > T[tk]);
                const unsigned long long eql = __ballot(vl[tk] && ul[tk] == T[tk]), eqh = __ballot(vh[tk] && uh[tk] == T[tk]);
                const int need = 16 - (__popcll(gtl) + __popcll(gth));
                const unsigned long long lm = (1ull << lane) - 1ull;
                const int rl = __popcll(eql & lm), rh = __popcll(eql) + __popcll(eqh & lm);
                msk[tk >> 1][tk & 1][0] = gtl | __ballot(vl[tk] && ul[tk] == T[tk] && rl < need); msk[tk >> 1][tk & 1][1] = gth | __ballot(vh[tk] && uh[tk] == T[tk] && rh < need);
            }
        }
        const bf16_t* Kw = WSP(bf16_t, WS_KW) + (size_t)bg * 128 * 4096; const bf16_t* Vw = WSP(bf16_t, WS_VWT) + (size_t)bg * 128 * 4096;
        const int loW = T0 - 511 > 0 ? T0 - 511 : 0; const int jb0W = loW >> 6, jb1W = (T0 + 31) >> 6;
        const int wbase = (((curW >> 2) + 1) & 1) * 4;
        {
            const bf16_t* Ks = WSP(bf16_t, WS_KS) + (size_t)bg * 128 * 4096; const bf16_t* Vs = WSP(bf16_t, WS_VST) + (size_t)bg * 128 * 4096;
            NSA_ZERO_O();
            unsigned long long any[2][2], mine[2][2], both[2][2];
#pragma unroll
            for (int pr = 0; pr < 2; ++pr)
#pragma unroll
                for (int h = 0; h < 2; ++h) { any[pr][h] = msk[pr][0][h] | msk[pr][1][h]; both[pr][h] = msk[pr][0][h] & msk[pr][1][h]; mine[pr][h] = (fr >> 3) ? msk[pr][1][h] : msk[pr][0][h]; }
            const int ng = (curW >> 2) + 1;
            SH_BAR();
#pragma unroll
            for (int bb = 0; bb < 4; ++bb) if (bb <= curW) SH_ISSUE(Ks, Vs, bb, bb, true);
            for (int gi = 0; gi < ng; ++gi) {
                SH_WAIT_BAR();
                if (gi + 1 < ng) {
#pragma unroll
                    for (int bb = 0; bb < 4; ++bb) if (4 * (gi + 1) + bb <= curW) SH_ISSUE(Ks, Vs, 4 * (gi + 1) + bb, ((gi + 1) & 1) * 4 + bb, true);
                } else SH_ISSUE(Kw, Vw, jb0W, ((gi + 1) & 1) * 4, true);
#pragma unroll 1
                for (int bb = 0; bb < 4; ++bb) {
                    const int j = 4 * gi + bb; if (j > curW) break;
                    const int slot = (gi & 1) * 4 + bb;
                    const bool a0 = ((j < 64 ? (any[0][0] >> j) : (any[0][1] >> (j - 64))) & 1ull) != 0ull, a1 = ((j < 64 ? (any[1][0] >> j) : (any[1][1] >> (j - 64))) & 1ull) != 0ull;
#pragma unroll
                    for (int pr = 0; pr < 2; ++pr) if (pr == 0 ? a0 : a1) {
                        const bool colok = ((j < 64 ? (mine[pr][0] >> j) : (mine[pr][1] >> (j - 64))) & 1ull) != 0ull;
                        const bool bothsel = ((j < 64 ? (both[pr][0] >> j) : (both[pr][1] >> (j - 64))) & 1ull) != 0ull;
                        attn_step_lds(SH_SLOT(slot), qf[pr], j * 64, tcol[pr], -1, colok, bothsel, j * 64 + 63 <= t0[pr], O[pr], lsum[pr], lane, fq); }
                }
            }
#pragma unroll
            for (int pr = 0; pr < 2; ++pr) { float l = lsum[pr]; l += __shfl_xor(l, 16); l += __shfl_xor(l, 32); const float sc = l > 0.f ? g1[pr] / l : 0.f;
#pragma unroll
                for (int dt = 0; dt < 4; ++dt) out[pr][dt] += O[pr][dt] * sc; }
        }
        {
            NSA_ZERO_O();
            for (int jb = jb0W; jb <= jb1W; ++jb) {
                const int slot = wbase + ((jb - jb0W) & 1);
                SH_WAIT_BAR();
                if (jb < jb1W) SH_ISSUE(Kw, Vw, jb + 1, wbase + ((jb + 1 - jb0W) & 1), true);
#pragma unroll
                for (int pr = 0; pr < 2; ++pr) { const int lo = t0[pr] - 511 > 0 ? t0[pr] - 511 : 0;
                    if (jb >= (lo >> 6) && jb <= ((t0[pr] + 1) >> 6))
                        attn_step_lds(SH_SLOT(slot), qf[pr], jb * 64, tcol[pr], tcol[pr] - 512, true, true, jb * 64 > t0[pr] + 1 - 512 && jb * 64 + 63 <= t0[pr], O[pr], lsum[pr], lane, fq); }
            }
#pragma unroll
            for (int pr = 0; pr < 2; ++pr) { float l = lsum[pr]; l += __shfl_xor(l, 16); l += __shfl_xor(l, 32); const float sc = l > 0.f ? g2[pr] / l : 0.f;
#pragma unroll
                for (int dt = 0; dt < 4; ++dt) out[pr][dt] += O[pr][dt] * sc; }
        }
#pragma unroll
        for (int pr = 0; pr < 2; ++pr) { bf16_t* op = WSP(bf16_t, WS_RA) + tokc[pr] * 2048 + 1024 + head * 64 + 4 * fq;
#pragma unroll
            for (int dt = 0; dt < 4; ++dt) { u32x2 ov; ov.x = pk2(out[pr][dt][0], out[pr][dt][1]); ov.y = pk2(out[pr][dt][2], out[pr][dt][3]); *(u32x2*)(op + 16 * dt) = ov; } }
#undef NSA_ZERO_O
        {
#pragma unroll 1
            for (int r = kk * crpt; r < (kk + 1) * crpt && r < crounds; ++r) { const int item = c.gw + r * (c.G * NWAVES);
                if (item < cntot) { const bool nx = lconv >= 0 && item < CONV_ITEMS; const int i0 = nx ? item : item - (lconv >= 0 ? CONV_ITEMS : 0);
                    if (nx || !conv_is_early(i0)) conv_one(c, nx ? lconv : 0, i0); } }
        }
    }
#pragma unroll 1
    for (int r = kk * crpt; r < crounds; ++r) { const int item = c.gw + r * (c.G * NWAVES);
        if (item < cntot) { const bool nx = lconv >= 0 && item < CONV_ITEMS; const int i0 = nx ? item : item - (lconv >= 0 ? CONV_ITEMS : 0);
            if (nx || !conv_is_early(i0)) conv_one(c, nx ? lconv : 0, i0); } }
    SH_BAR();
#undef NSA_QCTR
}

__device__ __forceinline__ void phase_route(const Ctx& c, int l) {
    const int lane = c.lane, gw = c.gw, NW = c.G * NWAVES, fr = lane & 15, fq = lane >> 4;
    LAS int* cnt = (LAS int*)(c.lds + LDS_CTL_OFF + 64);
    if (c.tid < 32) cnt[c.tid] = 0;
    for (int i = blockIdx.x * NTHREADS + c.tid; i < XROWS; i += c.G * NTHREADS) WSP(int, WS_ROWTOK)[i] = 0;
    __syncthreads();
    {
        const bf16_t* rwf = WSP(bf16_t, WS_RWF) + (size_t)l * 32 * 2 * 2 * 512 + lane * 8;
#pragma unroll
        for (int i = 0; i < 16; ++i) { const int blk = c.wave * 16 + i;
            __builtin_amdgcn_global_load_lds((const unsigned*)(rwf + (size_t)blk * 512), (LAS unsigned*)(c.lds + blk * 1024), 16, 0, 0); }
        asm volatile("s_waitcnt vmcnt(0)" ::: "memory"); __syncthreads();
    }
    const float b0 = c.router_b[(size_t)l * NEXP + fr], b1 = c.router_b[(size_t)l * NEXP + 16 + fr];
    for (int tile = gw; tile < NTOK / 16; tile += NW) {
        const int tok0 = tile * 16; const float* xr = (l == 0 ? c.x_in : (const float*)c.out) + (size_t)(tok0 + fr) * D + 4 * fq;
        const bf16_t* dr = WSP(bf16_t, WS_PROJ) + (size_t)(tok0 + fr) * D + 4 * fq;
        bf16_t* hrow = WSP(bf16_t, WS_H) + (size_t)(tok0 + fr) * D + 4 * fq;
        f32x4 acc0 = {0.f, 0.f, 0.f, 0.f}, acc1 = {0.f, 0.f, 0.f, 0.f}; float ss = 0.f;
#pragma unroll 1
        for (int kg = 0; kg < 8; ++kg) {
            f32x4 xa[4], xb[4]; u32x2 da[4], db[4]; bf16x8 wv[4][4];
#pragma unroll
            for (int u = 0; u < 4; ++u) { const int ks = kg * 4 + u; xa[u] = *(const f32x4*)(xr + 32 * ks); xb[u] = *(const f32x4*)(xr + 32 * ks + 16);
                da[u] = *(const u32x2*)(dr + 32 * ks); db[u] = *(const u32x2*)(dr + 32 * ks + 16);
#pragma unroll
                for (int q = 0; q < 4; ++q) wv[u][q] = *(const LAS bf16x8*)(c.lds + (ks * 4 + q) * 1024 + lane * 16); }
            __builtin_amdgcn_sched_barrier(0);
#pragma unroll
            for (int u = 0; u < 4; ++u) {
                float v[8] = {xa[u][0] + bflo(da[u].x), xa[u][1] + bfhi(da[u].x), xa[u][2] + bflo(da[u].y), xa[u][3] + bfhi(da[u].y),
                              xb[u][0] + bflo(db[u].x), xb[u][1] + bfhi(db[u].x), xb[u][2] + bflo(db[u].y), xb[u][3] + bfhi(db[u].y)}; float lo[8]; u32x4 hw, lw;
#pragma unroll
                for (int j = 0; j < 8; ++j) ss += v[j] * v[j];
#pragma unroll
                for (int j = 0; j < 4; ++j) { hw[j] = pk2(v[2 * j], v[2 * j + 1]); lo[2 * j] = v[2 * j] - bflo(hw[j]); lo[2 * j + 1] = v[2 * j + 1] - bfhi(hw[j]); }
#pragma unroll
                for (int j = 0; j < 4; ++j) lw[j] = pk2(lo[2 * j], lo[2 * j + 1]);
                const bf16x8 ah = mk8(hw), al = mk8(lw);
                { bf16_t* hp = hrow + 32 * (kg * 4 + u); u32x2 h0, h1; h0.x = hw[0]; h0.y = hw[1]; h1.x = hw[2]; h1.y = hw[3]; *(u32x2*)hp = h0; *(u32x2*)(hp + 16) = h1; }
                acc0 = mfma16(ah, wv[u][0], acc0); acc1 = mfma16(ah, wv[u][2], acc1);
                acc0 = mfma16(ah, wv[u][1], acc0); acc1 = mfma16(ah, wv[u][3], acc1);
                acc0 = mfma16(al, wv[u][0], acc0); acc1 = mfma16(al, wv[u][2], acc1);
            }
            MFMA_FENCE();
        }
        ss += __shfl_xor(ss, 16); ss += __shfl_xor(ss, 32);
        const float rs = rsqrtf(ss * (1.0f / 1024.0f) + NORM_EPS);
        if (fq == 0) WSP(float, WS_RSTD)[tok0 + fr] = rs;
#pragma unroll
        for (int r = 0; r < 4; ++r) {
            const float rt = __shfl(rs, 4 * fq + r);
            float v0 = acc0[r] * rt + b0, v1 = acc1[r] * rt + b1; float tv[4]; int te[4];
#pragma unroll
            for (int k = 0; k < 4; ++k) { float bv = v0; int be = fr; if (v1 > bv) { bv = v1; be = 16 + fr; }
#pragma unroll
                for (int o = 8; o >= 1; o >>= 1) { const float ov = __shfl_xor(bv, o); const int oe = __shfl_xor(be, o); if (ov > bv || (ov == bv && oe < be)) { bv = ov; be = oe; } }
                tv[k] = bv; te[k] = be; if (be == fr) v0 = -INFINITY; if (be == 16 + fr) v1 = -INFINITY; }
            const float e1 = expf(tv[1] - tv[0]), e2 = expf(tv[2] - tv[0]), e3 = expf(tv[3] - tv[0]); const float inv = 1.0f / (1.0f + e1 + e2 + e3);
            if (fr < 4) { const int e = fr == 0 ? te[0] : fr == 1 ? te[1] : fr == 2 ? te[2] : te[3]; const float wv_ = (fr == 0 ? 1.0f : fr == 1 ? e1 : fr == 2 ? e2 : e3) * inv;
                const int rk = atomicAdd((int*)&cnt[e], 1); const size_t o = (size_t)(tok0 + 4 * fq + r) * 4 + fr;
                WSP(int, WS_TE)[o] = e; WSP(float, WS_TW)[o] = wv_; WSP(int, WS_RANK)[o] = rk; }
        }
    }
    __syncthreads();
    if (c.tid < 32) WSP(int, WS_HIST)[blockIdx.x * 32 + c.tid] = cnt[c.tid];
    __syncthreads();
}

__device__ __forceinline__ void phase_scatter(const Ctx& c, int l) {
    const int lane = c.lane, gw = c.gw, NW = c.G * NWAVES;
    LAS int* hist = (LAS int*)c.lds;
    LAS int* part = (LAS int*)(c.lds + 65536);
    LAS int* base = part + 1024;
    LAS int* pst = base + 32;
    LAS int* nblk = pst + 40;
    for (int i = c.tid; i < c.G * 32; i += NTHREADS) hist[i] = WSP(int, WS_HIST)[i];
    __syncthreads();
    { const int e = c.tid & 31, p = c.tid >> 5, per = (c.G + 15) >> 4; const int w1 = (p + 1) * per < c.G ? (p + 1) * per : c.G; int before = 0, tot = 0;
      for (int w = p * per; w < w1; ++w) { const int v = hist[w * 32 + e]; if (w < (int)blockIdx.x) before += v; tot += v; }
      part[(p * 32 + e) * 2] = before; part[(p * 32 + e) * 2 + 1] = tot; }
    __syncthreads();
    if (c.tid < 32) { int before = 0, tot = 0;
#pragma unroll
        for (int p = 0; p < 16; ++p) { before += part[(p * 32 + c.tid) * 2]; tot += part[(p * 32 + c.tid) * 2 + 1]; }
        base[c.tid] = before; const int padded = (tot + 255) & ~255; int incl = padded;
#pragma unroll
        for (int o = 1; o < 32; o <<= 1) { const int t = __shfl_up(incl, o); if (c.tid >= o) incl += t; }
        pst[c.tid] = incl - padded; if (c.tid == 31) pst[32] = incl; nblk[c.tid] = padded >> 8; }
    __syncthreads();
    if (blockIdx.x == 0 && c.tid < 32) {
        int* meta = WSP(int, WS_META); const int e = c.tid, x = e & 7; int off = 0;
        for (int e2 = x; e2 < e; e2 += 8) off += nblk[e2];
        const int rb0 = pst[e] >> 8, nb = nblk[e];
        for (int i = 0; i < nb; ++i) { meta[64 + rb0 + i] = e; meta[1024 + 640 * x + off + i] = rb0 + i; }
        if (e >= 24) meta[16 + x] = off + nb;
        if (e == 0) meta[0] = pst[32] >> 8; }
    for (int tile = gw; tile < NTOK / 16; tile += NW) {
        const int o = tile * 64 + lane, tok = o >> 2;
        const int e = WSP(int, WS_TE)[o], rk = WSP(int, WS_RANK)[o];
        const int dst = pst[e] + base[e] + rk;
        WSP(int, WS_ROWTOK)[dst] = tok; WSP(float, WS_RSROW)[dst] = WSP(float, WS_RSTD)[tok]; WSP(int, WS_SLOT)[o] = dst;
    }
}

__device__ __forceinline__ void phase_combine(const Ctx& c, int l) {
    const int lane = c.lane, gw = c.gw, NW = c.G * NWAVES;
    for (int tok = gw; tok < NTOK; tok += NW) {
        float* xr = c.out + (size_t)tok * D; const bf16_t* hs = WSP(bf16_t, WS_H) + (size_t)tok * D;
        const u32x4 sl = *(const u32x4*)(WSP(int, WS_SLOT) + (size_t)tok * 4); const f32x4 tw = *(const f32x4*)(WSP(float, WS_TW) + (size_t)tok * 4);
        f32x4 v[4];
#pragma unroll
        for (int i = 0; i < 4; ++i) { const u32x2 d = *(const u32x2*)(hs + i * 256 + lane * 4); v[i][0] = bflo(d.x); v[i][1] = bfhi(d.x); v[i][2] = bflo(d.y); v[i][3] = bfhi(d.y); }
#pragma unroll
        for (int k = 0; k < 4; ++k) { const bf16_t* yr = WSP(bf16_t, WS_XBUF) + (size_t)sl[k] * D; const float w = tw[k];
#pragma unroll
            for (int i = 0; i < 4; ++i) { const u32x2 y = *(const u32x2*)(yr + i * 256 + lane * 4);
                v[i][0] += w * bflo(y.x); v[i][1] += w * bfhi(y.x); v[i][2] += w * bflo(y.y); v[i][3] += w * bfhi(y.y); } }
        float ss = 0.f;
#pragma unroll
        for (int i = 0; i < 4; ++i) { *(f32x4*)(xr + i * 256 + lane * 4) = v[i]; ss += v[i][0] * v[i][0] + v[i][1] * v[i][1] + v[i][2] * v[i][2] + v[i][3] * v[i][3]; }
        if (l + 1 < NL) {
            ss = wave_sum(ss); const float rs = rsqrtf(ss * (1.0f / 1024.0f) + NORM_EPS);
            const float* nw = c.norm1_w + (size_t)(l + 1) * D; bf16_t* hr = WSP(bf16_t, WS_H) + (size_t)tok * D;
#pragma unroll
            for (int i = 0; i < 4; ++i) { const f32x4 w = *(const f32x4*)(nw + i * 256 + lane * 4);
                u32x2 o; o.x = pk2(v[i][0] * rs * w[0], v[i][1] * rs * w[1]); o.y = pk2(v[i][2] * rs * w[2], v[i][3] * rs * w[3]); *(u32x2*)(hr + i * 256 + lane * 4) = o; }
        }
    }
}

constexpr int PH_PER_LAYER = 14, N_PHASES = 1 + NL * PH_PER_LAYER;
#ifndef PH_MASK
#define PH_MASK 0xffff
#endif
#define IN(k) (lo <= (k) && (k) < hi)
#define INL(j) (((PH_MASK >> ((j) + 1)) & 1) && IN(pb + (j)))
#define FRESH() do { int _t = threadIdx.x; asm volatile("" : "+v"(_t)); c.tid = _t; c.lane = _t & 63; c.wave = __builtin_amdgcn_readfirstlane(_t >> 6); c.gw = blockIdx.x * NWAVES + c.wave; } while (0)
#define SEAM(k) do { if (IN((k) + 1) || IN((k) + 2)) xcd_barrier(bar); else __syncthreads(); } while (0)

template <int l>
__device__ __forceinline__ void run_layer(Ctx& c, const XcdBarrier& bar, const int lo, const int hi) {
        const int pb = 1 + l * PH_PER_LAYER;
        if (INL(0)) { FRESH();
            g8::SchedPlain S{(const char*)WSP(bf16_t, WS_H), (const char*)(WSP(bf16_t, WS_WIN) + (size_t)l * NPROJ * D), (size_t)256 * D * 2, (size_t)256 * D * 2, NTOK / 256, NPROJ / 256, (NTOK / 256) * (NPROJ / 256), c.G, (int)blockIdx.x};
            g8::EpiBf16 E{WSP(bf16_t, WS_PROJ), NPROJ};
            g8::gemm_phase(c.lds, c.tid, D, D * 2, D * 2, S, E);
            SEAM(pb + 0);
        }
        if (INL(1)) { FRESH(); phase_prep(c, l); SEAM(pb + 1); }
        if (INL(2)) { FRESH();
            g8::SchedCmp S{(const char*)WSP(bf16_t, WS_KCT), (const char*)WSP(bf16_t, WS_VCT), (const char*)(WSP(bf16_t, WS_WC1) + (size_t)l * 2 * 256 * 2048), c.G, (int)blockIdx.x};
            g8::EpiSlab E{WSP(float, WS_ACT)};
            g8::gemm_phase(c.lds, c.tid, 256, 1024 * 2, 2048 * 2, S, E);
            SEAM(pb + 2);
        }
        if (INL(3)) { FRESH(); phase_cmp2(c, l); __syncthreads(); FRESH(); phase_scan(c); SEAM(pb + 3); }
        if (INL(5)) { FRESH(); phase_retout(c, l); FRESH(); phase_nsa(c, l, l + 1 < NL ? l + 1 : -1, l == 0); SEAM(pb + 5); }
        if (INL(7)) { FRESH();
            {
                g8::SchedPlain S{(const char*)WSP(bf16_t, WS_RA), (const char*)(WSP(bf16_t, WS_WO) + (size_t)l * D * 2048), (size_t)256 * 2048 * 2, (size_t)256 * 2048 * 2, NTOK / 256, D / 256, (NTOK / 256) * (D / 256), c.G, (int)blockIdx.x};
                g8::EpiGate E{WSP(bf16_t, WS_MIX), WSP(bf16_t, WS_PROJ), 0};
                g8::gemm_phase(c.lds, c.tid, D, 2048 * 2, 2048 * 2, S, E);
            }
            asm volatile("s_waitcnt vmcnt(0)" ::: "memory"); __syncthreads();
            {
                g8::SchedPlain S{(const char*)(WSP(bf16_t, WS_RA) + 1024), (const char*)(WSP(bf16_t, WS_WO) + (size_t)l * D * 2048 + 1024), (size_t)256 * 2048 * 2, (size_t)256 * 2048 * 2, NTOK / 256, D / 256, (NTOK / 256) * (D / 256), c.G, (int)blockIdx.x};
                g8::EpiGate E{WSP(bf16_t, WS_MIX), WSP(bf16_t, WS_PROJ), 1};
                g8::gemm_phase(c.lds, c.tid, D, 2048 * 2, 2048 * 2, S, E);
            }
            SEAM(pb + 7);
        }
        if (INL(8)) { FRESH();
            g8::SchedPlain S{(const char*)WSP(bf16_t, WS_MIX), (const char*)(WSP(bf16_t, WS_WOUT) + (size_t)l * D * D), (size_t)256 * D * 2, (size_t)256 * D * 2, NTOK / 256, D / 256, (NTOK / 256) * (D / 256), c.G, (int)blockIdx.x};
            g8::EpiBf16 E{WSP(bf16_t, WS_PROJ), D};
            g8::gemm_phase(c.lds, c.tid, D, D * 2, D * 2, S, E);
            SEAM(pb + 8);
        }
        if (INL(9)) { FRESH(); phase_route(c, l); SEAM(pb + 9); }
        if (INL(10)) { FRESH(); phase_scatter(c, l); SEAM(pb + 10); }
        if (INL(11)) { FRESH();
            LAS int* tab = (LAS int*)(c.lds + 131072); g8::moe_units(tab, WSP(int, WS_META), 8, c.G, (int)blockIdx.x, c.tid);
            g8::SchedMoeG S{(const char*)WSP(bf16_t, WS_H), (const char*)(WSP(bf16_t, WS_WGU) + (size_t)l * NEXP * 2048 * D), tab, 8, (size_t)2048 * D * 2, WSP(int, WS_ROWTOK)};
            g8::EpiSwiglu E{WSP(bf16_t, WS_ACT), c.b_gate_up + (size_t)l * NEXP * 2048, WSP(float, WS_RSROW), c.lds + 131072 + 8192};
            g8::gemm_phase(c.lds, c.tid, D, D * 2, D * 2, S, E);
            SEAM(pb + 11);
        }
        if (INL(12)) { FRESH();
            LAS int* tab = (LAS int*)(c.lds + 131072); g8::moe_units(tab, WSP(int, WS_META), 4, c.G, (int)blockIdx.x, c.tid);
            g8::SchedMoe S{(const char*)WSP(bf16_t, WS_ACT), (const char*)(WSP(bf16_t, WS_WD) + (size_t)l * NEXP * D * D), tab, 4, (size_t)D * D * 2};
            g8::EpiDown E{WSP(bf16_t, WS_XBUF), c.b_down + (size_t)l * NEXP * D};
            g8::gemm_phase(c.lds, c.tid, D, D * 2, D * 2, S, E);
            SEAM(pb + 12);
        }
        if (INL(13)) { FRESH(); phase_combine(c, l); SEAM(pb + 13); }
    }
__global__ void __launch_bounds__(NTHREADS, 2) mk_fwd(Args args) {
    extern __shared__ __attribute__((aligned(16))) unsigned char lds_raw[];
    Ctx c;
    c.x_in = args.in[0]; c.norm1_w = args.in[1]; c.w_in = args.in[2]; c.ret_gn_w = args.in[3]; c.qk_norm_w = args.in[4]; c.cmp_pos = args.in[5]; c.cmp_w1 = args.in[6]; c.cmp_w2 = args.in[7];
    c.w_o_ret = args.in[8]; c.w_o_nsa = args.in[9]; c.w_out = args.in[10]; c.norm2_w = args.in[11]; c.router_w = args.in[12]; c.router_b = args.in[13]; c.w_gate_up = args.in[14]; c.b_gate_up = args.in[15];
    c.w_down = args.in[16]; c.b_down = args.in[17];
    c.out = args.out; c.ws = args.ws; c.lds = (LAS unsigned char*)lds_raw;
    c.tid = threadIdx.x; c.lane = c.tid & 63; c.wave = __builtin_amdgcn_readfirstlane(c.tid >> 6); c.G = gridDim.x; c.gw = blockIdx.x * NWAVES + c.wave;
    volatile LAS unsigned* lctl = (volatile LAS unsigned*)(c.lds + LDS_CTL_OFF);
    if (c.tid < 16) lctl[c.tid] = 0u;
    __syncthreads();
    const int lo = args.ph_lo, hi = args.ph_hi;
    XcdBarrier bar; bar.bar = WSP(unsigned, WS_CTL); bar.x = 0; bar.st = lctl;
    if (hi - lo > 1) bar = xcd_barrier_post(WSP(unsigned, WS_CTL), lctl);
    if ((PH_MASK & 1) && IN(0)) { FRESH(); phase_prologue(c); SEAM(0); }

    run_layer<0>(c, bar, lo, hi); run_layer<1>(c, bar, lo, hi); run_layer<2>(c, bar, lo, hi); run_layer<3>(c, bar, lo, hi);
#undef IN
#undef INL
#undef SEAM
}


extern "C" void kernel_launch(void* const* d_in, const int* in_sizes, int n_in, void* d_out, int out_size, void* d_ws, size_t ws_size, hipStream_t stream) {
    static int grid = 0;
    if (grid == 0) {
        if (n_in != 18 || out_size != NTOK * D || ws_size < WS_END) { fprintf(stderr, "kernel_launch: unexpected shapes (n_in %d out %d ws %zu need %zu)\n", n_in, out_size, ws_size, (size_t)WS_END); grid = -1; return; }
        int dev = 0, cus = 0;
        if (hipGetDevice(&dev) != hipSuccess || hipDeviceGetAttribute(&cus, hipDeviceAttributeMultiprocessorCount, dev) != hipSuccess) { grid = -1; return; }
        if (hipFuncSetAttribute((const void*)mk_fwd, hipFuncAttributeMaxDynamicSharedMemorySize, LDS_BYTES) != hipSuccess) { fprintf(stderr, "kernel_launch: hipFuncSetAttribute failed\n"); grid = -1; return; }
        int per_cu = 0;
        if (hipOccupancyMaxActiveBlocksPerMultiprocessor(&per_cu, (const void*)mk_fwd, NTHREADS, LDS_BYTES) != hipSuccess || per_cu < 1) fprintf(stderr, "kernel_launch: occupancy query says %d\n", per_cu);
        (void)hipGetLastError();
        grid = cus;
    }
    if (grid < 0) return;
    (void)hipMemsetAsync((char*)d_ws + WS_CTL, 0, CTL_BYTES, stream);
    Args a{};
    for (int i = 0; i < 18; ++i) a.in[i] = (const float*)d_in[i];
    a.out = (float*)d_out; a.ws = (unsigned char*)d_ws;
#if MK_ONE_LAUNCH
    a.ph_lo = 0; a.ph_hi = N_PHASES;
    hipLaunchKernelGGL(mk_fwd, dim3(grid), dim3(NTHREADS), LDS_BYTES, stream, a);
#else
    for (int p = 0; p < N_PHASES; ++p) { a.ph_lo = p; a.ph_hi = p + 1; hipLaunchKernelGGL(mk_fwd, dim3(grid), dim3(NTHREADS), LDS_BYTES, stream, a); }
#endif
}
```

```cpp
#include <hip/hip_runtime.h>
#include <stdint.h>
#include <stdio.h>

#ifndef MK_ONE_LAUNCH
#define MK_ONE_LAUNCH 1
#endif

#define LAS __attribute__((address_space(3)))
typedef unsigned short bf16_t;
typedef short bf16x8 __attribute__((ext_vector_type(8)));
typedef float f32x4 __attribute__((ext_vector_type(4)));
typedef float f32x2 __attribute__((ext_vector_type(2)));
typedef unsigned u32x4 __attribute__((ext_vector_type(4)));
typedef unsigned u32x2 __attribute__((ext_vector_type(2)));

constexpr int D = 1024, NB = 4, SEQ = 8192, NTOK = NB * SEQ, NL = 4;
constexpr int NPROJ = 7168, IN_TOTAL = 6960;
constexpr int C_RQ = 0, C_RK = 512, C_RV = 1024, C_RG = 2048, C_NQ = 3072, C_KC = 4096, C_VC = 4224, C_KS = 4352, C_VS = 4480, C_KW = 4608, C_VW = 4736, C_NG = 4864, C_MG = 5120;
constexpr int NEXP = 32, XROWS = 139264;
constexpr int NWAVES = 8, NTHREADS = 512;
constexpr float NORM_EPS = 1e-6f;

constexpr size_t al256(size_t x) { return (x + 255) & ~(size_t)255; }
constexpr size_t WS_CTL = 0, CTL_BYTES = 65536;
constexpr size_t WS_HIST = WS_CTL + CTL_BYTES;
constexpr size_t WS_META = WS_HIST + 1024 * 32 * 4;
constexpr size_t WS_ROPER = WS_META + 32768;
constexpr size_t WS_ROPEN = WS_ROPER + (size_t)SEQ * 64 * 2 * 4;
constexpr size_t WS_PEB = WS_ROPEN + (size_t)SEQ * 8 * 2 * 4;
constexpr size_t WS_RWF = al256(WS_PEB + 8 * NL * 2 * 256 * 4);
constexpr size_t WS_RSTD = WS_RWF + (size_t)NL * 32 * 2 * 2 * 512 * 2;
constexpr size_t WS_WIN = al256(WS_RSTD + (size_t)NTOK * 4);
constexpr size_t WS_WO = WS_WIN + (size_t)NL * NPROJ * D * 2;
constexpr size_t WS_WOUT = WS_WO + (size_t)NL * D * 2048 * 2;
constexpr size_t WS_WC1 = WS_WOUT + (size_t)NL * D * D * 2;
constexpr size_t WS_WGU = WS_WC1 + (size_t)NL * 2 * 256 * 2048 * 2;
constexpr size_t WS_WD = WS_WGU + (size_t)NL * NEXP * 2048 * D * 2;
constexpr size_t WS_H = WS_WD + (size_t)NL * NEXP * D * D * 2;
constexpr size_t WS_PROJ = WS_H + (size_t)NTOK * D * 2;
constexpr size_t WS_QR = WS_PROJ + (size_t)NTOK * NPROJ * 2;
constexpr size_t WS_KR = WS_QR + (size_t)NTOK * 512 * 2;
constexpr size_t WS_KZT = WS_KR + (size_t)NTOK * 512 * 2;
constexpr size_t WS_VT = WS_KZT + (size_t)NTOK * 512 * 2;
constexpr size_t WS_RT = WS_VT + (size_t)NTOK * 1024 * 2;
constexpr size_t WS_QN = WS_RT + (size_t)16 * 64 * 256 * 128 * 2;
constexpr size_t WS_KS = WS_QN + (size_t)NTOK * 1024 * 2;
constexpr size_t WS_VST = WS_KS + (size_t)NTOK * 128 * 2;
constexpr size_t WS_KW = WS_VST + (size_t)NTOK * 128 * 2;
constexpr size_t WS_VWT = WS_KW + (size_t)NTOK * 128 * 2;
constexpr size_t WS_KCT = WS_VWT + (size_t)NTOK * 128 * 2;
constexpr size_t WS_VCT = WS_KCT + (size_t)NTOK * 128 * 2 + 4096;
constexpr size_t WS_HID = WS_VCT + (size_t)NTOK * 128 * 2 + 4096;
constexpr size_t WS_KCMP = WS_HID + (size_t)2 * 8 * 512 * 256 * 2;
constexpr size_t WS_VCMPT = WS_KCMP + (size_t)8 * 512 * 64 * 2;
constexpr size_t WS_RA = WS_VCMPT + (size_t)8 * 512 * 64 * 2;
constexpr size_t WS_MIX = WS_RA + (size_t)NTOK * 2048 * 2;
constexpr size_t WS_TE = WS_MIX + (size_t)NTOK * D * 2;
constexpr size_t WS_TW = WS_TE + (size_t)NTOK * 16;
constexpr size_t WS_RANK = WS_TW + (size_t)NTOK * 16;
constexpr size_t WS_SLOT = WS_RANK + (size_t)NTOK * 16;
constexpr size_t WS_ROWTOK = WS_SLOT + (size_t)NTOK * 16;
constexpr size_t WS_RSROW = WS_ROWTOK + (size_t)XROWS * 4;
constexpr size_t WS_XBUF = al256(WS_RSROW + (size_t)XROWS * 4);
constexpr size_t WS_ACT = WS_XBUF + (size_t)XROWS * D * 2;
constexpr size_t WS_END = WS_ACT + (size_t)XROWS * D * 2;

constexpr int LDS_SCRATCH = 149504;
constexpr int LDS_CTL_OFF = LDS_SCRATCH;
constexpr int LDS_BYTES = LDS_SCRATCH + 1024;

__device__ __forceinline__ float bf2f(bf16_t v) { return __uint_as_float(((unsigned)v) << 16); }
__device__ __forceinline__ float bflo(unsigned w) { return __uint_as_float(w << 16); }
__device__ __forceinline__ float bfhi(unsigned w) { return __uint_as_float(w & 0xffff0000u); }
__device__ __forceinline__ unsigned f2bf(float f) { unsigned u = __float_as_uint(f); return (u + 0x7fffu + ((u >> 16) & 1u)) >> 16; }
typedef __bf16 bf16x2_t __attribute__((ext_vector_type(2)));
__device__ __forceinline__ unsigned pk2(float lo, float hi) { const f32x2 v = {lo, hi}; const bf16x2_t r = __builtin_convertvector(v, bf16x2_t); return __builtin_bit_cast(unsigned, r); }
__device__ __forceinline__ float fexp2(float x) { return __builtin_amdgcn_exp2f(x); }
__device__ __forceinline__ float frcp(float x) { return __builtin_amdgcn_rcpf(x); }
__device__ __forceinline__ float sigmoidf_(float x) { return frcp(1.0f + fexp2(-1.4426950408889634f * x)); }
__device__ __forceinline__ bf16x8 mk8(u32x4 v) { return __builtin_bit_cast(bf16x8, v); }
__device__ __forceinline__ bf16x8 ld8(const bf16_t* p) { return __builtin_bit_cast(bf16x8, *(const u32x4*)p); }
__device__ __forceinline__ f32x4 mfma16(bf16x8 a, bf16x8 b, f32x4 c) { return __builtin_amdgcn_mfma_f32_16x16x32_bf16(a, b, c, 0, 0, 0); }
#define MFMA_FENCE() do { __builtin_amdgcn_sched_barrier(0); asm volatile("s_nop 7\n\ts_nop 7" ::: "memory"); __builtin_amdgcn_sched_barrier(0); } while (0)
__device__ __forceinline__ float sum8(float v) { v += __int_as_float(__builtin_amdgcn_update_dpp(0, __float_as_int(v), 0xB1, 0xf, 0xf, true));
    v += __int_as_float(__builtin_amdgcn_update_dpp(0, __float_as_int(v), 0x4E, 0xf, 0xf, true)); v += __int_as_float(__builtin_amdgcn_update_dpp(0, __float_as_int(v), 0x141, 0xf, 0xf, true)); return v; }
__device__ __forceinline__ float wave_sum(float v) {
#pragma unroll
    for (int o = 32; o >= 1; o >>= 1) v += __shfl_xor(v, o);
    return v;
}

#define XB_TMO      128
#define XB_XCNT(j)  (256  + 64 * (j))
#define XB_XSUB(j)  (1280 + 64 * (j))
#define XB_XGEN(j)  (2304 + 64 * (j))
#define XB_TOP      3328
#define XB_TOPGEN   3392
#define XCD_BAR_WORDS 3456
#define XB_SPIN_CAP (1u << 18)
__device__ __forceinline__ unsigned xb_ld(unsigned* p)              { return __hip_atomic_load(p, __ATOMIC_RELAXED, __HIP_MEMORY_SCOPE_AGENT); }
__device__ __forceinline__ unsigned xb_add(unsigned* p, unsigned v) { return __hip_atomic_fetch_add(p, v, __ATOMIC_RELAXED, __HIP_MEMORY_SCOPE_AGENT); }
__device__ __forceinline__ unsigned xb_xcc_id() { return (unsigned)__builtin_amdgcn_s_getreg((3 << 11) | 20) & 0xFu; }
#define XB_SPIN(cond, bar) do { unsigned _sp = 0; while (cond) { __builtin_amdgcn_s_sleep(1); \
    if ((++_sp & 255u) == 0u) { if (xb_ld(&(bar)[XB_TMO])) break; if (_sp > XB_SPIN_CAP) { atomicAdd(&(bar)[XB_TMO], 1u); break; } } } } while (0)
struct XcdBarrier { unsigned* bar; unsigned x; volatile LAS unsigned* st; };
__device__ __forceinline__ XcdBarrier xcd_barrier_post(unsigned* bar, volatile LAS unsigned* st) {
    XcdBarrier b; b.bar = bar; b.x = xb_xcc_id(); b.st = st;
    if (threadIdx.x == 0) (void)xb_add(&bar[XB_XCNT(b.x)], 1u);
    return b;
}
__device__ __forceinline__ void xcd_barrier_complete(unsigned* bar, unsigned x, unsigned& nloc, unsigned& nx) {
    const unsigned G = gridDim.x * gridDim.y * gridDim.z;
    unsigned sum, cnt, mine, sp = 0u;
    for (;;) {
        sum = 0u; cnt = 0u; mine = 0u;
#pragma unroll
        for (unsigned j = 0; j < 16; ++j) { const unsigned c = xb_ld(&bar[XB_XCNT(j)]); sum += c; cnt += (c > 0u) ? 1u : 0u; mine = (j == x) ? c : mine; }
        if (sum == G) break;
        __builtin_amdgcn_s_sleep(1);
        if ((++sp & 255u) == 0u) { if (xb_ld(&bar[XB_TMO])) break; if (sp > XB_SPIN_CAP) { atomicAdd(&bar[XB_TMO], 1u); break; } }
    }
    nloc = mine > 0u ? mine : 1u; nx = cnt > 0u ? cnt : 1u;
}
__device__ __forceinline__ void xcd_barrier(const XcdBarrier& b) {
    asm volatile("s_waitcnt vmcnt(0)" ::: "memory");
    __syncthreads();
    if (threadIdx.x == 0) {
        unsigned* bar = b.bar;
        __builtin_amdgcn_s_waitcnt(0);
        unsigned nloc = b.st[0], nx = b.st[1];
        if (nloc == 0u) { xcd_barrier_complete(bar, b.x, nloc, nx); b.st[0] = nloc; b.st[1] = nx; }
        const unsigned old = xb_add(&bar[XB_XSUB(b.x)], 1u);
        const unsigned gen = old / nloc;
        if (old + 1u == (gen + 1u) * nloc) {
            __builtin_amdgcn_fence(__ATOMIC_RELEASE, "agent");
            asm volatile("s_waitcnt vmcnt(0)" ::: "memory");
            const unsigned og = xb_add(&bar[XB_TOP], 1u);
            const unsigned tg = og / nx;
            if (og + 1u == (tg + 1u) * nx) xb_add(&bar[XB_TOPGEN], 1u);
            else XB_SPIN(xb_ld(&bar[XB_TOPGEN]) == tg, bar);
            __builtin_amdgcn_fence(__ATOMIC_ACQUIRE, "agent");
            xb_add(&bar[XB_XGEN(b.x)], 1u);
            asm volatile("s_waitcnt vmcnt(0)" ::: "memory");
        } else {
            XB_SPIN(xb_ld(&bar[XB_XGEN(b.x)]) == gen, bar);
            __builtin_amdgcn_fence(__ATOMIC_ACQUIRE, "agent");
            asm volatile("s_waitcnt vmcnt(0)" ::: "memory");
        }
    }
    __syncthreads();
}

struct Args { const float* in[18]; float* out; unsigned char* ws; int ph_lo, ph_hi; };
struct Ctx {
    const float *x_in, *norm1_w, *w_in, *ret_gn_w, *qk_norm_w, *cmp_pos, *cmp_w1, *cmp_w2, *w_o_ret, *w_o_nsa, *w_out, *norm2_w, *router_w, *router_b, *w_gate_up, *b_gate_up, *w_down, *b_down;
    float* out; unsigned char* ws; LAS unsigned char* lds;
    int tid, lane, wave, gw, G;
};
#define WSP(T, off) ((T*)(c.ws + (off)))

namespace g8 {
constexpr int BM = 256, BK = 64, HALF = 128, HTB = HALF * BK * 2, STAGE_BYTES = 8 * HTB, NXCD = 8, WGM = 8;
__device__ __forceinline__ int lds_byte(int r, int c) { const int st = (r >> 4) * 2 + (c >> 5), rr = r & 15, cc = c & 31, ob = rr * 64 + cc * 2; return st * 1024 + (ob ^ (((ob >> 9) & 1) << 5)); }
__device__ __forceinline__ void stage_rc(int b, int& R, int& C) { const int st = b / 1024, sb = b % 1024, swz = sb ^ (((sb >> 9) & 1) << 5); R = (st >> 1) * 16 + swz / 64; C = (st & 1) * 32 + (swz % 64) / 2; }
__device__ __forceinline__ int perm32(int rho) { const int n = rho >> 4, i = rho & 15; return 8 * (i >> 2) + 4 * n + (i & 3); }

struct Unit { const char* A; const char* B; int pm, pn, e; };

struct SchedPlain {
    static constexpr bool GATHER = false;
    const char* A; const char* B; size_t tA, tB; int nM, nN, nwg, G, c;
    __device__ __forceinline__ bool next(int i, Unit& u) const {
        const long L = (long)i * G + c; if (L >= nwg) return false;
        int wgid = (int)L; { const int q = nwg / NXCD, r = nwg % NXCD, xcd = wgid % NXCD, off = wgid / NXCD; wgid = (xcd < r ? xcd * (q + 1) : r * (q + 1) + (xcd - r) * q) + off; }
        const int nig = WGM * nN, gid = wgid / nig, fm = gid * WGM, gsz = (nM - fm) < WGM ? (nM - fm) : WGM;
        u.pm = fm + ((wgid % nig) % gsz); u.pn = (wgid % nig) / gsz; u.e = 0;
        u.A = A + (size_t)u.pm * tA; u.B = B + (size_t)u.pn * tB; return true;
    }
};
struct SchedCmp {         static constexpr bool GATHER = false;
    const char* KCT; const char* VCT; const char* W; int G, c;
    __device__ __forceinline__ bool next(int i, Unit& u) const {
        const int idx = i * G + c; if (idx >= 256) return false;
        const int ksl = idx & 7, r = idx >> 3, kv = r >> 4, bg = (r >> 1) & 7, half = r & 1;
        u.A = (kv ? VCT : KCT) + ((size_t)bg * SEQ * 64 + (size_t)half * 256 * 1024 + (size_t)ksl * 256) * 2;
        u.B = W + ((size_t)kv * 256 * 2048 + (size_t)ksl * 256) * 2; u.pm = (kv * 8 + bg) * 2 + half; u.pn = 0; u.e = ksl; return true;
    }
};
struct SchedMoe {
    static constexpr bool GATHER = false;
    const char* A; const char* W; const LAS int* tab; int NT; size_t wstride;
    __device__ __forceinline__ bool next(int i, Unit& u) const {
        const int v = __builtin_amdgcn_readfirstlane(tab[i]); if (v < 0) return false;
        const int rb = v & 0xfff, pn = (v >> 12) & 0xf, e = v >> 16;
        u.A = A + (size_t)rb * 256 * 1024 * 2; u.B = W + (size_t)e * wstride + (size_t)pn * 256 * 1024 * 2; u.pm = rb; u.pn = pn; u.e = e; return true;
    }
};
struct SchedMoeG {
    static constexpr bool GATHER = true;
    const char* A; const char* W; const LAS int* tab; int NT; size_t wstride; const int* rowtok;
    __device__ __forceinline__ bool next(int i, Unit& u) const {
        const int v = __builtin_amdgcn_readfirstlane(tab[i]); if (v < 0) return false;
        const int rb = v & 0xfff, pn = (v >> 12) & 0xf, e = v >> 16;
        u.A = A; u.B = W + (size_t)e * wstride + (size_t)pn * 256 * 1024 * 2; u.pm = rb; u.pn = pn; u.e = e; return true;
    }
};
__device__ __forceinline__ void moe_units(LAS int* tab, const int* meta, const int NT, const int G, const int c, const int tid) {
    if (tid < 256) {
        int v = -1; const int i = tid;
        if ((G & 7) == 0) { const int x = c & 7, q = i * (G >> 3) + (c >> 3); const int nb = meta[16 + x];
            if (q < nb * NT) { const int rbi = q / NT, pn = q - rbi * NT, rb = meta[1024 + 640 * x + rbi]; v = rb | (pn << 12) | (meta[64 + rb] << 16); } }
        else { const int idx = i * G + c; const int nblk = meta[0]; if (idx < nblk * NT) { const int rb = idx / NT, pn = idx - rb * NT; v = rb | (pn << 12) | (meta[64 + rb] << 16); } }
        tab[i] = v;
    }
    __syncthreads();
}

typedef f32x4 Acc[2][2][4][2];

struct EpiBf16 {
    struct Pre {}; __device__ __forceinline__ void pre(Pre&, const Unit&, int, int, int, int) const {}
    static constexpr bool PERM = true;
    bf16_t* O; int ldc;
    __device__ __forceinline__ void operator()(const Acc& acc, const Unit& u, int wr, int wc, int fr, int fq, const Pre&) const {
        const int row0 = u.pm * BM + wr * 64 + fr, col0 = u.pn * BM + wc * 32 + 8 * fq;
#pragma unroll
        for (int ai = 0; ai < 2; ++ai)
#pragma unroll
            for (int m = 0; m < 4; ++m) { bf16_t* rowp = O + (size_t)(row0 + ai * HALF + m * 16) * ldc + col0;
#pragma unroll
                for (int bj = 0; bj < 2; ++bj) { const f32x4 v0 = acc[ai][bj][m][0], v1 = acc[ai][bj][m][1];
                    u32x4 w; w.x = pk2(v0[0], v0[1]); w.y = pk2(v0[2], v0[3]); w.z = pk2(v1[0], v1[1]); w.w = pk2(v1[2], v1[3]);
                    *(u32x4*)(rowp + bj * HALF) = w; } }
    }
};
struct EpiSlab {
    struct Pre {}; __device__ __forceinline__ void pre(Pre&, const Unit&, int, int, int, int) const {}
    static constexpr bool PERM = false;
    float* O;
    __device__ __forceinline__ void operator()(const Acc& acc, const Unit& u, int wr, int wc, int fr, int fq, const Pre&) const {
        const int row0 = u.pm * BM + wr * 64 + fr, col0 = wc * 32 + 4 * fq;
        float* base = O + (size_t)u.e * 8192 * 256;
#pragma unroll
        for (int ai = 0; ai < 2; ++ai)
#pragma unroll
            for (int m = 0; m < 4; ++m) { const size_t off = (size_t)(row0 + ai * HALF + m * 16) * 256 + col0;
#pragma unroll
                for (int bj = 0; bj < 2; ++bj)
#pragma unroll
                    for (int n = 0; n < 2; ++n) *(f32x4*)(base + off + bj * HALF + n * 16) = acc[ai][bj][m][n]; }
    }
};
struct EpiGate {
    struct Pre {}; __device__ __forceinline__ void pre(Pre&, const Unit&, int, int, int, int) const {}
    static constexpr bool PERM = true;
    bf16_t* O; const bf16_t* proj; int second;
    __device__ __forceinline__ void operator()(const Acc& acc, const Unit& u, int wr, int wc, int fr, int fq, const Pre&) const {
        const int row0 = u.pm * BM + wr * 64 + fr, col0 = u.pn * BM + wc * 32 + 8 * fq;
#pragma unroll
        for (int ai = 0; ai < 2; ++ai)
#pragma unroll
            for (int m = 0; m < 4; ++m) { const size_t row = (size_t)(row0 + ai * HALF + m * 16); const bf16_t* rp = proj + row * NPROJ + C_MG + (second ? 1024 : 0) + col0;
#pragma unroll
                for (int bj = 0; bj < 2; ++bj) { const u32x4 wb = *(const u32x4*)(rp + bj * HALF); u32x4 prev = {0u, 0u, 0u, 0u};
                    if (second) prev = *(const u32x4*)(O + row * D + col0 + bj * HALF);
                    float o[8];
#pragma unroll
                    for (int j = 0; j < 8; ++j) { const unsigned ub = wb[j >> 1], up = prev[j >> 1]; const float b = (j & 1) ? bfhi(ub) : bflo(ub), pv = (j & 1) ? bfhi(up) : bflo(up);
                        o[j] = pv + (j < 4 ? acc[ai][bj][m][0][j] : acc[ai][bj][m][1][j - 4]) * sigmoidf_(b); }
                    u32x4 w; w.x = pk2(o[0], o[1]); w.y = pk2(o[2], o[3]); w.z = pk2(o[4], o[5]); w.w = pk2(o[6], o[7]);
                    *(u32x4*)(O + row * D + col0 + bj * HALF) = w; } }
    }
};
struct EpiSwiglu {
    static constexpr bool PERM = true;
    bf16_t* O; const float* bgu;
    const float* rsrow;
    LAS unsigned char* rsl;
    struct Pre {};
    __device__ __forceinline__ void pre(Pre&, const Unit& u, int wc, int fq, int wid, int lane) const {
        LAS unsigned char* my = rsl + wid * 768;
        const float* rp = rsrow + u.pm * BM + (wid >> 2) * 64 + lane;
        __builtin_amdgcn_global_load_lds((const unsigned*)rp, (LAS unsigned*)my, 4, 0, 0);
        __builtin_amdgcn_global_load_lds((const unsigned*)(rp + HALF), (LAS unsigned*)(my + 256), 4, 0, 0);
        const float* bp = bgu + (size_t)u.e * 2048 + u.pn * 128 + wc * 32 + (lane & 31) + (lane >> 5) * 1024;
        __builtin_amdgcn_global_load_lds((const unsigned*)bp, (LAS unsigned*)(my + 512), 4, 0, 0); }
    __device__ __forceinline__ void operator()(const Acc& acc, const Unit& u, int wr, int wc, int fr, int fq, const Pre&) const {
        const int row0 = u.pm * BM + wr * 64 + fr, col0 = u.pn * 128 + wc * 32 + 8 * fq;
        const LAS unsigned char* my = rsl + (wr * 4 + wc) * 768;
        const f32x4 g0 = *(const LAS f32x4*)(my + 512 + 32 * fq), g1 = *(const LAS f32x4*)(my + 512 + 32 * fq + 16), u0 = *(const LAS f32x4*)(my + 640 + 32 * fq), u1 = *(const LAS f32x4*)(my + 640 + 32 * fq + 16);
#pragma unroll
        for (int ai = 0; ai < 2; ++ai)
#pragma unroll
            for (int m = 0; m < 4; ++m) { float o[8]; const float rs = *(const LAS float*)(my + ai * 256 + (m * 16 + fr) * 4);
#pragma unroll
                for (int j = 0; j < 8; ++j) {
                    float gv = (j < 4 ? acc[ai][0][m][0][j] * rs + g0[j] : acc[ai][0][m][1][j - 4] * rs + g1[j - 4]);
                    float uv = (j < 4 ? acc[ai][1][m][0][j] * rs + u0[j] : acc[ai][1][m][1][j - 4] * rs + u1[j - 4]);
                    gv = fminf(gv, 7.0f); uv = fminf(fmaxf(uv, -7.0f), 7.0f);
                    const float glu = gv * frcp(1.0f + fexp2(-1.702f * 1.4426950408889634f * gv)); o[j] = (uv + 1.0f) * glu; }
                u32x4 w; w.x = pk2(o[0], o[1]); w.y = pk2(o[2], o[3]); w.z = pk2(o[4], o[5]); w.w = pk2(o[6], o[7]);
                *(u32x4*)(O + (size_t)(row0 + ai * HALF + m * 16) * D + col0) = w; }
    }
};
struct EpiDown {
    static constexpr bool PERM = true;
    bf16_t* O; const float* bd;
    struct Pre { f32x4 b[2][2]; };
    __device__ __forceinline__ void pre(Pre& p, const Unit& u, int wc, int fq, int wid, int lane) const { const float* bp = bd + (size_t)u.e * D + u.pn * BM + wc * 32 + 8 * fq;
#pragma unroll
        for (int bj = 0; bj < 2; ++bj) { p.b[bj][0] = *(const f32x4*)(bp + bj * HALF); p.b[bj][1] = *(const f32x4*)(bp + bj * HALF + 4); } }
    __device__ __forceinline__ void operator()(const Acc& acc, const Unit& u, int wr, int wc, int fr, int fq, const Pre& p) const {
        const int row0 = u.pm * BM + wr * 64 + fr, col0 = u.pn * BM + wc * 32 + 8 * fq;
#pragma unroll
        for (int bj = 0; bj < 2; ++bj) { const f32x4 b0 = p.b[bj][0], b1 = p.b[bj][1];
#pragma unroll
            for (int ai = 0; ai < 2; ++ai)
#pragma unroll
                for (int m = 0; m < 4; ++m) { const f32x4 v0 = acc[ai][bj][m][0] + b0, v1 = acc[ai][bj][m][1] + b1;
                    u32x4 w; w.x = pk2(v0[0], v0[1]); w.y = pk2(v0[2], v0[3]); w.z = pk2(v1[0], v1[1]); w.w = pk2(v1[2], v1[3]);
                    *(u32x4*)(O + (size_t)(row0 + ai * HALF + m * 16) * D + col0 + bj * HALF) = w; } }
    }
};

template <class Epi, class Sched>
__device__ __forceinline__ void gemm_phase(LAS unsigned char* lds, const int tid, const int K, const unsigned lda, const unsigned ldb, const Sched& S, const Epi& E) {
    const int wid = __builtin_amdgcn_readfirstlane(tid >> 6), lane = tid & 63, wr = wid >> 2, wc = wid & 3, fr = lane & 15, fq = lane >> 4;
    const int nt = K / BK;
    unsigned voffA[2], voffB[2]; int Rs[2];
#pragma unroll
    for (int i = 0; i < 2; ++i) { int R, C; stage_rc(tid * 16 + i * 8192, R, C); const int Rb = Epi::PERM ? ((R & ~31) + perm32(R & 31)) : R; Rs[i] = R;
        voffA[i] = Sched::GATHER ? (unsigned)C * 2u : (unsigned)R * lda + (unsigned)C * 2u; voffB[i] = (unsigned)Rb * ldb + (unsigned)C * 2u; }
    unsigned offc[2][2] = {{0u, 0u}, {0u, 0u}}, offn[2][2] = {{0u, 0u}, {0u, 0u}};
    const size_t kstep = (size_t)(BK * 2);
    const size_t hstepA = (size_t)HALF * lda, hstepB = (size_t)HALF * ldb;
    const unsigned ldsw = (unsigned)wid * 1024u;
    const int aoff = lds_byte(wr * 64 + fr, fq * 8), boff = lds_byte(wc * 32 + fr, fq * 8);
#define G8_SA(b, h) (((b) * 2 + (h)) * HTB)
#define G8_SB(b, h) ((4 + (b) * 2 + (h)) * HTB)
#define G8_STAGE(bufoff, gbase, voff) do { _Pragma("unroll") for (int _i = 0; _i < 2; ++_i) \
        __builtin_amdgcn_global_load_lds((const unsigned*)((const char*)(gbase) + (voff)[_i]), (LAS unsigned*)(lds + (bufoff) + ldsw + _i * 8192), 16, 0, 0); } while (0)
#define G8_STAGEA(bufoff, kt, h, nx) do { _Pragma("unroll") for (int _i = 0; _i < 2; ++_i) { \
        const char* _g = Sched::GATHER ? (cA + (size_t)(kt) * kstep + ((nx) ? offn[h][_i] : offc[h][_i]) + voffA[_i]) : (((nx) ? nA : cA) + (size_t)(kt) * kstep + (size_t)(h) * hstepA + voffA[_i]); \
        __builtin_amdgcn_global_load_lds((const unsigned*)_g, (LAS unsigned*)(lds + (bufoff) + ldsw + _i * 8192), 16, 0, 0); } } while (0)
#define G8_LOADOFF(dst, un) do { if constexpr (Sched::GATHER) { _Pragma("unroll") for (int _h = 0; _h < 2; ++_h) _Pragma("unroll") for (int _i = 0; _i < 2; ++_i) \
        dst[_h][_i] = (unsigned)S.rowtok[(un).pm * 256 + _h * 128 + Rs[_i]] * (unsigned)(D * 2); } } while (0)
#define G8_LDA(dst, b, h) do { _Pragma("unroll") for (int m = 0; m < 4; ++m) _Pragma("unroll") for (int k = 0; k < 2; ++k) dst[m][k] = *(const LAS bf16x8*)(lds + G8_SA(b, h) + aoff + m * 2048 + k * 1024); } while (0)
#define G8_LDB(dst, b, h) do { _Pragma("unroll") for (int n = 0; n < 2; ++n) _Pragma("unroll") for (int k = 0; k < 2; ++k) dst[n][k] = *(const LAS bf16x8*)(lds + G8_SB(b, h) + boff + n * 2048 + k * 1024); } while (0)
#define G8_MMA(ai, bj, At, Bt) do { __builtin_amdgcn_s_setprio(1); _Pragma("unroll") for (int m = 0; m < 4; ++m) _Pragma("unroll") for (int n = 0; n < 2; ++n) _Pragma("unroll") for (int k = 0; k < 2; ++k) \
        acc[ai][bj][m][n] = __builtin_amdgcn_mfma_f32_16x16x32_bf16(Bt[n][k], At[m][k], acc[ai][bj][m][n], 0, 0, 0); __builtin_amdgcn_s_setprio(0); } while (0)
#define G8_WAIT_V(n) asm volatile("s_waitcnt vmcnt(" #n ")" ::: "memory")
#define G8_WAIT_L(n) asm volatile("s_waitcnt lgkmcnt(" #n ")" ::: "memory")
#define G8_BAR __builtin_amdgcn_s_barrier()
#define G8_SCHED __builtin_amdgcn_sched_barrier(0)
    Unit cur, nxt; int ui = 0;
    if (!S.next(0, cur)) return;
    Acc acc;
#pragma unroll
    for (int a = 0; a < 2; ++a)
#pragma unroll
        for (int b = 0; b < 2; ++b)
#pragma unroll
            for (int m = 0; m < 4; ++m)
#pragma unroll
                for (int n = 0; n < 2; ++n) acc[a][b][m][n] = (f32x4){0.f, 0.f, 0.f, 0.f};
    bf16x8 At[4][2], B0[2][2], B1[2][2];
    const char* cA = cur.A; const char* cB = cur.B; const char* nA = cA;
    typename Epi::Pre epre; E.pre(epre, cur, wc, fq, wid, lane);
    G8_LOADOFF(offc, cur);
    if constexpr (Sched::GATHER) asm volatile("s_waitcnt vmcnt(0)" ::: "memory");
    G8_STAGE(G8_SB(0, 0), cB, voffB); G8_STAGEA(G8_SA(0, 0), 0, 0, false); G8_STAGE(G8_SB(0, 1), cB + hstepB, voffB); G8_STAGEA(G8_SA(0, 1), 0, 1, false);
    if (wr == 1) G8_BAR;
    G8_WAIT_V(4); G8_BAR;
    G8_STAGE(G8_SB(1, 0), cB + kstep, voffB); G8_STAGEA(G8_SA(1, 0), 1, 0, false); G8_STAGE(G8_SB(1, 1), cB + hstepB + kstep, voffB);
    G8_WAIT_V(6); G8_BAR;
    for (;;) {
        const bool has_next = S.next(ui + 1, nxt);
        nA = has_next ? nxt.A : cA; const char* nB = has_next ? nxt.B : cB;
        if (has_next) G8_LOADOFF(offn, nxt);
        else { _Pragma("unroll") for (int _h = 0; _h < 2; ++_h) _Pragma("unroll") for (int _i = 0; _i < 2; ++_i) offn[_h][_i] = offc[_h][_i]; }
        for (int t = 0; t < nt; t += 2) {
            const bool last = (t == nt - 2);
            const char* b2 = last ? nB : cB + (size_t)(t + 2) * kstep;
            const char* b3 = b2 + kstep;
            const int k2 = last ? 0 : t + 2, k3 = last ? 1 : t + 3;
            G8_LDB(B0, 0, 0); G8_SCHED; G8_LDA(At, 0, 0); G8_STAGEA(G8_SA(1, 1), t + 1, 1, false);
            G8_WAIT_L(8); G8_BAR; G8_WAIT_L(0); G8_MMA(0, 0, At, B0); G8_BAR; G8_SCHED;
            G8_LDB(B1, 0, 1); G8_STAGE(G8_SB(0, 0), b2, voffB);
            G8_BAR; G8_WAIT_L(0); G8_MMA(0, 1, At, B1); G8_BAR;
            G8_LDA(At, 0, 1); G8_STAGEA(G8_SA(0, 0), k2, 0, last);
            G8_BAR; G8_WAIT_L(0); G8_MMA(1, 0, At, B0); G8_BAR; G8_SCHED;
            G8_STAGE(G8_SB(0, 1), b2 + hstepB, voffB);
            G8_WAIT_V(6); G8_BAR; G8_MMA(1, 1, At, B1); G8_BAR;
            G8_LDB(B0, 1, 0); G8_SCHED; G8_LDA(At, 1, 0); G8_STAGEA(G8_SA(0, 1), k2, 1, last);
            G8_WAIT_L(8); G8_BAR; G8_WAIT_L(0); G8_MMA(0, 0, At, B0); G8_BAR; G8_SCHED;
            G8_LDB(B1, 1, 1); G8_STAGE(G8_SB(1, 0), b3, voffB);
            G8_BAR; G8_WAIT_L(0); G8_MMA(0, 1, At, B1); G8_BAR;
            G8_LDA(At, 1, 1); G8_STAGEA(G8_SA(1, 0), k3, 0, last);
            G8_BAR; G8_WAIT_L(0); G8_MMA(1, 0, At, B0); G8_BAR; G8_SCHED;
            G8_STAGE(G8_SB(1, 1), b3 + hstepB, voffB);
            G8_WAIT_V(6); G8_BAR; G8_MMA(1, 1, At, B1); G8_BAR;
        }
        MFMA_FENCE();
        E(acc, cur, wr, wc, fr, fq, epre);
        if (!has_next) break;
#pragma unroll
        for (int a = 0; a < 2; ++a)
#pragma unroll
            for (int b = 0; b < 2; ++b)
#pragma unroll
                for (int m = 0; m < 4; ++m)
#pragma unroll
                    for (int n = 0; n < 2; ++n) acc[a][b][m][n] = (f32x4){0.f, 0.f, 0.f, 0.f};
        cur = nxt; cA = nA; cB = nB; ++ui;
        { _Pragma("unroll") for (int _h = 0; _h < 2; ++_h) _Pragma("unroll") for (int _i = 0; _i < 2; ++_i) offc[_h][_i] = offn[_h][_i]; }
        E.pre(epre, cur, wc, fq, wid, lane);
    }
    G8_WAIT_V(0);
    if (wr == 0) G8_BAR;
    G8_BAR;
#undef G8_SA
#undef G8_SB
#undef G8_STAGE
#undef G8_LDA
#undef G8_STAGEA
#undef G8_LOADOFF
#undef G8_LDB
#undef G8_MMA
#undef G8_WAIT_V
#undef G8_WAIT_L
#undef G8_BAR
#undef G8_SCHED
}
}

__device__ __forceinline__ void conv_item(const float* __restrict__ src, int ldS, int col4  , int k0, bf16_t* __restrict__ dst  , int K, int kq, const float* __restrict__ ksc = nullptr  ) {
    f32x4 v[16];
#pragma unroll
    for (int j = 0; j < 16; ++j) v[j] = col4 >= 0 ? *(const f32x4*)(src + (size_t)(k0 + kq * 16 + j) * ldS + col4) : (f32x4){0.f, 0.f, 0.f, 0.f};
    if (ksc) {
#pragma unroll
        for (int j = 0; j < 16; ++j) v[j] *= ksc[k0 + kq * 16 + j];
    }
#pragma unroll
    for (int r = 0; r < 4; ++r) {
        u32x4 w0, w1;
#pragma unroll
        for (int j = 0; j < 4; ++j) { w0[j] = pk2(v[2 * j][r], v[2 * j + 1][r]); w1[j] = pk2(v[8 + 2 * j][r], v[8 + 2 * j + 1][r]); }
        bf16_t* d = dst + (size_t)r * K + kq * 16;
        *(u32x4*)d = w0; *(u32x4*)(d + 8) = w1;
    }
}
__device__ __forceinline__ void rms_row_to_h(const float* __restrict__ xr, const float* __restrict__ nw, bf16_t* __restrict__ hr, int lane) {
    f32x4 v[4]; float ss = 0.f;
#pragma unroll
    for (int i = 0; i < 4; ++i) { v[i] = *(const f32x4*)(xr + i * 256 + lane * 4); ss += v[i][0] * v[i][0] + v[i][1] * v[i][1] + v[i][2] * v[i][2] + v[i][3] * v[i][3]; }
    ss = wave_sum(ss);
    const float rs = rsqrtf(ss * (1.0f / 1024.0f) + NORM_EPS);
#pragma unroll
    for (int i = 0; i < 4; ++i) { const f32x4 w = *(const f32x4*)(nw + i * 256 + lane * 4);
        u32x2 o; o.x = pk2(v[i][0] * rs * w[0], v[i][1] * rs * w[1]); o.y = pk2(v[i][2] * rs * w[2], v[i][3] * rs * w[3]);
        *(u32x2*)(hr + i * 256 + lane * 4) = o; }
}
constexpr int CONV_ITEMS = 112 * 16 + 16 * 32 + 16 * 16 + 2 * 4 * 32 + 32 * 32 * 16 + 32 * 16 * 16;
__device__ __forceinline__ void conv_one(const Ctx& c, const int l, const int it) {
    const int lane = c.lane;
    constexpr int I_IN = 112 * 16, I_O = 16 * 32, I_OUT = 16 * 16, I_C1 = 2 * 4 * 32, I_GU = 32 * 32 * 16;
    constexpr int E1 = I_IN, E2 = E1 + I_O, E3 = E2 + I_OUT, E4 = E3 + I_C1, E5 = E4 + I_GU;
    const int n4 = (lane & 15) * 4, kq = lane >> 4;
    if (it < E1) { const int nb = it / 16, kb = it % 16; const int n = nb * 64 + n4;
        const int col = n < 4912 ? n : (n < 5120 ? -1 : n - 208);
        conv_item(c.w_in + (size_t)l * D * IN_TOTAL, IN_TOTAL, col, kb * 64, WSP(bf16_t, WS_WIN) + ((size_t)l * NPROJ + n) * D + kb * 64, D, kq);
    } else if (it < E2) { const int r = it - E1, nb = r / 32, kb = r % 32; const int n = nb * 64 + n4;
        const float* src = (kb < 16 ? c.w_o_ret : c.w_o_nsa) + (size_t)l * D * D;
        conv_item(src, D, n, (kb & 15) * 64, WSP(bf16_t, WS_WO) + ((size_t)l * D + n) * 2048 + kb * 64, 2048, kq);
    } else if (it < E3) { const int r = it - E2, nb = r / 16, kb = r % 16; const int n = nb * 64 + n4;
        conv_item(c.w_out + (size_t)l * D * D, D, n, kb * 64, WSP(bf16_t, WS_WOUT) + ((size_t)l * D + n) * D + kb * 64, D, kq);
    } else if (it < E4) { const int j = it - E3, lk = l * 2 + j / 128, r = j % 128, nb = r / 32, kb = r % 32; const int n = nb * 64 + n4;
        conv_item(c.cmp_w1 + (size_t)lk * 2048 * 256, 256, n, kb * 64, WSP(bf16_t, WS_WC1) + ((size_t)lk * 256 + n) * 2048 + kb * 64, 2048, kq);
    } else if (it < E5) { const int j = it - E4, le = l * NEXP + j / 512, r = j % 512, nb = r / 16, kb = r % 16; const int n = nb * 64 + n4;
        const int pn = n >> 8, jj = n & 255; const int col = jj < 128 ? pn * 128 + jj : 1024 + pn * 128 + (jj - 128);
        conv_item(c.w_gate_up + (size_t)le * D * 2048, 2048, col, kb * 64, WSP(bf16_t, WS_WGU) + ((size_t)le * 2048 + n) * D + kb * 64, D, kq, c.norm2_w + (size_t)l * D);
    } else { const int j = it - E5, le = l * NEXP + j / 256, r = j % 256, nb = r / 16, kb = r % 16; const int n = nb * 64 + n4;
        conv_item(c.w_down + (size_t)le * D * D, D, n, kb * 64, WSP(bf16_t, WS_WD) + ((size_t)le * D + n) * D + kb * 64, D, kq);
    }
}
__device__ __forceinline__ bool conv_is_early(const int it) { return it < 112 * 16 || (it >= 112 * 16 + 16 * 32 + 16 * 16 && it < 112 * 16 + 16 * 32 + 16 * 16 + 2 * 4 * 32); }
__device__ __forceinline__ void conv_layer_early(const Ctx& c, const int l, const int widx, const int nw) {
    for (int it = widx; it < 112 * 16; it += nw) conv_one(c, l, it);
    for (int it = 112 * 16 + 16 * 32 + 16 * 16 + widx; it < 112 * 16 + 16 * 32 + 16 * 16 + 2 * 4 * 32; it += nw) conv_one(c, l, it);
}
__device__ __forceinline__ void phase_prologue(const Ctx& c) {
    const int lane = c.lane, gw = c.gw, NW = c.G * NWAVES;
    conv_layer_early(c, 0, gw, NW);
    const int gtid = blockIdx.x * NTHREADS + c.tid, NT = c.G * NTHREADS;
    for (int pos = gw; pos < SEQ; pos += NW) {
#pragma unroll
        for (int pass = 0; pass < 2; ++pass) {
            if (pass == 1 && lane >= 8) break;
            const int j = pass == 0 ? lane : 64 + lane;
            float inv; if (j < 64) inv = powf(10000.0f, -(float)(2 * j) / 128.0f); else inv = powf(500000.0f, -(float)(2 * (j - 64)) / 16.0f);
            const float ang = (float)pos * inv;
            double rev = (double)ang * 0.15915494309189535; rev -= floor(rev);
            const float rv = (float)rev; const float sn = __builtin_amdgcn_sinf(rv), cs = __builtin_amdgcn_cosf(rv);
            if (j < 64) { float* t = WSP(float, WS_ROPER) + ((size_t)pos * 64 + j) * 2; t[0] = cs; t[1] = sn; }
            else { float* t = WSP(float, WS_ROPEN) + ((size_t)pos * 8 + (j - 64)) * 2; t[0] = cs; t[1] = sn; }
        }
    }
    for (int u = blockIdx.x + c.wave * c.G; u < NL * 2 * 16 * 8; u += c.G * NWAVES) {
        const int kh = u & 7, lk = u >> 7, n = ((u >> 3) & 15) * 16 + (lane & 15), k0 = kh * 256 + (lane >> 4) * 64;
        const float* pe = c.cmp_pos + (size_t)lk * 2048 + k0; const float* w1 = c.cmp_w1 + ((size_t)lk * 2048 + k0) * 256 + n;
        float s0 = 0.f, s1 = 0.f, s2 = 0.f, s3 = 0.f;
#pragma unroll 4
        for (int k = 0; k < 64; k += 4) { s0 += pe[k] * w1[(size_t)k * 256]; s1 += pe[k + 1] * w1[(size_t)(k + 1) * 256]; s2 += pe[k + 2] * w1[(size_t)(k + 2) * 256]; s3 += pe[k + 3] * w1[(size_t)(k + 3) * 256]; }
        float s = (s0 + s1) + (s2 + s3);
        s += __shfl_xor(s, 16); s += __shfl_xor(s, 32);
        if (lane < 16) WSP(float, WS_PEB)[kh * (NL * 2 * 256) + lk * 256 + n] = s;
    }
    for (int i = gtid; i < NL * 32 * 2 * 64 * 8; i += NT) {
        const int j = i & 7, ln = (i >> 3) & 63, nt = (i >> 9) & 1, ks = (i >> 10) & 31, l = i >> 15;
        const int fr_ = ln & 15, fq_ = ln >> 4, k = 32 * ks + (j < 4 ? 4 * fq_ + j : 16 + 4 * fq_ + (j - 4)), e = 16 * nt + fr_;
        const float w = c.norm2_w[(size_t)l * D + k] * c.router_w[((size_t)l * D + k) * NEXP + e];
        const unsigned hi = f2bf(w); const float wl = w - __uint_as_float(hi << 16);
        bf16_t* dst = WSP(bf16_t, WS_RWF) + ((((size_t)l * 32 + ks) * 2 + nt) * 2) * 512 + ln * 8 + j;
        dst[0] = (bf16_t)hi; dst[512] = (bf16_t)f2bf(wl);
    }
    for (int tok = gw; tok < NTOK; tok += NW) rms_row_to_h(c.x_in + (size_t)tok * D, c.norm1_w, WSP(bf16_t, WS_H) + (size_t)tok * D, lane);
}

constexpr float SM_SCALE_L2 = 0.125f * 1.4426950408889634f;
__device__ __forceinline__ void phase_prep(const Ctx& c, int l) {
    const int lane = c.lane, gw = c.gw, NW = c.G * NWAVES;
    const bf16_t* proj = WSP(bf16_t, WS_PROJ);
    const float* ropeR = WSP(float, WS_ROPER); const float* ropeN = WSP(float, WS_ROPEN);
    const float* qkw = c.qk_norm_w + (size_t)l * 4 * 64;
    for (int tok = gw; tok < NTOK; tok += NW) {
        const int b = tok / SEQ, s = tok % SEQ; const bf16_t* pr = proj + (size_t)tok * NPROJ;
        const int job = lane >> 3, l8 = lane & 7, isk = job >> 2;
        const bf16_t* src1 = pr + (isk ? C_RK : C_RQ) + (job & 3) * 128 + 8 * l8;
        const u32x4 a_w1 = *(const u32x4*)src1, a_w2 = *(const u32x4*)(src1 + 64);
        f32x4 a_cs[4];
#pragma unroll
        for (int j = 0; j < 4; ++j) a_cs[j] = *(const f32x4*)(ropeR + ((size_t)s * 64 + 8 * l8) * 2 + 4 * j);
        const bf16_t* src2 = pr + C_NQ + (lane >> 2) * 64 + (lane & 3) * 16;
        const u32x4 b_w0 = *(const u32x4*)src2, b_w1 = *(const u32x4*)(src2 + 8);
        f32x4 rn[4];
#pragma unroll
        for (int j = 0; j < 4; ++j) rn[j] = *(const f32x4*)(ropeN + (size_t)s * 16 + 4 * j);
        u32x4 c_w0 = {0u, 0u, 0u, 0u}, c_w1 = {0u, 0u, 0u, 0u};
        if (lane < 16) { const int hh = lane >> 2, part = lane & 3; const bf16_t* src = pr + ((hh >> 1) ? C_KW : C_KS) + (hh & 1) * 64 + part * 16; c_w0 = *(const u32x4*)src; c_w1 = *(const u32x4*)(src + 8); }
        else if (lane < 48) { const int q = lane - 16, isv = q >> 4, r = q & 15; c_w0 = *(const u32x4*)(pr + (isv ? C_VC : C_KC) + (r >> 3) * 64 + (r & 7) * 8); }
        {
            const int h = job & 3;
            const u32x4 w1 = a_w1, w2 = a_w2;
            const float ksc = isk ? 0.08838834764831845f : 1.0f;
            u32x4 o1, o2;
#pragma unroll
            for (int j = 0; j < 4; ++j) { const f32x4 cs = a_cs[j];
                const float a1 = bflo(w1[j]), a2 = bflo(w2[j]), b1 = bfhi(w1[j]), b2 = bfhi(w2[j]);
                o1[j] = pk2((a1 * cs[0] - a2 * cs[1]) * ksc, (b1 * cs[2] - b2 * cs[3]) * ksc);
                o2[j] = pk2((a1 * cs[1] + a2 * cs[0]) * ksc, (b1 * cs[3] + b2 * cs[2]) * ksc); }
            bf16_t* dst = WSP(bf16_t, isk ? WS_KR : WS_QR) + ((size_t)(b * 4 + h) * SEQ + s) * 128 + 8 * l8;
            *(u32x4*)dst = o1; *(u32x4*)(dst + 64) = o2;
        }
        {
            const int head = lane >> 2, part = lane & 3;
            const u32x4 w0 = b_w0, w1 = b_w1; float v[16];
#pragma unroll
            for (int j = 0; j < 4; ++j) { v[2 * j] = bflo(w0[j]); v[2 * j + 1] = bfhi(w0[j]); v[8 + 2 * j] = bflo(w1[j]); v[8 + 2 * j + 1] = bfhi(w1[j]); }
            float ss = 0.f;
#pragma unroll
            for (int j = 0; j < 16; ++j) ss += v[j] * v[j];
            ss += __shfl_xor(ss, 1); ss += __shfl_xor(ss, 2);
            const float rs = rsqrtf(ss * (1.0f / 64.0f) + NORM_EPS);
#pragma unroll
            for (int j = 0; j < 16; ++j) v[j] = v[j] * (rs * SM_SCALE_L2) * qkw[0 * 64 + part * 16 + j];
            if (part == 0) {
#pragma unroll
                for (int i = 0; i < 8; ++i) { const float cc = rn[i >> 1][(i & 1) * 2], sc = rn[i >> 1][(i & 1) * 2 + 1]; const float x1 = v[i], x2 = v[i + 8]; v[i] = x1 * cc - x2 * sc; v[i + 8] = x1 * sc + x2 * cc; }
            }
            u32x4 o0, o1;
#pragma unroll
            for (int j = 0; j < 4; ++j) { o0[j] = pk2(v[2 * j], v[2 * j + 1]); o1[j] = pk2(v[8 + 2 * j], v[8 + 2 * j + 1]); }
            bf16_t* dst = WSP(bf16_t, WS_QN) + ((size_t)tok * 16 + head) * 64 + part * 16;
            *(u32x4*)dst = o0; *(u32x4*)(dst + 8) = o1;
        }
        if (lane < 16) {
            const int hh = lane >> 2, part = lane & 3, isw = hh >> 1, g = hh & 1;
            const u32x4 w0 = c_w0, w1 = c_w1; float v[16];
#pragma unroll
            for (int j = 0; j < 4; ++j) { v[2 * j] = bflo(w0[j]); v[2 * j + 1] = bfhi(w0[j]); v[8 + 2 * j] = bflo(w1[j]); v[8 + 2 * j + 1] = bfhi(w1[j]); }
            float ss = 0.f;
#pragma unroll
            for (int j = 0; j < 16; ++j) ss += v[j] * v[j];
            ss += __shfl_xor(ss, 1); ss += __shfl_xor(ss, 2);
            const float rs = rsqrtf(ss * (1.0f / 64.0f) + NORM_EPS);
            const float* w = qkw + (isw ? 3 : 2) * 64 + part * 16;
#pragma unroll
            for (int j = 0; j < 16; ++j) v[j] = v[j] * rs * w[j];
            if (part == 0) {
#pragma unroll
                for (int i = 0; i < 8; ++i) { const float cc = rn[i >> 1][(i & 1) * 2], sc = rn[i >> 1][(i & 1) * 2 + 1]; const float x1 = v[i], x2 = v[i + 8]; v[i] = x1 * cc - x2 * sc; v[i + 8] = x1 * sc + x2 * cc; }
            }
            u32x4 o0, o1;
#pragma unroll
            for (int j = 0; j < 4; ++j) { o0[j] = pk2(v[2 * j], v[2 * j + 1]); o1[j] = pk2(v[8 + 2 * j], v[8 + 2 * j + 1]); }
            bf16_t* dst = WSP(bf16_t, isw ? WS_KW : WS_KS) + ((((size_t)(b * 2 + g) * 128 + (s >> 6)) * 4 + ((s >> 4) & 3)) * 2 + (part >> 1)) * 512 + ((2 * (part & 1)) * 16 + (s & 15)) * 8;
            *(u32x4*)dst = o0; *(u32x4*)(dst + 128) = o1;
        } else if (lane < 48) {
            const int q = lane - 16, isv = q >> 4, r = q & 15, g = r >> 3, part = r & 7;
            const u32x4 w = c_w0;
            *(u32x4*)(WSP(bf16_t, isv ? WS_VCT : WS_KCT) + ((size_t)(b * 2 + g) * SEQ + s) * 64 + part * 8) = w;
        }
    }
    const float lgam[4] = {log2f(1.0f - 1.0f / 32.0f), log2f(1.0f - 1.0f / 64.0f), log2f(1.0f - 1.0f / 128.0f), log2f(1.0f - 1.0f / 256.0f)};
    LAS bf16_t* tile = (LAS bf16_t*)(c.lds + c.wave * 8192);
    for (int grp = gw; grp < NTOK / 8; grp += NW) {
        const int tok0 = grp * 8, b = tok0 / SEQ, s0 = tok0 % SEQ; const bf16_t* pr = proj + (size_t)tok0 * NPROJ;
#define PREP_LOAD_TILE(col0) do { _Pragma("unroll") for (int _t = 0; _t < 8; ++_t) { const u32x4 _w = *(const u32x4*)(pr + (size_t)_t * NPROJ + (col0) + lane * 8); *(LAS u32x4*)(tile + _t * 512 + lane * 8) = _w; } } while (0)
#define PREP_COL8(cc, w) do { unsigned short _v[8]; _Pragma("unroll") for (int _t = 0; _t < 8; ++_t) _v[_t] = tile[_t * 512 + (cc)]; \
        (w).x = _v[0] | ((unsigned)_v[1] << 16); (w).y = _v[2] | ((unsigned)_v[3] << 16); (w).z = _v[4] | ((unsigned)_v[5] << 16); (w).w = _v[6] | ((unsigned)_v[7] << 16); } while (0)
        PREP_LOAD_TILE(C_RK);
        {
            float cs[8], sn[8], zz[8];
#pragma unroll
            for (int t = 0; t < 8; ++t) { const f32x2 tb = *(const f32x2*)(ropeR + ((size_t)(s0 + t) * 64 + lane) * 2); cs[t] = tb[0]; sn[t] = tb[1]; }
#pragma unroll
            for (int h = 0; h < 4; ++h) { float o1[8], o2[8];
#pragma unroll
                for (int t = 0; t < 8; ++t) { const float k1 = bf2f(tile[t * 512 + h * 128 + lane]), k2 = bf2f(tile[t * 512 + h * 128 + 64 + lane]);
                    const float z = fexp2(lgam[h] * (float)(127 - ((s0 + t) & 127))) * 0.08838834764831845f;
                    o1[t] = (k1 * cs[t] - k2 * sn[t]) * z; o2[t] = (k1 * sn[t] + k2 * cs[t]) * z; }
                u32x4 w1, w2;
#pragma unroll
                for (int j = 0; j < 4; ++j) { w1[j] = pk2(o1[2 * j], o1[2 * j + 1]); w2[j] = pk2(o2[2 * j], o2[2 * j + 1]); }
                { const int tk = s0 & 127, q = tk & 31, fqa = (q & 15) >> 2, jb = q >= 16 ? 4 : 0;
                  bf16_t* base = WSP(bf16_t, WS_KZT) + ((((size_t)(b * 4 + h) * 64 + (s0 >> 7)) * 8) * 4 + (tk >> 5)) * 512 + (fqa * 16 + (lane & 15)) * 8 + jb;
                  bf16_t* d1 = base + (size_t)(lane >> 4) * 2048, *d2 = base + (size_t)(4 + (lane >> 4)) * 2048;
                  u32x2 a; a.x = w1.x; a.y = w1.y; *(u32x2*)d1 = a; a.x = w1.z; a.y = w1.w; *(u32x2*)(d1 + 128) = a;
                  a.x = w2.x; a.y = w2.y; *(u32x2*)d2 = a; a.x = w2.z; a.y = w2.w; *(u32x2*)(d2 + 128) = a; } }
        }
#pragma unroll 1
        for (int hf = 0; hf < 2; ++hf) {
            PREP_LOAD_TILE(C_RV + hf * 512);
#pragma unroll
            for (int i = 0; i < 8; ++i) { const int cc = i * 64 + lane; u32x4 w; PREP_COL8(cc, w);
                { const int ch_ = hf * 512 + cc, hh = ch_ >> 8, dv = ch_ & 255, tk = s0 & 127, q = tk & 31, fqa = (q & 15) >> 2, jb = q >= 16 ? 4 : 0;
                  bf16_t* d = WSP(bf16_t, WS_VT) + (((((size_t)(b * 4 + hh) * 64 + (s0 >> 7)) * 4 + (tk >> 5)) * 16 + (dv >> 4)) * 64 + fqa * 16 + (dv & 15)) * 8 + jb;
                  u32x2 a; a.x = w.x; a.y = w.y; *(u32x2*)d = a; a.x = w.z; a.y = w.w; *(u32x2*)(d + 128) = a; } }
        }
        {
#pragma unroll
            for (int _t = 0; _t < 8; ++_t) { const int piece = lane >> 4, off = (lane & 15) * 8;
                if (lane < 32) { const u32x4 _w = *(const u32x4*)(pr + (size_t)_t * NPROJ + (piece ? C_VW : C_VS) + off); *(LAS u32x4*)(tile + _t * 512 + piece * 128 + off) = _w; } }
#pragma unroll
            for (int i = 0; i < 4; ++i) { const int isw = i >> 1, g = i & 1; u32x4 w; PREP_COL8(isw * 128 + g * 64 + lane, w);
                const int q = s0 & 31; bf16_t* dst = WSP(bf16_t, isw ? WS_VWT : WS_VST) + ((((size_t)(b * 2 + g) * 128 + (s0 >> 6)) * 2 + ((s0 >> 5) & 1)) * 4 + (lane >> 4)) * 512 + ((((q & 15) >> 2)) * 16 + (lane & 15)) * 8 + (q >= 16 ? 4 : 0);
                u32x2 w0, w1; w0.x = w.x; w0.y = w.y; w1.x = w.z; w1.y = w.w; *(u32x2*)dst = w0; *(u32x2*)(dst + 128) = w1; }
        }
#undef PREP_LOAD_TILE
#undef PREP_COL8
    }
}

__device__ __forceinline__ void phase_cmp2(const Ctx& c, int l) {
    const int lane = c.lane, gw = c.gw, NW = c.G * NWAVES;
    const float* ropeN = WSP(float, WS_ROPEN);
    for (int r0 = 0; r0 < 2 * 8 * 512; r0 += c.G * 32) {
        const int rowb = r0 + blockIdx.x * 32 + c.wave * 4; if (rowb >= 2 * 8 * 512) break;
        const int kv = rowb >> 12, bg = (rowb >> 9) & 7;
        const float* w2 = c.cmp_w2 + ((size_t)l * 2 + kv) * 256 * 64 + lane;
        LAS float* hl = (LAS float*)(c.lds + c.wave * 4096);
        { const float* sl = WSP(float, WS_ACT) + (size_t)rowb * 256 + lane * 4; f32x4 pb = *(const f32x4*)(WSP(float, WS_PEB) + (size_t)l * 512 + kv * 256 + lane * 4);
#pragma unroll
          for (int kh = 1; kh < 8; ++kh) pb += *(const f32x4*)(WSP(float, WS_PEB) + (size_t)kh * (NL * 2 * 256) + (size_t)l * 512 + kv * 256 + lane * 4);
#pragma unroll
          for (int rr = 0; rr < 4; ++rr) { f32x4 a = pb;
#pragma unroll
              for (int q = 0; q < 8; ++q) a += *(const f32x4*)(sl + (size_t)q * 8192 * 256 + rr * 256);
#pragma unroll
              for (int j = 0; j < 4; ++j) { const float x = a[j]; const float t = 0.7978845608028654f * (x + 0.044715f * x * x * x);
                  const float th = 1.0f - 2.0f * frcp(1.0f + fexp2(2.8853900817779268f * t)); a[j] = 0.5f * x * (1.0f + th); }
              *(LAS f32x4*)(hl + rr * 256 + lane * 4) = a; } }
        float acc4[4] = {0.f, 0.f, 0.f, 0.f};
#pragma unroll 1
        for (int k0 = 0; k0 < 256; k0 += 32) {
            float wv[32];
#pragma unroll
            for (int i = 0; i < 32; ++i) wv[i] = w2[(size_t)(k0 + i) * 64];
#pragma unroll
            for (int i = 0; i < 32; i += 2) {
#pragma unroll
                for (int rr = 0; rr < 4; ++rr) { const f32x2 hw = *(const LAS f32x2*)(hl + rr * 256 + k0 + i); acc4[rr] += hw[0] * wv[i] + hw[1] * wv[i + 1]; } }
        }
#pragma unroll
        for (int rr = 0; rr < 4; ++rr) {
            const int n = (rowb + rr) & 511; const float acc = acc4[rr];
            if (kv == 0) {
                const float ss = wave_sum(acc * acc); float v = acc * rsqrtf(ss * (1.0f / 64.0f) + NORM_EPS) * c.qk_norm_w[(size_t)l * 256 + 64 + lane];
                const float other = __shfl_xor(v, 8);
                int pos = 16 * n + 31; if (pos > SEQ - 1) pos = SEQ - 1;
                if (lane < 16) { const int i = lane & 7; const float cc = ropeN[((size_t)pos * 8 + i) * 2], sc = ropeN[((size_t)pos * 8 + i) * 2 + 1];
                    v = lane < 8 ? v * cc - other * sc : other * sc + v * cc; }
                WSP(bf16_t, WS_KCMP)[((((size_t)bg * 8 + (n >> 6)) * 4 + ((n >> 4) & 3)) * 2 + (lane >> 5)) * 512 + (((lane >> 3) & 3) * 16 + (n & 15)) * 8 + (lane & 7)] = (bf16_t)f2bf(v);
            } else {
                const int q = n & 31; WSP(bf16_t, WS_VCMPT)[((((size_t)bg * 8 + (n >> 6)) * 2 + ((n >> 5) & 1)) * 4 + (lane >> 4)) * 512 + (((q & 15) >> 2) * 16 + (lane & 15)) * 8 + (q >= 16 ? 4 : 0) + (q & 3)] = (bf16_t)(n < 511 ? f2bf(acc) : 0u);
            }
        }
    }
}

__device__ __forceinline__ void phase_scan(const Ctx& c) {
    const int lane = c.lane, w = c.wave, fr = lane & 15, fq = lane >> 4;
    for (int it0 = blockIdx.x; it0 < 256; it0 += c.G) {
        const int it = (c.G == 256) ? ((it0 & 7) * 32 + (it0 >> 3)) : it0;
        const int bh = it >> 4, dvs = it & 15, h = bh & 3;
        const float cdec = fexp2(log2f(1.0f - fexp2(-5.0f - (float)h)) * 128.0f);
        const bf16_t* kz = WSP(bf16_t, WS_KZT) + ((size_t)bh * 64 * 8 + w) * 2048 + lane * 8;
        const bf16_t* vt = WSP(bf16_t, WS_VT) + ((size_t)bh * 64 * 64 + dvs) * 512 + lane * 8;
        bf16_t* rt = WSP(bf16_t, WS_RT) + ((((size_t)bh * 64) * 16 + dvs) * 4 + (w >> 1)) * 512 + ((2 * (w & 1) + (fq >> 1)) * 16 + fr) * 8 + 4 * (fq & 1);
        f32x4 acc = {0.f, 0.f, 0.f, 0.f};
        bf16x8 kf[2][4];
        u32x2 st[64];
        const bf16_t* vt0 = WSP(bf16_t, WS_VT) + ((size_t)bh * 64 * 64 + dvs) * 512 + lane * 8;
#define SCAN_VBATCH(b) do { _Pragma("unroll") for (int _i = 0; _i < 8; ++_i) { const int _blk = w * 8 + _i; \
            __builtin_amdgcn_global_load_lds((const unsigned*)(vt0 + (size_t)(16 * (b) + (_blk >> 2)) * 32768 + (_blk & 3) * 8192), (LAS unsigned*)(c.lds + ((b) & 1) * 65536 + _blk * 1024), 16, 0, 0); } } while (0)
        SCAN_VBATCH(0);
#pragma unroll
        for (int u = 0; u < 2; ++u)
#pragma unroll
            for (int ks = 0; ks < 4; ++ks) kf[u][ks] = ld8(kz + (size_t)u * 16384 + ks * 512);
#pragma unroll
        for (int ch = 0; ch < 64; ++ch) {
            const int u = ch & 1;
            if ((ch & 15) == 0) { asm volatile("s_waitcnt vmcnt(0)" ::: "memory"); __builtin_amdgcn_s_barrier(); asm volatile("" ::: "memory");
                if (ch + 16 < 64) SCAN_VBATCH((ch >> 4) + 1); }
            st[ch].x = pk2(acc[0], acc[1]); st[ch].y = pk2(acc[2], acc[3]);
            acc *= cdec;
            const LAS unsigned char* vb = c.lds + ((ch >> 4) & 1) * 65536 + (ch & 15) * 4096 + lane * 16;
#pragma unroll
            for (int ks = 0; ks < 4; ++ks) acc = mfma16(kf[u][ks], *(const LAS bf16x8*)(vb + ks * 1024), acc);
            if (ch + 2 < 64) {
#pragma unroll
                for (int ks = 0; ks < 4; ++ks) kf[u][ks] = ld8(kz + (size_t)(ch + 2) * 16384 + ks * 512);
            }
        }
#undef SCAN_VBATCH
        MFMA_FENCE();
#pragma unroll
        for (int ch = 0; ch < 64; ++ch) *(u32x2*)(rt + (size_t)ch * 32768) = st[ch];
    }
}

#define SH_BAR() do { asm volatile("" ::: "memory"); __builtin_amdgcn_s_barrier(); asm volatile("" ::: "memory"); } while (0)
#define SH_WAIT_BAR() do { asm volatile("s_waitcnt vmcnt(0)" ::: "memory"); __builtin_amdgcn_s_barrier(); asm volatile("" ::: "memory"); } while (0)
__device__ __forceinline__ void phase_retout(const Ctx& c, int l) {
    const int lane = c.lane, wave = c.wave, fr = lane & 15, fq = lane >> 4;
    const bf16_t* proj = WSP(bf16_t, WS_PROJ);
    LAS unsigned char* lv = c.lds;
    LAS unsigned char* lr = c.lds + 65536;
    for (int u = blockIdx.x; u < 16 * 64; u += c.G) {
        const int qt = wave, ch = u & 63, bh = u >> 6, b = bh >> 2, h = bh & 3;
        const float lg = log2f(1.0f - fexp2(-5.0f - (float)h));
        const bf16_t* Q = WSP(bf16_t, WS_QR) + ((size_t)bh * SEQ + ch * 128) * 128;
        const bf16_t* Kp = WSP(bf16_t, WS_KR) + ((size_t)bh * SEQ + ch * 128) * 128;
        const bf16_t* VTp = WSP(bf16_t, WS_VT) + ((size_t)(bh * 64 + ch)) * 32768;
        const bf16_t* RTp = WSP(bf16_t, WS_RT) + ((size_t)(bh * 64 + ch)) * 32768;
        SH_BAR();
#pragma unroll
        for (int i = 0; i < 8; ++i) {
            __builtin_amdgcn_global_load_lds((const unsigned*)(VTp + (size_t)(wave * 8 + i) * 512 + lane * 8), (LAS unsigned*)(lv + (wave * 8 + i) * 1024), 16, 0, 0);
            __builtin_amdgcn_global_load_lds((const unsigned*)(RTp + (size_t)(wave * 8 + i) * 512 + lane * 8), (LAS unsigned*)(lr + (wave * 8 + i) * 1024), 16, 0, 0);
        }
        const int n = 16 * qt + fr;
        bf16x8 qf[4], qs[4];
        const float xi = fexp2(lg * (float)(n + 1));
#pragma unroll
        for (int ks = 0; ks < 4; ++ks) { const u32x4 w = *(const u32x4*)(Q + (size_t)n * 128 + 32 * ks + 8 * fq); qf[ks] = mk8(w);
            u32x4 s;
#pragma unroll
            for (int j = 0; j < 4; ++j) s[j] = pk2(bflo(w[j]) * xi, bfhi(w[j]) * xi);
            qs[ks] = mk8(s); }
        const size_t tok = (size_t)b * SEQ + ch * 128 + n;
        const bf16_t* gp = proj + tok * NPROJ + C_RG + h * 256 + 4 * fq; const float* gw_ = c.ret_gn_w + (size_t)l * 1024 + h * 256 + 4 * fq;
        u32x2 gv[16];
#pragma unroll
        for (int dt = 0; dt < 16; ++dt) gv[dt] = *(const u32x2*)(gp + 16 * dt);
        bf16x8 kk[8];
#pragma unroll
        for (int ks = 0; ks < 4; ++ks) { kk[ks] = ld8(Kp + (size_t)fr * 128 + 32 * ks + 8 * fq); kk[4 + ks] = ld8(Kp + (size_t)((qt >= 1 ? 16 : 0) + fr) * 128 + 32 * ks + 8 * fq); }
        f32x4 o[16];
#pragma unroll
        for (int dt = 0; dt < 16; ++dt) o[dt] = (f32x4){0.f, 0.f, 0.f, 0.f};
        SH_WAIT_BAR();
        for (int p = 0; p <= (qt >> 1); ++p) {
            f32x4 s0 = {0.f, 0.f, 0.f, 0.f}, s1 = {0.f, 0.f, 0.f, 0.f};
            const bool two = (2 * p + 1 <= qt);
#pragma unroll
            for (int ks = 0; ks < 4; ++ks) s0 = mfma16(kk[ks], qf[ks], s0);
#pragma unroll
            for (int ks = 0; ks < 4; ++ks) s1 = mfma16(kk[4 + ks], qf[ks], s1);
            MFMA_FENCE();
            if (p + 1 <= (qt >> 1)) {
                const bool two_n = (2 * (p + 1) + 1 <= qt);
#pragma unroll
                for (int ks = 0; ks < 4; ++ks) { kk[ks] = ld8(Kp + (size_t)(32 * (p + 1) + fr) * 128 + 32 * ks + 8 * fq); kk[4 + ks] = ld8(Kp + (size_t)(32 * (p + 1) + (two_n ? 16 : 0) + fr) * 128 + 32 * ks + 8 * fq); }
            }
#pragma unroll
            for (int r = 0; r < 4; ++r) { const int d0 = n - (32 * p + 4 * fq + r), d1 = d0 - 16;
                s0[r] = d0 >= 0 ? s0[r] * fexp2(lg * (float)d0) : 0.f; s1[r] = (two && d1 >= 0) ? s1[r] * fexp2(lg * (float)d1) : 0.f; }
            u32x4 pw; pw.x = pk2(s0[0], s0[1]); pw.y = pk2(s0[2], s0[3]); pw.z = pk2(s1[0], s1[1]); pw.w = pk2(s1[2], s1[3]);
            const bf16x8 pb = mk8(pw);
#pragma unroll
            for (int dt = 0; dt < 16; ++dt) o[dt] = mfma16(*(const LAS bf16x8*)(lv + (p * 16 + dt) * 1024 + lane * 16), pb, o[dt]);
            MFMA_FENCE();
        }
#pragma unroll
        for (int dt = 0; dt < 16; ++dt)
#pragma unroll
            for (int ks = 0; ks < 4; ++ks) o[dt] = mfma16(*(const LAS bf16x8*)(lr + (dt * 4 + ks) * 1024 + lane * 16), qs[ks], o[dt]);
        float s = 0.f;
#pragma unroll
        for (int dt = 0; dt < 16; ++dt) s += (o[dt][0] + o[dt][1]) + (o[dt][2] + o[dt][3]);
        s += __shfl_xor(s, 16); s += __shfl_xor(s, 32);
        const float mu = s * (1.0f / 256.0f); float q = 0.f;
#pragma unroll
        for (int dt = 0; dt < 16; ++dt)
#pragma unroll
            for (int r = 0; r < 4; ++r) { const float d = o[dt][r] - mu; q += d * d; }
        q += __shfl_xor(q, 16); q += __shfl_xor(q, 32);
        const float rstd = rsqrtf(q * (1.0f / 256.0f) + NORM_EPS);
        bf16_t* op = WSP(bf16_t, WS_RA) + tok * 2048 + h * 256 + 4 * fq;
#pragma unroll
        for (int dt = 0; dt < 16; ++dt) { const f32x4 wv = *(const f32x4*)(gw_ + 16 * dt);
            float g[4] = {bflo(gv[dt].x), bfhi(gv[dt].x), bflo(gv[dt].y), bfhi(gv[dt].y)}; float r_[4];
#pragma unroll
            for (int r = 0; r < 4; ++r) r_[r] = (o[dt][r] - mu) * rstd * wv[r] * g[r] * sigmoidf_(g[r]);
            u32x2 ov; ov.x = pk2(r_[0], r_[1]); ov.y = pk2(r_[2], r_[3]); *(u32x2*)(op + 16 * dt) = ov; }
    }
    SH_BAR();
}

__device__ __forceinline__ void attn_step_lds(const LAS unsigned char* slot, const bf16x8 (&qf)[2], const int key0, const int hiK, const int loK, const bool colok, const bool allok, const bool full,
                                              f32x4 (&O)[4], float& lsum, const int lane, const int fq) {
    bf16x8 kv[8];
#pragma unroll
    for (int i = 0; i < 8; ++i) kv[i] = *(const LAS bf16x8*)(slot + i * 1024 + lane * 16);
    f32x4 s[4];
    __builtin_amdgcn_s_setprio(1);
#pragma unroll
    for (int kt = 0; kt < 4; ++kt) { s[kt] = (f32x4){0.f, 0.f, 0.f, 0.f};
#pragma unroll
        for (int ks = 0; ks < 2; ++ks) s[kt] = mfma16(kv[kt * 2 + ks], qf[ks], s[kt]); }
    __builtin_amdgcn_s_setprio(0);
#pragma unroll
    for (int i = 0; i < 8; ++i) kv[i] = *(const LAS bf16x8*)(slot + 8192 + i * 1024 + lane * 16);
    float ps = 0.f;
    if (full) {
        if (allok) {
#pragma unroll
            for (int kt = 0; kt < 4; ++kt)
#pragma unroll
                for (int r = 0; r < 4; ++r) { const float p = fexp2(s[kt][r]); s[kt][r] = p; ps += p; }
        } else {
#pragma unroll
            for (int kt = 0; kt < 4; ++kt)
#pragma unroll
                for (int r = 0; r < 4; ++r) { const float p = colok ? fexp2(s[kt][r]) : 0.f; s[kt][r] = p; ps += p; }
        }
    } else {
#pragma unroll
        for (int kt = 0; kt < 4; ++kt)
#pragma unroll
            for (int r = 0; r < 4; ++r) { const int key = key0 + 16 * kt + 4 * fq + r; const bool ok = colok && (key <= hiK) && (key > loK);
                const float p = ok ? fexp2(s[kt][r]) : 0.f; s[kt][r] = p; ps += p; }
    }
    lsum += ps;
#pragma unroll
    for (int p2 = 0; p2 < 2; ++p2) {
        u32x4 pw; pw.x = pk2(s[2 * p2][0], s[2 * p2][1]); pw.y = pk2(s[2 * p2][2], s[2 * p2][3]); pw.z = pk2(s[2 * p2 + 1][0], s[2 * p2 + 1][1]); pw.w = pk2(s[2 * p2 + 1][2], s[2 * p2 + 1][3]);
        const bf16x8 pb = mk8(pw);
        __builtin_amdgcn_s_setprio(1);
#pragma unroll
        for (int dt = 0; dt < 4; ++dt) O[dt] = mfma16(kv[p2 * 4 + dt], pb, O[dt]);
        __builtin_amdgcn_s_setprio(0);
    }
    MFMA_FENCE();
}
__device__ __forceinline__ int sel_pop(unsigned long long& lo, unsigned long long& hi) {
    if (lo) { const int j = __builtin_ctzll(lo); lo &= lo - 1ull; return j; }
    if (hi) { const int j = 64 + __builtin_ctzll(hi); hi &= hi - 1ull; return j; }
    return -1;
}
#define SH_SLOT(s) (shb + (s) * 16384)
#define SH_ISSUE(kbase, vbase, blk, slot, withv) do { \
        __builtin_amdgcn_global_load_lds((const unsigned*)((kbase) + (size_t)(blk) * 4096 + (wave * 64 + lane) * 8), (LAS unsigned*)(SH_SLOT(slot) + wave * 1024), 16, 0, 0); \
        if (withv) __builtin_amdgcn_global_load_lds((const unsigned*)((vbase) + (size_t)(blk) * 4096 + (wave * 64 + lane) * 8), (LAS unsigned*)(SH_SLOT(slot) + 8192 + wave * 1024), 16, 0, 0); } while (0)
#define SH_READ_K(slot) do { _Pragma("unroll") for (int _i = 0; _i < 8; ++_i) kf[_i] = *(const LAS bf16x8*)(SH_SLOT(slot) + _i * 1024 + lane * 16); } while (0)
#define SH_READ_V(slot) do { _Pragma("unroll") for (int _i = 0; _i < 8; ++_i) vf[_i] = *(const LAS bf16x8*)(SH_SLOT(slot) + 8192 + _i * 1024 + lane * 16); } while (0)
__device__ __forceinline__ void phase_nsa(const Ctx& c, const int layer, const int lconv  , const bool late0  ) {
    const int lane = c.lane, wave = c.wave, fr = lane & 15, fq = lane >> 4;
    const bf16_t* proj = WSP(bf16_t, WS_PROJ);
    volatile LAS float* imp = (volatile LAS float*)(c.lds + 131072 + wave * 2304);
    LAS unsigned char* shb = c.lds;
    const int cntot = (lconv >= 0 ? CONV_ITEMS : 0) + (late0 ? CONV_ITEMS : 0), crounds = (cntot + c.G * NWAVES - 1) / (c.G * NWAVES);
    const int cntl = (2048 + c.G - 1) / c.G, crpt = (crounds + cntl - 1) / cntl;
    volatile LAS int* qs = (volatile LAS int*)(c.lds + LDS_CTL_OFF + 256);
#define NSA_QCTR (WSP(unsigned, WS_CTL + 16384) + layer * 64)
    if (c.tid == 0) { qs[0] = (int)__hip_atomic_fetch_add(NSA_QCTR, 1u, __ATOMIC_RELAXED, __HIP_MEMORY_SCOPE_AGENT); asm volatile("s_waitcnt lgkmcnt(0)" ::: "memory"); }
    int kk = 0;
    for (;; ++kk) {
        SH_BAR();
        const int U = __builtin_amdgcn_readfirstlane(qs[kk & 1]);
        if (U >= 2048) break;
        const int bg = U >> 8; const int tl = 255 - (U & 255);
        const int b = bg >> 1, g = bg & 1, T0 = 32 * tl, curW = T0 >> 6;
        int t0[2], tcol[2]; bf16x8 qf[2][2]; float g0[2], g1[2], g2[2]; size_t tokc[2];
        const int head = g * 8 + (fr & 7);
#pragma unroll
        for (int pr = 0; pr < 2; ++pr) {
            t0[pr] = T0 + 4 * wave + 2 * pr; tcol[pr] = t0[pr] + (fr >> 3); tokc[pr] = (size_t)b * SEQ + tcol[pr];
#pragma unroll
            for (int ks = 0; ks < 2; ++ks) qf[pr][ks] = ld8(WSP(bf16_t, WS_QN) + (tokc[pr] * 16 + head) * 64 + 32 * ks + 8 * fq);
            const bf16_t* gp = proj + tokc[pr] * NPROJ + C_NG + head * 3;
            g0[pr] = sigmoidf_(bf2f(gp[0])); g1[pr] = sigmoidf_(bf2f(gp[1])); g2[pr] = sigmoidf_(bf2f(gp[2]));
        }
        f32x4 out[2][4], O[2][4]; float lsum[2];
        bf16x8 kf[8];
#define NSA_ZERO_O() do { _Pragma("unroll") for (int _p = 0; _p < 2; ++_p) { lsum[_p] = 0.f; _Pragma("unroll") for (int _d = 0; _d < 4; ++_d) O[_p][_d] = (f32x4){0.f, 0.f, 0.f, 0.f}; } } while (0)
        int nbc[2];
#pragma unroll
        for (int pr = 0; pr < 2; ++pr) { const int nv = (t0[pr] + 1 >= 31) ? ((t0[pr] + 1 - 31) >> 4) + 1 : 0; nbc[pr] = (nv + 63) >> 6; }
        const int nvW = (T0 + 31 >= 31) ? ((T0 + 31 - 31) >> 4) + 1 : 0, nbcW = (nvW + 63) >> 6;
        const bf16_t* Kc = WSP(bf16_t, WS_KCMP) + (size_t)bg * 8 * 4096; const bf16_t* Vc = WSP(bf16_t, WS_VCMPT) + (size_t)bg * 8 * 4096;
        NSA_ZERO_O();
        SH_BAR();
        int nq = 0; if (c.tid == 0) nq = (int)__hip_atomic_fetch_add(NSA_QCTR, 1u, __ATOMIC_RELAXED, __HIP_MEMORY_SCOPE_AGENT);
        for (int kb = 0; kb < nbcW; ++kb) SH_ISSUE(Kc, Vc, kb, kb, true);
        SH_WAIT_BAR();
        if (c.tid == 0) { qs[(kk + 1) & 1] = nq; asm volatile("s_waitcnt lgkmcnt(0)" ::: "memory"); }
        for (int kb = 0; kb < nbcW; ++kb) {
#pragma unroll
            for (int pr = 0; pr < 2; ++pr) if (kb < nbc[pr])
                attn_step_lds(SH_SLOT(kb), qf[pr], kb * 64, (tcol[pr] - 31) >> 4, -1, true, true, 16 * (kb * 64 + 63) + 31 <= t0[pr], O[pr], lsum[pr], lane, fq);
        }
        float il[2];
#pragma unroll
        for (int pr = 0; pr < 2; ++pr) { float l = lsum[pr]; l += __shfl_xor(l, 16); l += __shfl_xor(l, 32); il[pr] = l > 0.f ? 1.0f / l : 0.f;
#pragma unroll
            for (int dt = 0; dt < 4; ++dt) out[pr][dt] = O[pr][dt] * (g0[pr] * il[pr]); }
        for (int i = lane; i < 4 * 136; i += 64) imp[i] = 0.f;
        for (int kb = 0; kb < nbcW; ++kb) {
            if (kb < nbc[1]) {
                SH_READ_K(kb);
#pragma unroll
                for (int pr = 0; pr < 2; ++pr) if (kb < nbc[pr]) {
                    f32x4 s4[4];
#pragma unroll
                    for (int kt = 0; kt < 4; ++kt) { s4[kt] = (f32x4){0.f, 0.f, 0.f, 0.f};
#pragma unroll
                        for (int ks = 0; ks < 2; ++ks) s4[kt] = mfma16(kf[kt * 2 + ks], qf[pr][ks], s4[kt]); }
                    MFMA_FENCE();
#pragma unroll
                    for (int kt = 0; kt < 4; ++kt) {
                        float pa = 0.f, p3 = 0.f;
#pragma unroll
                        for (int r = 0; r < 4; ++r) { const int key = kb * 64 + 16 * kt + 4 * fq + r; const bool ok = (16 * key + 31 <= tcol[pr]);
                            const float p = ok ? fexp2(s4[kt][r]) * il[pr] : 0.f; pa += p; if (r == 3) p3 = p; }
                        pa = sum8(pa); p3 = sum8(p3);
                        const int jb = 4 * (4 * kb + kt) + fq, tk = pr * 2 + (fr >> 3);
                        if ((fr & 7) == 0) { (void)__hip_atomic_fetch_add((LAS float*)imp + tk * 136 + jb, pa, __ATOMIC_RELAXED, __HIP_MEMORY_SCOPE_WORKGROUP);
                            (void)__hip_atomic_fetch_add((LAS float*)imp + tk * 136 + jb + 1, p3, __ATOMIC_RELAXED, __HIP_MEMORY_SCOPE_WORKGROUP); }
                    }
                }
            }
        }
        unsigned long long msk[2][2][2];
        {
            bool vl[4], vh[4]; unsigned ul[4], uh[4], T[4];
#pragma unroll
            for (int tk = 0; tk < 4; ++tk) {
                const int t = T0 + 4 * wave + tk, cur = t >> 6; const int jl = lane, jh = lane + 64;
                vl[tk] = jl <= cur; vh[tk] = jh <= cur;
                const bool fl = (jl == 0) || (jl == cur) || (jl == cur - 1), fh = (jh == cur) || (jh == cur - 1);
                ul[tk] = fl ? 0x7f800000u : __float_as_uint(imp[tk * 136 + jl]); uh[tk] = fh ? 0x7f800000u : __float_as_uint(imp[tk * 136 + jh]); T[tk] = 0u;
            }
            int cT[4];
#pragma unroll
            for (int tk = 0; tk < 4; ++tk) cT[tk] = __popcll(__ballot(vl[tk])) + __popcll(__ballot(vh[tk]));
#pragma unroll 1
            for (int bit = 30; bit >= 0; --bit) {
#pragma unroll
                for (int tk = 0; tk < 4; ++tk) { const unsigned cand = T[tk] | (1u << bit);
                    const int cnt = __popcll(__ballot(vl[tk] && ul[tk] >= cand)) + __popcll(__ballot(vh[tk] && uh[tk] >= cand));
                    if (cnt >= 16) { T[tk] = cand; cT[tk] = cnt; } }
                if (cT[0] <= 16 && cT[1] <= 16 && cT[2] <= 16 && cT[3] <= 16) break;
            }
#pragma unroll
            for (int tk = 0; tk < 4; ++tk) {
                const unsigned long long gtl = __ballot(vl[tk] && ul[tk] > T[tk]), gth = __ballot(vh[tk] && uh[tk] > T[tk]);
                const unsigned long long eql = __ballot(vl[tk] && ul[tk] == T[tk]), eqh = __ballot(vh[tk] && uh[tk] == T[tk]);
                const int need = 16 - (__popcll(gtl) + __popcll(gth));
                const unsigned long long lm = (1ull << lane) - 1ull;
                const int rl = __popcll(eql & lm), rh = __popcll(eql) + __popcll(eqh & lm);
                msk[tk >> 1][tk & 1][0] = gtl | __ballot(vl[tk] && ul[tk] == T[tk] && rl < need); msk[tk >> 1][tk & 1][1] = gth | __ballot(vh[tk] && uh[tk] == T[tk] && rh < need);
            }
        }
        const bf16_t* Kw = WSP(bf16_t, WS_KW) + (size_t)bg * 128 * 4096; const bf16_t* Vw = WSP(bf16_t, WS_VWT) + (size_t)bg * 128 * 4096;
        const int loW = T0 - 511 > 0 ? T0 - 511 : 0; const int jb0W = loW >> 6, jb1W = (T0 + 31) >> 6;
        const int wbase = (((curW >> 2) + 1) & 1) * 4;
        {
            const bf16_t* Ks = WSP(bf16_t, WS_KS) + (size_t)bg * 128 * 4096; const bf16_t* Vs = WSP(bf16_t, WS_VST) + (size_t)bg * 128 * 4096;
            NSA_ZERO_O();
            unsigned long long any[2][2], mine[2][2], both[2][2];
#pragma unroll
            for (int pr = 0; pr < 2; ++pr)
#pragma unroll
                for (int h = 0; h < 2; ++h) { any[pr][h] = msk[pr][0][h] | msk[pr][1][h]; both[pr][h] = msk[pr][0][h] & msk[pr][1][h]; mine[pr][h] = (fr >> 3) ? msk[pr][1][h] : msk[pr][0][h]; }
            const int ng = (curW >> 2) + 1;
            SH_BAR();
#pragma unroll
            for (int bb = 0; bb < 4; ++bb) if (bb <= curW) SH_ISSUE(Ks, Vs, bb, bb, true);
            for (int gi = 0; gi < ng; ++gi) {
                SH_WAIT_BAR();
                if (gi + 1 < ng) {
#pragma unroll
                    for (int bb = 0; bb < 4; ++bb) if (4 * (gi + 1) + bb <= curW) SH_ISSUE(Ks, Vs, 4 * (gi + 1) + bb, ((gi + 1) & 1) * 4 + bb, true);
                } else SH_ISSUE(Kw, Vw, jb0W, ((gi + 1) & 1) * 4, true);
#pragma unroll 1
                for (int bb = 0; bb < 4; ++bb) {
                    const int j = 4 * gi + bb; if (j > curW) break;
                    const int slot = (gi & 1) * 4 + bb;
                    const bool a0 = ((j < 64 ? (any[0][0] >> j) : (any[0][1] >> (j - 64))) & 1ull) != 0ull, a1 = ((j < 64 ? (any[1][0] >> j) : (any[1][1] >> (j - 64))) & 1ull) != 0ull;
#pragma unroll
                    for (int pr = 0; pr < 2; ++pr) if (pr == 0 ? a0 : a1) {
                        const bool colok = ((j < 64 ? (mine[pr][0] >> j) : (mine[pr][1] >> (j - 64))) & 1ull) != 0ull;
                        const bool bothsel = ((j < 64 ? (both[pr][0] >> j) : (both[pr][1] >> (j - 64))) & 1ull) != 0ull;
                        attn_step_lds(SH_SLOT(slot), qf[pr], j * 64, tcol[pr], -1, colok, bothsel, j * 64 + 63 <= t0[pr], O[pr], lsum[pr], lane, fq); }
                }
            }
#pragma unroll
            for (int pr = 0; pr < 2; ++pr) { float l = lsum[pr]; l += __shfl_xor(l, 16); l += __shfl_xor(l, 32); const float sc = l > 0.f ? g1[pr] / l : 0.f;
#pragma unroll
                for (int dt = 0; dt < 4; ++dt) out[pr][dt] += O[pr][dt] * sc; }
        }
        {
            NSA_ZERO_O();
            for (int jb = jb0W; jb <= jb1W; ++jb) {
                const int slot = wbase + ((jb - jb0W) & 1);
                SH_WAIT_BAR();
                if (jb < jb1W) SH_ISSUE(Kw, Vw, jb + 1, wbase + ((jb + 1 - jb0W) & 1), true);
#pragma unroll
                for (int pr = 0; pr < 2; ++pr) { const int lo = t0[pr] - 511 > 0 ? t0[pr] - 511 : 0;
                    if (jb >= (lo >> 6) && jb <= ((t0[pr] + 1) >> 6))
                        attn_step_lds(SH_SLOT(slot), qf[pr], jb * 64, tcol[pr], tcol[pr] - 512, true, true, jb * 64 > t0[pr] + 1 - 512 && jb * 64 + 63 <= t0[pr], O[pr], lsum[pr], lane, fq); }
            }
#pragma unroll
            for (int pr = 0; pr < 2; ++pr) { float l = lsum[pr]; l += __shfl_xor(l, 16); l += __shfl_xor(l, 32); const float sc = l > 0.f ? g2[pr] / l : 0.f;
#pragma unroll
                for (int dt = 0; dt < 4; ++dt) out[pr][dt] += O[pr][dt] * sc; }
        }
#pragma unroll
        for (int pr = 0; pr < 2; ++pr) { bf16_t* op = WSP(bf16_t, WS_RA) + tokc[pr] * 2048 + 1024 + head * 64 + 4 * fq;
#pragma unroll
            for (int dt = 0; dt < 4; ++dt) { u32x2 ov; ov.x = pk2(out[pr][dt][0], out[pr][dt][1]); ov.y = pk2(out[pr][dt][2], out[pr][dt][3]); *(u32x2*)(op + 16 * dt) = ov; } }
#undef NSA_ZERO_O
        {
#pragma unroll 1
            for (int r = kk * crpt; r < (kk + 1) * crpt && r < crounds; ++r) { const int item = c.gw + r * (c.G * NWAVES);
                if (item < cntot) { const bool nx = lconv >= 0 && item < CONV_ITEMS; const int i0 = nx ? item : item - (lconv >= 0 ? CONV_ITEMS : 0);
                    if (nx || !conv_is_early(i0)) conv_one(c, nx ? lconv : 0, i0); } }
        }
    }
#pragma unroll 1
    for (int r = kk * crpt; r < crounds; ++r) { const int item = c.gw + r * (c.G * NWAVES);
        if (item < cntot) { const bool nx = lconv >= 0 && item < CONV_ITEMS; const int i0 = nx ? item : item - (lconv >= 0 ? CONV_ITEMS : 0);
            if (nx || !conv_is_early(i0)) conv_one(c, nx ? lconv : 0, i0); } }
    SH_BAR();
#undef NSA_QCTR
}

__device__ __forceinline__ void phase_route(const Ctx& c, int l) {
    const int lane = c.lane, gw = c.gw, NW = c.G * NWAVES, fr = lane & 15, fq = lane >> 4;
    LAS int* cnt = (LAS int*)(c.lds + LDS_CTL_OFF + 64);
    if (c.tid < 32) cnt[c.tid] = 0;
    for (int i = blockIdx.x * NTHREADS + c.tid; i < XROWS; i += c.G * NTHREADS) WSP(int, WS_ROWTOK)[i] = 0;
    __syncthreads();
    {
        const bf16_t* rwf = WSP(bf16_t, WS_RWF) + (size_t)l * 32 * 2 * 2 * 512 + lane * 8;
#pragma unroll
        for (int i = 0; i < 16; ++i) { const int blk = c.wave * 16 + i;
            __builtin_amdgcn_global_load_lds((const unsigned*)(rwf + (size_t)blk * 512), (LAS unsigned*)(c.lds + blk * 1024), 16, 0, 0); }
        asm volatile("s_waitcnt vmcnt(0)" ::: "memory"); __syncthreads();
    }
    const float b0 = c.router_b[(size_t)l * NEXP + fr], b1 = c.router_b[(size_t)l * NEXP + 16 + fr];
    for (int tile = gw; tile < NTOK / 16; tile += NW) {
        const int tok0 = tile * 16; const float* xr = (l == 0 ? c.x_in : (const float*)c.out) + (size_t)(tok0 + fr) * D + 4 * fq;
        const bf16_t* dr = WSP(bf16_t, WS_PROJ) + (size_t)(tok0 + fr) * D + 4 * fq;
        bf16_t* hrow = WSP(bf16_t, WS_H) + (size_t)(tok0 + fr) * D + 4 * fq;
        f32x4 acc0 = {0.f, 0.f, 0.f, 0.f}, acc1 = {0.f, 0.f, 0.f, 0.f}; float ss = 0.f;
#pragma unroll 1
        for (int kg = 0; kg < 8; ++kg) {
            f32x4 xa[4], xb[4]; u32x2 da[4], db[4]; bf16x8 wv[4][4];
#pragma unroll
            for (int u = 0; u < 4; ++u) { const int ks = kg * 4 + u; xa[u] = *(const f32x4*)(xr + 32 * ks); xb[u] = *(const f32x4*)(xr + 32 * ks + 16);
                da[u] = *(const u32x2*)(dr + 32 * ks); db[u] = *(const u32x2*)(dr + 32 * ks + 16);
#pragma unroll
                for (int q = 0; q < 4; ++q) wv[u][q] = *(const LAS bf16x8*)(c.lds + (ks * 4 + q) * 1024 + lane * 16); }
            __builtin_amdgcn_sched_barrier(0);
#pragma unroll
            for (int u = 0; u < 4; ++u) {
                float v[8] = {xa[u][0] + bflo(da[u].x), xa[u][1] + bfhi(da[u].x), xa[u][2] + bflo(da[u].y), xa[u][3] + bfhi(da[u].y),
                              xb[u][0] + bflo(db[u].x), xb[u][1] + bfhi(db[u].x), xb[u][2] + bflo(db[u].y), xb[u][3] + bfhi(db[u].y)}; float lo[8]; u32x4 hw, lw;
#pragma unroll
                for (int j = 0; j < 8; ++j) ss += v[j] * v[j];
#pragma unroll
                for (int j = 0; j < 4; ++j) { hw[j] = pk2(v[2 * j], v[2 * j + 1]); lo[2 * j] = v[2 * j] - bflo(hw[j]); lo[2 * j + 1] = v[2 * j + 1] - bfhi(hw[j]); }
#pragma unroll
                for (int j = 0; j < 4; ++j) lw[j] = pk2(lo[2 * j], lo[2 * j + 1]);
                const bf16x8 ah = mk8(hw), al = mk8(lw);
                { bf16_t* hp = hrow + 32 * (kg * 4 + u); u32x2 h0, h1; h0.x = hw[0]; h0.y = hw[1]; h1.x = hw[2]; h1.y = hw[3]; *(u32x2*)hp = h0; *(u32x2*)(hp + 16) = h1; }
                acc0 = mfma16(ah, wv[u][0], acc0); acc1 = mfma16(ah, wv[u][2], acc1);
                acc0 = mfma16(ah, wv[u][1], acc0); acc1 = mfma16(ah, wv[u][3], acc1);
                acc0 = mfma16(al, wv[u][0], acc0); acc1 = mfma16(al, wv[u][2], acc1);
            }
            MFMA_FENCE();
        }
        ss += __shfl_xor(ss, 16); ss += __shfl_xor(ss, 32);
        const float rs = rsqrtf(ss * (1.0f / 1024.0f) + NORM_EPS);
        if (fq == 0) WSP(float, WS_RSTD)[tok0 + fr] = rs;
#pragma unroll
        for (int r = 0; r < 4; ++r) {
            const float rt = __shfl(rs, 4 * fq + r);
            float v0 = acc0[r] * rt + b0, v1 = acc1[r] * rt + b1; float tv[4]; int te[4];
#pragma unroll
            for (int k = 0; k < 4; ++k) { float bv = v0; int be = fr; if (v1 > bv) { bv = v1; be = 16 + fr; }
#pragma unroll
                for (int o = 8; o >= 1; o >>= 1) { const float ov = __shfl_xor(bv, o); const int oe = __shfl_xor(be, o); if (ov > bv || (ov == bv && oe < be)) { bv = ov; be = oe; } }
                tv[k] = bv; te[k] = be; if (be == fr) v0 = -INFINITY; if (be == 16 + fr) v1 = -INFINITY; }
            const float e1 = expf(tv[1] - tv[0]), e2 = expf(tv[2] - tv[0]), e3 = expf(tv[3] - tv[0]); const float inv = 1.0f / (1.0f + e1 + e2 + e3);
            if (fr < 4) { const int e = fr == 0 ? te[0] : fr == 1 ? te[1] : fr == 2 ? te[2] : te[3]; const float wv_ = (fr == 0 ? 1.0f : fr == 1 ? e1 : fr == 2 ? e2 : e3) * inv;
                const int rk = atomicAdd((int*)&cnt[e], 1); const size_t o = (size_t)(tok0 + 4 * fq + r) * 4 + fr;
                WSP(int, WS_TE)[o] = e; WSP(float, WS_TW)[o] = wv_; WSP(int, WS_RANK)[o] = rk; }
        }
    }
    __syncthreads();
    if (c.tid < 32) WSP(int, WS_HIST)[blockIdx.x * 32 + c.tid] = cnt[c.tid];
    __syncthreads();
}

__device__ __forceinline__ void phase_scatter(const Ctx& c, int l) {
    const int lane = c.lane, gw = c.gw, NW = c.G * NWAVES;
    LAS int* hist = (LAS int*)c.lds;
    LAS int* part = (LAS int*)(c.lds + 65536);
    LAS int* base = part + 1024;
    LAS int* pst = base + 32;
    LAS int* nblk = pst + 40;
    for (int i = c.tid; i < c.G * 32; i += NTHREADS) hist[i] = WSP(int, WS_HIST)[i];
    __syncthreads();
    { const int e = c.tid & 31, p = c.tid >> 5, per = (c.G + 15) >> 4; const int w1 = (p + 1) * per < c.G ? (p + 1) * per : c.G; int before = 0, tot = 0;
      for (int w = p * per; w < w1; ++w) { const int v = hist[w * 32 + e]; if (w < (int)blockIdx.x) before += v; tot += v; }
      part[(p * 32 + e) * 2] = before; part[(p * 32 + e) * 2 + 1] = tot; }
    __syncthreads();
    if (c.tid < 32) { int before = 0, tot = 0;
#pragma unroll
        for (int p = 0; p < 16; ++p) { before += part[(p * 32 + c.tid) * 2]; tot += part[(p * 32 + c.tid) * 2 + 1]; }
        base[c.tid] = before; const int padded = (tot + 255) & ~255; int incl = padded;
#pragma unroll
        for (int o = 1; o < 32; o <<= 1) { const int t = __shfl_up(incl, o); if (c.tid >= o) incl += t; }
        pst[c.tid] = incl - padded; if (c.tid == 31) pst[32] = incl; nblk[c.tid] = padded >> 8; }
    __syncthreads();
    if (blockIdx.x == 0 && c.tid < 32) {
        int* meta = WSP(int, WS_META); const int e = c.tid, x = e & 7; int off = 0;
        for (int e2 = x; e2 < e; e2 += 8) off += nblk[e2];
        const int rb0 = pst[e] >> 8, nb = nblk[e];
        for (int i = 0; i < nb; ++i) { meta[64 + rb0 + i] = e; meta[1024 + 640 * x + off + i] = rb0 + i; }
        if (e >= 24) meta[16 + x] = off + nb;
        if (e == 0) meta[0] = pst[32] >> 8; }
    for (int tile = gw; tile < NTOK / 16; tile += NW) {
        const int o = tile * 64 + lane, tok = o >> 2;
        const int e = WSP(int, WS_TE)[o], rk = WSP(int, WS_RANK)[o];
        const int dst = pst[e] + base[e] + rk;
        WSP(int, WS_ROWTOK)[dst] = tok; WSP(float, WS_RSROW)[dst] = WSP(float, WS_RSTD)[tok]; WSP(int, WS_SLOT)[o] = dst;
    }
}

__device__ __forceinline__ void phase_combine(const Ctx& c, int l) {
    const int lane = c.lane, gw = c.gw, NW = c.G * NWAVES;
    for (int tok = gw; tok < NTOK; tok += NW) {
        float* xr = c.out + (size_t)tok * D; const bf16_t* hs = WSP(bf16_t, WS_H) + (size_t)tok * D;
        const u32x4 sl = *(const u32x4*)(WSP(int, WS_SLOT) + (size_t)tok * 4); const f32x4 tw = *(const f32x4*)(WSP(float, WS_TW) + (size_t)tok * 4);
        f32x4 v[4];
#pragma unroll
        for (int i = 0; i < 4; ++i) { const u32x2 d = *(const u32x2*)(hs + i * 256 + lane * 4); v[i][0] = bflo(d.x); v[i][1] = bfhi(d.x); v[i][2] = bflo(d.y); v[i][3] = bfhi(d.y); }
#pragma unroll
        for (int k = 0; k < 4; ++k) { const bf16_t* yr = WSP(bf16_t, WS_XBUF) + (size_t)sl[k] * D; const float w = tw[k];
#pragma unroll
            for (int i = 0; i < 4; ++i) { const u32x2 y = *(const u32x2*)(yr + i * 256 + lane * 4);
                v[i][0] += w * bflo(y.x); v[i][1] += w * bfhi(y.x); v[i][2] += w * bflo(y.y); v[i][3] += w * bfhi(y.y); } }
        float ss = 0.f;
#pragma unroll
        for (int i = 0; i < 4; ++i) { *(f32x4*)(xr + i * 256 + lane * 4) = v[i]; ss += v[i][0] * v[i][0] + v[i][1] * v[i][1] + v[i][2] * v[i][2] + v[i][3] * v[i][3]; }
        if (l + 1 < NL) {
            ss = wave_sum(ss); const float rs = rsqrtf(ss * (1.0f / 1024.0f) + NORM_EPS);
            const float* nw = c.norm1_w + (size_t)(l + 1) * D; bf16_t* hr = WSP(bf16_t, WS_H) + (size_t)tok * D;
#pragma unroll
            for (int i = 0; i < 4; ++i) { const f32x4 w = *(const f32x4*)(nw + i * 256 + lane * 4);
                u32x2 o; o.x = pk2(v[i][0] * rs * w[0], v[i][1] * rs * w[1]); o.y = pk2(v[i][2] * rs * w[2], v[i][3] * rs * w[3]); *(u32x2*)(hr + i * 256 + lane * 4) = o; }
        }
    }
}

constexpr int PH_PER_LAYER = 14, N_PHASES = 1 + NL * PH_PER_LAYER;
#ifndef PH_MASK
#define PH_MASK 0xffff
#endif
#define IN(k) (lo <= (k) && (k) < hi)
#define INL(j) (((PH_MASK >> ((j) + 1)) & 1) && IN(pb + (j)))
#define FRESH() do { int _t = threadIdx.x; asm volatile("" : "+v"(_t)); c.tid = _t; c.lane = _t & 63; c.wave = __builtin_amdgcn_readfirstlane(_t >> 6); c.gw = blockIdx.x * NWAVES + c.wave; } while (0)
#define SEAM(k) do { if (IN((k) + 1) || IN((k) + 2)) xcd_barrier(bar); else __syncthreads(); } while (0)

template <int l>
__device__ __forceinline__ void run_layer(Ctx& c, const XcdBarrier& bar, const int lo, const int hi) {
        const int pb = 1 + l * PH_PER_LAYER;
        if (INL(0)) { FRESH();
            g8::SchedPlain S{(const char*)WSP(bf16_t, WS_H), (const char*)(WSP(bf16_t, WS_WIN) + (size_t)l * NPROJ * D), (size_t)256 * D * 2, (size_t)256 * D * 2, NTOK / 256, NPROJ / 256, (NTOK / 256) * (NPROJ / 256), c.G, (int)blockIdx.x};
            g8::EpiBf16 E{WSP(bf16_t, WS_PROJ), NPROJ};
            g8::gemm_phase(c.lds, c.tid, D, D * 2, D * 2, S, E);
            SEAM(pb + 0);
        }
        if (INL(1)) { FRESH(); phase_prep(c, l); SEAM(pb + 1); }
        if (INL(2)) { FRESH();
            g8::SchedCmp S{(const char*)WSP(bf16_t, WS_KCT), (const char*)WSP(bf16_t, WS_VCT), (const char*)(WSP(bf16_t, WS_WC1) + (size_t)l * 2 * 256 * 2048), c.G, (int)blockIdx.x};
            g8::EpiSlab E{WSP(float, WS_ACT)};
            g8::gemm_phase(c.lds, c.tid, 256, 1024 * 2, 2048 * 2, S, E);
            SEAM(pb + 2);
        }
        if (INL(3)) { FRESH(); phase_cmp2(c, l); __syncthreads(); FRESH(); phase_scan(c); SEAM(pb + 3); }
        if (INL(5)) { FRESH(); phase_retout(c, l); FRESH(); phase_nsa(c, l, l + 1 < NL ? l + 1 : -1, l == 0); SEAM(pb + 5); }
        if (INL(7)) { FRESH();
            {
                g8::SchedPlain S{(const char*)WSP(bf16_t, WS_RA), (const char*)(WSP(bf16_t, WS_WO) + (size_t)l * D * 2048), (size_t)256 * 2048 * 2, (size_t)256 * 2048 * 2, NTOK / 256, D / 256, (NTOK / 256) * (D / 256), c.G, (int)blockIdx.x};
                g8::EpiGate E{WSP(bf16_t, WS_MIX), WSP(bf16_t, WS_PROJ), 0};
                g8::gemm_phase(c.lds, c.tid, D, 2048 * 2, 2048 * 2, S, E);
            }
            asm volatile("s_waitcnt vmcnt(0)" ::: "memory"); __syncthreads();
            {
                g8::SchedPlain S{(const char*)(WSP(bf16_t, WS_RA) + 1024), (const char*)(WSP(bf16_t, WS_WO) + (size_t)l * D * 2048 + 1024), (size_t)256 * 2048 * 2, (size_t)256 * 2048 * 2, NTOK / 256, D / 256, (NTOK / 256) * (D / 256), c.G, (int)blockIdx.x};
                g8::EpiGate E{WSP(bf16_t, WS_MIX), WSP(bf16_t, WS_PROJ), 1};
                g8::gemm_phase(c.lds, c.tid, D, 2048 * 2, 2048 * 2, S, E);
            }
            SEAM(pb + 7);
        }
        if (INL(8)) { FRESH();
            g8::SchedPlain S{(const char*)WSP(bf16_t, WS_MIX), (const char*)(WSP(bf16_t, WS_WOUT) + (size_t)l * D * D), (size_t)256 * D * 2, (size_t)256 * D * 2, NTOK / 256, D / 256, (NTOK / 256) * (D / 256), c.G, (int)blockIdx.x};
            g8::EpiBf16 E{WSP(bf16_t, WS_PROJ), D};
            g8::gemm_phase(c.lds, c.tid, D, D * 2, D * 2, S, E);
            SEAM(pb + 8);
        }
        if (INL(9)) { FRESH(); phase_route(c, l); SEAM(pb + 9); }
        if (INL(10)) { FRESH(); phase_scatter(c, l); SEAM(pb + 10); }
        if (INL(11)) { FRESH();
            LAS int* tab = (LAS int*)(c.lds + 131072); g8::moe_units(tab, WSP(int, WS_META), 8, c.G, (int)blockIdx.x, c.tid);
            g8::SchedMoeG S{(const char*)WSP(bf16_t, WS_H), (const char*)(WSP(bf16_t, WS_WGU) + (size_t)l * NEXP * 2048 * D), tab, 8, (size_t)2048 * D * 2, WSP(int, WS_ROWTOK)};
            g8::EpiSwiglu E{WSP(bf16_t, WS_ACT), c.b_gate_up + (size_t)l * NEXP * 2048, WSP(float, WS_RSROW), c.lds + 131072 + 8192};
            g8::gemm_phase(c.lds, c.tid, D, D * 2, D * 2, S, E);
            SEAM(pb + 11);
        }
        if (INL(12)) { FRESH();
            LAS int* tab = (LAS int*)(c.lds + 131072); g8::moe_units(tab, WSP(int, WS_META), 4, c.G, (int)blockIdx.x, c.tid);
            g8::SchedMoe S{(const char*)WSP(bf16_t, WS_ACT), (const char*)(WSP(bf16_t, WS_WD) + (size_t)l * NEXP * D * D), tab, 4, (size_t)D * D * 2};
            g8::EpiDown E{WSP(bf16_t, WS_XBUF), c.b_down + (size_t)l * NEXP * D};
            g8::gemm_phase(c.lds, c.tid, D, D * 2, D * 2, S, E);
            SEAM(pb + 12);
        }
        if (INL(13)) { FRESH(); phase_combine(c, l); SEAM(pb + 13); }
    }
__global__ void __launch_bounds__(NTHREADS, 2) mk_fwd(Args args) {
    extern __shared__ __attribute__((aligned(16))) unsigned char lds_raw[];
    Ctx c;
    c.x_in = args.in[0]; c.norm1_w = args.in[1]; c.w_in = args.in[2]; c.ret_gn_w = args.in[3]; c.qk_norm_w = args.in[4]; c.cmp_pos = args.in[5]; c.cmp_w1 = args.in[6]; c.cmp_w2 = args.in[7];
    c.w_o_ret = args.in[8]; c.w_o_nsa = args.in[9]; c.w_out = args.in[10]; c.norm2_w = args.in[11]; c.router_w = args.in[12]; c.router_b = args.in[13]; c.w_gate_up = args.in[14]; c.b_gate_up = args.in[15];
    c.w_down = args.in[16]; c.b_down = args.in[17];
    c.out = args.out; c.ws = args.ws; c.lds = (LAS unsigned char*)lds_raw;
    c.tid = threadIdx.x; c.lane = c.tid & 63; c.wave = __builtin_amdgcn_readfirstlane(c.tid >> 6); c.G = gridDim.x; c.gw = blockIdx.x * NWAVES + c.wave;
    volatile LAS unsigned* lctl = (volatile LAS unsigned*)(c.lds + LDS_CTL_OFF);
    if (c.tid < 16) lctl[c.tid] = 0u;
    __syncthreads();
    const int lo = args.ph_lo, hi = args.ph_hi;
    XcdBarrier bar; bar.bar = WSP(unsigned, WS_CTL); bar.x = 0; bar.st = lctl;
    if (hi - lo > 1) bar = xcd_barrier_post(WSP(unsigned, WS_CTL), lctl);
    if ((PH_MASK & 1) && IN(0)) { FRESH(); phase_prologue(c); SEAM(0); }

    run_layer<0>(c, bar, lo, hi); run_layer<1>(c, bar, lo, hi); run_layer<2>(c, bar, lo, hi); run_layer<3>(c, bar, lo, hi);
#undef IN
#undef INL
#undef SEAM
}


extern "C" void kernel_launch(void* const* d_in, const int* in_sizes, int n_in, void* d_out, int out_size, void* d_ws, size_t ws_size, hipStream_t stream) {
    static int grid = 0;
    if (grid == 0) {
        if (n_in != 18 || out_size != NTOK * D || ws_size < WS_END) { fprintf(stderr, "kernel_launch: unexpected shapes (n_in %d out %d ws %zu need %zu)\n", n_in, out_size, ws_size, (size_t)WS_END); grid = -1; return; }
        int dev = 0, cus = 0;
        if (hipGetDevice(&dev) != hipSuccess || hipDeviceGetAttribute(&cus, hipDeviceAttributeMultiprocessorCount, dev) != hipSuccess) { grid = -1; return; }
        if (hipFuncSetAttribute((const void*)mk_fwd, hipFuncAttributeMaxDynamicSharedMemorySize, LDS_BYTES) != hipSuccess) { fprintf(stderr, "kernel_launch: hipFuncSetAttribute failed\n"); grid = -1; return; }
        int per_cu = 0;
        if (hipOccupancyMaxActiveBlocksPerMultiprocessor(&per_cu, (const void*)mk_fwd, NTHREADS, LDS_BYTES) != hipSuccess || per_cu < 1) fprintf(stderr, "kernel_launch: occupancy query says %d\n", per_cu);
        (void)hipGetLastError();
        grid = cus;
    }
    if (grid < 0) return;
    (void)hipMemsetAsync((char*)d_ws + WS_CTL, 0, CTL_BYTES, stream);
    Args a{};
    for (int i = 0; i < 18; ++i) a.in[i] = (const float*)d_in[i];
    a.out = (float*)d_out; a.ws = (unsigned char*)d_ws;
#if MK_ONE_LAUNCH
    a.ph_lo = 0; a.ph_hi = N_PHASES;
    hipLaunchKernelGGL(mk_fwd, dim3(grid), dim3(NTHREADS), LDS_BYTES, stream, a);
#else
    for (int p = 0; p < N_PHASES; ++p) { a.ph_lo = p; a.ph_hi = p + 1; hipLaunchKernelGGL(mk_fwd, dim3(grid), dim3(NTHREADS), LDS_BYTES, stream, a); }
#endif
}
```

```cpp
#include <hip/hip_runtime.h>
#include <stdint.h>
#include <stdio.h>

#ifndef MK_ONE_LAUNCH
#define MK_ONE_LAUNCH 1
#endif

#define LAS __attribute__((address_space(3)))
typedef unsigned short bf16_t;
typedef short bf16x8 __attribute__((ext_vector_type(8)));
typedef float f32x4 __attribute__((ext_vector_type(4)));
typedef float f32x2 __attribute__((ext_vector_type(2)));
typedef unsigned u32x4 __attribute__((ext_vector_type(4)));
typedef unsigned u32x2 __attribute__((ext_vector_type(2)));

constexpr int D = 1024, NB = 4, SEQ = 8192, NTOK = NB * SEQ, NL = 4;
constexpr int NPROJ = 7168, IN_TOTAL = 6960;
constexpr int C_RQ = 0, C_RK = 512, C_RV = 1024, C_RG = 2048, C_NQ = 3072, C_KC = 4096, C_VC = 4224, C_KS = 4352, C_VS = 4480, C_KW = 4608, C_VW = 4736, C_NG = 4864, C_MG = 5120;
constexpr int NEXP = 32, XROWS = 139264;
constexpr int NWAVES = 8, NTHREADS = 512;
constexpr float NORM_EPS = 1e-6f;

constexpr size_t al256(size_t x) { return (x + 255) & ~(size_t)255; }
constexpr size_t WS_CTL = 0, CTL_BYTES = 65536;
constexpr size_t WS_HIST = WS_CTL + CTL_BYTES;
constexpr size_t WS_META = WS_HIST + 1024 * 32 * 4;
constexpr size_t WS_ROPER = WS_META + 32768;
constexpr size_t WS_ROPEN = WS_ROPER + (size_t)SEQ * 64 * 2 * 4;
constexpr size_t WS_PEB = WS_ROPEN + (size_t)SEQ * 8 * 2 * 4;
constexpr size_t WS_RWF = al256(WS_PEB + 8 * NL * 2 * 256 * 4);
constexpr size_t WS_RSTD = WS_RWF + (size_t)NL * 32 * 2 * 2 * 512 * 2;
constexpr size_t WS_WIN = al256(WS_RSTD + (size_t)NTOK * 4);
constexpr size_t WS_WO = WS_WIN + (size_t)NL * NPROJ * D * 2;
constexpr size_t WS_WOUT = WS_WO + (size_t)NL * D * 2048 * 2;
constexpr size_t WS_WC1 = WS_WOUT + (size_t)NL * D * D * 2;
constexpr size_t WS_WGU = WS_WC1 + (size_t)NL * 2 * 256 * 2048 * 2;
constexpr size_t WS_WD = WS_WGU + (size_t)NL * NEXP * 2048 * D * 2;
constexpr size_t WS_H = WS_WD + (size_t)NL * NEXP * D * D * 2;
constexpr size_t WS_PROJ = WS_H + (size_t)NTOK * D * 2;
constexpr size_t WS_QR = WS_PROJ + (size_t)NTOK * NPROJ * 2;
constexpr size_t WS_KR = WS_QR + (size_t)NTOK * 512 * 2;
constexpr size_t WS_KZT = WS_KR + (size_t)NTOK * 512 * 2;
constexpr size_t WS_VT = WS_KZT + (size_t)NTOK * 512 * 2;
constexpr size_t WS_RT = WS_VT + (size_t)NTOK * 1024 * 2;
constexpr size_t WS_QN = WS_RT + (size_t)16 * 64 * 256 * 128 * 2;
constexpr size_t WS_KS = WS_QN + (size_t)NTOK * 1024 * 2;
constexpr size_t WS_VST = WS_KS + (size_t)NTOK * 128 * 2;
constexpr size_t WS_KW = WS_VST + (size_t)NTOK * 128 * 2;
constexpr size_t WS_VWT = WS_KW + (size_t)NTOK * 128 * 2;
constexpr size_t WS_KCT = WS_VWT + (size_t)NTOK * 128 * 2;
constexpr size_t WS_VCT = WS_KCT + (size_t)NTOK * 128 * 2 + 4096;
constexpr size_t WS_HID = WS_VCT + (size_t)NTOK * 128 * 2 + 4096;
constexpr size_t WS_KCMP = WS_HID + (size_t)2 * 8 * 512 * 256 * 2;
constexpr size_t WS_VCMPT = WS_KCMP + (size_t)8 * 512 * 64 * 2;
constexpr size_t WS_RA = WS_VCMPT + (size_t)8 * 512 * 64 * 2;
constexpr size_t WS_MIX = WS_RA + (size_t)NTOK * 2048 * 2;
constexpr size_t WS_TE = WS_MIX + (size_t)NTOK * D * 2;
constexpr size_t WS_TW = WS_TE + (size_t)NTOK * 16;
constexpr size_t WS_RANK = WS_TW + (size_t)NTOK * 16;
constexpr size_t WS_SLOT = WS_RANK + (size_t)NTOK * 16;
constexpr size_t WS_ROWTOK = WS_SLOT + (size_t)NTOK * 16;
constexpr size_t WS_RSROW = WS_ROWTOK + (size_t)XROWS * 4;
constexpr size_t WS_XBUF = al256(WS_RSROW + (size_t)XROWS * 4);
constexpr size_t WS_ACT = WS_XBUF + (size_t)XROWS * D * 2;
constexpr size_t WS_END = WS_ACT + (size_t)XROWS * D * 2;

constexpr int LDS_SCRATCH = 149504;
constexpr int LDS_CTL_OFF = LDS_SCRATCH;
constexpr int LDS_BYTES = LDS_SCRATCH + 1024;

__device__ __forceinline__ float bf2f(bf16_t v) { return __uint_as_float(((unsigned)v) << 16); }
__device__ __forceinline__ float bflo(unsigned w) { return __uint_as_float(w << 16); }
__device__ __forceinline__ float bfhi(unsigned w) { return __uint_as_float(w & 0xffff0000u); }
__device__ __forceinline__ unsigned f2bf(float f) { unsigned u = __float_as_uint(f); return (u + 0x7fffu + ((u >> 16) & 1u)) >> 16; }
typedef __bf16 bf16x2_t __attribute__((ext_vector_type(2)));
__device__ __forceinline__ unsigned pk2(float lo, float hi) { const f32x2 v = {lo, hi}; const bf16x2_t r = __builtin_convertvector(v, bf16x2_t); return __builtin_bit_cast(unsigned, r); }
__device__ __forceinline__ float fexp2(float x) { return __builtin_amdgcn_exp2f(x); }
__device__ __forceinline__ float frcp(float x) { return __builtin_amdgcn_rcpf(x); }
__device__ __forceinline__ float sigmoidf_(float x) { return frcp(1.0f + fexp2(-1.4426950408889634f * x)); }
__device__ __forceinline__ bf16x8 mk8(u32x4 v) { return __builtin_bit_cast(bf16x8, v); }
__device__ __forceinline__ bf16x8 ld8(const bf16_t* p) { return __builtin_bit_cast(bf16x8, *(const u32x4*)p); }
__device__ __forceinline__ f32x4 mfma16(bf16x8 a, bf16x8 b, f32x4 c) { return __builtin_amdgcn_mfma_f32_16x16x32_bf16(a, b, c, 0, 0, 0); }
#define MFMA_FENCE() do { __builtin_amdgcn_sched_barrier(0); asm volatile("s_nop 7\n\ts_nop 7" ::: "memory"); __builtin_amdgcn_sched_barrier(0); } while (0)
__device__ __forceinline__ float sum8(float v) { v += __int_as_float(__builtin_amdgcn_update_dpp(0, __float_as_int(v), 0xB1, 0xf, 0xf, true));
    v += __int_as_float(__builtin_amdgcn_update_dpp(0, __float_as_int(v), 0x4E, 0xf, 0xf, true)); v += __int_as_float(__builtin_amdgcn_update_dpp(0, __float_as_int(v), 0x141, 0xf, 0xf, true)); return v; }
__device__ __forceinline__ float wave_sum(float v) {
#pragma unroll
    for (int o = 32; o >= 1; o >>= 1) v += __shfl_xor(v, o);
    return v;
}

#define XB_TMO      128
#define XB_XCNT(j)  (256  + 64 * (j))
#define XB_XSUB(j)  (1280 + 64 * (j))
#define XB_XGEN(j)  (2304 + 64 * (j))
#define XB_TOP      3328
#define XB_TOPGEN   3392
#define XCD_BAR_WORDS 3456
#define XB_SPIN_CAP (1u << 18)
__device__ __forceinline__ unsigned xb_ld(unsigned* p)              { return __hip_atomic_load(p, __ATOMIC_RELAXED, __HIP_MEMORY_SCOPE_AGENT); }
__device__ __forceinline__ unsigned xb_add(unsigned* p, unsigned v) { return __hip_atomic_fetch_add(p, v, __ATOMIC_RELAXED, __HIP_MEMORY_SCOPE_AGENT); }
__device__ __forceinline__ unsigned xb_xcc_id() { return (unsigned)__builtin_amdgcn_s_getreg((3 << 11) | 20) & 0xFu; }
#define XB_SPIN(cond, bar) do { unsigned _sp = 0; while (cond) { __builtin_amdgcn_s_sleep(1); \
    if ((++_sp & 255u) == 0u) { if (xb_ld(&(bar)[XB_TMO])) break; if (_sp > XB_SPIN_CAP) { atomicAdd(&(bar)[XB_TMO], 1u); break; } } } } while (0)
struct XcdBarrier { unsigned* bar; unsigned x; volatile LAS unsigned* st; };
__device__ __forceinline__ XcdBarrier xcd_barrier_post(unsigned* bar, volatile LAS unsigned* st) {
    XcdBarrier b; b.bar = bar; b.x = xb_xcc_id(); b.st = st;
    if (threadIdx.x == 0) (void)xb_add(&bar[XB_XCNT(b.x)], 1u);
    return b;
}
__device__ __forceinline__ void xcd_barrier_complete(unsigned* bar, unsigned x, unsigned& nloc, unsigned& nx) {
    const unsigned G = gridDim.x * gridDim.y * gridDim.z;
    unsigned sum, cnt, mine, sp = 0u;
    for (;;) {
        sum = 0u; cnt = 0u; mine = 0u;
#pragma unroll
        for (unsigned j = 0; j < 16; ++j) { const unsigned c = xb_ld(&bar[XB_XCNT(j)]); sum += c; cnt += (c > 0u) ? 1u : 0u; mine = (j == x) ? c : mine; }
        if (sum == G) break;
        __builtin_amdgcn_s_sleep(1);
        if ((++sp & 255u) == 0u) { if (xb_ld(&bar[XB_TMO])) break; if (sp > XB_SPIN_CAP) { atomicAdd(&bar[XB_TMO], 1u); break; } }
    }
    nloc = mine > 0u ? mine : 1u; nx = cnt > 0u ? cnt : 1u;
}
__device__ __forceinline__ void xcd_barrier(const XcdBarrier& b) {
    asm volatile("s_waitcnt vmcnt(0)" ::: "memory");
    __syncthreads();
    if (threadIdx.x == 0) {
        unsigned* bar = b.bar;
        __builtin_amdgcn_s_waitcnt(0);
        unsigned nloc = b.st[0], nx = b.st[1];
        if (nloc == 0u) { xcd_barrier_complete(bar, b.x, nloc, nx); b.st[0] = nloc; b.st[1] = nx; }
        const unsigned old = xb_add(&bar[XB_XSUB(b.x)], 1u);
        const unsigned gen = old / nloc;
        if (old + 1u == (gen + 1u) * nloc) {
            __builtin_amdgcn_fence(__ATOMIC_RELEASE, "agent");
            asm volatile("s_waitcnt vmcnt(0)" ::: "memory");
            const unsigned og = xb_add(&bar[XB_TOP], 1u);
            const unsigned tg = og / nx;
            if (og + 1u == (tg + 1u) * nx) xb_add(&bar[XB_TOPGEN], 1u);
            else XB_SPIN(xb_ld(&bar[XB_TOPGEN]) == tg, bar);
            __builtin_amdgcn_fence(__ATOMIC_ACQUIRE, "agent");
            xb_add(&bar[XB_XGEN(b.x)], 1u);
            asm volatile("s_waitcnt vmcnt(0)" ::: "memory");
        } else {
            XB_SPIN(xb_ld(&bar[XB_XGEN(b.x)]) == gen, bar);
            __builtin_amdgcn_fence(__ATOMIC_ACQUIRE, "agent");
            asm volatile("s_waitcnt vmcnt(0)" ::: "memory");
        }
    }
    __syncthreads();
}

struct Args { const float* in[18]; float* out; unsigned char* ws; int ph_lo, ph_hi; };
struct Ctx {
    const float *x_in, *norm1_w, *w_in, *ret_gn_w, *qk_norm_w, *cmp_pos, *cmp_w1, *cmp_w2, *w_o_ret, *w_o_nsa, *w_out, *norm2_w, *router_w, *router_b, *w_gate_up, *b_gate_up, *w_down, *b_down;
    float* out; unsigned char* ws; LAS unsigned char* lds;
    int tid, lane, wave, gw, G;
};
#define WSP(T, off) ((T*)(c.ws + (off)))

namespace g8 {
constexpr int BM = 256, BK = 64, HALF = 128, HTB = HALF * BK * 2, STAGE_BYTES = 8 * HTB, NXCD = 8, WGM = 8;
__device__ __forceinline__ int lds_byte(int r, int c) { const int st = (r >> 4) * 2 + (c >> 5), rr = r & 15, cc = c & 31, ob = rr * 64 + cc * 2; return st * 1024 + (ob ^ (((ob >> 9) & 1) << 5)); }
__device__ __forceinline__ void stage_rc(int b, int& R, int& C) { const int st = b / 1024, sb = b % 1024, swz = sb ^ (((sb >> 9) & 1) << 5); R = (st >> 1) * 16 + swz / 64; C = (st & 1) * 32 + (swz % 64) / 2; }
__device__ __forceinline__ int perm32(int rho) { const int n = rho >> 4, i = rho & 15; return 8 * (i >> 2) + 4 * n + (i & 3); }

struct Unit { const char* A; const char* B; int pm, pn, e; };

struct SchedPlain {
    static constexpr bool GATHER = false;
    const char* A; const char* B; size_t tA, tB; int nM, nN, nwg, G, c;
    __device__ __forceinline__ bool next(int i, Unit& u) const {
        const long L = (long)i * G + c; if (L >= nwg) return false;
        int wgid = (int)L; { const int q = nwg / NXCD, r = nwg % NXCD, xcd = wgid % NXCD, off = wgid / NXCD; wgid = (xcd < r ? xcd * (q + 1) : r * (q + 1) + (xcd - r) * q) + off; }
        const int nig = WGM * nN, gid = wgid / nig, fm = gid * WGM, gsz = (nM - fm) < WGM ? (nM - fm) : WGM;
        u.pm = fm + ((wgid % nig) % gsz); u.pn = (wgid % nig) / gsz; u.e = 0;
        u.A = A + (size_t)u.pm * tA; u.B = B + (size_t)u.pn * tB; return true;
    }
};
struct SchedCmp {         static constexpr bool GATHER = false;
    const char* KCT; const char* VCT; const char* W; int G, c;
    __device__ __forceinline__ bool next(int i, Unit& u) const {
        const int idx = i * G + c; if (idx >= 256) return false;
        const int ksl = idx & 7, r = idx >> 3, kv = r >> 4, bg = (r >> 1) & 7, half = r & 1;
        u.A = (kv ? VCT : KCT) + ((size_t)bg * SEQ * 64 + (size_t)half * 256 * 1024 + (size_t)ksl * 256) * 2;
        u.B = W + ((size_t)kv * 256 * 2048 + (size_t)ksl * 256) * 2; u.pm = (kv * 8 + bg) * 2 + half; u.pn = 0; u.e = ksl; return true;
    }
};
struct SchedMoe {
    static constexpr bool GATHER = false;
    const char* A; const char* W; const LAS int* tab; int NT; size_t wstride;
    __device__ __forceinline__ bool next(int i, Unit& u) const {
        const int v = __builtin_amdgcn_readfirstlane(tab[i]); if (v < 0) return false;
        const int rb = v & 0xfff, pn = (v >> 12) & 0xf, e = v >> 16;
        u.A = A + (size_t)rb * 256 * 1024 * 2; u.B = W + (size_t)e * wstride + (size_t)pn * 256 * 1024 * 2; u.pm = rb; u.pn = pn; u.e = e; return true;
    }
};
struct SchedMoeG {
    static constexpr bool GATHER = true;
    const char* A; const char* W; const LAS int* tab; int NT; size_t wstride; const int* rowtok;
    __device__ __forceinline__ bool next(int i, Unit& u) const {
        const int v = __builtin_amdgcn_readfirstlane(tab[i]); if (v < 0) return false;
        const int rb = v & 0xfff, pn = (v >> 12) & 0xf, e = v >> 16;
        u.A = A; u.B = W + (size_t)e * wstride + (size_t)pn * 256 * 1024 * 2; u.pm = rb; u.pn = pn; u.e = e; return true;
    }
};
__device__ __forceinline__ void moe_units(LAS int* tab, const int* meta, const int NT, const int G, const int c, const int tid) {
    if (tid < 256) {
        int v = -1; const int i = tid;
        if ((G & 7) == 0) { const int x = c & 7, q = i * (G >> 3) + (c >> 3); const int nb = meta[16 + x];
            if (q < nb * NT) { const int rbi = q / NT, pn = q - rbi * NT, rb = meta[1024 + 640 * x + rbi]; v = rb | (pn << 12) | (meta[64 + rb] << 16); } }
        else { const int idx = i * G + c; const int nblk = meta[0]; if (idx < nblk * NT) { const int rb = idx / NT, pn = idx - rb * NT; v = rb | (pn << 12) | (meta[64 + rb] << 16); } }
        tab[i] = v;
    }
    __syncthreads();
}

typedef f32x4 Acc[2][2][4][2];

struct EpiBf16 {
    struct Pre {}; __device__ __forceinline__ void pre(Pre&, const Unit&, int, int, int, int) const {}
    static constexpr bool PERM = true;
    bf16_t* O; int ldc;
    __device__ __forceinline__ void operator()(const Acc& acc, const Unit& u, int wr, int wc, int fr, int fq, const Pre&) const {
        const int row0 = u.pm * BM + wr * 64 + fr, col0 = u.pn * BM + wc * 32 + 8 * fq;
#pragma unroll
        for (int ai = 0; ai < 2; ++ai)
#pragma unroll
            for (int m = 0; m < 4; ++m) { bf16_t* rowp = O + (size_t)(row0 + ai * HALF + m * 16) * ldc + col0;
#pragma unroll
                for (int bj = 0; bj < 2; ++bj) { const f32x4 v0 = acc[ai][bj][m][0], v1 = acc[ai][bj][m][1];
                    u32x4 w; w.x = pk2(v0[0], v0[1]); w.y = pk2(v0[2], v0[3]); w.z = pk2(v1[0], v1[1]); w.w = pk2(v1[2], v1[3]);
                    *(u32x4*)(rowp + bj * HALF) = w; } }
    }
};
struct EpiSlab {
    struct Pre {}; __device__ __forceinline__ void pre(Pre&, const Unit&, int, int, int, int) const {}
    static constexpr bool PERM = false;
    float* O;
    __device__ __forceinline__ void operator()(const Acc& acc, const Unit& u, int wr, int wc, int fr, int fq, const Pre&) const {
        const int row0 = u.pm * BM + wr * 64 + fr, col0 = wc * 32 + 4 * fq;
        float* base = O + (size_t)u.e * 8192 * 256;
#pragma unroll
        for (int ai = 0; ai < 2; ++ai)
#pragma unroll
            for (int m = 0; m < 4; ++m) { const size_t off = (size_t)(row0 + ai * HALF + m * 16) * 256 + col0;
#pragma unroll
                for (int bj = 0; bj < 2; ++bj)
#pragma unroll
                    for (int n = 0; n < 2; ++n) *(f32x4*)(base + off + bj * HALF + n * 16) = acc[ai][bj][m][n]; }
    }
};
struct EpiGate {
    struct Pre {}; __device__ __forceinline__ void pre(Pre&, const Unit&, int, int, int, int) const {}
    static constexpr bool PERM = true;
    bf16_t* O; const bf16_t* proj; int second;
    __device__ __forceinline__ void operator()(const Acc& acc, const Unit& u, int wr, int wc, int fr, int fq, const Pre&) const {
        const int row0 = u.pm * BM + wr * 64 + fr, col0 = u.pn * BM + wc * 32 + 8 * fq;
#pragma unroll
        for (int ai = 0; ai < 2; ++ai)
#pragma unroll
            for (int m = 0; m < 4; ++m) { const size_t row = (size_t)(row0 + ai * HALF + m * 16); const bf16_t* rp = proj + row * NPROJ + C_MG + (second ? 1024 : 0) + col0;
#pragma unroll
                for (int bj = 0; bj < 2; ++bj) { const u32x4 wb = *(const u32x4*)(rp + bj * HALF); u32x4 prev = {0u, 0u, 0u, 0u};
                    if (second) prev = *(const u32x4*)(O + row * D + col0 + bj * HALF);
                    float o[8];
#pragma unroll
                    for (int j = 0; j < 8; ++j) { const unsigned ub = wb[j >> 1], up = prev[j >> 1]; const float b = (j & 1) ? bfhi(ub) : bflo(ub), pv = (j & 1) ? bfhi(up) : bflo(up);
                        o[j] = pv + (j < 4 ? acc[ai][bj][m][0][j] : acc[ai][bj][m][1][j - 4]) * sigmoidf_(b); }
                    u32x4 w; w.x = pk2(o[0], o[1]); w.y = pk2(o[2], o[3]); w.z = pk2(o[4], o[5]); w.w = pk2(o[6], o[7]);
                    *(u32x4*)(O + row * D + col0 + bj * HALF) = w; } }
    }
};
struct EpiSwiglu {
    static constexpr bool PERM = true;
    bf16_t* O; const float* bgu;
    const float* rsrow;
    LAS unsigned char* rsl;
    struct Pre {};
    __device__ __forceinline__ void pre(Pre&, const Unit& u, int wc, int fq, int wid, int lane) const {
        LAS unsigned char* my = rsl + wid * 768;
        const float* rp = rsrow + u.pm * BM + (wid >> 2) * 64 + lane;
        __builtin_amdgcn_global_load_lds((const unsigned*)rp, (LAS unsigned*)my, 4, 0, 0);
        __builtin_amdgcn_global_load_lds((const unsigned*)(rp + HALF), (LAS unsigned*)(my + 256), 4, 0, 0);
        const float* bp = bgu + (size_t)u.e * 2048 + u.pn * 128 + wc * 32 + (lane & 31) + (lane >> 5) * 1024;
        __builtin_amdgcn_global_load_lds((const unsigned*)bp, (LAS unsigned*)(my + 512), 4, 0, 0); }
    __device__ __forceinline__ void operator()(const Acc& acc, const Unit& u, int wr, int wc, int fr, int fq, const Pre&) const {
        const int row0 = u.pm * BM + wr * 64 + fr, col0 = u.pn * 128 + wc * 32 + 8 * fq;
        const LAS unsigned char* my = rsl + (wr * 4 + wc) * 768;
        const f32x4 g0 = *(const LAS f32x4*)(my + 512 + 32 * fq), g1 = *(const LAS f32x4*)(my + 512 + 32 * fq + 16), u0 = *(const LAS f32x4*)(my + 640 + 32 * fq), u1 = *(const LAS f32x4*)(my + 640 + 32 * fq + 16);
#pragma unroll
        for (int ai = 0; ai < 2; ++ai)
#pragma unroll
            for (int m = 0; m < 4; ++m) { float o[8]; const float rs = *(const LAS float*)(my + ai * 256 + (m * 16 + fr) * 4);
#pragma unroll
                for (int j = 0; j < 8; ++j) {
                    float gv = (j < 4 ? acc[ai][0][m][0][j] * rs + g0[j] : acc[ai][0][m][1][j - 4] * rs + g1[j - 4]);
                    float uv = (j < 4 ? acc[ai][1][m][0][j] * rs + u0[j] : acc[ai][1][m][1][j - 4] * rs + u1[j - 4]);
                    gv = fminf(gv, 7.0f); uv = fminf(fmaxf(uv, -7.0f), 7.0f);
                    const float glu = gv * frcp(1.0f + fexp2(-1.702f * 1.4426950408889634f * gv)); o[j] = (uv + 1.0f) * glu; }
                u32x4 w; w.x = pk2(o[0], o[1]); w.y = pk2(o[2], o[3]); w.z = pk2(o[4], o[5]); w.w = pk2(o[6], o[7]);
                *(u32x4*)(O + (size_t)(row0 + ai * HALF + m * 16) * D + col0) = w; }
    }
};
struct EpiDown {
    static constexpr bool PERM = true;
    bf16_t* O; const float* bd;
    struct Pre { f32x4 b[2][2]; };
    __device__ __forceinline__ void pre(Pre& p, const Unit& u, int wc, int fq, int wid, int lane) const { const float* bp = bd + (size_t)u.e * D + u.pn * BM + wc * 32 + 8 * fq;
#pragma unroll
        for (int bj = 0; bj < 2; ++bj) { p.b[bj][0] = *(const f32x4*)(bp + bj * HALF); p.b[bj][1] = *(const f32x4*)(bp + bj * HALF + 4); } }
    __device__ __forceinline__ void operator()(const Acc& acc, const Unit& u, int wr, int wc, int fr, int fq, const Pre& p) const {
        const int row0 = u.pm * BM + wr * 64 + fr, col0 = u.pn * BM + wc * 32 + 8 * fq;
#pragma unroll
        for (int bj = 0; bj < 2; ++bj) { const f32x4 b0 = p.b[bj][0], b1 = p.b[bj][1];
#pragma unroll
            for (int ai = 0; ai < 2; ++ai)
#pragma unroll
                for (int m = 0; m < 4; ++m) { const f32x4 v0 = acc[ai][bj][m][0] + b0, v1 = acc[ai][bj][m][1] + b1;
                    u32x4 w; w.x = pk2(v0[0], v0[1]); w.y = pk2(v0[2], v0[3]); w.z = pk2(v1[0], v1[1]); w.w = pk2(v1[2], v1[3]);
                    *(u32x4*)(O + (size_t)(row0 + ai * HALF + m * 16) * D + col0 + bj * HALF) = w; } }
    }
};

template <class Epi, class Sched>
__device__ __forceinline__ void gemm_phase(LAS unsigned char* lds, const int tid, const int K, const unsigned lda, const unsigned ldb, const Sched& S, const Epi& E) {
    const int wid = __builtin_amdgcn_readfirstlane(tid >> 6), lane = tid & 63, wr = wid >> 2, wc = wid & 3, fr = lane & 15, fq = lane >> 4;
    const int nt = K / BK;
    unsigned voffA[2], voffB[2]; int Rs[2];
#pragma unroll
    for (int i = 0; i < 2; ++i) { int R, C; stage_rc(tid * 16 + i * 8192, R, C); const int Rb = Epi::PERM ? ((R & ~31) + perm32(R & 31)) : R; Rs[i] = R;
        voffA[i] = Sched::GATHER ? (unsigned)C * 2u : (unsigned)R * lda + (unsigned)C * 2u; voffB[i] = (unsigned)Rb * ldb + (unsigned)C * 2u; }
    unsigned offc[2][2] = {{0u, 0u}, {0u, 0u}}, offn[2][2] = {{0u, 0u}, {0u, 0u}};
    const size_t kstep = (size_t)(BK * 2);
    const size_t hstepA = (size_t)HALF * lda, hstepB = (size_t)HALF * ldb;
    const unsigned ldsw = (unsigned)wid * 1024u;
    const int aoff = lds_byte(wr * 64 + fr, fq * 8), boff = lds_byte(wc * 32 + fr, fq * 8);
#define G8_SA(b, h) (((b) * 2 + (h)) * HTB)
#define G8_SB(b, h) ((4 + (b) * 2 + (h)) * HTB)
#define G8_STAGE(bufoff, gbase, voff) do { _Pragma("unroll") for (int _i = 0; _i < 2; ++_i) \
        __builtin_amdgcn_global_load_lds((const unsigned*)((const char*)(gbase) + (voff)[_i]), (LAS unsigned*)(lds + (bufoff) + ldsw + _i * 8192), 16, 0, 0); } while (0)
#define G8_STAGEA(bufoff, kt, h, nx) do { _Pragma("unroll") for (int _i = 0; _i < 2; ++_i) { \
        const char* _g = Sched::GATHER ? (cA + (size_t)(kt) * kstep + ((nx) ? offn[h][_i] : offc[h][_i]) + voffA[_i]) : (((nx) ? nA : cA) + (size_t)(kt) * kstep + (size_t)(h) * hstepA + voffA[_i]); \
        __builtin_amdgcn_global_load_lds((const unsigned*)_g, (LAS unsigned*)(lds + (bufoff) + ldsw + _i * 8192), 16, 0, 0); } } while (0)
#define G8_LOADOFF(dst, un) do { if constexpr (Sched::GATHER) { _Pragma("unroll") for (int _h = 0; _h < 2; ++_h) _Pragma("unroll") for (int _i = 0; _i < 2; ++_i) \
        dst[_h][_i] = (unsigned)S.rowtok[(un).pm * 256 + _h * 128 + Rs[_i]] * (unsigned)(D * 2); } } while (0)
#define G8_LDA(dst, b, h) do { _Pragma("unroll") for (int m = 0; m < 4; ++m) _Pragma("unroll") for (int k = 0; k < 2; ++k) dst[m][k] = *(const LAS bf16x8*)(lds + G8_SA(b, h) + aoff + m * 2048 + k * 1024); } while (0)
#define G8_LDB(dst, b, h) do { _Pragma("unroll") for (int n = 0; n < 2; ++n) _Pragma("unroll") for (int k = 0; k < 2; ++k) dst[n][k] = *(const LAS bf16x8*)(lds + G8_SB(b, h) + boff + n * 2048 + k * 1024); } while (0)
#define G8_MMA(ai, bj, At, Bt) do { __builtin_amdgcn_s_setprio(1); _Pragma("unroll") for (int m = 0; m < 4; ++m) _Pragma("unroll") for (int n = 0; n < 2; ++n) _Pragma("unroll") for (int k = 0; k < 2; ++k) \
        acc[ai][bj][m][n] = __builtin_amdgcn_mfma_f32_16x16x32_bf16(Bt[n][k], At[m][k], acc[ai][bj][m][n], 0, 0, 0); __builtin_amdgcn_s_setprio(0); } while (0)
#define G8_WAIT_V(n) asm volatile("s_waitcnt vmcnt(" #n ")" ::: "memory")
#define G8_WAIT_L(n) asm volatile("s_waitcnt lgkmcnt(" #n ")" ::: "memory")
#define G8_BAR __builtin_amdgcn_s_barrier()
#define G8_SCHED __builtin_amdgcn_sched_barrier(0)
    Unit cur, nxt; int ui = 0;
    if (!S.next(0, cur)) return;
    Acc acc;
#pragma unroll
    for (int a = 0; a < 2; ++a)
#pragma unroll
        for (int b = 0; b < 2; ++b)
#pragma unroll
            for (int m = 0; m < 4; ++m)
#pragma unroll
                for (int n = 0; n < 2; ++n) acc[a][b][m][n] = (f32x4){0.f, 0.f, 0.f, 0.f};
    bf16x8 At[4][2], B0[2][2], B1[2][2];
    const char* cA = cur.A; const char* cB = cur.B; const char* nA = cA;
    typename Epi::Pre epre; E.pre(epre, cur, wc, fq, wid, lane);
    G8_LOADOFF(offc, cur);
    if constexpr (Sched::GATHER) asm volatile("s_waitcnt vmcnt(0)" ::: "memory");
    G8_STAGE(G8_SB(0, 0), cB, voffB); G8_STAGEA(G8_SA(0, 0), 0, 0, false); G8_STAGE(G8_SB(0, 1), cB + hstepB, voffB); G8_STAGEA(G8_SA(0, 1), 0, 1, false);
    if (wr == 1) G8_BAR;
    G8_WAIT_V(4); G8_BAR;
    G8_STAGE(G8_SB(1, 0), cB + kstep, voffB); G8_STAGEA(G8_SA(1, 0), 1, 0, false); G8_STAGE(G8_SB(1, 1), cB + hstepB + kstep, voffB);
    G8_WAIT_V(6); G8_BAR;
    for (;;) {
        const bool has_next = S.next(ui + 1, nxt);
        nA = has_next ? nxt.A : cA; const char* nB = has_next ? nxt.B : cB;
        if (has_next) G8_LOADOFF(offn, nxt);
        else { _Pragma("unroll") for (int _h = 0; _h < 2; ++_h) _Pragma("unroll") for (int _i = 0; _i < 2; ++_i) offn[_h][_i] = offc[_h][_i]; }
        for (int t = 0; t < nt; t += 2) {
            const bool last = (t == nt - 2);
            const char* b2 = last ? nB : cB + (size_t)(t + 2) * kstep;
            const char* b3 = b2 + kstep;
            const int k2 = last ? 0 : t + 2, k3 = last ? 1 : t + 3;
            G8_LDB(B0, 0, 0); G8_SCHED; G8_LDA(At, 0, 0); G8_STAGEA(G8_SA(1, 1), t + 1, 1, false);
            G8_WAIT_L(8); G8_BAR; G8_WAIT_L(0); G8_MMA(0, 0, At, B0); G8_BAR; G8_SCHED;
            G8_LDB(B1, 0, 1); G8_STAGE(G8_SB(0, 0), b2, voffB);
            G8_BAR; G8_WAIT_L(0); G8_MMA(0, 1, At, B1); G8_BAR;
            G8_LDA(At, 0, 1); G8_STAGEA(G8_SA(0, 0), k2, 0, last);
            G8_BAR; G8_WAIT_L(0); G8_MMA(1, 0, At, B0); G8_BAR; G8_SCHED;
            G8_STAGE(G8_SB(0, 1), b2 + hstepB, voffB);
            G8_WAIT_V(6); G8_BAR; G8_MMA(1, 1, At, B1); G8_BAR;
            G8_LDB(B0, 1, 0); G8_SCHED; G8_LDA(At, 1, 0); G8_STAGEA(G8_SA(0, 1), k2, 1, last);
            G8_WAIT_L(8); G8_BAR; G8_WAIT_L(0); G8_MMA(0, 0, At, B0); G8_BAR; G8_SCHED;
            G8_LDB(B1, 1, 1); G8_STAGE(G8_SB(1, 0), b3, voffB);
            G8_BAR; G8_WAIT_L(0); G8_MMA(0, 1, At, B1); G8_BAR;
            G8_LDA(At, 1, 1); G8_STAGEA(G8_SA(1, 0), k3, 0, last);
            G8_BAR; G8_WAIT_L(0); G8_MMA(1, 0, At, B0); G8_BAR; G8_SCHED;
            G8_STAGE(G8_SB(1, 1), b3 + hstepB, voffB);
            G8_WAIT_V(6); G8_BAR; G8_MMA(1, 1, At, B1); G8_BAR;
        }
        MFMA_FENCE();
        E(acc, cur, wr, wc, fr, fq, epre);
        if (!has_next) break;
#pragma unroll
        for (int a = 0; a < 2; ++a)
#pragma unroll
            for (int b = 0; b < 2; ++b)
#pragma unroll
                for (int m = 0; m < 4; ++m)
#pragma unroll
                    for (int n = 0; n < 2; ++n) acc[a][b][m][n] = (f32x4){0.f, 0.f, 0.f, 0.f};
        cur = nxt; cA = nA; cB = nB; ++ui;
        { _Pragma("unroll") for (int _h = 0; _h < 2; ++_h) _Pragma("unroll") for (int _i = 0; _i < 2; ++_i) offc[_h][_i] = offn[_h][_i]; }
        E.pre(epre, cur, wc, fq, wid, lane);
    }
    G8_WAIT_V(0);
    if (wr == 0) G8_BAR;
    G8_BAR;
#undef G8_SA
#undef G8_SB
#undef G8_STAGE
#undef G8_LDA
#undef G8_STAGEA
#undef G8_LOADOFF
#undef G8_LDB
#undef G8_MMA
#undef G8_WAIT_V
#undef G8_WAIT_L
#undef G8_BAR
#undef G8_SCHED
}
}

__device__ __forceinline__ void conv_item(const float* __restrict__ src, int ldS, int col4  , int k0, bf16_t* __restrict__ dst  , int K, int kq, const float* __restrict__ ksc = nullptr  ) {
    f32x4 v[16];
#pragma unroll
    for (int j = 0; j < 16; ++j) v[j] = col4 >= 0 ? *(const f32x4*)(src + (size_t)(k0 + kq * 16 + j) * ldS + col4) : (f32x4){0.f, 0.f, 0.f, 0.f};
    if (ksc) {
#pragma unroll
        for (int j = 0; j < 16; ++j) v[j] *= ksc[k0 + kq * 16 + j];
    }
#pragma unroll
    for (int r = 0; r < 4; ++r) {
        u32x4 w0, w1;
#pragma unroll
        for (int j = 0; j < 4; ++j) { w0[j] = pk2(v[2 * j][r], v[2 * j + 1][r]); w1[j] = pk2(v[8 + 2 * j][r], v[8 + 2 * j + 1][r]); }
        bf16_t* d = dst + (size_t)r * K + kq * 16;
        *(u32x4*)d = w0; *(u32x4*)(d + 8) = w1;
    }
}
__device__ __forceinline__ void rms_row_to_h(const float* __restrict__ xr, const float* __restrict__ nw, bf16_t* __restrict__ hr, int lane) {
    f32x4 v[4]; float ss = 0.f;
#pragma unroll
    for (int i = 0; i < 4; ++i) { v[i] = *(const f32x4*)(xr + i * 256 + lane * 4); ss += v[i][0] * v[i][0] + v[i][1] * v[i][1] + v[i][2] * v[i][2] + v[i][3] * v[i][3]; }
    ss = wave_sum(ss);
    const float rs = rsqrtf(ss * (1.0f / 1024.0f) + NORM_EPS);
#pragma unroll
    for (int i = 0; i < 4; ++i) { const f32x4 w = *(const f32x4*)(nw + i * 256 + lane * 4);
        u32x2 o; o.x = pk2(v[i][0] * rs * w[0], v[i][1] * rs * w[1]); o.y = pk2(v[i][2] * rs * w[2], v[i][3] * rs * w[3]);
        *(u32x2*)(hr + i * 256 + lane * 4) = o; }
}
constexpr int CONV_ITEMS = 112 * 16 + 16 * 32 + 16 * 16 + 2 * 4 * 32 + 32 * 32 * 16 + 32 * 16 * 16;
__device__ __forceinline__ void conv_one(const Ctx& c, const int l, const int it) {
    const int lane = c.lane;
    constexpr int I_IN = 112 * 16, I_O = 16 * 32, I_OUT = 16 * 16, I_C1 = 2 * 4 * 32, I_GU = 32 * 32 * 16;
    constexpr int E1 = I_IN, E2 = E1 + I_O, E3 = E2 + I_OUT, E4 = E3 + I_C1, E5 = E4 + I_GU;
    const int n4 = (lane & 15) * 4, kq = lane >> 4;
    if (it < E1) { const int nb = it / 16, kb = it % 16; const int n = nb * 64 + n4;
        const int col = n < 4912 ? n : (n < 5120 ? -1 : n - 208);
        conv_item(c.w_in + (size_t)l * D * IN_TOTAL, IN_TOTAL, col, kb * 64, WSP(bf16_t, WS_WIN) + ((size_t)l * NPROJ + n) * D + kb * 64, D, kq);
    } else if (it < E2) { const int r = it - E1, nb = r / 32, kb = r % 32; const int n = nb * 64 + n4;
        const float* src = (kb < 16 ? c.w_o_ret : c.w_o_nsa) + (size_t)l * D * D;
        conv_item(src, D, n, (kb & 15) * 64, WSP(bf16_t, WS_WO) + ((size_t)l * D + n) * 2048 + kb * 64, 2048, kq);
    } else if (it < E3) { const int r = it - E2, nb = r / 16, kb = r % 16; const int n = nb * 64 + n4;
        conv_item(c.w_out + (size_t)l * D * D, D, n, kb * 64, WSP(bf16_t, WS_WOUT) + ((size_t)l * D + n) * D + kb * 64, D, kq);
    } else if (it < E4) { const int j = it - E3, lk = l * 2 + j / 128, r = j % 128, nb = r / 32, kb = r % 32; const int n = nb * 64 + n4;
        conv_item(c.cmp_w1 + (size_t)lk * 2048 * 256, 256, n, kb * 64, WSP(bf16_t, WS_WC1) + ((size_t)lk * 256 + n) * 2048 + kb * 64, 2048, kq);
    } else if (it < E5) { const int j = it - E4, le = l * NEXP + j / 512, r = j % 512, nb = r / 16, kb = r % 16; const int n = nb * 64 + n4;
        const int pn = n >> 8, jj = n & 255; const int col = jj < 128 ? pn * 128 + jj : 1024 + pn * 128 + (jj - 128);
        conv_item(c.w_gate_up + (size_t)le * D * 2048, 2048, col, kb * 64, WSP(bf16_t, WS_WGU) + ((size_t)le * 2048 + n) * D + kb * 64, D, kq, c.norm2_w + (size_t)l * D);
    } else { const int j = it - E5, le = l * NEXP + j / 256, r = j % 256, nb = r / 16, kb = r % 16; const int n = nb * 64 + n4;
        conv_item(c.w_down + (size_t)le * D * D, D, n, kb * 64, WSP(bf16_t, WS_WD) + ((size_t)le * D + n) * D + kb * 64, D, kq);
    }
}
__device__ __forceinline__ bool conv_is_early(const int it) { return it < 112 * 16 || (it >= 112 * 16 + 16 * 32 + 16 * 16 && it < 112 * 16 + 16 * 32 + 16 * 16 + 2 * 4 * 32); }
__device__ __forceinline__ void conv_layer_early(const Ctx& c, const int l, const int widx, const int nw) {
    for (int it = widx; it < 112 * 16; it += nw) conv_one(c, l, it);
    for (int it = 112 * 16 + 16 * 32 + 16 * 16 + widx; it < 112 * 16 + 16 * 32 + 16 * 16 + 2 * 4 * 32; it += nw) conv_one(c, l, it);
}
__device__ __forceinline__ void phase_prologue(const Ctx& c) {
    const int lane = c.lane, gw = c.gw, NW = c.G * NWAVES;
    conv_layer_early(c, 0, gw, NW);
    const int gtid = blockIdx.x * NTHREADS + c.tid, NT = c.G * NTHREADS;
    for (int pos = gw; pos < SEQ; pos += NW) {
#pragma unroll
        for (int pass = 0; pass < 2; ++pass) {
            if (pass == 1 && lane >= 8) break;
            const int j = pass == 0 ? lane : 64 + lane;
            float inv; if (j < 64) inv = powf(10000.0f, -(float)(2 * j) / 128.0f); else inv = powf(500000.0f, -(float)(2 * (j - 64)) / 16.0f);
            const float ang = (float)pos * inv;
            double rev = (double)ang * 0.15915494309189535; rev -= floor(rev);
            const float rv = (float)rev; const float sn = __builtin_amdgcn_sinf(rv), cs = __builtin_amdgcn_cosf(rv);
            if (j < 64) { float* t = WSP(float, WS_ROPER) + ((size_t)pos * 64 + j) * 2; t[0] = cs; t[1] = sn; }
            else { float* t = WSP(float, WS_ROPEN) + ((size_t)pos * 8 + (j - 64)) * 2; t[0] = cs; t[1] = sn; }
        }
    }
    for (int u = blockIdx.x + c.wave * c.G; u < NL * 2 * 16 * 8; u += c.G * NWAVES) {
        const int kh = u & 7, lk = u >> 7, n = ((u >> 3) & 15) * 16 + (lane & 15), k0 = kh * 256 + (lane >> 4) * 64;
        const float* pe = c.cmp_pos + (size_t)lk * 2048 + k0; const float* w1 = c.cmp_w1 + ((size_t)lk * 2048 + k0) * 256 + n;
        float s0 = 0.f, s1 = 0.f, s2 = 0.f, s3 = 0.f;
#pragma unroll 4
        for (int k = 0; k < 64; k += 4) { s0 += pe[k] * w1[(size_t)k * 256]; s1 += pe[k + 1] * w1[(size_t)(k + 1) * 256]; s2 += pe[k + 2] * w1[(size_t)(k + 2) * 256]; s3 += pe[k + 3] * w1[(size_t)(k + 3) * 256]; }
        float s = (s0 + s1) + (s2 + s3);
        s += __shfl_xor(s, 16); s += __shfl_xor(s, 32);
        if (lane < 16) WSP(float, WS_PEB)[kh * (NL * 2 * 256) + lk * 256 + n] = s;
    }
    for (int i = gtid; i < NL * 32 * 2 * 64 * 8; i += NT) {
        const int j = i & 7, ln = (i >> 3) & 63, nt = (i >> 9) & 1, ks = (i >> 10) & 31, l = i >> 15;
        const int fr_ = ln & 15, fq_ = ln >> 4, k = 32 * ks + (j < 4 ? 4 * fq_ + j : 16 + 4 * fq_ + (j - 4)), e = 16 * nt + fr_;
        const float w = c.norm2_w[(size_t)l * D + k] * c.router_w[((size_t)l * D + k) * NEXP + e];
        const unsigned hi = f2bf(w); const float wl = w - __uint_as_float(hi << 16);
        bf16_t* dst = WSP(bf16_t, WS_RWF) + ((((size_t)l * 32 + ks) * 2 + nt) * 2) * 512 + ln * 8 + j;
        dst[0] = (bf16_t)hi; dst[512] = (bf16_t)f2bf(wl);
    }
    for (int tok = gw; tok < NTOK; tok += NW) rms_row_to_h(c.x_in + (size_t)tok * D, c.norm1_w, WSP(bf16_t, WS_H) + (size_t)tok * D, lane);
}

constexpr float SM_SCALE_L2 = 0.125f * 1.4426950408889634f;
__device__ __forceinline__ void phase_prep(const Ctx& c, int l) {
    const int lane = c.lane, gw = c.gw, NW = c.G * NWAVES;
    const bf16_t* proj = WSP(bf16_t, WS_PROJ);
    const float* ropeR = WSP(float, WS_ROPER); const float* ropeN = WSP(float, WS_ROPEN);
    const float* qkw = c.qk_norm_w + (size_t)l * 4 * 64;
    for (int tok = gw; tok < NTOK; tok += NW) {
        const int b = tok / SEQ, s = tok % SEQ; const bf16_t* pr = proj + (size_t)tok * NPROJ;
        const int job = lane >> 3, l8 = lane & 7, isk = job >> 2;
        const bf16_t* src1 = pr + (isk ? C_RK : C_RQ) + (job & 3) * 128 + 8 * l8;
        const u32x4 a_w1 = *(const u32x4*)src1, a_w2 = *(const u32x4*)(src1 + 64);
        f32x4 a_cs[4];
#pragma unroll
        for (int j = 0; j < 4; ++j) a_cs[j] = *(const f32x4*)(ropeR + ((size_t)s * 64 + 8 * l8) * 2 + 4 * j);
        const bf16_t* src2 = pr + C_NQ + (lane >> 2) * 64 + (lane & 3) * 16;
        const u32x4 b_w0 = *(const u32x4*)src2, b_w1 = *(const u32x4*)(src2 + 8);
        f32x4 rn[4];
#pragma unroll
        for (int j = 0; j < 4; ++j) rn[j] = *(const f32x4*)(ropeN + (size_t)s * 16 + 4 * j);
        u32x4 c_w0 = {0u, 0u, 0u, 0u}, c_w1 = {0u, 0u, 0u, 0u};
        if (lane < 16) { const int hh = lane >> 2, part = lane & 3; const bf16_t* src = pr + ((hh >> 1) ? C_KW : C_KS) + (hh & 1) * 64 + part * 16; c_w0 = *(const u32x4*)src; c_w1 = *(const u32x4*)(src + 8); }
        else if (lane < 48) { const int q = lane - 16, isv = q >> 4, r = q & 15; c_w0 = *(const u32x4*)(pr + (isv ? C_VC : C_KC) + (r >> 3) * 64 + (r & 7) * 8); }
        {
            const int h = job & 3;
            const u32x4 w1 = a_w1, w2 = a_w2;
            const float ksc = isk ? 0.08838834764831845f : 1.0f;
            u32x4 o1, o2;
#pragma unroll
            for (int j = 0; j < 4; ++j) { const f32x4 cs = a_cs[j];
                const float a1 = bflo(w1[j]), a2 = bflo(w2[j]), b1 = bfhi(w1[j]), b2 = bfhi(w2[j]);
                o1[j] = pk2((a1 * cs[0] - a2 * cs[1]) * ksc, (b1 * cs[2] - b2 * cs[3]) * ksc);
                o2[j] = pk2((a1 * cs[1] + a2 * cs[0]) * ksc, (b1 * cs[3] + b2 * cs[2]) * ksc); }
            bf16_t* dst = WSP(bf16_t, isk ? WS_KR : WS_QR) + ((size_t)(b * 4 + h) * SEQ + s) * 128 + 8 * l8;
            *(u32x4*)dst = o1; *(u32x4*)(dst + 64) = o2;
        }
        {
            const int head = lane >> 2, part = lane & 3;
            const u32x4 w0 = b_w0, w1 = b_w1; float v[16];
#pragma unroll
            for (int j = 0; j < 4; ++j) { v[2 * j] = bflo(w0[j]); v[2 * j + 1] = bfhi(w0[j]); v[8 + 2 * j] = bflo(w1[j]); v[8 + 2 * j + 1] = bfhi(w1[j]); }
            float ss = 0.f;
#pragma unroll
            for (int j = 0; j < 16; ++j) ss += v[j] * v[j];
            ss += __shfl_xor(ss, 1); ss += __shfl_xor(ss, 2);
            const float rs = rsqrtf(ss * (1.0f / 64.0f) + NORM_EPS);
#pragma unroll
            for (int j = 0; j < 16; ++j) v[j] = v[j] * (rs * SM_SCALE_L2) * qkw[0 * 64 + part * 16 + j];
            if (part == 0) {
#pragma unroll
                for (int i = 0; i < 8; ++i) { const float cc = rn[i >> 1][(i & 1) * 2], sc = rn[i >> 1][(i & 1) * 2 + 1]; const float x1 = v[i], x2 = v[i + 8]; v[i] = x1 * cc - x2 * sc; v[i + 8] = x1 * sc + x2 * cc; }
            }
            u32x4 o0, o1;
#pragma unroll
            for (int j = 0; j < 4; ++j) { o0[j] = pk2(v[2 * j], v[2 * j + 1]); o1[j] = pk2(v[8 + 2 * j], v[8 + 2 * j + 1]); }
            bf16_t* dst = WSP(bf16_t, WS_QN) + ((size_t)tok * 16 + head) * 64 + part * 16;
            *(u32x4*)dst = o0; *(u32x4*)(dst + 8) = o1;
        }
        if (lane < 16) {
            const int hh = lane >> 2, part = lane & 3, isw = hh >> 1, g = hh & 1;
            const u32x4 w0 = c_w0, w1 = c_w1; float v[16];
#pragma unroll
            for (int j = 0; j < 4; ++j) { v[2 * j] = bflo(w0[j]); v[2 * j + 1] = bfhi(w0[j]); v[8 + 2 * j] = bflo(w1[j]); v[8 + 2 * j + 1] = bfhi(w1[j]); }
            float ss = 0.f;
#pragma unroll
            for (int j = 0; j < 16; ++j) ss += v[j] * v[j];
            ss += __shfl_xor(ss, 1); ss += __shfl_xor(ss, 2);
            const float rs = rsqrtf(ss * (1.0f / 64.0f) + NORM_EPS);
            const float* w = qkw + (isw ? 3 : 2) * 64 + part * 16;
#pragma unroll
            for (int j = 0; j < 16; ++j) v[j] = v[j] * rs * w[j];
            if (part == 0) {
#pragma unroll
                for (int i = 0; i < 8; ++i) { const float cc = rn[i >> 1][(i & 1) * 2], sc = rn[i >> 1][(i & 1) * 2 + 1]; const float x1 = v[i], x2 = v[i + 8]; v[i] = x1 * cc - x2 * sc; v[i + 8] = x1 * sc + x2 * cc; }
            }
            u32x4 o0, o1;
#pragma unroll
            for (int j = 0; j < 4; ++j) { o0[j] = pk2(v[2 * j], v[2 * j + 1]); o1[j] = pk2(v[8 + 2 * j], v[8 + 2 * j + 1]); }
            bf16_t* dst = WSP(bf16_t, isw ? WS_KW : WS_KS) + ((((size_t)(b * 2 + g) * 128 + (s >> 6)) * 4 + ((s >> 4) & 3)) * 2 + (part >> 1)) * 512 + ((2 * (part & 1)) * 16 + (s & 15)) * 8;
            *(u32x4*)dst = o0; *(u32x4*)(dst + 128) = o1;
        } else if (lane < 48) {
            const int q = lane - 16, isv = q >> 4, r = q & 15, g = r >> 3, part = r & 7;
            const u32x4 w = c_w0;
            *(u32x4*)(WSP(bf16_t, isv ? WS_VCT : WS_KCT) + ((size_t)(b * 2 + g) * SEQ + s) * 64 + part * 8) = w;
        }
    }
    const float lgam[4] = {log2f(1.0f - 1.0f / 32.0f), log2f(1.0f - 1.0f / 64.0f), log2f(1.0f - 1.0f / 128.0f), log2f(1.0f - 1.0f / 256.0f)};
    LAS bf16_t* tile = (LAS bf16_t*)(c.lds + c.wave * 8192);
    for (int grp = gw; grp < NTOK / 8; grp += NW) {
        const int tok0 = grp * 8, b = tok0 / SEQ, s0 = tok0 % SEQ; const bf16_t* pr = proj + (size_t)tok0 * NPROJ;
        u32x4 R[8];
#define PREP_LDG(col0) do { _Pragma("unroll") for (int _t = 0; _t < 8; ++_t) R[_t] = *(const u32x4*)(pr + (size_t)_t * NPROJ + (col0) + lane * 8); } while (0)
#define PREP_STL() do { _Pragma("unroll") for (int _t = 0; _t < 8; ++_t) *(LAS u32x4*)(tile + _t * 512 + lane * 8) = R[_t]; } while (0)
#define PREP_COL8(cc, w) do { unsigned short _v[8]; _Pragma("unroll") for (int _t = 0; _t < 8; ++_t) _v[_t] = tile[_t * 512 + (cc)]; \
        (w).x = _v[0] | ((unsigned)_v[1] << 16); (w).y = _v[2] | ((unsigned)_v[3] << 16); (w).z = _v[4] | ((unsigned)_v[5] << 16); (w).w = _v[6] | ((unsigned)_v[7] << 16); } while (0)
        PREP_LDG(C_RK);
        float cs[8], sn[8];
#pragma unroll
        for (int t = 0; t < 8; ++t) { const f32x2 tb = *(const f32x2*)(ropeR + ((size_t)(s0 + t) * 64 + lane) * 2); cs[t] = tb[0]; sn[t] = tb[1]; }
        PREP_STL(); PREP_LDG(C_RV);
        {
#pragma unroll
            for (int h = 0; h < 4; ++h) { float o1[8], o2[8];
#pragma unroll
                for (int t = 0; t < 8; ++t) { const float k1 = bf2f(tile[t * 512 + h * 128 + lane]), k2 = bf2f(tile[t * 512 + h * 128 + 64 + lane]);
                    const float z = fexp2(lgam[h] * (float)(127 - ((s0 + t) & 127))) * 0.08838834764831845f;
                    o1[t] = (k1 * cs[t] - k2 * sn[t]) * z; o2[t] = (k1 * sn[t] + k2 * cs[t]) * z; }
                u32x4 w1, w2;
#pragma unroll
                for (int j = 0; j < 4; ++j) { w1[j] = pk2(o1[2 * j], o1[2 * j + 1]); w2[j] = pk2(o2[2 * j], o2[2 * j + 1]); }
                { const int tk = s0 & 127, q = tk & 31, fqa = (q & 15) >> 2, jb = q >= 16 ? 4 : 0;
                  bf16_t* base = WSP(bf16_t, WS_KZT) + ((((size_t)(b * 4 + h) * 64 + (s0 >> 7)) * 8) * 4 + (tk >> 5)) * 512 + (fqa * 16 + (lane & 15)) * 8 + jb;
                  bf16_t* d1 = base + (size_t)(lane >> 4) * 2048, *d2 = base + (size_t)(4 + (lane >> 4)) * 2048;
                  u32x2 a; a.x = w1.x; a.y = w1.y; *(u32x2*)d1 = a; a.x = w1.z; a.y = w1.w; *(u32x2*)(d1 + 128) = a;
                  a.x = w2.x; a.y = w2.y; *(u32x2*)d2 = a; a.x = w2.z; a.y = w2.w; *(u32x2*)(d2 + 128) = a; } }
        }
#pragma unroll
        for (int hf = 0; hf < 2; ++hf) {
            PREP_STL();
            if (hf == 0) PREP_LDG(C_RV + 512);
            else {
#pragma unroll
                for (int _t = 0; _t < 8; ++_t) if (lane < 32) R[_t] = *(const u32x4*)(pr + (size_t)_t * NPROJ + ((lane >> 4) ? C_VW : C_VS) + (lane & 15) * 8);
            }
#pragma unroll
            for (int i = 0; i < 8; ++i) { const int cc = i * 64 + lane; u32x4 w; PREP_COL8(cc, w);
                { const int ch_ = hf * 512 + cc, hh = ch_ >> 8, dv = ch_ & 255, tk = s0 & 127, q = tk & 31, fqa = (q & 15) >> 2, jb = q >= 16 ? 4 : 0;
                  bf16_t* d = WSP(bf16_t, WS_VT) + (((((size_t)(b * 4 + hh) * 64 + (s0 >> 7)) * 4 + (tk >> 5)) * 16 + (dv >> 4)) * 64 + fqa * 16 + (dv & 15)) * 8 + jb;
                  u32x2 a; a.x = w.x; a.y = w.y; *(u32x2*)d = a; a.x = w.z; a.y = w.w; *(u32x2*)(d + 128) = a; } }
        }
        {
#pragma unroll
            for (int _t = 0; _t < 8; ++_t) { const int piece = lane >> 4, off = (lane & 15) * 8;
                if (lane < 32) *(LAS u32x4*)(tile + _t * 512 + piece * 128 + off) = R[_t]; }
#pragma unroll
            for (int i = 0; i < 4; ++i) { const int isw = i >> 1, g = i & 1; u32x4 w; PREP_COL8(isw * 128 + g * 64 + lane, w);
                const int q = s0 & 31; bf16_t* dst = WSP(bf16_t, isw ? WS_VWT : WS_VST) + ((((size_t)(b * 2 + g) * 128 + (s0 >> 6)) * 2 + ((s0 >> 5) & 1)) * 4 + (lane >> 4)) * 512 + ((((q & 15) >> 2)) * 16 + (lane & 15)) * 8 + (q >= 16 ? 4 : 0);
                u32x2 w0, w1; w0.x = w.x; w0.y = w.y; w1.x = w.z; w1.y = w.w; *(u32x2*)dst = w0; *(u32x2*)(dst + 128) = w1; }
        }
#undef PREP_LDG
#undef PREP_STL
#undef PREP_COL8
    }
}

__device__ __forceinline__ void phase_cmp2(const Ctx& c, int l) {
    const int lane = c.lane, gw = c.gw, NW = c.G * NWAVES;
    const float* ropeN = WSP(float, WS_ROPEN);
    for (int r0 = 0; r0 < 2 * 8 * 512; r0 += c.G * 32) {
        const int rowb = r0 + blockIdx.x * 32 + c.wave * 4; if (rowb >= 2 * 8 * 512) break;
        const int kv = rowb >> 12, bg = (rowb >> 9) & 7;
        const float* w2 = c.cmp_w2 + ((size_t)l * 2 + kv) * 256 * 64 + lane;
        LAS float* hl = (LAS float*)(c.lds + c.wave * 4096);
        { const float* sl = WSP(float, WS_ACT) + (size_t)rowb * 256 + lane * 4; f32x4 pb = *(const f32x4*)(WSP(float, WS_PEB) + (size_t)l * 512 + kv * 256 + lane * 4);
#pragma unroll
          for (int kh = 1; kh < 8; ++kh) pb += *(const f32x4*)(WSP(float, WS_PEB) + (size_t)kh * (NL * 2 * 256) + (size_t)l * 512 + kv * 256 + lane * 4);
#pragma unroll
          for (int rr = 0; rr < 4; ++rr) { f32x4 a = pb;
#pragma unroll
              for (int q = 0; q < 8; ++q) a += *(const f32x4*)(sl + (size_t)q * 8192 * 256 + rr * 256);
#pragma unroll
              for (int j = 0; j < 4; ++j) { const float x = a[j]; const float t = 0.7978845608028654f * (x + 0.044715f * x * x * x);
                  const float th = 1.0f - 2.0f * frcp(1.0f + fexp2(2.8853900817779268f * t)); a[j] = 0.5f * x * (1.0f + th); }
              *(LAS f32x4*)(hl + rr * 256 + lane * 4) = a; } }
        float acc4[4] = {0.f, 0.f, 0.f, 0.f};
#pragma unroll 1
        for (int k0 = 0; k0 < 256; k0 += 32) {
            float wv[32];
#pragma unroll
            for (int i = 0; i < 32; ++i) wv[i] = w2[(size_t)(k0 + i) * 64];
#pragma unroll
            for (int i = 0; i < 32; i += 2) {
#pragma unroll
                for (int rr = 0; rr < 4; ++rr) { const f32x2 hw = *(const LAS f32x2*)(hl + rr * 256 + k0 + i); acc4[rr] += hw[0] * wv[i] + hw[1] * wv[i + 1]; } }
        }
#pragma unroll
        for (int rr = 0; rr < 4; ++rr) {
            const int n = (rowb + rr) & 511; const float acc = acc4[rr];
            if (kv == 0) {
                const float ss = wave_sum(acc * acc); float v = acc * rsqrtf(ss * (1.0f / 64.0f) + NORM_EPS) * c.qk_norm_w[(size_t)l * 256 + 64 + lane];
                const float other = __shfl_xor(v, 8);
                int pos = 16 * n + 31; if (pos > SEQ - 1) pos = SEQ - 1;
                if (lane < 16) { const int i = lane & 7; const float cc = ropeN[((size_t)pos * 8 + i) * 2], sc = ropeN[((size_t)pos * 8 + i) * 2 + 1];
                    v = lane < 8 ? v * cc - other * sc : other * sc + v * cc; }
                WSP(bf16_t, WS_KCMP)[((((size_t)bg * 8 + (n >> 6)) * 4 + ((n >> 4) & 3)) * 2 + (lane >> 5)) * 512 + (((lane >> 3) & 3) * 16 + (n & 15)) * 8 + (lane & 7)] = (bf16_t)f2bf(v);
            } else {
                const int q = n & 31; WSP(bf16_t, WS_VCMPT)[((((size_t)bg * 8 + (n >> 6)) * 2 + ((n >> 5) & 1)) * 4 + (lane >> 4)) * 512 + (((q & 15) >> 2) * 16 + (lane & 15)) * 8 + (q >= 16 ? 4 : 0) + (q & 3)] = (bf16_t)(n < 511 ? f2bf(acc) : 0u);
            }
        }
    }
}

__device__ __forceinline__ void phase_scan(const Ctx& c) {
    const int lane = c.lane, w = c.wave, fr = lane & 15, fq = lane >> 4;
    for (int it0 = blockIdx.x; it0 < 256; it0 += c.G) {
        const int it = (c.G == 256) ? ((it0 & 7) * 32 + (it0 >> 3)) : it0;
        const int bh = it >> 4, dvs = it & 15, h = bh & 3;
        const float cdec = fexp2(log2f(1.0f - fexp2(-5.0f - (float)h)) * 128.0f);
        const bf16_t* kz = WSP(bf16_t, WS_KZT) + ((size_t)bh * 64 * 8 + w) * 2048 + lane * 8;
        const bf16_t* vt = WSP(bf16_t, WS_VT) + ((size_t)bh * 64 * 64 + dvs) * 512 + lane * 8;
        bf16_t* rt = WSP(bf16_t, WS_RT) + ((((size_t)bh * 64) * 16 + dvs) * 4 + (w >> 1)) * 512 + ((2 * (w & 1) + (fq >> 1)) * 16 + fr) * 8 + 4 * (fq & 1);
        f32x4 acc = {0.f, 0.f, 0.f, 0.f};
        bf16x8 kf[2][4];
        u32x2 st[64];
        const bf16_t* vt0 = WSP(bf16_t, WS_VT) + ((size_t)bh * 64 * 64 + dvs) * 512 + lane * 8;
#define SCAN_VBATCH(b) do { _Pragma("unroll") for (int _i = 0; _i < 8; ++_i) { const int _blk = w * 8 + _i; \
            __builtin_amdgcn_global_load_lds((const unsigned*)(vt0 + (size_t)(16 * (b) + (_blk >> 2)) * 32768 + (_blk & 3) * 8192), (LAS unsigned*)(c.lds + ((b) & 1) * 65536 + _blk * 1024), 16, 0, 0); } } while (0)
        SCAN_VBATCH(0);
#pragma unroll
        for (int u = 0; u < 2; ++u)
#pragma unroll
            for (int ks = 0; ks < 4; ++ks) kf[u][ks] = ld8(kz + (size_t)u * 16384 + ks * 512);
#pragma unroll
        for (int ch = 0; ch < 64; ++ch) {
            const int u = ch & 1;
            if ((ch & 15) == 0) { asm volatile("s_waitcnt vmcnt(0)" ::: "memory"); __builtin_amdgcn_s_barrier(); asm volatile("" ::: "memory");
                if (ch + 16 < 64) SCAN_VBATCH((ch >> 4) + 1); }
            st[ch].x = pk2(acc[0], acc[1]); st[ch].y = pk2(acc[2], acc[3]);
            acc *= cdec;
            const LAS unsigned char* vb = c.lds + ((ch >> 4) & 1) * 65536 + (ch & 15) * 4096 + lane * 16;
#pragma unroll
            for (int ks = 0; ks < 4; ++ks) acc = mfma16(kf[u][ks], *(const LAS bf16x8*)(vb + ks * 1024), acc);
            if (ch + 2 < 64) {
#pragma unroll
                for (int ks = 0; ks < 4; ++ks) kf[u][ks] = ld8(kz + (size_t)(ch + 2) * 16384 + ks * 512);
            }
        }
#undef SCAN_VBATCH
        MFMA_FENCE();
#pragma unroll
        for (int ch = 0; ch < 64; ++ch) *(u32x2*)(rt + (size_t)ch * 32768) = st[ch];
    }
}

#define SH_BAR() do { asm volatile("" ::: "memory"); __builtin_amdgcn_s_barrier(); asm volatile("" ::: "memory"); } while (0)
#define SH_WAIT_BAR() do { asm volatile("s_waitcnt vmcnt(0)" ::: "memory"); __builtin_amdgcn_s_barrier(); asm volatile("" ::: "memory"); } while (0)
__device__ __forceinline__ void phase_retout(const Ctx& c, int l) {
    const int lane = c.lane, wave = c.wave, fr = lane & 15, fq = lane >> 4;
    const bf16_t* proj = WSP(bf16_t, WS_PROJ);
    LAS unsigned char* lv = c.lds;
    LAS unsigned char* lr = c.lds + 65536;
    for (int u = blockIdx.x; u < 16 * 64; u += c.G) {
        const int qt = wave, ch = u & 63, bh = u >> 6, b = bh >> 2, h = bh & 3;
        const float lg = log2f(1.0f - fexp2(-5.0f - (float)h));
        const bf16_t* Q = WSP(bf16_t, WS_QR) + ((size_t)bh * SEQ + ch * 128) * 128;
        const bf16_t* Kp = WSP(bf16_t, WS_KR) + ((size_t)bh * SEQ + ch * 128) * 128;
        const bf16_t* VTp = WSP(bf16_t, WS_VT) + ((size_t)(bh * 64 + ch)) * 32768;
        const bf16_t* RTp = WSP(bf16_t, WS_RT) + ((size_t)(bh * 64 + ch)) * 32768;
        SH_BAR();
#pragma unroll
        for (int i = 0; i < 8; ++i) {
            __builtin_amdgcn_global_load_lds((const unsigned*)(VTp + (size_t)(wave * 8 + i) * 512 + lane * 8), (LAS unsigned*)(lv + (wave * 8 + i) * 1024), 16, 0, 0);
            __builtin_amdgcn_global_load_lds((const unsigned*)(RTp + (size_t)(wave * 8 + i) * 512 + lane * 8), (LAS unsigned*)(lr + (wave * 8 + i) * 1024), 16, 0, 0);
        }
        const int n = 16 * qt + fr;
        bf16x8 qf[4], qs[4];
        const float xi = fexp2(lg * (float)(n + 1));
#pragma unroll
        for (int ks = 0; ks < 4; ++ks) { const u32x4 w = *(const u32x4*)(Q + (size_t)n * 128 + 32 * ks + 8 * fq); qf[ks] = mk8(w);
            u32x4 s;
#pragma unroll
            for (int j = 0; j < 4; ++j) s[j] = pk2(bflo(w[j]) * xi, bfhi(w[j]) * xi);
            qs[ks] = mk8(s); }
        const size_t tok = (size_t)b * SEQ + ch * 128 + n;
        const bf16_t* gp = proj + tok * NPROJ + C_RG + h * 256 + 4 * fq; const float* gw_ = c.ret_gn_w + (size_t)l * 1024 + h * 256 + 4 * fq;
        u32x2 gv[16];
#pragma unroll
        for (int dt = 0; dt < 16; ++dt) gv[dt] = *(const u32x2*)(gp + 16 * dt);
        bf16x8 kk[8];
#pragma unroll
        for (int ks = 0; ks < 4; ++ks) { kk[ks] = ld8(Kp + (size_t)fr * 128 + 32 * ks + 8 * fq); kk[4 + ks] = ld8(Kp + (size_t)((qt >= 1 ? 16 : 0) + fr) * 128 + 32 * ks + 8 * fq); }
        f32x4 o[16];
#pragma unroll
        for (int dt = 0; dt < 16; ++dt) o[dt] = (f32x4){0.f, 0.f, 0.f, 0.f};
        SH_WAIT_BAR();
        for (int p = 0; p <= (qt >> 1); ++p) {
            f32x4 s0 = {0.f, 0.f, 0.f, 0.f}, s1 = {0.f, 0.f, 0.f, 0.f};
            const bool two = (2 * p + 1 <= qt);
#pragma unroll
            for (int ks = 0; ks < 4; ++ks) s0 = mfma16(kk[ks], qf[ks], s0);
#pragma unroll
            for (int ks = 0; ks < 4; ++ks) s1 = mfma16(kk[4 + ks], qf[ks], s1);
            MFMA_FENCE();
            if (p + 1 <= (qt >> 1)) {
                const bool two_n = (2 * (p + 1) + 1 <= qt);
#pragma unroll
                for (int ks = 0; ks < 4; ++ks) { kk[ks] = ld8(Kp + (size_t)(32 * (p + 1) + fr) * 128 + 32 * ks + 8 * fq); kk[4 + ks] = ld8(Kp + (size_t)(32 * (p + 1) + (two_n ? 16 : 0) + fr) * 128 + 32 * ks + 8 * fq); }
            }
#pragma unroll
            for (int r = 0; r < 4; ++r) { const int d0 = n - (32 * p + 4 * fq + r), d1 = d0 - 16;
                s0[r] = d0 >= 0 ? s0[r] * fexp2(lg * (float)d0) : 0.f; s1[r] = (two && d1 >= 0) ? s1[r] * fexp2(lg * (float)d1) : 0.f; }
            u32x4 pw; pw.x = pk2(s0[0], s0[1]); pw.y = pk2(s0[2], s0[3]); pw.z = pk2(s1[0], s1[1]); pw.w = pk2(s1[2], s1[3]);
            const bf16x8 pb = mk8(pw);
#pragma unroll
            for (int dt = 0; dt < 16; ++dt) o[dt] = mfma16(*(const LAS bf16x8*)(lv + (p * 16 + dt) * 1024 + lane * 16), pb, o[dt]);
            MFMA_FENCE();
        }
#pragma unroll
        for (int dt = 0; dt < 16; ++dt)
#pragma unroll
            for (int ks = 0; ks < 4; ++ks) o[dt] = mfma16(*(const LAS bf16x8*)(lr + (dt * 4 + ks) * 1024 + lane * 16), qs[ks], o[dt]);
        float s = 0.f;
#pragma unroll
        for (int dt = 0; dt < 16; ++dt) s += (o[dt][0] + o[dt][1]) + (o[dt][2] + o[dt][3]);
        s += __shfl_xor(s, 16); s += __shfl_xor(s, 32);
        const float mu = s * (1.0f / 256.0f); float q = 0.f;
#pragma unroll
        for (int dt = 0; dt < 16; ++dt)
#pragma unroll
            for (int r = 0; r < 4; ++r) { const float d = o[dt][r] - mu; q += d * d; }
        q += __shfl_xor(q, 16); q += __shfl_xor(q, 32);
        const float rstd = rsqrtf(q * (1.0f / 256.0f) + NORM_EPS);
        bf16_t* op = WSP(bf16_t, WS_RA) + tok * 2048 + h * 256 + 4 * fq;
#pragma unroll
        for (int dt = 0; dt < 16; ++dt) { const f32x4 wv = *(const f32x4*)(gw_ + 16 * dt);
            float g[4] = {bflo(gv[dt].x), bfhi(gv[dt].x), bflo(gv[dt].y), bfhi(gv[dt].y)}; float r_[4];
#pragma unroll
            for (int r = 0; r < 4; ++r) r_[r] = (o[dt][r] - mu) * rstd * wv[r] * g[r] * sigmoidf_(g[r]);
            u32x2 ov; ov.x = pk2(r_[0], r_[1]); ov.y = pk2(r_[2], r_[3]); *(u32x2*)(op + 16 * dt) = ov; }
    }
    SH_BAR();
}

__device__ __forceinline__ void attn_step_lds(const LAS unsigned char* slot, const bf16x8 (&qf)[2], const int key0, const int hiK, const int loK, const bool colok, const bool allok, const bool full,
                                              f32x4 (&O)[4], float& lsum, const int lane, const int fq) {
    bf16x8 kv[8];
#pragma unroll
    for (int i = 0; i < 8; ++i) kv[i] = *(const LAS bf16x8*)(slot + i * 1024 + lane * 16);
    f32x4 s[4];
    __builtin_amdgcn_s_setprio(1);
#pragma unroll
    for (int kt = 0; kt < 4; ++kt) { s[kt] = (f32x4){0.f, 0.f, 0.f, 0.f};
#pragma unroll
        for (int ks = 0; ks < 2; ++ks) s[kt] = mfma16(kv[kt * 2 + ks], qf[ks], s[kt]); }
    __builtin_amdgcn_s_setprio(0);
#pragma unroll
    for (int i = 0; i < 8; ++i) kv[i] = *(const LAS bf16x8*)(slot + 8192 + i * 1024 + lane * 16);
    float ps = 0.f;
    if (full) {
        if (allok) {
#pragma unroll
            for (int kt = 0; kt < 4; ++kt)
#pragma unroll
                for (int r = 0; r < 4; ++r) { const float p = fexp2(s[kt][r]); s[kt][r] = p; ps += p; }
        } else {
#pragma unroll
            for (int kt = 0; kt < 4; ++kt)
#pragma unroll
                for (int r = 0; r < 4; ++r) { const float p = colok ? fexp2(s[kt][r]) : 0.f; s[kt][r] = p; ps += p; }
        }
    } else {
#pragma unroll
        for (int kt = 0; kt < 4; ++kt)
#pragma unroll
            for (int r = 0; r < 4; ++r) { const int key = key0 + 16 * kt + 4 * fq + r; const bool ok = colok && (key <= hiK) && (key > loK);
                const float p = ok ? fexp2(s[kt][r]) : 0.f; s[kt][r] = p; ps += p; }
    }
    lsum += ps;
#pragma unroll
    for (int p2 = 0; p2 < 2; ++p2) {
        u32x4 pw; pw.x = pk2(s[2 * p2][0], s[2 * p2][1]); pw.y = pk2(s[2 * p2][2], s[2 * p2][3]); pw.z = pk2(s[2 * p2 + 1][0], s[2 * p2 + 1][1]); pw.w = pk2(s[2 * p2 + 1][2], s[2 * p2 + 1][3]);
        const bf16x8 pb = mk8(pw);
        __builtin_amdgcn_s_setprio(1);
#pragma unroll
        for (int dt = 0; dt < 4; ++dt) O[dt] = mfma16(kv[p2 * 4 + dt], pb, O[dt]);
        __builtin_amdgcn_s_setprio(0);
    }
    MFMA_FENCE();
}
__device__ __forceinline__ int sel_pop(unsigned long long& lo, unsigned long long& hi) {
    if (lo) { const int j = __builtin_ctzll(lo); lo &= lo - 1ull; return j; }
    if (hi) { const int j = 64 + __builtin_ctzll(hi); hi &= hi - 1ull; return j; }
    return -1;
}
#define SH_SLOT(s) (shb + (s) * 16384)
#define SH_ISSUE(kbase, vbase, blk, slot, withv) do { \
        __builtin_amdgcn_global_load_lds((const unsigned*)((kbase) + (size_t)(blk) * 4096 + (wave * 64 + lane) * 8), (LAS unsigned*)(SH_SLOT(slot) + wave * 1024), 16, 0, 0); \
        if (withv) __builtin_amdgcn_global_load_lds((const unsigned*)((vbase) + (size_t)(blk) * 4096 + (wave * 64 + lane) * 8), (LAS unsigned*)(SH_SLOT(slot) + 8192 + wave * 1024), 16, 0, 0); } while (0)
#define SH_READ_K(slot) do { _Pragma("unroll") for (int _i = 0; _i < 8; ++_i) kf[_i] = *(const LAS bf16x8*)(SH_SLOT(slot) + _i * 1024 + lane * 16); } while (0)
#define SH_READ_V(slot) do { _Pragma("unroll") for (int _i = 0; _i < 8; ++_i) vf[_i] = *(const LAS bf16x8*)(SH_SLOT(slot) + 8192 + _i * 1024 + lane * 16); } while (0)
__device__ __forceinline__ void phase_nsa(const Ctx& c, const int layer, const int lconv  , const bool late0  ) {
    const int lane = c.lane, wave = c.wave, fr = lane & 15, fq = lane >> 4;
    const bf16_t* proj = WSP(bf16_t, WS_PROJ);
    volatile LAS float* imp = (volatile LAS float*)(c.lds + 131072 + wave * 2304);
    LAS unsigned char* shb = c.lds;
    const int cntot = (lconv >= 0 ? CONV_ITEMS : 0) + (late0 ? CONV_ITEMS : 0), crounds = (cntot + c.G * NWAVES - 1) / (c.G * NWAVES);
    const int cntl = (2048 + c.G - 1) / c.G, crpt = (crounds + cntl - 1) / cntl;
    volatile LAS int* qs = (volatile LAS int*)(c.lds + LDS_CTL_OFF + 256);
#define NSA_QCTR (WSP(unsigned, WS_CTL + 16384) + layer * 64)
    if (c.tid == 0) { qs[0] = (int)__hip_atomic_fetch_add(NSA_QCTR, 1u, __ATOMIC_RELAXED, __HIP_MEMORY_SCOPE_AGENT); asm volatile("s_waitcnt lgkmcnt(0)" ::: "memory"); }
    int kk = 0;
    for (;; ++kk) {
        SH_BAR();
        const int U = __builtin_amdgcn_readfirstlane(qs[kk & 1]);
        if (U >= 2048) break;
        const int bg = U >> 8; const int tl = 255 - (U & 255);
        const int b = bg >> 1, g = bg & 1, T0 = 32 * tl, curW = T0 >> 6;
        int t0[2], tcol[2]; bf16x8 qf[2][2]; float g0[2], g1[2], g2[2]; size_t tokc[2];
        const int head = g * 8 + (fr & 7);
#pragma unroll
        for (int pr = 0; pr < 2; ++pr) {
            t0[pr] = T0 + 4 * wave + 2 * pr; tcol[pr] = t0[pr] + (fr >> 3); tokc[pr] = (size_t)b * SEQ + tcol[pr];
#pragma unroll
            for (int ks = 0; ks < 2; ++ks) qf[pr][ks] = ld8(WSP(bf16_t, WS_QN) + (tokc[pr] * 16 + head) * 64 + 32 * ks + 8 * fq);
            const bf16_t* gp = proj + tokc[pr] * NPROJ + C_NG + head * 3;
            g0[pr] = sigmoidf_(bf2f(gp[0])); g1[pr] = sigmoidf_(bf2f(gp[1])); g2[pr] = sigmoidf_(bf2f(gp[2]));
        }
        f32x4 out[2][4], O[2][4]; float lsum[2];
        bf16x8 kf[8];
#define NSA_ZERO_O() do { _Pragma("unroll") for (int _p = 0; _p < 2; ++_p) { lsum[_p] = 0.f; _Pragma("unroll") for (int _d = 0; _d < 4; ++_d) O[_p][_d] = (f32x4){0.f, 0.f, 0.f, 0.f}; } } while (0)
        int nbc[2];
#pragma unroll
        for (int pr = 0; pr < 2; ++pr) { const int nv = (t0[pr] + 1 >= 31) ? ((t0[pr] + 1 - 31) >> 4) + 1 : 0; nbc[pr] = (nv + 63) >> 6; }
        const int nvW = (T0 + 31 >= 31) ? ((T0 + 31 - 31) >> 4) + 1 : 0, nbcW = (nvW + 63) >> 6;
        const bf16_t* Kc = WSP(bf16_t, WS_KCMP) + (size_t)bg * 8 * 4096; const bf16_t* Vc = WSP(bf16_t, WS_VCMPT) + (size_t)bg * 8 * 4096;
        NSA_ZERO_O();
        SH_BAR();
        int nq = 0; if (c.tid == 0) nq = (int)__hip_atomic_fetch_add(NSA_QCTR, 1u, __ATOMIC_RELAXED, __HIP_MEMORY_SCOPE_AGENT);
        for (int kb = 0; kb < nbcW; ++kb) SH_ISSUE(Kc, Vc, kb, kb, true);
        SH_WAIT_BAR();
        if (c.tid == 0) { qs[(kk + 1) & 1] = nq; asm volatile("s_waitcnt lgkmcnt(0)" ::: "memory"); }
        for (int kb = 0; kb < nbcW; ++kb) {
#pragma unroll
            for (int pr = 0; pr < 2; ++pr) if (kb < nbc[pr])
                attn_step_lds(SH_SLOT(kb), qf[pr], kb * 64, (tcol[pr] - 31) >> 4, -1, true, true, 16 * (kb * 64 + 63) + 31 <= t0[pr], O[pr], lsum[pr], lane, fq);
        }
        float il[2];
#pragma unroll
        for (int pr = 0; pr < 2; ++pr) { float l = lsum[pr]; l += __shfl_xor(l, 16); l += __shfl_xor(l, 32); il[pr] = l > 0.f ? 1.0f / l : 0.f;
#pragma unroll
            for (int dt = 0; dt < 4; ++dt) out[pr][dt] = O[pr][dt] * (g0[pr] * il[pr]); }
        for (int i = lane; i < 4 * 136; i += 64) imp[i] = 0.f;
        for (int kb = 0; kb < nbcW; ++kb) {
            if (kb < nbc[1]) {
                SH_READ_K(kb);
#pragma unroll
                for (int pr = 0; pr < 2; ++pr) if (kb < nbc[pr]) {
                    f32x4 s4[4];
#pragma unroll
                    for (int kt = 0; kt < 4; ++kt) { s4[kt] = (f32x4){0.f, 0.f, 0.f, 0.f};
#pragma unroll
                        for (int ks = 0; ks < 2; ++ks) s4[kt] = mfma16(kf[kt * 2 + ks], qf[pr][ks], s4[kt]); }
                    MFMA_FENCE();
#pragma unroll
                    for (int kt = 0; kt < 4; ++kt) {
                        float pa = 0.f, p3 = 0.f;
#pragma unroll
                        for (int r = 0; r < 4; ++r) { const int key = kb * 64 + 16 * kt + 4 * fq + r; const bool ok = (16 * key + 31 <= tcol[pr]);
                            const float p = ok ? fexp2(s4[kt][r]) * il[pr] : 0.f; pa += p; if (r == 3) p3 = p; }
                        pa = sum8(pa); p3 = sum8(p3);
                        const int jb = 4 * (4 * kb + kt) + fq, tk = pr * 2 + (fr >> 3);
                        if ((fr & 7) == 0) { (void)__hip_atomic_fetch_add((LAS float*)imp + tk * 136 + jb, pa, __ATOMIC_RELAXED, __HIP_MEMORY_SCOPE_WORKGROUP);
                            (void)__hip_atomic_fetch_add((LAS float*)imp + tk * 136 + jb + 1, p3, __ATOMIC_RELAXED, __HIP_MEMORY_SCOPE_WORKGROUP); }
                    }
                }
            }
        }
        unsigned long long msk[2][2][2];
        {
            bool vl[4], vh[4]; unsigned ul[4], uh[4], T[4];
#pragma unroll
            for (int tk = 0; tk < 4; ++tk) {
                const int t = T0 + 4 * wave + tk, cur = t >> 6; const int jl = lane, jh = lane + 64;
                vl[tk] = jl <= cur; vh[tk] = jh <= cur;
                const bool fl = (jl == 0) || (jl == cur) || (jl == cur - 1), fh = (jh == cur) || (jh == cur - 1);
                ul[tk] = fl ? 0x7f800000u : __float_as_uint(imp[tk * 136 + jl]); uh[tk] = fh ? 0x7f800000u : __float_as_uint(imp[tk * 136 + jh]); T[tk] = 0u;
            }
            int cT[4];
#pragma unroll
            for (int tk = 0; tk < 4; ++tk) cT[tk] = __popcll(__ballot(vl[tk])) + __popcll(__ballot(vh[tk]));
#pragma unroll 1
            for (int bit = 30; bit >= 0; --bit) {
#pragma unroll
                for (int tk = 0; tk < 4; ++tk) { const unsigned cand = T[tk] | (1u << bit);
                    const int cnt = __popcll(__ballot(vl[tk] && ul[tk] >= cand)) + __popcll(__ballot(vh[tk] && uh[tk] >= cand));
                    if (cnt >= 16) { T[tk] = cand; cT[tk] = cnt; } }
                if (cT[0] <= 16 && cT[1] <= 16 && cT[2] <= 16 && cT[3] <= 16) break;
            }
#pragma unroll
            for (int tk = 0; tk < 4; ++tk) {
                const unsigned long long gtl = __ballot(vl[tk] && ul[tk] > T[tk]), gth = __ballot(vh[tk] && uh[tk] > T[tk]);
                const unsigned long long eql = __ballot(vl[tk] && ul[tk] == T[tk]), eqh = __ballot(vh[tk] && uh[tk] == T[tk]);
                const int need = 16 - (__popcll(gtl) + __popcll(gth));
                const unsigned long long lm = (1ull << lane) - 1ull;
                const int rl = __popcll(eql & lm), rh = __popcll(eql) + __popcll(eqh & lm);
                msk[tk >> 1][tk & 1][0] = gtl | __ballot(vl[tk] && ul[tk] == T[tk] && rl < need); msk[tk >> 1][tk & 1][1] = gth | __ballot(vh[tk] && uh[tk] == T[tk] && rh < need);
            }
        }
        const bf16_t* Kw = WSP(bf16_t, WS_KW) + (size_t)bg * 128 * 4096; const bf16_t* Vw = WSP(bf16_t, WS_VWT) + (size_t)bg * 128 * 4096;
        const int loW = T0 - 511 > 0 ? T0 - 511 : 0; const int jb0W = loW >> 6, jb1W = (T0 + 31) >> 6;
        const int wbase = (((curW >> 2) + 1) & 1) * 4;
        {
            const bf16_t* Ks = WSP(bf16_t, WS_KS) + (size_t)bg * 128 * 4096; const bf16_t* Vs = WSP(bf16_t, WS_VST) + (size_t)bg * 128 * 4096;
            NSA_ZERO_O();
            unsigned long long any[2][2], mine[2][2], both[2][2];
#pragma unroll
            for (int pr = 0; pr < 2; ++pr)
#pragma unroll
                for (int h = 0; h < 2; ++h) { any[pr][h] = msk[pr][0][h] | msk[pr][1][h]; both[pr][h] = msk[pr][0][h] & msk[pr][1][h]; mine[pr][h] = (fr >> 3) ? msk[pr][1][h] : msk[pr][0][h]; }
            const int ng = (curW >> 2) + 1;
            SH_BAR();
#pragma unroll
            for (int bb = 0; bb < 4; ++bb) if (bb <= curW) SH_ISSUE(Ks, Vs, bb, bb, true);
            for (int gi = 0; gi < ng; ++gi) {
                SH_WAIT_BAR();
                if (gi + 1 < ng) {
#pragma unroll
                    for (int bb = 0; bb < 4; ++bb) if (4 * (gi + 1) + bb <= curW) SH_ISSUE(Ks, Vs, 4 * (gi + 1) + bb, ((gi + 1) & 1) * 4 + bb, true);
                } else SH_ISSUE(Kw, Vw, jb0W, ((gi + 1) & 1) * 4, true);
#pragma unroll 1
                for (int bb = 0; bb < 4; ++bb) {
                    const int j = 4 * gi + bb; if (j > curW) break;
                    const int slot = (gi & 1) * 4 + bb;
                    const bool a0 = ((j < 64 ? (any[0][0] >> j) : (any[0][1] >> (j - 64))) & 1ull) != 0ull, a1 = ((j < 64 ? (any[1][0] >> j) : (any[1][1] >> (j - 64))) & 1ull) != 0ull;
#pragma unroll
                    for (int pr = 0; pr < 2; ++pr) if (pr == 0 ? a0 : a1) {
                        const bool colok = ((j < 64 ? (mine[pr][0] >> j) : (mine[pr][1] >> (j - 64))) & 1ull) != 0ull;
                        const bool bothsel = ((j < 64 ? (both[pr][0] >> j) : (both[pr][1] >> (j - 64))) & 1ull) != 0ull;
                        attn_step_lds(SH_SLOT(slot), qf[pr], j * 64, tcol[pr], -1, colok, bothsel, j * 64 + 63 <= t0[pr], O[pr], lsum[pr], lane, fq); }
                }
            }
#pragma unroll
            for (int pr = 0; pr < 2; ++pr) { float l = lsum[pr]; l += __shfl_xor(l, 16); l += __shfl_xor(l, 32); const float sc = l > 0.f ? g1[pr] / l : 0.f;
#pragma unroll
                for (int dt = 0; dt < 4; ++dt) out[pr][dt] += O[pr][dt] * sc; }
        }
        {
            NSA_ZERO_O();
            for (int jb = jb0W; jb <= jb1W; ++jb) {
                const int slot = wbase + ((jb - jb0W) & 1);
                SH_WAIT_BAR();
                if (jb < jb1W) SH_ISSUE(Kw, Vw, jb + 1, wbase + ((jb + 1 - jb0W) & 1), true);
#pragma unroll
                for (int pr = 0; pr < 2; ++pr) { const int lo = t0[pr] - 511 > 0 ? t0[pr] - 511 : 0;
                    if (jb >= (lo >> 6) && jb <= ((t0[pr] + 1) >> 6))
                        attn_step_lds(SH_SLOT(slot), qf[pr], jb * 64, tcol[pr], tcol[pr] - 512, true, true, jb * 64 > t0[pr] + 1 - 512 && jb * 64 + 63 <= t0[pr], O[pr], lsum[pr], lane, fq); }
            }
#pragma unroll
            for (int pr = 0; pr < 2; ++pr) { float l = lsum[pr]; l += __shfl_xor(l, 16); l += __shfl_xor(l, 32); const float sc = l > 0.f ? g2[pr] / l : 0.f;
#pragma unroll
                for (int dt = 0; dt < 4; ++dt) out[pr][dt] += O[pr][dt] * sc; }
        }
#pragma unroll
        for (int pr = 0; pr < 2; ++pr) { bf16_t* op = WSP(bf16_t, WS_RA) + tokc[pr] * 2048 + 1024 + head * 64 + 4 * fq;
#pragma unroll
            for (int dt = 0; dt < 4; ++dt) { u32x2 ov; ov.x = pk2(out[pr][dt][0], out[pr][dt][1]); ov.y = pk2(out[pr][dt][2], out[pr][dt][3]); *(u32x2*)(op + 16 * dt) = ov; } }
#undef NSA_ZERO_O
        {
#pragma unroll 1
            for (int r = kk * crpt; r < (kk + 1) * crpt && r < crounds; ++r) { const int item = c.gw + r * (c.G * NWAVES);
                if (item < cntot) { const bool nx = lconv >= 0 && item < CONV_ITEMS; const int i0 = nx ? item : item - (lconv >= 0 ? CONV_ITEMS : 0);
                    if (nx || !conv_is_early(i0)) conv_one(c, nx ? lconv : 0, i0); } }
        }
    }
#pragma unroll 1
    for (int r = kk * crpt; r < crounds; ++r) { const int item = c.gw + r * (c.G * NWAVES);
        if (item < cntot) { const bool nx = lconv >= 0 && item < CONV_ITEMS; const int i0 = nx ? item : item - (lconv >= 0 ? CONV_ITEMS : 0);
            if (nx || !conv_is_early(i0)) conv_one(c, nx ? lconv : 0, i0); } }
    SH_BAR();
#undef NSA_QCTR
}

__device__ __forceinline__ void phase_route(const Ctx& c, int l) {
    const int lane = c.lane, gw = c.gw, NW = c.G * NWAVES, fr = lane & 15, fq = lane >> 4;
    LAS int* cnt = (LAS int*)(c.lds + LDS_CTL_OFF + 64);
    if (c.tid < 32) cnt[c.tid] = 0;
    for (int i = blockIdx.x * NTHREADS + c.tid; i < XROWS; i += c.G * NTHREADS) WSP(int, WS_ROWTOK)[i] = 0;
    __syncthreads();
    {
        const bf16_t* rwf = WSP(bf16_t, WS_RWF) + (size_t)l * 32 * 2 * 2 * 512 + lane * 8;
#pragma unroll
        for (int i = 0; i < 16; ++i) { const int blk = c.wave * 16 + i;
            __builtin_amdgcn_global_load_lds((const unsigned*)(rwf + (size_t)blk * 512), (LAS unsigned*)(c.lds + blk * 1024), 16, 0, 0); }
        asm volatile("s_waitcnt vmcnt(0)" ::: "memory"); __syncthreads();
    }
    const float b0 = c.router_b[(size_t)l * NEXP + fr], b1 = c.router_b[(size_t)l * NEXP + 16 + fr];
    for (int tile = gw; tile < NTOK / 16; tile += NW) {
        const int tok0 = tile * 16; const float* xr = (l == 0 ? c.x_in : (const float*)c.out) + (size_t)(tok0 + fr) * D + 4 * fq;
        const bf16_t* dr = WSP(bf16_t, WS_PROJ) + (size_t)(tok0 + fr) * D + 4 * fq;
        bf16_t* hrow = WSP(bf16_t, WS_H) + (size_t)(tok0 + fr) * D + 4 * fq;
        f32x4 acc0 = {0.f, 0.f, 0.f, 0.f}, acc1 = {0.f, 0.f, 0.f, 0.f}; float ss = 0.f;
#pragma unroll 1
        for (int kg = 0; kg < 8; ++kg) {
            f32x4 xa[4], xb[4]; u32x2 da[4], db[4]; bf16x8 wv[4][4];
#pragma unroll
            for (int u = 0; u < 4; ++u) { const int ks = kg * 4 + u; xa[u] = *(const f32x4*)(xr + 32 * ks); xb[u] = *(const f32x4*)(xr + 32 * ks + 16);
                da[u] = *(const u32x2*)(dr + 32 * ks); db[u] = *(const u32x2*)(dr + 32 * ks + 16);
#pragma unroll
                for (int q = 0; q < 4; ++q) wv[u][q] = *(const LAS bf16x8*)(c.lds + (ks * 4 + q) * 1024 + lane * 16); }
            __builtin_amdgcn_sched_barrier(0);
#pragma unroll
            for (int u = 0; u < 4; ++u) {
                float v[8] = {xa[u][0] + bflo(da[u].x), xa[u][1] + bfhi(da[u].x), xa[u][2] + bflo(da[u].y), xa[u][3] + bfhi(da[u].y),
                              xb[u][0] + bflo(db[u].x), xb[u][1] + bfhi(db[u].x), xb[u][2] + bflo(db[u].y), xb[u][3] + bfhi(db[u].y)}; float lo[8]; u32x4 hw, lw;
#pragma unroll
                for (int j = 0; j < 8; ++j) ss += v[j] * v[j];
#pragma unroll
                for (int j = 0; j < 4; ++j) { hw[j] = pk2(v[2 * j], v[2 * j + 1]); lo[2 * j] = v[2 * j] - bflo(hw[j]); lo[2 * j + 1] = v[2 * j + 1] - bfhi(hw[j]); }
#pragma unroll
                for (int j = 0; j < 4; ++j) lw[j] = pk2(lo[2 * j], lo[2 * j + 1]);
                const bf16x8 ah = mk8(hw), al = mk8(lw);
                { bf16_t* hp = hrow + 32 * (kg * 4 + u); u32x2 h0, h1; h0.x = hw[0]; h0.y = hw[1]; h1.x = hw[2]; h1.y = hw[3]; *(u32x2*)hp = h0; *(u32x2*)(hp + 16) = h1; }
                acc0 = mfma16(ah, wv[u][0], acc0); acc1 = mfma16(ah, wv[u][2], acc1);
                acc0 = mfma16(ah, wv[u][1], acc0); acc1 = mfma16(ah, wv[u][3], acc1);
                acc0 = mfma16(al, wv[u][0], acc0); acc1 = mfma16(al, wv[u][2], acc1);
            }
            MFMA_FENCE();
        }
        ss += __shfl_xor(ss, 16); ss += __shfl_xor(ss, 32);
        const float rs = rsqrtf(ss * (1.0f / 1024.0f) + NORM_EPS);
        if (fq == 0) WSP(float, WS_RSTD)[tok0 + fr] = rs;
#pragma unroll
        for (int r = 0; r < 4; ++r) {
            const float rt = __shfl(rs, 4 * fq + r);
            float v0 = acc0[r] * rt + b0, v1 = acc1[r] * rt + b1; float tv[4]; int te[4];
#pragma unroll
            for (int k = 0; k < 4; ++k) { float bv = v0; int be = fr; if (v1 > bv) { bv = v1; be = 16 + fr; }
#pragma unroll
                for (int o = 8; o >= 1; o >>= 1) { const float ov = __shfl_xor(bv, o); const int oe = __shfl_xor(be, o); if (ov > bv || (ov == bv && oe < be)) { bv = ov; be = oe; } }
                tv[k] = bv; te[k] = be; if (be == fr) v0 = -INFINITY; if (be == 16 + fr) v1 = -INFINITY; }
            const float e1 = expf(tv[1] - tv[0]), e2 = expf(tv[2] - tv[0]), e3 = expf(tv[3] - tv[0]); const float inv = 1.0f / (1.0f + e1 + e2 + e3);
            if (fr < 4) { const int e = fr == 0 ? te[0] : fr == 1 ? te[1] : fr == 2 ? te[2] : te[3]; const float wv_ = (fr == 0 ? 1.0f : fr == 1 ? e1 : fr == 2 ? e2 : e3) * inv;
                const int rk = atomicAdd((int*)&cnt[e], 1); const size_t o = (size_t)(tok0 + 4 * fq + r) * 4 + fr;
                WSP(int, WS_TE)[o] = e; WSP(float, WS_TW)[o] = wv_; WSP(int, WS_RANK)[o] = rk; }
        }
    }
    __syncthreads();
    if (c.tid < 32) WSP(int, WS_HIST)[blockIdx.x * 32 + c.tid] = cnt[c.tid];
    __syncthreads();
}

__device__ __forceinline__ void phase_scatter(const Ctx& c, int l) {
    const int lane = c.lane, gw = c.gw, NW = c.G * NWAVES;
    LAS int* hist = (LAS int*)c.lds;
    LAS int* part = (LAS int*)(c.lds + 65536);
    LAS int* base = part + 1024;
    LAS int* pst = base + 32;
    LAS int* nblk = pst + 40;
    for (int i = c.tid; i < c.G * 32; i += NTHREADS) hist[i] = WSP(int, WS_HIST)[i];
    __syncthreads();
    { const int e = c.tid & 31, p = c.tid >> 5, per = (c.G + 15) >> 4; const int w1 = (p + 1) * per < c.G ? (p + 1) * per : c.G; int before = 0, tot = 0;
      for (int w = p * per; w < w1; ++w) { const int v = hist[w * 32 + e]; if (w < (int)blockIdx.x) before += v; tot += v; }
      part[(p * 32 + e) * 2] = before; part[(p * 32 + e) * 2 + 1] = tot; }
    __syncthreads();
    if (c.tid < 32) { int before = 0, tot = 0;
#pragma unroll
        for (int p = 0; p < 16; ++p) { before += part[(p * 32 + c.tid) * 2]; tot += part[(p * 32 + c.tid) * 2 + 1]; }
        base[c.tid] = before; const int padded = (tot + 255) & ~255; int incl = padded;
#pragma unroll
        for (int o = 1; o < 32; o <<= 1) { const int t = __shfl_up(incl, o); if (c.tid >= o) incl += t; }
        pst[c.tid] = incl - padded; if (c.tid == 31) pst[32] = incl; nblk[c.tid] = padded >> 8; }
    __syncthreads();
    if (blockIdx.x == 0 && c.tid < 32) {
        int* meta = WSP(int, WS_META); const int e = c.tid, x = e & 7; int off = 0;
        for (int e2 = x; e2 < e; e2 += 8) off += nblk[e2];
        const int rb0 = pst[e] >> 8, nb = nblk[e];
        for (int i = 0; i < nb; ++i) { meta[64 + rb0 + i] = e; meta[1024 + 640 * x + off + i] = rb0 + i; }
        if (e >= 24) meta[16 + x] = off + nb;
        if (e == 0) meta[0] = pst[32] >> 8; }
    for (int tile = gw; tile < NTOK / 16; tile += NW) {
        const int o = tile * 64 + lane, tok = o >> 2;
        const int e = WSP(int, WS_TE)[o], rk = WSP(int, WS_RANK)[o];
        const int dst = pst[e] + base[e] + rk;
        WSP(int, WS_ROWTOK)[dst] = tok; WSP(float, WS_RSROW)[dst] = WSP(float, WS_RSTD)[tok]; WSP(int, WS_SLOT)[o] = dst;
    }
}

__device__ __forceinline__ void phase_combine(const Ctx& c, int l) {
    const int lane = c.lane, gw = c.gw, NW = c.G * NWAVES;
    for (int tok = gw; tok < NTOK; tok += NW) {
        float* xr = c.out + (size_t)tok * D; const bf16_t* hs = WSP(bf16_t, WS_H) + (size_t)tok * D;
        const u32x4 sl = *(const u32x4*)(WSP(int, WS_SLOT) + (size_t)tok * 4); const f32x4 tw = *(const f32x4*)(WSP(float, WS_TW) + (size_t)tok * 4);
        f32x4 v[4];
#pragma unroll
        for (int i = 0; i < 4; ++i) { const u32x2 d = *(const u32x2*)(hs + i * 256 + lane * 4); v[i][0] = bflo(d.x); v[i][1] = bfhi(d.x); v[i][2] = bflo(d.y); v[i][3] = bfhi(d.y); }
#pragma unroll
        for (int k = 0; k < 4; ++k) { const bf16_t* yr = WSP(bf16_t, WS_XBUF) + (size_t)sl[k] * D; const float w = tw[k];
#pragma unroll
            for (int i = 0; i < 4; ++i) { const u32x2 y = *(const u32x2*)(yr + i * 256 + lane * 4);
                v[i][0] += w * bflo(y.x); v[i][1] += w * bfhi(y.x); v[i][2] += w * bflo(y.y); v[i][3] += w * bfhi(y.y); } }
        float ss = 0.f;
#pragma unroll
        for (int i = 0; i < 4; ++i) { *(f32x4*)(xr + i * 256 + lane * 4) = v[i]; ss += v[i][0] * v[i][0] + v[i][1] * v[i][1] + v[i][2] * v[i][2] + v[i][3] * v[i][3]; }
        if (l + 1 < NL) {
            ss = wave_sum(ss); const float rs = rsqrtf(ss * (1.0f / 1024.0f) + NORM_EPS);
            const float* nw = c.norm1_w + (size_t)(l + 1) * D; bf16_t* hr = WSP(bf16_t, WS_H) + (size_t)tok * D;
#pragma unroll
            for (int i = 0; i < 4; ++i) { const f32x4 w = *(const f32x4*)(nw + i * 256 + lane * 4);
                u32x2 o; o.x = pk2(v[i][0] * rs * w[0], v[i][1] * rs * w[1]); o.y = pk2(v[i][2] * rs * w[2], v[i][3] * rs * w[3]); *(u32x2*)(hr + i * 256 + lane * 4) = o; }
        }
    }
}

constexpr int PH_PER_LAYER = 14, N_PHASES = 1 + NL * PH_PER_LAYER;
#ifndef PH_MASK
#define PH_MASK 0xffff
#endif
#define IN(k) (lo <= (k) && (k) < hi)
#define INL(j) (((PH_MASK >> ((j) + 1)) & 1) && IN(pb + (j)))
#define FRESH() do { int _t = threadIdx.x; asm volatile("" : "+v"(_t)); c.tid = _t; c.lane = _t & 63; c.wave = __builtin_amdgcn_readfirstlane(_t >> 6); c.gw = blockIdx.x * NWAVES + c.wave; } while (0)
#define SEAM(k) do { if (IN((k) + 1) || IN((k) + 2)) xcd_barrier(bar); else __syncthreads(); } while (0)

template <int l>
__device__ __forceinline__ void run_layer(Ctx& c, const XcdBarrier& bar, const int lo, const int hi) {
        const int pb = 1 + l * PH_PER_LAYER;
        if (INL(0)) { FRESH();
            g8::SchedPlain S{(const char*)WSP(bf16_t, WS_H), (const char*)(WSP(bf16_t, WS_WIN) + (size_t)l * NPROJ * D), (size_t)256 * D * 2, (size_t)256 * D * 2, NTOK / 256, NPROJ / 256, (NTOK / 256) * (NPROJ / 256), c.G, (int)blockIdx.x};
            g8::EpiBf16 E{WSP(bf16_t, WS_PROJ), NPROJ};
            g8::gemm_phase(c.lds, c.tid, D, D * 2, D * 2, S, E);
            SEAM(pb + 0);
        }
        if (INL(1)) { FRESH(); phase_prep(c, l); SEAM(pb + 1); }
        if (INL(2)) { FRESH();
            g8::SchedCmp S{(const char*)WSP(bf16_t, WS_KCT), (const char*)WSP(bf16_t, WS_VCT), (const char*)(WSP(bf16_t, WS_WC1) + (size_t)l * 2 * 256 * 2048), c.G, (int)blockIdx.x};
            g8::EpiSlab E{WSP(float, WS_ACT)};
            g8::gemm_phase(c.lds, c.tid, 256, 1024 * 2, 2048 * 2, S, E);
            SEAM(pb + 2);
        }
        if (INL(3)) { FRESH(); phase_cmp2(c, l); __syncthreads(); FRESH(); phase_scan(c); SEAM(pb + 3); }
        if (INL(5)) { FRESH(); phase_retout(c, l); FRESH(); phase_nsa(c, l, l + 1 < NL ? l + 1 : -1, l == 0); SEAM(pb + 5); }
        if (INL(7)) { FRESH();
            {
                g8::SchedPlain S{(const char*)WSP(bf16_t, WS_RA), (const char*)(WSP(bf16_t, WS_WO) + (size_t)l * D * 2048), (size_t)256 * 2048 * 2, (size_t)256 * 2048 * 2, NTOK / 256, D / 256, (NTOK / 256) * (D / 256), c.G, (int)blockIdx.x};
                g8::EpiGate E{WSP(bf16_t, WS_MIX), WSP(bf16_t, WS_PROJ), 0};
                g8::gemm_phase(c.lds, c.tid, D, 2048 * 2, 2048 * 2, S, E);
            }
            asm volatile("s_waitcnt vmcnt(0)" ::: "memory"); __syncthreads();
            {
                g8::SchedPlain S{(const char*)(WSP(bf16_t, WS_RA) + 1024), (const char*)(WSP(bf16_t, WS_WO) + (size_t)l * D * 2048 + 1024), (size_t)256 * 2048 * 2, (size_t)256 * 2048 * 2, NTOK / 256, D / 256, (NTOK / 256) * (D / 256), c.G, (int)blockIdx.x};
                g8::EpiGate E{WSP(bf16_t, WS_MIX), WSP(bf16_t, WS_PROJ), 1};
                g8::gemm_phase(c.lds, c.tid, D, 2048 * 2, 2048 * 2, S, E);
            }
            SEAM(pb + 7);
        }
        if (INL(8)) { FRESH();
            g8::SchedPlain S{(const char*)WSP(bf16_t, WS_MIX), (const char*)(WSP(bf16_t, WS_WOUT) + (size_t)l * D * D), (size_t)256 * D * 2, (size_t)256 * D * 2, NTOK / 256, D / 256, (NTOK / 256) * (D / 256), c.G, (int)blockIdx.x};
            g8::EpiBf16 E{WSP(bf16_t, WS_PROJ), D};
            g8::gemm_phase(c.lds, c.tid, D, D * 2, D * 2, S, E);
            SEAM(pb + 8);
        }
        if (INL(9)) { FRESH(); phase_route(c, l); SEAM(pb + 9); }
        if (INL(10)) { FRESH(); phase_scatter(c, l); SEAM(pb + 10); }
        if (INL(11)) { FRESH();
            LAS int* tab = (LAS int*)(c.lds + 131072); g8::moe_units(tab, WSP(int, WS_META), 8, c.G, (int)blockIdx.x, c.tid);
            g8::SchedMoeG S{(const char*)WSP(bf16_t, WS_H), (const char*)(WSP(bf16_t, WS_WGU) + (size_t)l * NEXP * 2048 * D), tab, 8, (size_t)2048 * D * 2, WSP(int, WS_ROWTOK)};
            g8::EpiSwiglu E{WSP(bf16_t, WS_ACT), c.b_gate_up + (size_t)l * NEXP * 2048, WSP(float, WS_RSROW), c.lds + 131072 + 8192};
            g8::gemm_phase(c.lds, c.tid, D, D * 2, D * 2, S, E);
            SEAM(pb + 11);
        }
        if (INL(12)) { FRESH();
            LAS int* tab = (LAS int*)(c.lds + 131072); g8::moe_units(tab, WSP(int, WS_META), 4, c.G, (int)blockIdx.x, c.tid);
            g8::SchedMoe S{(const char*)WSP(bf16_t, WS_ACT), (const char*)(WSP(bf16_t, WS_WD) + (size_t)l * NEXP * D * D), tab, 4, (size_t)D * D * 2};
            g8::EpiDown E{WSP(bf16_t, WS_XBUF), c.b_down + (size_t)l * NEXP * D};
            g8::gemm_phase(c.lds, c.tid, D, D * 2, D * 2, S, E);
            SEAM(pb + 12);
        }
        if (INL(13)) { FRESH(); phase_combine(c, l); SEAM(pb + 13); }
    }
__global__ void __launch_bounds__(NTHREADS, 2) mk_fwd(Args args) {
    extern __shared__ __attribute__((aligned(16))) unsigned char lds_raw[];
    Ctx c;
    c.x_in = args.in[0]; c.norm1_w = args.in[1]; c.w_in = args.in[2]; c.ret_gn_w = args.in[3]; c.qk_norm_w = args.in[4]; c.cmp_pos = args.in[5]; c.cmp_w1 = args.in[6]; c.cmp_w2 = args.in[7];
    c.w_o_ret = args.in[8]; c.w_o_nsa = args.in[9]; c.w_out = args.in[10]; c.norm2_w = args.in[11]; c.router_w = args.in[12]; c.router_b = args.in[13]; c.w_gate_up = args.in[14]; c.b_gate_up = args.in[15];
    c.w_down = args.in[16]; c.b_down = args.in[17];
    c.out = args.out; c.ws = args.ws; c.lds = (LAS unsigned char*)lds_raw;
    c.tid = threadIdx.x; c.lane = c.tid & 63; c.wave = __builtin_amdgcn_readfirstlane(c.tid >> 6); c.G = gridDim.x; c.gw = blockIdx.x * NWAVES + c.wave;
    volatile LAS unsigned* lctl = (volatile LAS unsigned*)(c.lds + LDS_CTL_OFF);
    if (c.tid < 16) lctl[c.tid] = 0u;
    __syncthreads();
    const int lo = args.ph_lo, hi = args.ph_hi;
    XcdBarrier bar; bar.bar = WSP(unsigned, WS_CTL); bar.x = 0; bar.st = lctl;
    if (hi - lo > 1) bar = xcd_barrier_post(WSP(unsigned, WS_CTL), lctl);
    if ((PH_MASK & 1) && IN(0)) { FRESH(); phase_prologue(c); SEAM(0); }

    run_layer<0>(c, bar, lo, hi); run_layer<1>(c, bar, lo, hi); run_layer<2>(c, bar, lo, hi); run_layer<3>(c, bar, lo, hi);
#undef IN
#undef INL
#undef SEAM
}


extern "C" void kernel_launch(void* const* d_in, const int* in_sizes, int n_in, void* d_out, int out_size, void* d_ws, size_t ws_size, hipStream_t stream) {
    static int grid = 0;
    if (grid == 0) {
        if (n_in != 18 || out_size != NTOK * D || ws_size < WS_END) { fprintf(stderr, "kernel_launch: unexpected shapes (n_in %d out %d ws %zu need %zu)\n", n_in, out_size, ws_size, (size_t)WS_END); grid = -1; return; }
        int dev = 0, cus = 0;
        if (hipGetDevice(&dev) != hipSuccess || hipDeviceGetAttribute(&cus, hipDeviceAttributeMultiprocessorCount, dev) != hipSuccess) { grid = -1; return; }
        if (hipFuncSetAttribute((const void*)mk_fwd, hipFuncAttributeMaxDynamicSharedMemorySize, LDS_BYTES) != hipSuccess) { fprintf(stderr, "kernel_launch: hipFuncSetAttribute failed\n"); grid = -1; return; }
        int per_cu = 0;
        if (hipOccupancyMaxActiveBlocksPerMultiprocessor(&per_cu, (const void*)mk_fwd, NTHREADS, LDS_BYTES) != hipSuccess || per_cu < 1) fprintf(stderr, "kernel_launch: occupancy query says %d\n", per_cu);
        (void)hipGetLastError();
        grid = cus;
    }
    if (grid < 0) return;
    (void)hipMemsetAsync((char*)d_ws + WS_CTL, 0, CTL_BYTES, stream);
    Args a{};
    for (int i = 0; i < 18; ++i) a.in[i] = (const float*)d_in[i];
    a.out = (float*)d_out; a.ws = (unsigned char*)d_ws;
#if MK_ONE_LAUNCH
    a.ph_lo = 0; a.ph_hi = N_PHASES;
    hipLaunchKernelGGL(mk_fwd, dim3(grid), dim3(NTHREADS), LDS_BYTES, stream, a);
#else
    for (int p = 0; p < N_PHASES; ++p) { a.ph_lo = p; a.ph_hi = p + 1; hipLaunchKernelGGL(mk_fwd, dim3(grid), dim3(NTHREADS), LDS_BYTES, stream, a); }
#endif
}
```

```cpp
#include <hip/hip_runtime.h>
#include <stdint.h>
#include <stdio.h>

#ifndef MK_ONE_LAUNCH
#define MK_ONE_LAUNCH 1
#endif

#define LAS __attribute__((address_space(3)))
typedef unsigned short bf16_t;
typedef short bf16x8 __attribute__((ext_vector_type(8)));
typedef float f32x4 __attribute__((ext_vector_type(4)));
typedef float f32x2 __attribute__((ext_vector_type(2)));
typedef unsigned u32x4 __attribute__((ext_vector_type(4)));
typedef unsigned u32x2 __attribute__((ext_vector_type(2)));

constexpr int D = 1024, NB = 4, SEQ = 8192, NTOK = NB * SEQ, NL = 4;
constexpr int NPROJ = 7168, IN_TOTAL = 6960;
constexpr int C_RQ = 0, C_RK = 512, C_RV = 1024, C_RG = 2048, C_NQ = 3072, C_KC = 4096, C_VC = 4224, C_KS = 4352, C_VS = 4480, C_KW = 4608, C_VW = 4736, C_NG = 4864, C_MG = 5120;
constexpr int NEXP = 32, XROWS = 139264;
constexpr int NWAVES = 8, NTHREADS = 512;
constexpr float NORM_EPS = 1e-6f;

constexpr size_t al256(size_t x) { return (x + 255) & ~(size_t)255; }
constexpr size_t WS_CTL = 0, CTL_BYTES = 65536;
constexpr size_t WS_HIST = WS_CTL + CTL_BYTES;
constexpr size_t WS_META = WS_HIST + 1024 * 32 * 4;
constexpr size_t WS_ROPER = WS_META + 32768;
constexpr size_t WS_ROPEN = WS_ROPER + (size_t)SEQ * 64 * 2 * 4;
constexpr size_t WS_PEB = WS_ROPEN + (size_t)SEQ * 8 * 2 * 4;
constexpr size_t WS_RWF = al256(WS_PEB + 8 * NL * 2 * 256 * 4);
constexpr size_t WS_RSTD = WS_RWF + (size_t)NL * 32 * 2 * 2 * 512 * 2;
constexpr size_t WS_WIN = al256(WS_RSTD + (size_t)NTOK * 4);
constexpr size_t WS_WO = WS_WIN + (size_t)NL * NPROJ * D * 2;
constexpr size_t WS_WOUT = WS_WO + (size_t)NL * D * 2048 * 2;
constexpr size_t WS_WC1 = WS_WOUT + (size_t)NL * D * D * 2;
constexpr size_t WS_WGU = WS_WC1 + (size_t)NL * 2 * 256 * 2048 * 2;
constexpr size_t WS_WD = WS_WGU + (size_t)NL * NEXP * 2048 * D * 2;
constexpr size_t WS_H = WS_WD + (size_t)NL * NEXP * D * D * 2;
constexpr size_t WS_PROJ = WS_H + (size_t)NTOK * D * 2;
constexpr size_t WS_QR = WS_PROJ + (size_t)NTOK * NPROJ * 2;
constexpr size_t WS_KR = WS_QR + (size_t)NTOK * 512 * 2;
constexpr size_t WS_KZT = WS_KR + (size_t)NTOK * 512 * 2;
constexpr size_t WS_VT = WS_KZT + (size_t)NTOK * 512 * 2;
constexpr size_t WS_RT = WS_VT + (size_t)NTOK * 1024 * 2;
constexpr size_t WS_QN = WS_RT + (size_t)16 * 64 * 256 * 128 * 2;
constexpr size_t WS_KS = WS_QN + (size_t)NTOK * 1024 * 2;
constexpr size_t WS_VST = WS_KS + (size_t)NTOK * 128 * 2;
constexpr size_t WS_KW = WS_VST + (size_t)NTOK * 128 * 2;
constexpr size_t WS_VWT = WS_KW + (size_t)NTOK * 128 * 2;
constexpr size_t WS_KCT = WS_VWT + (size_t)NTOK * 128 * 2;
constexpr size_t WS_VCT = WS_KCT + (size_t)NTOK * 128 * 2 + 4096;
constexpr size_t WS_HID = WS_VCT + (size_t)NTOK * 128 * 2 + 4096;
constexpr size_t WS_KCMP = WS_HID + (size_t)2 * 8 * 512 * 256 * 2;
constexpr size_t WS_VCMPT = WS_KCMP + (size_t)8 * 512 * 64 * 2;
constexpr size_t WS_RA = WS_VCMPT + (size_t)8 * 512 * 64 * 2;
constexpr size_t WS_MIX = WS_RA + (size_t)NTOK * 2048 * 2;
constexpr size_t WS_TE = WS_MIX + (size_t)NTOK * D * 2;
constexpr size_t WS_TW = WS_TE + (size_t)NTOK * 16;
constexpr size_t WS_RANK = WS_TW + (size_t)NTOK * 16;
constexpr size_t WS_SLOT = WS_RANK + (size_t)NTOK * 16;
constexpr size_t WS_ROWTOK = WS_SLOT + (size_t)NTOK * 16;
constexpr size_t WS_RSROW = WS_ROWTOK + (size_t)XROWS * 4;
constexpr size_t WS_XBUF = al256(WS_RSROW + (size_t)XROWS * 4);
constexpr size_t WS_ACT = WS_XBUF + (size_t)XROWS * D * 2;
constexpr size_t WS_END = WS_ACT + (size_t)XROWS * D * 2;

constexpr int LDS_SCRATCH = 149504;
constexpr int LDS_CTL_OFF = LDS_SCRATCH;
constexpr int LDS_BYTES = LDS_SCRATCH + 1024;

__device__ __forceinline__ float bf2f(bf16_t v) { return __uint_as_float(((unsigned)v) << 16); }
__device__ __forceinline__ float bflo(unsigned w) { return __uint_as_float(w << 16); }
__device__ __forceinline__ float bfhi(unsigned w) { return __uint_as_float(w & 0xffff0000u); }
__device__ __forceinline__ unsigned f2bf(float f) { unsigned u = __float_as_uint(f); return (u + 0x7fffu + ((u >> 16) & 1u)) >> 16; }
typedef __bf16 bf16x2_t __attribute__((ext_vector_type(2)));
__device__ __forceinline__ unsigned pk2(float lo, float hi) { const f32x2 v = {lo, hi}; const bf16x2_t r = __builtin_convertvector(v, bf16x2_t); return __builtin_bit_cast(unsigned, r); }
__device__ __forceinline__ float fexp2(float x) { return __builtin_amdgcn_exp2f(x); }
__device__ __forceinline__ float frcp(float x) { return __builtin_amdgcn_rcpf(x); }
__device__ __forceinline__ float sigmoidf_(float x) { return frcp(1.0f + fexp2(-1.4426950408889634f * x)); }
__device__ __forceinline__ bf16x8 mk8(u32x4 v) { return __builtin_bit_cast(bf16x8, v); }
__device__ __forceinline__ bf16x8 ld8(const bf16_t* p) { return __builtin_bit_cast(bf16x8, *(const u32x4*)p); }
__device__ __forceinline__ f32x4 mfma16(bf16x8 a, bf16x8 b, f32x4 c) { return __builtin_amdgcn_mfma_f32_16x16x32_bf16(a, b, c, 0, 0, 0); }
#define MFMA_FENCE() do { __builtin_amdgcn_sched_barrier(0); asm volatile("s_nop 7\n\ts_nop 7" ::: "memory"); __builtin_amdgcn_sched_barrier(0); } while (0)
__device__ __forceinline__ float sum8(float v) { v += __int_as_float(__builtin_amdgcn_update_dpp(0, __float_as_int(v), 0xB1, 0xf, 0xf, true));
    v += __int_as_float(__builtin_amdgcn_update_dpp(0, __float_as_int(v), 0x4E, 0xf, 0xf, true)); v += __int_as_float(__builtin_amdgcn_update_dpp(0, __float_as_int(v), 0x141, 0xf, 0xf, true)); return v; }
__device__ __forceinline__ float wave_sum(float v) {
#pragma unroll
    for (int o = 32; o >= 1; o >>= 1) v += __shfl_xor(v, o);
    return v;
}

#define XB_TMO      128
#define XB_XCNT(j)  (256  + 64 * (j))
#define XB_XSUB(j)  (1280 + 64 * (j))
#define XB_XGEN(j)  (2304 + 64 * (j))
#define XB_TOP      3328
#define XB_TOPGEN   3392
#define XCD_BAR_WORDS 3456
#define XB_SPIN_CAP (1u << 18)
__device__ __forceinline__ unsigned xb_ld(unsigned* p)              { return __hip_atomic_load(p, __ATOMIC_RELAXED, __HIP_MEMORY_SCOPE_AGENT); }
__device__ __forceinline__ unsigned xb_add(unsigned* p, unsigned v) { return __hip_atomic_fetch_add(p, v, __ATOMIC_RELAXED, __HIP_MEMORY_SCOPE_AGENT); }
__device__ __forceinline__ unsigned xb_xcc_id() { return (unsigned)__builtin_amdgcn_s_getreg((3 << 11) | 20) & 0xFu; }
#define XB_SPIN(cond, bar) do { unsigned _sp = 0; while (cond) { __builtin_amdgcn_s_sleep(1); \
    if ((++_sp & 255u) == 0u) { if (xb_ld(&(bar)[XB_TMO])) break; if (_sp > XB_SPIN_CAP) { atomicAdd(&(bar)[XB_TMO], 1u); break; } } } } while (0)
struct XcdBarrier { unsigned* bar; unsigned x; volatile LAS unsigned* st; };
__device__ __forceinline__ XcdBarrier xcd_barrier_post(unsigned* bar, volatile LAS unsigned* st) {
    XcdBarrier b; b.bar = bar; b.x = xb_xcc_id(); b.st = st;
    if (threadIdx.x == 0) (void)xb_add(&bar[XB_XCNT(b.x)], 1u);
    return b;
}
__device__ __forceinline__ void xcd_barrier_complete(unsigned* bar, unsigned x, unsigned& nloc, unsigned& nx) {
    const unsigned G = gridDim.x * gridDim.y * gridDim.z;
    unsigned sum, cnt, mine, sp = 0u;
    for (;;) {
        sum = 0u; cnt = 0u; mine = 0u;
#pragma unroll
        for (unsigned j = 0; j < 16; ++j) { const unsigned c = xb_ld(&bar[XB_XCNT(j)]); sum += c; cnt += (c > 0u) ? 1u : 0u; mine = (j == x) ? c : mine; }
        if (sum == G) break;
        __builtin_amdgcn_s_sleep(1);
        if ((++sp & 255u) == 0u) { if (xb_ld(&bar[XB_TMO])) break; if (sp > XB_SPIN_CAP) { atomicAdd(&bar[XB_TMO], 1u); break; } }
    }
    nloc = mine > 0u ? mine : 1u; nx = cnt > 0u ? cnt : 1u;
}
__device__ __forceinline__ void xcd_barrier(const XcdBarrier& b) {
    asm volatile("s_waitcnt vmcnt(0)" ::: "memory");
    __syncthreads();
    if (threadIdx.x == 0) {
        unsigned* bar = b.bar;
        __builtin_amdgcn_s_waitcnt(0);
        unsigned nloc = b.st[0], nx = b.st[1];
        if (nloc == 0u) { xcd_barrier_complete(bar, b.x, nloc, nx); b.st[0] = nloc; b.st[1] = nx; }
        const unsigned old = xb_add(&bar[XB_XSUB(b.x)], 1u);
        const unsigned gen = old / nloc;
        if (old + 1u == (gen + 1u) * nloc) {
            __builtin_amdgcn_fence(__ATOMIC_RELEASE, "agent");
            asm volatile("s_waitcnt vmcnt(0)" ::: "memory");
            const unsigned og = xb_add(&bar[XB_TOP], 1u);
            const unsigned tg = og / nx;
            if (og + 1u == (tg + 1u) * nx) xb_add(&bar[XB_TOPGEN], 1u);
            else XB_SPIN(xb_ld(&bar[XB_TOPGEN]) == tg, bar);
            __builtin_amdgcn_fence(__ATOMIC_ACQUIRE, "agent");
            xb_add(&bar[XB_XGEN(b.x)], 1u);
            asm volatile("s_waitcnt vmcnt(0)" ::: "memory");
        } else {
            XB_SPIN(xb_ld(&bar[XB_XGEN(b.x)]) == gen, bar);
            __builtin_amdgcn_fence(__ATOMIC_ACQUIRE, "agent");
            asm volatile("s_waitcnt vmcnt(0)" ::: "memory");
        }
    }
    __syncthreads();
}

struct Args { const float* in[18]; float* out; unsigned char* ws; int ph_lo, ph_hi; };
struct Ctx {
    const float *x_in, *norm1_w, *w_in, *ret_gn_w, *qk_norm_w, *cmp_pos, *cmp_w1, *cmp_w2, *w_o_ret, *w_o_nsa, *w_out, *norm2_w, *router_w, *router_b, *w_gate_up, *b_gate_up, *w_down, *b_down;
    float* out; unsigned char* ws; LAS unsigned char* lds;
    int tid, lane, wave, gw, G;
};
#define WSP(T, off) ((T*)(c.ws + (off)))

namespace g8 {
constexpr int BM = 256, BK = 64, HALF = 128, HTB = HALF * BK * 2, STAGE_BYTES = 8 * HTB, NXCD = 8, WGM = 8;
__device__ __forceinline__ int lds_byte(int r, int c) { const int st = (r >> 4) * 2 + (c >> 5), rr = r & 15, cc = c & 31, ob = rr * 64 + cc * 2; return st * 1024 + (ob ^ (((ob >> 9) & 1) << 5)); }
__device__ __forceinline__ void stage_rc(int b, int& R, int& C) { const int st = b / 1024, sb = b % 1024, swz = sb ^ (((sb >> 9) & 1) << 5); R = (st >> 1) * 16 + swz / 64; C = (st & 1) * 32 + (swz % 64) / 2; }
__device__ __forceinline__ int perm32(int rho) { const int n = rho >> 4, i = rho & 15; return 8 * (i >> 2) + 4 * n + (i & 3); }

struct Unit { const char* A; const char* B; int pm, pn, e; };

struct SchedPlain {
    static constexpr bool GATHER = false;
    const char* A; const char* B; size_t tA, tB; int nM, nN, nwg, G, c;
    __device__ __forceinline__ bool next(int i, Unit& u) const {
        const long L = (long)i * G + c; if (L >= nwg) return false;
        int wgid = (int)L; { const int q = nwg / NXCD, r = nwg % NXCD, xcd = wgid % NXCD, off = wgid / NXCD; wgid = (xcd < r ? xcd * (q + 1) : r * (q + 1) + (xcd - r) * q) + off; }
        const int nig = WGM * nN, gid = wgid / nig, fm = gid * WGM, gsz = (nM - fm) < WGM ? (nM - fm) : WGM;
        u.pm = fm + ((wgid % nig) % gsz); u.pn = (wgid % nig) / gsz; u.e = 0;
        u.A = A + (size_t)u.pm * tA; u.B = B + (size_t)u.pn * tB; return true;
    }
};
struct SchedCmp {         static constexpr bool GATHER = false;
    const char* KCT; const char* VCT; const char* W; int G, c;
    __device__ __forceinline__ bool next(int i, Unit& u) const {
        const int idx = i * G + c; if (idx >= 256) return false;
        const int ksl = idx & 7, r = idx >> 3, kv = r >> 4, bg = (r >> 1) & 7, half = r & 1;
        u.A = (kv ? VCT : KCT) + ((size_t)bg * SEQ * 64 + (size_t)half * 256 * 1024 + (size_t)ksl * 256) * 2;
        u.B = W + ((size_t)kv * 256 * 2048 + (size_t)ksl * 256) * 2; u.pm = (kv * 8 + bg) * 2 + half; u.pn = 0; u.e = ksl; return true;
    }
};
struct SchedMoe {
    static constexpr bool GATHER = false;
    const char* A; const char* W; const LAS int* tab; int NT; size_t wstride;
    __device__ __forceinline__ bool next(int i, Unit& u) const {
        const int v = __builtin_amdgcn_readfirstlane(tab[i]); if (v < 0) return false;
        const int rb = v & 0xfff, pn = (v >> 12) & 0xf, e = v >> 16;
        u.A = A + (size_t)rb * 256 * 1024 * 2; u.B = W + (size_t)e * wstride + (size_t)pn * 256 * 1024 * 2; u.pm = rb; u.pn = pn; u.e = e; return true;
    }
};
struct SchedMoeG {
    static constexpr bool GATHER = true;
    const char* A; const char* W; const LAS int* tab; int NT; size_t wstride; const int* rowtok;
    __device__ __forceinline__ bool next(int i, Unit& u) const {
        const int v = __builtin_amdgcn_readfirstlane(tab[i]); if (v < 0) return false;
        const int rb = v & 0xfff, pn = (v >> 12) & 0xf, e = v >> 16;
        u.A = A; u.B = W + (size_t)e * wstride + (size_t)pn * 256 * 1024 * 2; u.pm = rb; u.pn = pn; u.e = e; return true;
    }
};
__device__ __forceinline__ void moe_units(LAS int* tab, const int* meta, const int NT, const int G, const int c, const int tid) {
    if (tid < 256) {
        int v = -1; const int i = tid;
        if ((G & 7) == 0) { const int x = c & 7, q = i * (G >> 3) + (c >> 3); const int nb = meta[16 + x];
            if (q < nb * NT) { const int rbi = q / NT, pn = q - rbi * NT, rb = meta[1024 + 640 * x + rbi]; v = rb | (pn << 12) | (meta[64 + rb] << 16); } }
        else { const int idx = i * G + c; const int nblk = meta[0]; if (idx < nblk * NT) { const int rb = idx / NT, pn = idx - rb * NT; v = rb | (pn << 12) | (meta[64 + rb] << 16); } }
        tab[i] = v;
    }
    __syncthreads();
}

typedef f32x4 Acc[2][2][4][2];

struct EpiBf16 {
    struct Pre {}; __device__ __forceinline__ void pre(Pre&, const Unit&, int, int, int, int) const {}
    static constexpr bool PERM = true;
    bf16_t* O; int ldc;
    __device__ __forceinline__ void operator()(const Acc& acc, const Unit& u, int wr, int wc, int fr, int fq, const Pre&) const {
        const int row0 = u.pm * BM + wr * 64 + fr, col0 = u.pn * BM + wc * 32 + 8 * fq;
#pragma unroll
        for (int ai = 0; ai < 2; ++ai)
#pragma unroll
            for (int m = 0; m < 4; ++m) { bf16_t* rowp = O + (size_t)(row0 + ai * HALF + m * 16) * ldc + col0;
#pragma unroll
                for (int bj = 0; bj < 2; ++bj) { const f32x4 v0 = acc[ai][bj][m][0], v1 = acc[ai][bj][m][1];
                    u32x4 w; w.x = pk2(v0[0], v0[1]); w.y = pk2(v0[2], v0[3]); w.z = pk2(v1[0], v1[1]); w.w = pk2(v1[2], v1[3]);
                    *(u32x4*)(rowp + bj * HALF) = w; } }
    }
};
struct EpiSlab {
    struct Pre {}; __device__ __forceinline__ void pre(Pre&, const Unit&, int, int, int, int) const {}
    static constexpr bool PERM = false;
    float* O;
    __device__ __forceinline__ void operator()(const Acc& acc, const Unit& u, int wr, int wc, int fr, int fq, const Pre&) const {
        const int row0 = u.pm * BM + wr * 64 + fr, col0 = wc * 32 + 4 * fq;
        float* base = O + (size_t)u.e * 8192 * 256;
#pragma unroll
        for (int ai = 0; ai < 2; ++ai)
#pragma unroll
            for (int m = 0; m < 4; ++m) { const size_t off = (size_t)(row0 + ai * HALF + m * 16) * 256 + col0;
#pragma unroll
                for (int bj = 0; bj < 2; ++bj)
#pragma unroll
                    for (int n = 0; n < 2; ++n) *(f32x4*)(base + off + bj * HALF + n * 16) = acc[ai][bj][m][n]; }
    }
};
struct EpiGate {
    struct Pre {}; __device__ __forceinline__ void pre(Pre&, const Unit&, int, int, int, int) const {}
    static constexpr bool PERM = true;
    bf16_t* O; const bf16_t* proj; int second;
    __device__ __forceinline__ void operator()(const Acc& acc, const Unit& u, int wr, int wc, int fr, int fq, const Pre&) const {
        const int row0 = u.pm * BM + wr * 64 + fr, col0 = u.pn * BM + wc * 32 + 8 * fq;
#pragma unroll
        for (int ai = 0; ai < 2; ++ai)
#pragma unroll
            for (int m = 0; m < 4; ++m) { const size_t row = (size_t)(row0 + ai * HALF + m * 16); const bf16_t* rp = proj + row * NPROJ + C_MG + (second ? 1024 : 0) + col0;
#pragma unroll
                for (int bj = 0; bj < 2; ++bj) { const u32x4 wb = *(const u32x4*)(rp + bj * HALF); u32x4 prev = {0u, 0u, 0u, 0u};
                    if (second) prev = *(const u32x4*)(O + row * D + col0 + bj * HALF);
                    float o[8];
#pragma unroll
                    for (int j = 0; j < 8; ++j) { const unsigned ub = wb[j >> 1], up = prev[j >> 1]; const float b = (j & 1) ? bfhi(ub) : bflo(ub), pv = (j & 1) ? bfhi(up) : bflo(up);
                        o[j] = pv + (j < 4 ? acc[ai][bj][m][0][j] : acc[ai][bj][m][1][j - 4]) * sigmoidf_(b); }
                    u32x4 w; w.x = pk2(o[0], o[1]); w.y = pk2(o[2], o[3]); w.z = pk2(o[4], o[5]); w.w = pk2(o[6], o[7]);
                    *(u32x4*)(O + row * D + col0 + bj * HALF) = w; } }
    }
};
struct EpiSwiglu {
    static constexpr bool PERM = true;
    bf16_t* O; const float* bgu;
    const float* rsrow;
    LAS unsigned char* rsl;
    struct Pre {};
    __device__ __forceinline__ void pre(Pre&, const Unit& u, int wc, int fq, int wid, int lane) const {
        LAS unsigned char* my = rsl + wid * 768;
        const float* rp = rsrow + u.pm * BM + (wid >> 2) * 64 + lane;
        __builtin_amdgcn_global_load_lds((const unsigned*)rp, (LAS unsigned*)my, 4, 0, 0);
        __builtin_amdgcn_global_load_lds((const unsigned*)(rp + HALF), (LAS unsigned*)(my + 256), 4, 0, 0);
        const float* bp = bgu + (size_t)u.e * 2048 + u.pn * 128 + wc * 32 + (lane & 31) + (lane >> 5) * 1024;
        __builtin_amdgcn_global_load_lds((const unsigned*)bp, (LAS unsigned*)(my + 512), 4, 0, 0); }
    __device__ __forceinline__ void operator()(const Acc& acc, const Unit& u, int wr, int wc, int fr, int fq, const Pre&) const {
        const int row0 = u.pm * BM + wr * 64 + fr, col0 = u.pn * 128 + wc * 32 + 8 * fq;
        const LAS unsigned char* my = rsl + (wr * 4 + wc) * 768;
        const f32x4 g0 = *(const LAS f32x4*)(my + 512 + 32 * fq), g1 = *(const LAS f32x4*)(my + 512 + 32 * fq + 16), u0 = *(const LAS f32x4*)(my + 640 + 32 * fq), u1 = *(const LAS f32x4*)(my + 640 + 32 * fq + 16);
#pragma unroll
        for (int ai = 0; ai < 2; ++ai)
#pragma unroll
            for (int m = 0; m < 4; ++m) { float o[8]; const float rs = *(const LAS float*)(my + ai * 256 + (m * 16 + fr) * 4);
#pragma unroll
                for (int j = 0; j < 8; ++j) {
                    float gv = (j < 4 ? acc[ai][0][m][0][j] * rs + g0[j] : acc[ai][0][m][1][j - 4] * rs + g1[j - 4]);
                    float uv = (j < 4 ? acc[ai][1][m][0][j] * rs + u0[j] : acc[ai][1][m][1][j - 4] * rs + u1[j - 4]);
                    gv = fminf(gv, 7.0f); uv = fminf(fmaxf(uv, -7.0f), 7.0f);
                    const float glu = gv * frcp(1.0f + fexp2(-1.702f * 1.4426950408889634f * gv)); o[j] = (uv + 1.0f) * glu; }
                u32x4 w; w.x = pk2(o[0], o[1]); w.y = pk2(o[2], o[3]); w.z = pk2(o[4], o[5]); w.w = pk2(o[6], o[7]);
                *(u32x4*)(O + (size_t)(row0 + ai * HALF + m * 16) * D + col0) = w; }
    }
};
struct EpiDown {
    static constexpr bool PERM = true;
    bf16_t* O; const float* bd;
    struct Pre { f32x4 b[2][2]; };
    __device__ __forceinline__ void pre(Pre& p, const Unit& u, int wc, int fq, int wid, int lane) const { const float* bp = bd + (size_t)u.e * D + u.pn * BM + wc * 32 + 8 * fq;
#pragma unroll
        for (int bj = 0; bj < 2; ++bj) { p.b[bj][0] = *(const f32x4*)(bp + bj * HALF); p.b[bj][1] = *(const f32x4*)(bp + bj * HALF + 4); } }
    __device__ __forceinline__ void operator()(const Acc& acc, const Unit& u, int wr, int wc, int fr, int fq, const Pre& p) const {
        const int row0 = u.pm * BM + wr * 64 + fr, col0 = u.pn * BM + wc * 32 + 8 * fq;
#pragma unroll
        for (int bj = 0; bj < 2; ++bj) { const f32x4 b0 = p.b[bj][0], b1 = p.b[bj][1];
#pragma unroll
            for (int ai = 0; ai < 2; ++ai)
#pragma unroll
                for (int m = 0; m < 4; ++m) { const f32x4 v0 = acc[ai][bj][m][0] + b0, v1 = acc[ai][bj][m][1] + b1;
                    u32x4 w; w.x = pk2(v0[0], v0[1]); w.y = pk2(v0[2], v0[3]); w.z = pk2(v1[0], v1[1]); w.w = pk2(v1[2], v1[3]);
                    *(u32x4*)(O + (size_t)(row0 + ai * HALF + m * 16) * D + col0 + bj * HALF) = w; } }
    }
};

template <class Epi, class Sched>
__device__ __forceinline__ void gemm_phase(LAS unsigned char* lds, const int tid, const int K, const unsigned lda, const unsigned ldb, const Sched& S, const Epi& E) {
    const int wid = __builtin_amdgcn_readfirstlane(tid >> 6), lane = tid & 63, wr = wid >> 2, wc = wid & 3, fr = lane & 15, fq = lane >> 4;
    const int nt = K / BK;
    unsigned voffA[2], voffB[2]; int Rs[2];
#pragma unroll
    for (int i = 0; i < 2; ++i) { int R, C; stage_rc(tid * 16 + i * 8192, R, C); const int Rb = Epi::PERM ? ((R & ~31) + perm32(R & 31)) : R; Rs[i] = R;
        voffA[i] = Sched::GATHER ? (unsigned)C * 2u : (unsigned)R * lda + (unsigned)C * 2u; voffB[i] = (unsigned)Rb * ldb + (unsigned)C * 2u; }
    unsigned offc[2][2] = {{0u, 0u}, {0u, 0u}}, offn[2][2] = {{0u, 0u}, {0u, 0u}};
    const size_t kstep = (size_t)(BK * 2);
    const size_t hstepA = (size_t)HALF * lda, hstepB = (size_t)HALF * ldb;
    const unsigned ldsw = (unsigned)wid * 1024u;
    const int aoff = lds_byte(wr * 64 + fr, fq * 8), boff = lds_byte(wc * 32 + fr, fq * 8);
#define G8_SA(b, h) (((b) * 2 + (h)) * HTB)
#define G8_SB(b, h) ((4 + (b) * 2 + (h)) * HTB)
#define G8_STAGE(bufoff, gbase, voff) do { _Pragma("unroll") for (int _i = 0; _i < 2; ++_i) \
        __builtin_amdgcn_global_load_lds((const unsigned*)((const char*)(gbase) + (voff)[_i]), (LAS unsigned*)(lds + (bufoff) + ldsw + _i * 8192), 16, 0, 0); } while (0)
#define G8_STAGEA(bufoff, kt, h, nx) do { _Pragma("unroll") for (int _i = 0; _i < 2; ++_i) { \
        const char* _g = Sched::GATHER ? (cA + (size_t)(kt) * kstep + ((nx) ? offn[h][_i] : offc[h][_i]) + voffA[_i]) : (((nx) ? nA : cA) + (size_t)(kt) * kstep + (size_t)(h) * hstepA + voffA[_i]); \
        __builtin_amdgcn_global_load_lds((const unsigned*)_g, (LAS unsigned*)(lds + (bufoff) + ldsw + _i * 8192), 16, 0, 0); } } while (0)
#define G8_LOADOFF(dst, un) do { if constexpr (Sched::GATHER) { _Pragma("unroll") for (int _h = 0; _h < 2; ++_h) _Pragma("unroll") for (int _i = 0; _i < 2; ++_i) \
        dst[_h][_i] = (unsigned)S.rowtok[(un).pm * 256 + _h * 128 + Rs[_i]] * (unsigned)(D * 2); } } while (0)
#define G8_LDA(dst, b, h) do { _Pragma("unroll") for (int m = 0; m < 4; ++m) _Pragma("unroll") for (int k = 0; k < 2; ++k) dst[m][k] = *(const LAS bf16x8*)(lds + G8_SA(b, h) + aoff + m * 2048 + k * 1024); } while (0)
#define G8_LDB(dst, b, h) do { _Pragma("unroll") for (int n = 0; n < 2; ++n) _Pragma("unroll") for (int k = 0; k < 2; ++k) dst[n][k] = *(const LAS bf16x8*)(lds + G8_SB(b, h) + boff + n * 2048 + k * 1024); } while (0)
#define G8_MMA(ai, bj, At, Bt) do { __builtin_amdgcn_s_setprio(1); _Pragma("unroll") for (int m = 0; m < 4; ++m) _Pragma("unroll") for (int n = 0; n < 2; ++n) _Pragma("unroll") for (int k = 0; k < 2; ++k) \
        acc[ai][bj][m][n] = __builtin_amdgcn_mfma_f32_16x16x32_bf16(Bt[n][k], At[m][k], acc[ai][bj][m][n], 0, 0, 0); __builtin_amdgcn_s_setprio(0); } while (0)
#define G8_WAIT_V(n) asm volatile("s_waitcnt vmcnt(" #n ")" ::: "memory")
#define G8_WAIT_L(n) asm volatile("s_waitcnt lgkmcnt(" #n ")" ::: "memory")
#define G8_BAR __builtin_amdgcn_s_barrier()
#define G8_SCHED __builtin_amdgcn_sched_barrier(0)
    Unit cur, nxt; int ui = 0;
    if (!S.next(0, cur)) return;
    Acc acc;
#pragma unroll
    for (int a = 0; a < 2; ++a)
#pragma unroll
        for (int b = 0; b < 2; ++b)
#pragma unroll
            for (int m = 0; m < 4; ++m)
#pragma unroll
                for (int n = 0; n < 2; ++n) acc[a][b][m][n] = (f32x4){0.f, 0.f, 0.f, 0.f};
    bf16x8 At[4][2], B0[2][2], B1[2][2];
    const char* cA = cur.A; const char* cB = cur.B; const char* nA = cA;
    typename Epi::Pre epre; E.pre(epre, cur, wc, fq, wid, lane);
    G8_LOADOFF(offc, cur);
    if constexpr (Sched::GATHER) asm volatile("s_waitcnt vmcnt(0)" ::: "memory");
    G8_STAGE(G8_SB(0, 0), cB, voffB); G8_STAGEA(G8_SA(0, 0), 0, 0, false); G8_STAGE(G8_SB(0, 1), cB + hstepB, voffB); G8_STAGEA(G8_SA(0, 1), 0, 1, false);
    if (wr == 1) G8_BAR;
    G8_WAIT_V(4); G8_BAR;
    G8_STAGE(G8_SB(1, 0), cB + kstep, voffB); G8_STAGEA(G8_SA(1, 0), 1, 0, false); G8_STAGE(G8_SB(1, 1), cB + hstepB + kstep, voffB);
    G8_WAIT_V(6); G8_BAR;
    for (;;) {
        const bool has_next = S.next(ui + 1, nxt);
        nA = has_next ? nxt.A : cA; const char* nB = has_next ? nxt.B : cB;
        if (has_next) G8_LOADOFF(offn, nxt);
        else { _Pragma("unroll") for (int _h = 0; _h < 2; ++_h) _Pragma("unroll") for (int _i = 0; _i < 2; ++_i) offn[_h][_i] = offc[_h][_i]; }
        for (int t = 0; t < nt; t += 2) {
            const bool last = (t == nt - 2);
            const char* b2 = last ? nB : cB + (size_t)(t + 2) * kstep;
            const char* b3 = b2 + kstep;
            const int k2 = last ? 0 : t + 2, k3 = last ? 1 : t + 3;
            G8_LDB(B0, 0, 0); G8_SCHED; G8_LDA(At, 0, 0); G8_STAGEA(G8_SA(1, 1), t + 1, 1, false);
            G8_WAIT_L(8); G8_BAR; G8_WAIT_L(0); G8_MMA(0, 0, At, B0); G8_BAR; G8_SCHED;
            G8_LDB(B1, 0, 1); G8_STAGE(G8_SB(0, 0), b2, voffB);
            G8_BAR; G8_WAIT_L(0); G8_MMA(0, 1, At, B1); G8_BAR;
            G8_LDA(At, 0, 1); G8_STAGEA(G8_SA(0, 0), k2, 0, last);
            G8_BAR; G8_WAIT_L(0); G8_MMA(1, 0, At, B0); G8_BAR; G8_SCHED;
            G8_STAGE(G8_SB(0, 1), b2 + hstepB, voffB);
            G8_WAIT_V(6); G8_BAR; G8_MMA(1, 1, At, B1); G8_BAR;
            G8_LDB(B0, 1, 0); G8_SCHED; G8_LDA(At, 1, 0); G8_STAGEA(G8_SA(0, 1), k2, 1, last);
            G8_WAIT_L(8); G8_BAR; G8_WAIT_L(0); G8_MMA(0, 0, At, B0); G8_BAR; G8_SCHED;
            G8_LDB(B1, 1, 1); G8_STAGE(G8_SB(1, 0), b3, voffB);
            G8_BAR; G8_WAIT_L(0); G8_MMA(0, 1, At, B1); G8_BAR;
            G8_LDA(At, 1, 1); G8_STAGEA(G8_SA(1, 0), k3, 0, last);
            G8_BAR; G8_WAIT_L(0); G8_MMA(1, 0, At, B0); G8_BAR; G8_SCHED;
            G8_STAGE(G8_SB(1, 1), b3 + hstepB, voffB);
            G8_WAIT_V(6); G8_BAR; G8_MMA(1, 1, At, B1); G8_BAR;
        }
        MFMA_FENCE();
        E(acc, cur, wr, wc, fr, fq, epre);
        if (!has_next) break;
#pragma unroll
        for (int a = 0; a < 2; ++a)
#pragma unroll
            for (int b = 0; b < 2; ++b)
#pragma unroll
                for (int m = 0; m < 4; ++m)
#pragma unroll
                    for (int n = 0; n < 2; ++n) acc[a][b][m][n] = (f32x4){0.f, 0.f, 0.f, 0.f};
        cur = nxt; cA = nA; cB = nB; ++ui;
        { _Pragma("unroll") for (int _h = 0; _h < 2; ++_h) _Pragma("unroll") for (int _i = 0; _i < 2; ++_i) offc[_h][_i] = offn[_h][_i]; }
        E.pre(epre, cur, wc, fq, wid, lane);
    }
    G8_WAIT_V(0);
    if (wr == 0) G8_BAR;
    G8_BAR;
#undef G8_SA
#undef G8_SB
#undef G8_STAGE
#undef G8_LDA
#undef G8_STAGEA
#undef G8_LOADOFF
#undef G8_LDB
#undef G8_MMA
#undef G8_WAIT_V
#undef G8_WAIT_L
#undef G8_BAR
#undef G8_SCHED
}
}

__device__ __forceinline__ void conv_item(const float* __restrict__ src, int ldS, int col4  , int k0, bf16_t* __restrict__ dst  , int K, int kq, const float* __restrict__ ksc = nullptr  ) {
    f32x4 v[16];
#pragma unroll
    for (int j = 0; j < 16; ++j) v[j] = col4 >= 0 ? *(const f32x4*)(src + (size_t)(k0 + kq * 16 + j) * ldS + col4) : (f32x4){0.f, 0.f, 0.f, 0.f};
    if (ksc) {
#pragma unroll
        for (int j = 0; j < 16; ++j) v[j] *= ksc[k0 + kq * 16 + j];
    }
#pragma unroll
    for (int r = 0; r < 4; ++r) {
        u32x4 w0, w1;
#pragma unroll
        for (int j = 0; j < 4; ++j) { w0[j] = pk2(v[2 * j][r], v[2 * j + 1][r]); w1[j] = pk2(v[8 + 2 * j][r], v[8 + 2 * j + 1][r]); }
        bf16_t* d = dst + (size_t)r * K + kq * 16;
        *(u32x4*)d = w0; *(u32x4*)(d + 8) = w1;
    }
}
__device__ __forceinline__ void rms_row_to_h(const float* __restrict__ xr, const float* __restrict__ nw, bf16_t* __restrict__ hr, int lane) {
    f32x4 v[4]; float ss = 0.f;
#pragma unroll
    for (int i = 0; i < 4; ++i) { v[i] = *(const f32x4*)(xr + i * 256 + lane * 4); ss += v[i][0] * v[i][0] + v[i][1] * v[i][1] + v[i][2] * v[i][2] + v[i][3] * v[i][3]; }
    ss = wave_sum(ss);
    const float rs = rsqrtf(ss * (1.0f / 1024.0f) + NORM_EPS);
#pragma unroll
    for (int i = 0; i < 4; ++i) { const f32x4 w = *(const f32x4*)(nw + i * 256 + lane * 4);
        u32x2 o; o.x = pk2(v[i][0] * rs * w[0], v[i][1] * rs * w[1]); o.y = pk2(v[i][2] * rs * w[2], v[i][3] * rs * w[3]);
        *(u32x2*)(hr + i * 256 + lane * 4) = o; }
}
constexpr int CONV_ITEMS = 112 * 16 + 16 * 32 + 16 * 16 + 2 * 4 * 32 + 32 * 32 * 16 + 32 * 16 * 16;
__device__ __forceinline__ void conv_one(const Ctx& c, const int l, const int it) {
    const int lane = c.lane;
    constexpr int I_IN = 112 * 16, I_O = 16 * 32, I_OUT = 16 * 16, I_C1 = 2 * 4 * 32, I_GU = 32 * 32 * 16;
    constexpr int E1 = I_IN, E2 = E1 + I_O, E3 = E2 + I_OUT, E4 = E3 + I_C1, E5 = E4 + I_GU;
    const int n4 = (lane & 15) * 4, kq = lane >> 4;
    if (it < E1) { const int nb = it / 16, kb = it % 16; const int n = nb * 64 + n4;
        const int col = n < 4912 ? n : (n < 5120 ? -1 : n - 208);
        conv_item(c.w_in + (size_t)l * D * IN_TOTAL, IN_TOTAL, col, kb * 64, WSP(bf16_t, WS_WIN) + ((size_t)l * NPROJ + n) * D + kb * 64, D, kq);
    } else if (it < E2) { const int r = it - E1, nb = r / 32, kb = r % 32; const int n = nb * 64 + n4;
        const float* src = (kb < 16 ? c.w_o_ret : c.w_o_nsa) + (size_t)l * D * D;
        conv_item(src, D, n, (kb & 15) * 64, WSP(bf16_t, WS_WO) + ((size_t)l * D + n) * 2048 + kb * 64, 2048, kq);
    } else if (it < E3) { const int r = it - E2, nb = r / 16, kb = r % 16; const int n = nb * 64 + n4;
        conv_item(c.w_out + (size_t)l * D * D, D, n, kb * 64, WSP(bf16_t, WS_WOUT) + ((size_t)l * D + n) * D + kb * 64, D, kq);
    } else if (it < E4) { const int j = it - E3, lk = l * 2 + j / 128, r = j % 128, nb = r / 32, kb = r % 32; const int n = nb * 64 + n4;
        conv_item(c.cmp_w1 + (size_t)lk * 2048 * 256, 256, n, kb * 64, WSP(bf16_t, WS_WC1) + ((size_t)lk * 256 + n) * 2048 + kb * 64, 2048, kq);
    } else if (it < E5) { const int j = it - E4, le = l * NEXP + j / 512, r = j % 512, nb = r / 16, kb = r % 16; const int n = nb * 64 + n4;
        const int pn = n >> 8, jj = n & 255; const int col = jj < 128 ? pn * 128 + jj : 1024 + pn * 128 + (jj - 128);
        conv_item(c.w_gate_up + (size_t)le * D * 2048, 2048, col, kb * 64, WSP(bf16_t, WS_WGU) + ((size_t)le * 2048 + n) * D + kb * 64, D, kq, c.norm2_w + (size_t)l * D);
    } else { const int j = it - E5, le = l * NEXP + j / 256, r = j % 256, nb = r / 16, kb = r % 16; const int n = nb * 64 + n4;
        conv_item(c.w_down + (size_t)le * D * D, D, n, kb * 64, WSP(bf16_t, WS_WD) + ((size_t)le * D + n) * D + kb * 64, D, kq);
    }
}
__device__ __forceinline__ bool conv_is_early(const int it) { return it < 112 * 16 || (it >= 112 * 16 + 16 * 32 + 16 * 16 && it < 112 * 16 + 16 * 32 + 16 * 16 + 2 * 4 * 32); }
__device__ __forceinline__ void conv_layer_early(const Ctx& c, const int l, const int widx, const int nw) {
    for (int it = widx; it < 112 * 16; it += nw) conv_one(c, l, it);
    for (int it = 112 * 16 + 16 * 32 + 16 * 16 + widx; it < 112 * 16 + 16 * 32 + 16 * 16 + 2 * 4 * 32; it += nw) conv_one(c, l, it);
}
__device__ __forceinline__ void phase_prologue(const Ctx& c) {
    const int lane = c.lane, gw = c.gw, NW = c.G * NWAVES;
    conv_layer_early(c, 0, gw, NW);
    const int gtid = blockIdx.x * NTHREADS + c.tid, NT = c.G * NTHREADS;
    for (int pos = gw; pos < SEQ; pos += NW) {
#pragma unroll
        for (int pass = 0; pass < 2; ++pass) {
            if (pass == 1 && lane >= 8) break;
            const int j = pass == 0 ? lane : 64 + lane;
            float inv; if (j < 64) inv = powf(10000.0f, -(float)(2 * j) / 128.0f); else inv = powf(500000.0f, -(float)(2 * (j - 64)) / 16.0f);
            const float ang = (float)pos * inv;
            double rev = (double)ang * 0.15915494309189535; rev -= floor(rev);
            const float rv = (float)rev; const float sn = __builtin_amdgcn_sinf(rv), cs = __builtin_amdgcn_cosf(rv);
            if (j < 64) { float* t = WSP(float, WS_ROPER) + ((size_t)pos * 64 + j) * 2; t[0] = cs; t[1] = sn; }
            else { float* t = WSP(float, WS_ROPEN) + ((size_t)pos * 8 + (j - 64)) * 2; t[0] = cs; t[1] = sn; }
        }
    }
    for (int u = blockIdx.x + c.wave * c.G; u < NL * 2 * 16 * 8; u += c.G * NWAVES) {
        const int kh = u & 7, lk = u >> 7, n = ((u >> 3) & 15) * 16 + (lane & 15), k0 = kh * 256 + (lane >> 4) * 64;
        const float* pe = c.cmp_pos + (size_t)lk * 2048 + k0; const float* w1 = c.cmp_w1 + ((size_t)lk * 2048 + k0) * 256 + n;
        float s0 = 0.f, s1 = 0.f, s2 = 0.f, s3 = 0.f;
#pragma unroll 4
        for (int k = 0; k < 64; k += 4) { s0 += pe[k] * w1[(size_t)k * 256]; s1 += pe[k + 1] * w1[(size_t)(k + 1) * 256]; s2 += pe[k + 2] * w1[(size_t)(k + 2) * 256]; s3 += pe[k + 3] * w1[(size_t)(k + 3) * 256]; }
        float s = (s0 + s1) + (s2 + s3);
        s += __shfl_xor(s, 16); s += __shfl_xor(s, 32);
        if (lane < 16) WSP(float, WS_PEB)[kh * (NL * 2 * 256) + lk * 256 + n] = s;
    }
    for (int i = gtid; i < NL * 32 * 2 * 64 * 8; i += NT) {
        const int j = i & 7, ln = (i >> 3) & 63, nt = (i >> 9) & 1, ks = (i >> 10) & 31, l = i >> 15;
        const int fr_ = ln & 15, fq_ = ln >> 4, k = 32 * ks + (j < 4 ? 4 * fq_ + j : 16 + 4 * fq_ + (j - 4)), e = 16 * nt + fr_;
        const float w = c.norm2_w[(size_t)l * D + k] * c.router_w[((size_t)l * D + k) * NEXP + e];
        const unsigned hi = f2bf(w); const float wl = w - __uint_as_float(hi << 16);
        bf16_t* dst = WSP(bf16_t, WS_RWF) + ((((size_t)l * 32 + ks) * 2 + nt) * 2) * 512 + ln * 8 + j;
        dst[0] = (bf16_t)hi; dst[512] = (bf16_t)f2bf(wl);
    }
    for (int tok = gw; tok < NTOK; tok += NW) rms_row_to_h(c.x_in + (size_t)tok * D, c.norm1_w, WSP(bf16_t, WS_H) + (size_t)tok * D, lane);
}

constexpr float SM_SCALE_L2 = 0.125f * 1.4426950408889634f;
__device__ __forceinline__ void phase_prep(const Ctx& c, int l) {
    const int lane = c.lane, gw = c.gw, NW = c.G * NWAVES;
    const bf16_t* proj = WSP(bf16_t, WS_PROJ);
    const float* ropeR = WSP(float, WS_ROPER); const float* ropeN = WSP(float, WS_ROPEN);
    const float* qkw = c.qk_norm_w + (size_t)l * 4 * 64;
    for (int tok = gw; tok < NTOK; tok += NW) {
        const int b = tok / SEQ, s = tok % SEQ; const bf16_t* pr = proj + (size_t)tok * NPROJ;
        const int job = lane >> 3, l8 = lane & 7, isk = job >> 2;
        const bf16_t* src1 = pr + (isk ? C_RK : C_RQ) + (job & 3) * 128 + 8 * l8;
        const u32x4 a_w1 = *(const u32x4*)src1, a_w2 = *(const u32x4*)(src1 + 64);
        f32x4 a_cs[4];
#pragma unroll
        for (int j = 0; j < 4; ++j) a_cs[j] = *(const f32x4*)(ropeR + ((size_t)s * 64 + 8 * l8) * 2 + 4 * j);
        const bf16_t* src2 = pr + C_NQ + (lane >> 2) * 64 + (lane & 3) * 16;
        const u32x4 b_w0 = *(const u32x4*)src2, b_w1 = *(const u32x4*)(src2 + 8);
        f32x4 rn[4];
#pragma unroll
        for (int j = 0; j < 4; ++j) rn[j] = *(const f32x4*)(ropeN + (size_t)s * 16 + 4 * j);
        u32x4 c_w0 = {0u, 0u, 0u, 0u}, c_w1 = {0u, 0u, 0u, 0u};
        if (lane < 16) { const int hh = lane >> 2, part = lane & 3; const bf16_t* src = pr + ((hh >> 1) ? C_KW : C_KS) + (hh & 1) * 64 + part * 16; c_w0 = *(const u32x4*)src; c_w1 = *(const u32x4*)(src + 8); }
        else if (lane < 48) { const int q = lane - 16, isv = q >> 4, r = q & 15; c_w0 = *(const u32x4*)(pr + (isv ? C_VC : C_KC) + (r >> 3) * 64 + (r & 7) * 8); }
        {
            const int h = job & 3;
            const u32x4 w1 = a_w1, w2 = a_w2;
            const float ksc = isk ? 0.08838834764831845f : 1.0f;
            u32x4 o1, o2;
#pragma unroll
            for (int j = 0; j < 4; ++j) { const f32x4 cs = a_cs[j];
                const float a1 = bflo(w1[j]), a2 = bflo(w2[j]), b1 = bfhi(w1[j]), b2 = bfhi(w2[j]);
                o1[j] = pk2((a1 * cs[0] - a2 * cs[1]) * ksc, (b1 * cs[2] - b2 * cs[3]) * ksc);
                o2[j] = pk2((a1 * cs[1] + a2 * cs[0]) * ksc, (b1 * cs[3] + b2 * cs[2]) * ksc); }
            bf16_t* dst = WSP(bf16_t, isk ? WS_KR : WS_QR) + ((size_t)(b * 4 + h) * SEQ + s) * 128 + 8 * l8;
            *(u32x4*)dst = o1; *(u32x4*)(dst + 64) = o2;
        }
        {
            const int head = lane >> 2, part = lane & 3;
            const u32x4 w0 = b_w0, w1 = b_w1; float v[16];
#pragma unroll
            for (int j = 0; j < 4; ++j) { v[2 * j] = bflo(w0[j]); v[2 * j + 1] = bfhi(w0[j]); v[8 + 2 * j] = bflo(w1[j]); v[8 + 2 * j + 1] = bfhi(w1[j]); }
            float ss = 0.f;
#pragma unroll
            for (int j = 0; j < 16; ++j) ss += v[j] * v[j];
            ss += __shfl_xor(ss, 1); ss += __shfl_xor(ss, 2);
            const float rs = rsqrtf(ss * (1.0f / 64.0f) + NORM_EPS);
#pragma unroll
            for (int j = 0; j < 16; ++j) v[j] = v[j] * (rs * SM_SCALE_L2) * qkw[0 * 64 + part * 16 + j];
            if (part == 0) {
#pragma unroll
                for (int i = 0; i < 8; ++i) { const float cc = rn[i >> 1][(i & 1) * 2], sc = rn[i >> 1][(i & 1) * 2 + 1]; const float x1 = v[i], x2 = v[i + 8]; v[i] = x1 * cc - x2 * sc; v[i + 8] = x1 * sc + x2 * cc; }
            }
            u32x4 o0, o1;
#pragma unroll
            for (int j = 0; j < 4; ++j) { o0[j] = pk2(v[2 * j], v[2 * j + 1]); o1[j] = pk2(v[8 + 2 * j], v[8 + 2 * j + 1]); }
            bf16_t* dst = WSP(bf16_t, WS_QN) + ((size_t)tok * 16 + head) * 64 + part * 16;
            *(u32x4*)dst = o0; *(u32x4*)(dst + 8) = o1;
        }
        if (lane < 16) {
            const int hh = lane >> 2, part = lane & 3, isw = hh >> 1, g = hh & 1;
            const u32x4 w0 = c_w0, w1 = c_w1; float v[16];
#pragma unroll
            for (int j = 0; j < 4; ++j) { v[2 * j] = bflo(w0[j]); v[2 * j + 1] = bfhi(w0[j]); v[8 + 2 * j] = bflo(w1[j]); v[8 + 2 * j + 1] = bfhi(w1[j]); }
            float ss = 0.f;
#pragma unroll
            for (int j = 0; j < 16; ++j) ss += v[j] * v[j];
            ss += __shfl_xor(ss, 1); ss += __shfl_xor(ss, 2);
            const float rs = rsqrtf(ss * (1.0f / 64.0f) + NORM_EPS);
            const float* w = qkw + (isw ? 3 : 2) * 64 + part * 16;
#pragma unroll
            for (int j = 0; j < 16; ++j) v[j] = v[j] * rs * w[j];
            if (part == 0) {
#pragma unroll
                for (int i = 0; i < 8; ++i) { const float cc = rn[i >> 1][(i & 1) * 2], sc = rn[i >> 1][(i & 1) * 2 + 1]; const float x1 = v[i], x2 = v[i + 8]; v[i] = x1 * cc - x2 * sc; v[i + 8] = x1 * sc + x2 * cc; }
            }
            u32x4 o0, o1;
#pragma unroll
            for (int j = 0; j < 4; ++j) { o0[j] = pk2(v[2 * j], v[2 * j + 1]); o1[j] = pk2(v[8 + 2 * j], v[8 + 2 * j + 1]); }
            bf16_t* dst = WSP(bf16_t, isw ? WS_KW : WS_KS) + ((((size_t)(b * 2 + g) * 128 + (s >> 6)) * 4 + ((s >> 4) & 3)) * 2 + (part >> 1)) * 512 + ((2 * (part & 1)) * 16 + (s & 15)) * 8;
            *(u32x4*)dst = o0; *(u32x4*)(dst + 128) = o1;
        } else if (lane < 48) {
            const int q = lane - 16, isv = q >> 4, r = q & 15, g = r >> 3, part = r & 7;
            const u32x4 w = c_w0;
            *(u32x4*)(WSP(bf16_t, isv ? WS_VCT : WS_KCT) + ((size_t)(b * 2 + g) * SEQ + s) * 64 + part * 8) = w;
        }
    }
    const float lgam[4] = {log2f(1.0f - 1.0f / 32.0f), log2f(1.0f - 1.0f / 64.0f), log2f(1.0f - 1.0f / 128.0f), log2f(1.0f - 1.0f / 256.0f)};
    LAS bf16_t* tile = (LAS bf16_t*)(c.lds + c.wave * 8192);
    for (int grp = gw; grp < NTOK / 8; grp += NW) {
        const int tok0 = grp * 8, b = tok0 / SEQ, s0 = tok0 % SEQ; const bf16_t* pr = proj + (size_t)tok0 * NPROJ;
        u32x4 R[8];
#define PREP_LDG(col0) do { _Pragma("unroll") for (int _t = 0; _t < 8; ++_t) R[_t] = *(const u32x4*)(pr + (size_t)_t * NPROJ + (col0) + lane * 8); } while (0)
#define PREP_STL() do { _Pragma("unroll") for (int _t = 0; _t < 8; ++_t) *(LAS u32x4*)(tile + _t * 512 + lane * 8) = R[_t]; } while (0)
#define PREP_COL8(cc, w) do { unsigned short _v[8]; _Pragma("unroll") for (int _t = 0; _t < 8; ++_t) _v[_t] = tile[_t * 512 + (cc)]; \
        (w).x = _v[0] | ((unsigned)_v[1] << 16); (w).y = _v[2] | ((unsigned)_v[3] << 16); (w).z = _v[4] | ((unsigned)_v[5] << 16); (w).w = _v[6] | ((unsigned)_v[7] << 16); } while (0)
        PREP_LDG(C_RK);
        float cs[8], sn[8];
#pragma unroll
        for (int t = 0; t < 8; ++t) { const f32x2 tb = *(const f32x2*)(ropeR + ((size_t)(s0 + t) * 64 + lane) * 2); cs[t] = tb[0]; sn[t] = tb[1]; }
        PREP_STL(); PREP_LDG(C_RV);
        {
#pragma unroll
            for (int h = 0; h < 4; ++h) { float o1[8], o2[8];
#pragma unroll
                for (int t = 0; t < 8; ++t) { const float k1 = bf2f(tile[t * 512 + h * 128 + lane]), k2 = bf2f(tile[t * 512 + h * 128 + 64 + lane]);
                    const float z = fexp2(lgam[h] * (float)(127 - ((s0 + t) & 127))) * 0.08838834764831845f;
                    o1[t] = (k1 * cs[t] - k2 * sn[t]) * z; o2[t] = (k1 * sn[t] + k2 * cs[t]) * z; }
                u32x4 w1, w2;
#pragma unroll
                for (int j = 0; j < 4; ++j) { w1[j] = pk2(o1[2 * j], o1[2 * j + 1]); w2[j] = pk2(o2[2 * j], o2[2 * j + 1]); }
                { const int tk = s0 & 127, q = tk & 31, fqa = (q & 15) >> 2, jb = q >= 16 ? 4 : 0;
                  bf16_t* base = WSP(bf16_t, WS_KZT) + ((((size_t)(b * 4 + h) * 64 + (s0 >> 7)) * 8) * 4 + (tk >> 5)) * 512 + (fqa * 16 + (lane & 15)) * 8 + jb;
                  bf16_t* d1 = base + (size_t)(lane >> 4) * 2048, *d2 = base + (size_t)(4 + (lane >> 4)) * 2048;
                  u32x2 a; a.x = w1.x; a.y = w1.y; *(u32x2*)d1 = a; a.x = w1.z; a.y = w1.w; *(u32x2*)(d1 + 128) = a;
                  a.x = w2.x; a.y = w2.y; *(u32x2*)d2 = a; a.x = w2.z; a.y = w2.w; *(u32x2*)(d2 + 128) = a; } }
        }
#pragma unroll
        for (int hf = 0; hf < 2; ++hf) {
            PREP_STL();
            if (hf == 0) PREP_LDG(C_RV + 512);
            else {
#pragma unroll
                for (int _t = 0; _t < 8; ++_t) if (lane < 32) R[_t] = *(const u32x4*)(pr + (size_t)_t * NPROJ + ((lane >> 4) ? C_VW : C_VS) + (lane & 15) * 8);
            }
#pragma unroll
            for (int i = 0; i < 8; ++i) { const int cc = i * 64 + lane; u32x4 w; PREP_COL8(cc, w);
                { const int ch_ = hf * 512 + cc, hh = ch_ >> 8, dv = ch_ & 255, tk = s0 & 127, q = tk & 31, fqa = (q & 15) >> 2, jb = q >= 16 ? 4 : 0;
                  bf16_t* d = WSP(bf16_t, WS_VT) + (((((size_t)(b * 4 + hh) * 64 + (s0 >> 7)) * 4 + (tk >> 5)) * 16 + (dv >> 4)) * 64 + fqa * 16 + (dv & 15)) * 8 + jb;
                  u32x2 a; a.x = w.x; a.y = w.y; *(u32x2*)d = a; a.x = w.z; a.y = w.w; *(u32x2*)(d + 128) = a; } }
        }
        {
#pragma unroll
            for (int _t = 0; _t < 8; ++_t) { const int piece = lane >> 4, off = (lane & 15) * 8;
                if (lane < 32) *(LAS u32x4*)(tile + _t * 512 + piece * 128 + off) = R[_t]; }
#pragma unroll
            for (int i = 0; i < 4; ++i) { const int isw = i >> 1, g = i & 1; u32x4 w; PREP_COL8(isw * 128 + g * 64 + lane, w);
                const int q = s0 & 31; bf16_t* dst = WSP(bf16_t, isw ? WS_VWT : WS_VST) + ((((size_t)(b * 2 + g) * 128 + (s0 >> 6)) * 2 + ((s0 >> 5) & 1)) * 4 + (lane >> 4)) * 512 + ((((q & 15) >> 2)) * 16 + (lane & 15)) * 8 + (q >= 16 ? 4 : 0);
                u32x2 w0, w1; w0.x = w.x; w0.y = w.y; w1.x = w.z; w1.y = w.w; *(u32x2*)dst = w0; *(u32x2*)(dst + 128) = w1; }
        }
#undef PREP_LDG
#undef PREP_STL
#undef PREP_COL8
    }
}

__device__ __forceinline__ void phase_cmp2(const Ctx& c, int l) {
    const int lane = c.lane, gw = c.gw, NW = c.G * NWAVES;
    const float* ropeN = WSP(float, WS_ROPEN);
    for (int r0 = 0; r0 < 2 * 8 * 512; r0 += c.G * 32) {
        const int rowb = r0 + blockIdx.x * 32 + c.wave * 4; if (rowb >= 2 * 8 * 512) break;
        const int kv = rowb >> 12, bg = (rowb >> 9) & 7;
        const float* w2 = c.cmp_w2 + ((size_t)l * 2 + kv) * 256 * 64 + lane;
        LAS float* hl = (LAS float*)(c.lds + c.wave * 4096);
        { const float* sl = WSP(float, WS_ACT) + (size_t)rowb * 256 + lane * 4; f32x4 pb = *(const f32x4*)(WSP(float, WS_PEB) + (size_t)l * 512 + kv * 256 + lane * 4);
#pragma unroll
          for (int kh = 1; kh < 8; ++kh) pb += *(const f32x4*)(WSP(float, WS_PEB) + (size_t)kh * (NL * 2 * 256) + (size_t)l * 512 + kv * 256 + lane * 4);
#pragma unroll
          for (int rr = 0; rr < 4; ++rr) { f32x4 a = pb;
#pragma unroll
              for (int q = 0; q < 8; ++q) a += *(const f32x4*)(sl + (size_t)q * 8192 * 256 + rr * 256);
#pragma unroll
              for (int j = 0; j < 4; ++j) { const float x = a[j]; const float t = 0.7978845608028654f * (x + 0.044715f * x * x * x);
                  const float th = 1.0f - 2.0f * frcp(1.0f + fexp2(2.8853900817779268f * t)); a[j] = 0.5f * x * (1.0f + th); }
              *(LAS f32x4*)(hl + rr * 256 + lane * 4) = a; } }
        float acc4[4] = {0.f, 0.f, 0.f, 0.f};
#pragma unroll 1
        for (int k0 = 0; k0 < 256; k0 += 32) {
            float wv[32];
#pragma unroll
            for (int i = 0; i < 32; ++i) wv[i] = w2[(size_t)(k0 + i) * 64];
#pragma unroll
            for (int i = 0; i < 32; i += 2) {
#pragma unroll
                for (int rr = 0; rr < 4; ++rr) { const f32x2 hw = *(const LAS f32x2*)(hl + rr * 256 + k0 + i); acc4[rr] += hw[0] * wv[i] + hw[1] * wv[i + 1]; } }
        }
#pragma unroll
        for (int rr = 0; rr < 4; ++rr) {
            const int n = (rowb + rr) & 511; const float acc = acc4[rr];
            if (kv == 0) {
                const float ss = wave_sum(acc * acc); float v = acc * rsqrtf(ss * (1.0f / 64.0f) + NORM_EPS) * c.qk_norm_w[(size_t)l * 256 + 64 + lane];
                const float other = __shfl_xor(v, 8);
                int pos = 16 * n + 31; if (pos > SEQ - 1) pos = SEQ - 1;
                if (lane < 16) { const int i = lane & 7; const float cc = ropeN[((size_t)pos * 8 + i) * 2], sc = ropeN[((size_t)pos * 8 + i) * 2 + 1];
                    v = lane < 8 ? v * cc - other * sc : other * sc + v * cc; }
                WSP(bf16_t, WS_KCMP)[((((size_t)bg * 8 + (n >> 6)) * 4 + ((n >> 4) & 3)) * 2 + (lane >> 5)) * 512 + (((lane >> 3) & 3) * 16 + (n & 15)) * 8 + (lane & 7)] = (bf16_t)f2bf(v);
            } else {
                const int q = n & 31; WSP(bf16_t, WS_VCMPT)[((((size_t)bg * 8 + (n >> 6)) * 2 + ((n >> 5) & 1)) * 4 + (lane >> 4)) * 512 + (((q & 15) >> 2) * 16 + (lane & 15)) * 8 + (q >= 16 ? 4 : 0) + (q & 3)] = (bf16_t)(n < 511 ? f2bf(acc) : 0u);
            }
        }
    }
}

__device__ __forceinline__ void phase_scan(const Ctx& c) {
    const int lane = c.lane, w = c.wave, fr = lane & 15, fq = lane >> 4;
    for (int it0 = blockIdx.x; it0 < 256; it0 += c.G) {
        const int it = (c.G == 256) ? ((it0 & 7) * 32 + (it0 >> 3)) : it0;
        const int bh = it >> 4, dvs = it & 15, h = bh & 3;
        const float cdec = fexp2(log2f(1.0f - fexp2(-5.0f - (float)h)) * 128.0f);
        const bf16_t* kz = WSP(bf16_t, WS_KZT) + ((size_t)bh * 64 * 8 + w) * 2048 + lane * 8;
        const bf16_t* vt = WSP(bf16_t, WS_VT) + ((size_t)bh * 64 * 64 + dvs) * 512 + lane * 8;
        bf16_t* rt = WSP(bf16_t, WS_RT) + ((((size_t)bh * 64) * 16 + dvs) * 4 + (w >> 1)) * 512 + ((2 * (w & 1) + (fq >> 1)) * 16 + fr) * 8 + 4 * (fq & 1);
        f32x4 acc = {0.f, 0.f, 0.f, 0.f};
        bf16x8 kf[2][4];
        u32x2 st[64];
        const bf16_t* vt0 = WSP(bf16_t, WS_VT) + ((size_t)bh * 64 * 64 + dvs) * 512 + lane * 8;
#define SCAN_VBATCH(b) do { _Pragma("unroll") for (int _i = 0; _i < 8; ++_i) { const int _blk = w * 8 + _i; \
            __builtin_amdgcn_global_load_lds((const unsigned*)(vt0 + (size_t)(16 * (b) + (_blk >> 2)) * 32768 + (_blk & 3) * 8192), (LAS unsigned*)(c.lds + ((b) & 1) * 65536 + _blk * 1024), 16, 0, 0); } } while (0)
        SCAN_VBATCH(0);
#pragma unroll
        for (int u = 0; u < 2; ++u)
#pragma unroll
            for (int ks = 0; ks < 4; ++ks) kf[u][ks] = ld8(kz + (size_t)u * 16384 + ks * 512);
#pragma unroll
        for (int ch = 0; ch < 64; ++ch) {
            const int u = ch & 1;
            if ((ch & 15) == 0) { asm volatile("s_waitcnt vmcnt(0)" ::: "memory"); __builtin_amdgcn_s_barrier(); asm volatile("" ::: "memory");
                if (ch + 16 < 64) SCAN_VBATCH((ch >> 4) + 1); }
            st[ch].x = pk2(acc[0], acc[1]); st[ch].y = pk2(acc[2], acc[3]);
            acc *= cdec;
            const LAS unsigned char* vb = c.lds + ((ch >> 4) & 1) * 65536 + (ch & 15) * 4096 + lane * 16;
#pragma unroll
            for (int ks = 0; ks < 4; ++ks) acc = mfma16(kf[u][ks], *(const LAS bf16x8*)(vb + ks * 1024), acc);
            if (ch + 2 < 64) {
#pragma unroll
                for (int ks = 0; ks < 4; ++ks) kf[u][ks] = ld8(kz + (size_t)(ch + 2) * 16384 + ks * 512);
            }
            if ((ch & 15) == 15 && ch < 63) {
#pragma unroll
                for (int c2 = ch - 15; c2 <= ch; ++c2) *(u32x2*)(rt + (size_t)c2 * 32768) = st[c2];
            }
        }
#undef SCAN_VBATCH
        MFMA_FENCE();
#pragma unroll
        for (int ch = 48; ch < 64; ++ch) *(u32x2*)(rt + (size_t)ch * 32768) = st[ch];
    }
}

#define SH_BAR() do { asm volatile("" ::: "memory"); __builtin_amdgcn_s_barrier(); asm volatile("" ::: "memory"); } while (0)
#define SH_WAIT_BAR() do { asm volatile("s_waitcnt vmcnt(0)" ::: "memory"); __builtin_amdgcn_s_barrier(); asm volatile("" ::: "memory"); } while (0)
__device__ __forceinline__ void phase_retout(const Ctx& c, int l) {
    const int lane = c.lane, wave = c.wave, fr = lane & 15, fq = lane >> 4;
    const bf16_t* proj = WSP(bf16_t, WS_PROJ);
    LAS unsigned char* lv = c.lds;
    LAS unsigned char* lr = c.lds + 65536;
    for (int u = blockIdx.x; u < 16 * 64; u += c.G) {
        const int qt = wave, ch = u & 63, bh = u >> 6, b = bh >> 2, h = bh & 3;
        const float lg = log2f(1.0f - fexp2(-5.0f - (float)h));
        const bf16_t* Q = WSP(bf16_t, WS_QR) + ((size_t)bh * SEQ + ch * 128) * 128;
        const bf16_t* Kp = WSP(bf16_t, WS_KR) + ((size_t)bh * SEQ + ch * 128) * 128;
        const bf16_t* VTp = WSP(bf16_t, WS_VT) + ((size_t)(bh * 64 + ch)) * 32768;
        const bf16_t* RTp = WSP(bf16_t, WS_RT) + ((size_t)(bh * 64 + ch)) * 32768;
        SH_BAR();
#pragma unroll
        for (int i = 0; i < 8; ++i) {
            __builtin_amdgcn_global_load_lds((const unsigned*)(VTp + (size_t)(wave * 8 + i) * 512 + lane * 8), (LAS unsigned*)(lv + (wave * 8 + i) * 1024), 16, 0, 0);
            __builtin_amdgcn_global_load_lds((const unsigned*)(RTp + (size_t)(wave * 8 + i) * 512 + lane * 8), (LAS unsigned*)(lr + (wave * 8 + i) * 1024), 16, 0, 0);
        }
        const int n = 16 * qt + fr;
        bf16x8 qf[4], qs[4];
        const float xi = fexp2(lg * (float)(n + 1));
#pragma unroll
        for (int ks = 0; ks < 4; ++ks) { const u32x4 w = *(const u32x4*)(Q + (size_t)n * 128 + 32 * ks + 8 * fq); qf[ks] = mk8(w);
            u32x4 s;
#pragma unroll
            for (int j = 0; j < 4; ++j) s[j] = pk2(bflo(w[j]) * xi, bfhi(w[j]) * xi);
            qs[ks] = mk8(s); }
        const size_t tok = (size_t)b * SEQ + ch * 128 + n;
        const bf16_t* gp = proj + tok * NPROJ + C_RG + h * 256 + 4 * fq; const float* gw_ = c.ret_gn_w + (size_t)l * 1024 + h * 256 + 4 * fq;
        u32x2 gv[16];
#pragma unroll
        for (int dt = 0; dt < 16; ++dt) gv[dt] = *(const u32x2*)(gp + 16 * dt);
        bf16x8 kk[8];
#pragma unroll
        for (int ks = 0; ks < 4; ++ks) { kk[ks] = ld8(Kp + (size_t)fr * 128 + 32 * ks + 8 * fq); kk[4 + ks] = ld8(Kp + (size_t)((qt >= 1 ? 16 : 0) + fr) * 128 + 32 * ks + 8 * fq); }
        f32x4 o[16];
#pragma unroll
        for (int dt = 0; dt < 16; ++dt) o[dt] = (f32x4){0.f, 0.f, 0.f, 0.f};
        SH_WAIT_BAR();
        for (int p = 0; p <= (qt >> 1); ++p) {
            f32x4 s0 = {0.f, 0.f, 0.f, 0.f}, s1 = {0.f, 0.f, 0.f, 0.f};
            const bool two = (2 * p + 1 <= qt);
#pragma unroll
            for (int ks = 0; ks < 4; ++ks) s0 = mfma16(kk[ks], qf[ks], s0);
#pragma unroll
            for (int ks = 0; ks < 4; ++ks) s1 = mfma16(kk[4 + ks], qf[ks], s1);
            MFMA_FENCE();
            if (p + 1 <= (qt >> 1)) {
                const bool two_n = (2 * (p + 1) + 1 <= qt);
#pragma unroll
                for (int ks = 0; ks < 4; ++ks) { kk[ks] = ld8(Kp + (size_t)(32 * (p + 1) + fr) * 128 + 32 * ks + 8 * fq); kk[4 + ks] = ld8(Kp + (size_t)(32 * (p + 1) + (two_n ? 16 : 0) + fr) * 128 + 32 * ks + 8 * fq); }
            }
#pragma unroll
            for (int r = 0; r < 4; ++r) { const int d0 = n - (32 * p + 4 * fq + r), d1 = d0 - 16;
                s0[r] = d0 >= 0 ? s0[r] * fexp2(lg * (float)d0) : 0.f; s1[r] = (two && d1 >= 0) ? s1[r] * fexp2(lg * (float)d1) : 0.f; }
            u32x4 pw; pw.x = pk2(s0[0], s0[1]); pw.y = pk2(s0[2], s0[3]); pw.z = pk2(s1[0], s1[1]); pw.w = pk2(s1[2], s1[3]);
            const bf16x8 pb = mk8(pw);
#pragma unroll
            for (int dt = 0; dt < 16; ++dt) o[dt] = mfma16(*(const LAS bf16x8*)(lv + (p * 16 + dt) * 1024 + lane * 16), pb, o[dt]);
            MFMA_FENCE();
        }
#pragma unroll
        for (int dt = 0; dt < 16; ++dt)
#pragma unroll
            for (int ks = 0; ks < 4; ++ks) o[dt] = mfma16(*(const LAS bf16x8*)(lr + (dt * 4 + ks) * 1024 + lane * 16), qs[ks], o[dt]);
        float s = 0.f;
#pragma unroll
        for (int dt = 0; dt < 16; ++dt) s += (o[dt][0] + o[dt][1]) + (o[dt][2] + o[dt][3]);
        s += __shfl_xor(s, 16); s += __shfl_xor(s, 32);
        const float mu = s * (1.0f / 256.0f); float q = 0.f;
#pragma unroll
        for (int dt = 0; dt < 16; ++dt)
#pragma unroll
            for (int r = 0; r < 4; ++r) { const float d = o[dt][r] - mu; q += d * d; }
        q += __shfl_xor(q, 16); q += __shfl_xor(q, 32);
        const float rstd = rsqrtf(q * (1.0f / 256.0f) + NORM_EPS);
        bf16_t* op = WSP(bf16_t, WS_RA) + tok * 2048 + h * 256 + 4 * fq;
#pragma unroll
        for (int dt = 0; dt < 16; ++dt) { const f32x4 wv = *(const f32x4*)(gw_ + 16 * dt);
            float g[4] = {bflo(gv[dt].x), bfhi(gv[dt].x), bflo(gv[dt].y), bfhi(gv[dt].y)}; float r_[4];
#pragma unroll
            for (int r = 0; r < 4; ++r) r_[r] = (o[dt][r] - mu) * rstd * wv[r] * g[r] * sigmoidf_(g[r]);
            u32x2 ov; ov.x = pk2(r_[0], r_[1]); ov.y = pk2(r_[2], r_[3]); *(u32x2*)(op + 16 * dt) = ov; }
    }
    SH_BAR();
}

__device__ __forceinline__ void attn_step_lds(const LAS unsigned char* slot, const bf16x8 (&qf)[2], const int key0, const int hiK, const int loK, const bool colok, const bool allok, const bool full,
                                              f32x4 (&O)[4], float& lsum, const int lane, const int fq) {
    bf16x8 kv[8];
#pragma unroll
    for (int i = 0; i < 8; ++i) kv[i] = *(const LAS bf16x8*)(slot + i * 1024 + lane * 16);
    f32x4 s[4];
    __builtin_amdgcn_s_setprio(1);
#pragma unroll
    for (int kt = 0; kt < 4; ++kt) { s[kt] = (f32x4){0.f, 0.f, 0.f, 0.f};
#pragma unroll
        for (int ks = 0; ks < 2; ++ks) s[kt] = mfma16(kv[kt * 2 + ks], qf[ks], s[kt]); }
    __builtin_amdgcn_s_setprio(0);
#pragma unroll
    for (int i = 0; i < 8; ++i) kv[i] = *(const LAS bf16x8*)(slot + 8192 + i * 1024 + lane * 16);
    float ps = 0.f;
    if (full) {
        if (allok) {
#pragma unroll
            for (int kt = 0; kt < 4; ++kt)
#pragma unroll
                for (int r = 0; r < 4; ++r) { const float p = fexp2(s[kt][r]); s[kt][r] = p; ps += p; }
        } else {
#pragma unroll
            for (int kt = 0; kt < 4; ++kt)
#pragma unroll
                for (int r = 0; r < 4; ++r) { const float p = colok ? fexp2(s[kt][r]) : 0.f; s[kt][r] = p; ps += p; }
        }
    } else {
#pragma unroll
        for (int kt = 0; kt < 4; ++kt)
#pragma unroll
            for (int r = 0; r < 4; ++r) { const int key = key0 + 16 * kt + 4 * fq + r; const bool ok = colok && (key <= hiK) && (key > loK);
                const float p = ok ? fexp2(s[kt][r]) : 0.f; s[kt][r] = p; ps += p; }
    }
    lsum += ps;
#pragma unroll
    for (int p2 = 0; p2 < 2; ++p2) {
        u32x4 pw; pw.x = pk2(s[2 * p2][0], s[2 * p2][1]); pw.y = pk2(s[2 * p2][2], s[2 * p2][3]); pw.z = pk2(s[2 * p2 + 1][0], s[2 * p2 + 1][1]); pw.w = pk2(s[2 * p2 + 1][2], s[2 * p2 + 1][3]);
        const bf16x8 pb = mk8(pw);
        __builtin_amdgcn_s_setprio(1);
#pragma unroll
        for (int dt = 0; dt < 4; ++dt) O[dt] = mfma16(kv[p2 * 4 + dt], pb, O[dt]);
        __builtin_amdgcn_s_setprio(0);
    }
    MFMA_FENCE();
}
__device__ __forceinline__ int sel_pop(unsigned long long& lo, unsigned long long& hi) {
    if (lo) { const int j = __builtin_ctzll(lo); lo &= lo - 1ull; return j; }
    if (hi) { const int j = 64 + __builtin_ctzll(hi); hi &= hi - 1ull; return j; }
    return -1;
}
#define SH_SLOT(s) (shb + (s) * 16384)
#define SH_ISSUE(kbase, vbase, blk, slot, withv) do { \
        __builtin_amdgcn_global_load_lds((const unsigned*)((kbase) + (size_t)(blk) * 4096 + (wave * 64 + lane) * 8), (LAS unsigned*)(SH_SLOT(slot) + wave * 1024), 16, 0, 0); \
        if (withv) __builtin_amdgcn_global_load_lds((const unsigned*)((vbase) + (size_t)(blk) * 4096 + (wave * 64 + lane) * 8), (LAS unsigned*)(SH_SLOT(slot) + 8192 + wave * 1024), 16, 0, 0); } while (0)
#define SH_READ_K(slot) do { _Pragma("unroll") for (int _i = 0; _i < 8; ++_i) kf[_i] = *(const LAS bf16x8*)(SH_SLOT(slot) + _i * 1024 + lane * 16); } while (0)
#define SH_READ_V(slot) do { _Pragma("unroll") for (int _i = 0; _i < 8; ++_i) vf[_i] = *(const LAS bf16x8*)(SH_SLOT(slot) + 8192 + _i * 1024 + lane * 16); } while (0)
__device__ __forceinline__ void phase_nsa(const Ctx& c, const int layer, const int lconv  , const bool late0  ) {
    const int lane = c.lane, wave = c.wave, fr = lane & 15, fq = lane >> 4;
    const bf16_t* proj = WSP(bf16_t, WS_PROJ);
    volatile LAS float* imp = (volatile LAS float*)(c.lds + 131072 + wave * 2304);
    LAS unsigned char* shb = c.lds;
    const int cntot = (lconv >= 0 ? CONV_ITEMS : 0) + (late0 ? CONV_ITEMS : 0), crounds = (cntot + c.G * NWAVES - 1) / (c.G * NWAVES);
    const int cntl = (2048 + c.G - 1) / c.G, crpt = (crounds + cntl - 1) / cntl;
    volatile LAS int* qs = (volatile LAS int*)(c.lds + LDS_CTL_OFF + 256);
#define NSA_QCTR (WSP(unsigned, WS_CTL + 16384) + layer * 64)
    if (c.tid == 0) { qs[0] = (int)__hip_atomic_fetch_add(NSA_QCTR, 1u, __ATOMIC_RELAXED, __HIP_MEMORY_SCOPE_AGENT); asm volatile("s_waitcnt lgkmcnt(0)" ::: "memory"); }
    int kk = 0;
    for (;; ++kk) {
        SH_BAR();
        const int U = __builtin_amdgcn_readfirstlane(qs[kk & 1]);
        if (U >= 2048) break;
        const int bg = U >> 8; const int tl = 255 - (U & 255);
        const int b = bg >> 1, g = bg & 1, T0 = 32 * tl, curW = T0 >> 6;
        int t0[2], tcol[2]; bf16x8 qf[2][2]; float g0[2], g1[2], g2[2]; size_t tokc[2];
        const int head = g * 8 + (fr & 7);
#pragma unroll
        for (int pr = 0; pr < 2; ++pr) {
            t0[pr] = T0 + 4 * wave + 2 * pr; tcol[pr] = t0[pr] + (fr >> 3); tokc[pr] = (size_t)b * SEQ + tcol[pr];
#pragma unroll
            for (int ks = 0; ks < 2; ++ks) qf[pr][ks] = ld8(WSP(bf16_t, WS_QN) + (tokc[pr] * 16 + head) * 64 + 32 * ks + 8 * fq);
            const bf16_t* gp = proj + tokc[pr] * NPROJ + C_NG + head * 3;
            g0[pr] = sigmoidf_(bf2f(gp[0])); g1[pr] = sigmoidf_(bf2f(gp[1])); g2[pr] = sigmoidf_(bf2f(gp[2]));
        }
        f32x4 out[2][4], O[2][4]; float lsum[2];
        bf16x8 kf[8];
#define NSA_ZERO_O() do { _Pragma("unroll") for (int _p = 0; _p < 2; ++_p) { lsum[_p] = 0.f; _Pragma("unroll") for (int _d = 0; _d < 4; ++_d) O[_p][_d] = (f32x4){0.f, 0.f, 0.f, 0.f}; } } while (0)
        int nbc[2];
#pragma unroll
        for (int pr = 0; pr < 2; ++pr) { const int nv = (t0[pr] + 1 >= 31) ? ((t0[pr] + 1 - 31) >> 4) + 1 : 0; nbc[pr] = (nv + 63) >> 6; }
        const int nvW = (T0 + 31 >= 31) ? ((T0 + 31 - 31) >> 4) + 1 : 0, nbcW = (nvW + 63) >> 6;
        const bf16_t* Kc = WSP(bf16_t, WS_KCMP) + (size_t)bg * 8 * 4096; const bf16_t* Vc = WSP(bf16_t, WS_VCMPT) + (size_t)bg * 8 * 4096;
        NSA_ZERO_O();
        SH_BAR();
        int nq = 0; if (c.tid == 0) nq = (int)__hip_atomic_fetch_add(NSA_QCTR, 1u, __ATOMIC_RELAXED, __HIP_MEMORY_SCOPE_AGENT);
        for (int kb = 0; kb < nbcW; ++kb) SH_ISSUE(Kc, Vc, kb, kb, true);
        SH_WAIT_BAR();
        if (c.tid == 0) { qs[(kk + 1) & 1] = nq; asm volatile("s_waitcnt lgkmcnt(0)" ::: "memory"); }
        for (int kb = 0; kb < nbcW; ++kb) {
#pragma unroll
            for (int pr = 0; pr < 2; ++pr) if (kb < nbc[pr])
                attn_step_lds(SH_SLOT(kb), qf[pr], kb * 64, (tcol[pr] - 31) >> 4, -1, true, true, 16 * (kb * 64 + 63) + 31 <= t0[pr], O[pr], lsum[pr], lane, fq);
        }
        float il[2];
#pragma unroll
        for (int pr = 0; pr < 2; ++pr) { float l = lsum[pr]; l += __shfl_xor(l, 16); l += __shfl_xor(l, 32); il[pr] = l > 0.f ? 1.0f / l : 0.f;
#pragma unroll
            for (int dt = 0; dt < 4; ++dt) out[pr][dt] = O[pr][dt] * (g0[pr] * il[pr]); }
        for (int i = lane; i < 4 * 136; i += 64) imp[i] = 0.f;
        for (int kb = 0; kb < nbcW; ++kb) {
            if (kb < nbc[1]) {
                SH_READ_K(kb);
#pragma unroll
                for (int pr = 0; pr < 2; ++pr) if (kb < nbc[pr]) {
                    f32x4 s4[4];
#pragma unroll
                    for (int kt = 0; kt < 4; ++kt) { s4[kt] = (f32x4){0.f, 0.f, 0.f, 0.f};
#pragma unroll
                        for (int ks = 0; ks < 2; ++ks) s4[kt] = mfma16(kf[kt * 2 + ks], qf[pr][ks], s4[kt]); }
                    MFMA_FENCE();
#pragma unroll
                    for (int kt = 0; kt < 4; ++kt) {
                        float pa = 0.f, p3 = 0.f;
#pragma unroll
                        for (int r = 0; r < 4; ++r) { const int key = kb * 64 + 16 * kt + 4 * fq + r; const bool ok = (16 * key + 31 <= tcol[pr]);
                            const float p = ok ? fexp2(s4[kt][r]) * il[pr] : 0.f; pa += p; if (r == 3) p3 = p; }
                        pa = sum8(pa); p3 = sum8(p3);
                        const int jb = 4 * (4 * kb + kt) + fq, tk = pr * 2 + (fr >> 3);
                        if ((fr & 7) == 0) { (void)__hip_atomic_fetch_add((LAS float*)imp + tk * 136 + jb, pa, __ATOMIC_RELAXED, __HIP_MEMORY_SCOPE_WORKGROUP);
                            (void)__hip_atomic_fetch_add((LAS float*)imp + tk * 136 + jb + 1, p3, __ATOMIC_RELAXED, __HIP_MEMORY_SCOPE_WORKGROUP); }
                    }
                }
            }
        }
        unsigned long long msk[2][2][2];
        {
            bool vl[4], vh[4]; unsigned ul[4], uh[4], T[4];
#pragma unroll
            for (int tk = 0; tk < 4; ++tk) {
                const int t = T0 + 4 * wave + tk, cur = t >> 6; const int jl = lane, jh = lane + 64;
                vl[tk] = jl <= cur; vh[tk] = jh <= cur;
                const bool fl = (jl == 0) || (jl == cur) || (jl == cur - 1), fh = (jh == cur) || (jh == cur - 1);
                ul[tk] = fl ? 0x7f800000u : __float_as_uint(imp[tk * 136 + jl]); uh[tk] = fh ? 0x7f800000u : __float_as_uint(imp[tk * 136 + jh]); T[tk] = 0u;
            }
            int cT[4];
#pragma unroll
            for (int tk = 0; tk < 4; ++tk) cT[tk] = __popcll(__ballot(vl[tk])) + __popcll(__ballot(vh[tk]));
#pragma unroll 1
            for (int bit = 30; bit >= 0; --bit) {
#pragma unroll
                for (int tk = 0; tk < 4; ++tk) { const unsigned cand = T[tk] | (1u << bit);
                    const int cnt = __popcll(__ballot(vl[tk] && ul[tk] >= cand)) + __popcll(__ballot(vh[tk] && uh[tk] >= cand));
                    if (cnt >= 16) { T[tk] = cand; cT[tk] = cnt; } }
                if (cT[0] <= 16 && cT[1] <= 16 && cT[2] <= 16 && cT[3] <= 16) break;
            }
#pragma unroll
            for (int tk = 0; tk < 4; ++tk) {
                const unsigned long long gtl = __ballot(vl[tk] && ul[tk] > T[tk]), gth = __ballot(vh[tk] && uh[tk] > T[tk]);
                const unsigned long long eql = __ballot(vl[tk] && ul[tk] == T[tk]), eqh = __ballot(vh[tk] && uh[tk] == T[tk]);
                const int need = 16 - (__popcll(gtl) + __popcll(gth));
                const unsigned long long lm = (1ull << lane) - 1ull;
                const int rl = __popcll(eql & lm), rh = __popcll(eql) + __popcll(eqh & lm);
                msk[tk >> 1][tk & 1][0] = gtl | __ballot(vl[tk] && ul[tk] == T[tk] && rl < need); msk[tk >> 1][tk & 1][1] = gth | __ballot(vh[tk] && uh[tk] == T[tk] && rh < need);
            }
        }
        const bf16_t* Kw = WSP(bf16_t, WS_KW) + (size_t)bg * 128 * 4096; const bf16_t* Vw = WSP(bf16_t, WS_VWT) + (size_t)bg * 128 * 4096;
        const int loW = T0 - 511 > 0 ? T0 - 511 : 0; const int jb0W = loW >> 6, jb1W = (T0 + 31) >> 6;
        const int wbase = (((curW >> 2) + 1) & 1) * 4;
        {
            const bf16_t* Ks = WSP(bf16_t, WS_KS) + (size_t)bg * 128 * 4096; const bf16_t* Vs = WSP(bf16_t, WS_VST) + (size_t)bg * 128 * 4096;
            NSA_ZERO_O();
            unsigned long long any[2][2], mine[2][2], both[2][2];
#pragma unroll
            for (int pr = 0; pr < 2; ++pr)
#pragma unroll
                for (int h = 0; h < 2; ++h) { any[pr][h] = msk[pr][0][h] | msk[pr][1][h]; both[pr][h] = msk[pr][0][h] & msk[pr][1][h]; mine[pr][h] = (fr >> 3) ? msk[pr][1][h] : msk[pr][0][h]; }
            const int ng = (curW >> 2) + 1;
            SH_BAR();
#pragma unroll
            for (int bb = 0; bb < 4; ++bb) if (bb <= curW) SH_ISSUE(Ks, Vs, bb, bb, true);
            for (int gi = 0; gi < ng; ++gi) {
                SH_WAIT_BAR();
                if (gi + 1 < ng) {
#pragma unroll
                    for (int bb = 0; bb < 4; ++bb) if (4 * (gi + 1) + bb <= curW) SH_ISSUE(Ks, Vs, 4 * (gi + 1) + bb, ((gi + 1) & 1) * 4 + bb, true);
                } else SH_ISSUE(Kw, Vw, jb0W, ((gi + 1) & 1) * 4, true);
#pragma unroll 1
                for (int bb = 0; bb < 4; ++bb) {
                    const int j = 4 * gi + bb; if (j > curW) break;
                    const int slot = (gi & 1) * 4 + bb;
                    const bool a0 = ((j < 64 ? (any[0][0] >> j) : (any[0][1] >> (j - 64))) & 1ull) != 0ull, a1 = ((j < 64 ? (any[1][0] >> j) : (any[1][1] >> (j - 64))) & 1ull) != 0ull;
#pragma unroll
                    for (int pr = 0; pr < 2; ++pr) if (pr == 0 ? a0 : a1) {
                        const bool colok = ((j < 64 ? (mine[pr][0] >> j) : (mine[pr][1] >> (j - 64))) & 1ull) != 0ull;
                        const bool bothsel = ((j < 64 ? (both[pr][0] >> j) : (both[pr][1] >> (j - 64))) & 1ull) != 0ull;
                        attn_step_lds(SH_SLOT(slot), qf[pr], j * 64, tcol[pr], -1, colok, bothsel, j * 64 + 63 <= t0[pr], O[pr], lsum[pr], lane, fq); }
                }
            }
#pragma unroll
            for (int pr = 0; pr < 2; ++pr) { float l = lsum[pr]; l += __shfl_xor(l, 16); l += __shfl_xor(l, 32); const float sc = l > 0.f ? g1[pr] / l : 0.f;
#pragma unroll
                for (int dt = 0; dt < 4; ++dt) out[pr][dt] += O[pr][dt] * sc; }
        }
        {
            NSA_ZERO_O();
            for (int jb = jb0W; jb <= jb1W; ++jb) {
                const int slot = wbase + ((jb - jb0W) & 1);
                SH_WAIT_BAR();
                if (jb < jb1W) SH_ISSUE(Kw, Vw, jb + 1, wbase + ((jb + 1 - jb0W) & 1), true);
#pragma unroll
                for (int pr = 0; pr < 2; ++pr) { const int lo = t0[pr] - 511 > 0 ? t0[pr] - 511 : 0;
                    if (jb >= (lo >> 6) && jb <= ((t0[pr] + 1) >> 6))
                        attn_step_lds(SH_SLOT(slot), qf[pr], jb * 64, tcol[pr], tcol[pr] - 512, true, true, jb * 64 > t0[pr] + 1 - 512 && jb * 64 + 63 <= t0[pr], O[pr], lsum[pr], lane, fq); }
            }
#pragma unroll
            for (int pr = 0; pr < 2; ++pr) { float l = lsum[pr]; l += __shfl_xor(l, 16); l += __shfl_xor(l, 32); const float sc = l > 0.f ? g2[pr] / l : 0.f;
#pragma unroll
                for (int dt = 0; dt < 4; ++dt) out[pr][dt] += O[pr][dt] * sc; }
        }
#pragma unroll
        for (int pr = 0; pr < 2; ++pr) { bf16_t* op = WSP(bf16_t, WS_RA) + tokc[pr] * 2048 + 1024 + head * 64 + 4 * fq;
#pragma unroll
            for (int dt = 0; dt < 4; ++dt) { u32x2 ov; ov.x = pk2(out[pr][dt][0], out[pr][dt][1]); ov.y = pk2(out[pr][dt][2], out[pr][dt][3]); *(u32x2*)(op + 16 * dt) = ov; } }
#undef NSA_ZERO_O
        {
#pragma unroll 1
            for (int r = kk * crpt; r < (kk + 1) * crpt && r < crounds; ++r) { const int item = c.gw + r * (c.G * NWAVES);
                if (item < cntot) { const bool nx = lconv >= 0 && item < CONV_ITEMS; const int i0 = nx ? item : item - (lconv >= 0 ? CONV_ITEMS : 0);
                    if (nx || !conv_is_early(i0)) conv_one(c, nx ? lconv : 0, i0); } }
        }
    }
#pragma unroll 1
    for (int r = kk * crpt; r < crounds; ++r) { const int item = c.gw + r * (c.G * NWAVES);
        if (item < cntot) { const bool nx = lconv >= 0 && item < CONV_ITEMS; const int i0 = nx ? item : item - (lconv >= 0 ? CONV_ITEMS : 0);
            if (nx || !conv_is_early(i0)) conv_one(c, nx ? lconv : 0, i0); } }
    SH_BAR();
#undef NSA_QCTR
}

__device__ __forceinline__ void phase_route(const Ctx& c, int l) {
    const int lane = c.lane, gw = c.gw, NW = c.G * NWAVES, fr = lane & 15, fq = lane >> 4;
    LAS int* cnt = (LAS int*)(c.lds + LDS_CTL_OFF + 64);
    if (c.tid < 32) cnt[c.tid] = 0;
    for (int i = blockIdx.x * NTHREADS + c.tid; i < XROWS; i += c.G * NTHREADS) WSP(int, WS_ROWTOK)[i] = 0;
    __syncthreads();
    {
        const bf16_t* rwf = WSP(bf16_t, WS_RWF) + (size_t)l * 32 * 2 * 2 * 512 + lane * 8;
#pragma unroll
        for (int i = 0; i < 16; ++i) { const int blk = c.wave * 16 + i;
            __builtin_amdgcn_global_load_lds((const unsigned*)(rwf + (size_t)blk * 512), (LAS unsigned*)(c.lds + blk * 1024), 16, 0, 0); }
        asm volatile("s_waitcnt vmcnt(0)" ::: "memory"); __syncthreads();
    }
    const float b0 = c.router_b[(size_t)l * NEXP + fr], b1 = c.router_b[(size_t)l * NEXP + 16 + fr];
    for (int tile = gw; tile < NTOK / 16; tile += NW) {
        const int tok0 = tile * 16; const float* xr = (l == 0 ? c.x_in : (const float*)c.out) + (size_t)(tok0 + fr) * D + 4 * fq;
        const bf16_t* dr = WSP(bf16_t, WS_PROJ) + (size_t)(tok0 + fr) * D + 4 * fq;
        bf16_t* hrow = WSP(bf16_t, WS_H) + (size_t)(tok0 + fr) * D + 4 * fq;
        f32x4 acc0 = {0.f, 0.f, 0.f, 0.f}, acc1 = {0.f, 0.f, 0.f, 0.f}; float ss = 0.f;
#pragma unroll 1
        for (int kg = 0; kg < 8; ++kg) {
            f32x4 xa[4], xb[4]; u32x2 da[4], db[4]; bf16x8 wv[4][4];
#pragma unroll
            for (int u = 0; u < 4; ++u) { const int ks = kg * 4 + u; xa[u] = *(const f32x4*)(xr + 32 * ks); xb[u] = *(const f32x4*)(xr + 32 * ks + 16);
                da[u] = *(const u32x2*)(dr + 32 * ks); db[u] = *(const u32x2*)(dr + 32 * ks + 16);
#pragma unroll
                for (int q = 0; q < 4; ++q) wv[u][q] = *(const LAS bf16x8*)(c.lds + (ks * 4 + q) * 1024 + lane * 16); }
            __builtin_amdgcn_sched_barrier(0);
#pragma unroll
            for (int u = 0; u < 4; ++u) {
                float v[8] = {xa[u][0] + bflo(da[u].x), xa[u][1] + bfhi(da[u].x), xa[u][2] + bflo(da[u].y), xa[u][3] + bfhi(da[u].y),
                              xb[u][0] + bflo(db[u].x), xb[u][1] + bfhi(db[u].x), xb[u][2] + bflo(db[u].y), xb[u][3] + bfhi(db[u].y)}; float lo[8]; u32x4 hw, lw;
#pragma unroll
                for (int j = 0; j < 8; ++j) ss += v[j] * v[j];
#pragma unroll
                for (int j = 0; j < 4; ++j) { hw[j] = pk2(v[2 * j], v[2 * j + 1]); lo[2 * j] = v[2 * j] - bflo(hw[j]); lo[2 * j + 1] = v[2 * j + 1] - bfhi(hw[j]); }
#pragma unroll
                for (int j = 0; j < 4; ++j) lw[j] = pk2(lo[2 * j], lo[2 * j + 1]);
                const bf16x8 ah = mk8(hw), al = mk8(lw);
                { bf16_t* hp = hrow + 32 * (kg * 4 + u); u32x2 h0, h1; h0.x = hw[0]; h0.y = hw[1]; h1.x = hw[2]; h1.y = hw[3]; *(u32x2*)hp = h0; *(u32x2*)(hp + 16) = h1; }
                acc0 = mfma16(ah, wv[u][0], acc0); acc1 = mfma16(ah, wv[u][2], acc1);
                acc0 = mfma16(ah, wv[u][1], acc0); acc1 = mfma16(ah, wv[u][3], acc1);
                acc0 = mfma16(al, wv[u][0], acc0); acc1 = mfma16(al, wv[u][2], acc1);
            }
            MFMA_FENCE();
        }
        ss += __shfl_xor(ss, 16); ss += __shfl_xor(ss, 32);
        const float rs = rsqrtf(ss * (1.0f / 1024.0f) + NORM_EPS);
        if (fq == 0) WSP(float, WS_RSTD)[tok0 + fr] = rs;
#pragma unroll
        for (int r = 0; r < 4; ++r) {
            const float rt = __shfl(rs, 4 * fq + r);
            float v0 = acc0[r] * rt + b0, v1 = acc1[r] * rt + b1; float tv[4]; int te[4];
#pragma unroll
            for (int k = 0; k < 4; ++k) { float bv = v0; int be = fr; if (v1 > bv) { bv = v1; be = 16 + fr; }
#pragma unroll
                for (int o = 8; o >= 1; o >>= 1) { const float ov = __shfl_xor(bv, o); const int oe = __shfl_xor(be, o); if (ov > bv || (ov == bv && oe < be)) { bv = ov; be = oe; } }
                tv[k] = bv; te[k] = be; if (be == fr) v0 = -INFINITY; if (be == 16 + fr) v1 = -INFINITY; }
            const float e1 = expf(tv[1] - tv[0]), e2 = expf(tv[2] - tv[0]), e3 = expf(tv[3] - tv[0]); const float inv = 1.0f / (1.0f + e1 + e2 + e3);
            if (fr < 4) { const int e = fr == 0 ? te[0] : fr == 1 ? te[1] : fr == 2 ? te[2] : te[3]; const float wv_ = (fr == 0 ? 1.0f : fr == 1 ? e1 : fr == 2 ? e2 : e3) * inv;
                const int rk = atomicAdd((int*)&cnt[e], 1); const size_t o = (size_t)(tok0 + 4 * fq + r) * 4 + fr;
                WSP(int, WS_TE)[o] = e; WSP(float, WS_TW)[o] = wv_; WSP(int, WS_RANK)[o] = rk; }
        }
    }
    __syncthreads();
    if (c.tid < 32) WSP(int, WS_HIST)[blockIdx.x * 32 + c.tid] = cnt[c.tid];
    __syncthreads();
}

__device__ __forceinline__ void phase_scatter(const Ctx& c, int l) {
    const int lane = c.lane, gw = c.gw, NW = c.G * NWAVES;
    LAS int* hist = (LAS int*)c.lds;
    LAS int* part = (LAS int*)(c.lds + 65536);
    LAS int* base = part + 1024;
    LAS int* pst = base + 32;
    LAS int* nblk = pst + 40;
    for (int i = c.tid; i < c.G * 32; i += NTHREADS) hist[i] = WSP(int, WS_HIST)[i];
    __syncthreads();
    { const int e = c.tid & 31, p = c.tid >> 5, per = (c.G + 15) >> 4; const int w1 = (p + 1) * per < c.G ? (p + 1) * per : c.G; int before = 0, tot = 0;
      for (int w = p * per; w < w1; ++w) { const int v = hist[w * 32 + e]; if (w < (int)blockIdx.x) before += v; tot += v; }
      part[(p * 32 + e) * 2] = before; part[(p * 32 + e) * 2 + 1] = tot; }
    __syncthreads();
    if (c.tid < 32) { int before = 0, tot = 0;
#pragma unroll
        for (int p = 0; p < 16; ++p) { before += part[(p * 32 + c.tid) * 2]; tot += part[(p * 32 + c.tid) * 2 + 1]; }
        base[c.tid] = before; const int padded = (tot + 255) & ~255; int incl = padded;
#pragma unroll
        for (int o = 1; o < 32; o <<= 1) { const int t = __shfl_up(incl, o); if (c.tid >= o) incl += t; }
        pst[c.tid] = incl - padded; if (c.tid == 31) pst[32] = incl; nblk[c.tid] = padded >> 8; }
    __syncthreads();
    if (blockIdx.x == 0 && c.tid < 32) {
        int* meta = WSP(int, WS_META); const int e = c.tid, x = e & 7; int off = 0;
        for (int e2 = x; e2 < e; e2 += 8) off += nblk[e2];
        const int rb0 = pst[e] >> 8, nb = nblk[e];
        for (int i = 0; i < nb; ++i) { meta[64 + rb0 + i] = e; meta[1024 + 640 * x + off + i] = rb0 + i; }
        if (e >= 24) meta[16 + x] = off + nb;
        if (e == 0) meta[0] = pst[32] >> 8; }
    for (int tile = gw; tile < NTOK / 16; tile += NW) {
        const int o = tile * 64 + lane, tok = o >> 2;
        const int e = WSP(int, WS_TE)[o], rk = WSP(int, WS_RANK)[o];
        const int dst = pst[e] + base[e] + rk;
        WSP(int, WS_ROWTOK)[dst] = tok; WSP(float, WS_RSROW)[dst] = WSP(float, WS_RSTD)[tok]; WSP(int, WS_SLOT)[o] = dst;
    }
}

__device__ __forceinline__ void phase_combine(const Ctx& c, int l) {
    const int lane = c.lane, gw = c.gw, NW = c.G * NWAVES;
    for (int tok = gw; tok < NTOK; tok += NW) {
        float* xr = c.out + (size_t)tok * D; const bf16_t* hs = WSP(bf16_t, WS_H) + (size_t)tok * D;
        const u32x4 sl = *(const u32x4*)(WSP(int, WS_SLOT) + (size_t)tok * 4); const f32x4 tw = *(const f32x4*)(WSP(float, WS_TW) + (size_t)tok * 4);
        f32x4 v[4];
#pragma unroll
        for (int i = 0; i < 4; ++i) { const u32x2 d = *(const u32x2*)(hs + i * 256 + lane * 4); v[i][0] = bflo(d.x); v[i][1] = bfhi(d.x); v[i][2] = bflo(d.y); v[i][3] = bfhi(d.y); }
#pragma unroll
        for (int k = 0; k < 4; ++k) { const bf16_t* yr = WSP(bf16_t, WS_XBUF) + (size_t)sl[k] * D; const float w = tw[k];
#pragma unroll
            for (int i = 0; i < 4; ++i) { const u32x2 y = *(const u32x2*)(yr + i * 256 + lane * 4);
                v[i][0] += w * bflo(y.x); v[i][1] += w * bfhi(y.x); v[i][2] += w * bflo(y.y); v[i][3] += w * bfhi(y.y); } }
        float ss = 0.f;
#pragma unroll
        for (int i = 0; i < 4; ++i) { *(f32x4*)(xr + i * 256 + lane * 4) = v[i]; ss += v[i][0] * v[i][0] + v[i][1] * v[i][1] + v[i][2] * v[i][2] + v[i][3] * v[i][3]; }
        if (l + 1 < NL) {
            ss = wave_sum(ss); const float rs = rsqrtf(ss * (1.0f / 1024.0f) + NORM_EPS);
            const float* nw = c.norm1_w + (size_t)(l + 1) * D; bf16_t* hr = WSP(bf16_t, WS_H) + (size_t)tok * D;
#pragma unroll
            for (int i = 0; i < 4; ++i) { const f32x4 w = *(const f32x4*)(nw + i * 256 + lane * 4);
                u32x2 o; o.x = pk2(v[i][0] * rs * w[0], v[i][1] * rs * w[1]); o.y = pk2(v[i][2] * rs * w[2], v[i][3] * rs * w[3]); *(u32x2*)(hr + i * 256 + lane * 4) = o; }
        }
    }
}

constexpr int PH_PER_LAYER = 14, N_PHASES = 1 + NL * PH_PER_LAYER;
#ifndef PH_MASK
#define PH_MASK 0xffff
#endif
#define IN(k) (lo <= (k) && (k) < hi)
#define INL(j) (((PH_MASK >> ((j) + 1)) & 1) && IN(pb + (j)))
#define FRESH() do { int _t = threadIdx.x; asm volatile("" : "+v"(_t)); c.tid = _t; c.lane = _t & 63; c.wave = __builtin_amdgcn_readfirstlane(_t >> 6); c.gw = blockIdx.x * NWAVES + c.wave; } while (0)
#define SEAM(k) do { if (IN((k) + 1) || IN((k) + 2)) xcd_barrier(bar); else __syncthreads(); } while (0)

template <int l>
__device__ __forceinline__ void run_layer(Ctx& c, const XcdBarrier& bar, const int lo, const int hi) {
        const int pb = 1 + l * PH_PER_LAYER;
        if (INL(0)) { FRESH();
            g8::SchedPlain S{(const char*)WSP(bf16_t, WS_H), (const char*)(WSP(bf16_t, WS_WIN) + (size_t)l * NPROJ * D), (size_t)256 * D * 2, (size_t)256 * D * 2, NTOK / 256, NPROJ / 256, (NTOK / 256) * (NPROJ / 256), c.G, (int)blockIdx.x};
            g8::EpiBf16 E{WSP(bf16_t, WS_PROJ), NPROJ};
            g8::gemm_phase(c.lds, c.tid, D, D * 2, D * 2, S, E);
            SEAM(pb + 0);
        }
        if (INL(1)) { FRESH(); phase_prep(c, l); SEAM(pb + 1); }
        if (INL(2)) { FRESH();
            g8::SchedCmp S{(const char*)WSP(bf16_t, WS_KCT), (const char*)WSP(bf16_t, WS_VCT), (const char*)(WSP(bf16_t, WS_WC1) + (size_t)l * 2 * 256 * 2048), c.G, (int)blockIdx.x};
            g8::EpiSlab E{WSP(float, WS_ACT)};
            g8::gemm_phase(c.lds, c.tid, 256, 1024 * 2, 2048 * 2, S, E);
            SEAM(pb + 2);
        }
        if (INL(3)) { FRESH(); phase_cmp2(c, l); __syncthreads(); FRESH(); phase_scan(c); SEAM(pb + 3); }
        if (INL(5)) { FRESH(); phase_retout(c, l); FRESH(); phase_nsa(c, l, l + 1 < NL ? l + 1 : -1, l == 0); SEAM(pb + 5); }
        if (INL(7)) { FRESH();
            {
                g8::SchedPlain S{(const char*)WSP(bf16_t, WS_RA), (const char*)(WSP(bf16_t, WS_WO) + (size_t)l * D * 2048), (size_t)256 * 2048 * 2, (size_t)256 * 2048 * 2, NTOK / 256, D / 256, (NTOK / 256) * (D / 256), c.G, (int)blockIdx.x};
                g8::EpiGate E{WSP(bf16_t, WS_MIX), WSP(bf16_t, WS_PROJ), 0};
                g8::gemm_phase(c.lds, c.tid, D, 2048 * 2, 2048 * 2, S, E);
            }
            asm volatile("s_waitcnt vmcnt(0)" ::: "memory"); __syncthreads();
            {
                g8::SchedPlain S{(const char*)(WSP(bf16_t, WS_RA) + 1024), (const char*)(WSP(bf16_t, WS_WO) + (size_t)l * D * 2048 + 1024), (size_t)256 * 2048 * 2, (size_t)256 * 2048 * 2, NTOK / 256, D / 256, (NTOK / 256) * (D / 256), c.G, (int)blockIdx.x};
                g8::EpiGate E{WSP(bf16_t, WS_MIX), WSP(bf16_t, WS_PROJ), 1};
                g8::gemm_phase(c.lds, c.tid, D, 2048 * 2, 2048 * 2, S, E);
            }
            SEAM(pb + 7);
        }
        if (INL(8)) { FRESH();
            g8::SchedPlain S{(const char*)WSP(bf16_t, WS_MIX), (const char*)(WSP(bf16_t, WS_WOUT) + (size_t)l * D * D), (size_t)256 * D * 2, (size_t)256 * D * 2, NTOK / 256, D / 256, (NTOK / 256) * (D / 256), c.G, (int)blockIdx.x};
            g8::EpiBf16 E{WSP(bf16_t, WS_PROJ), D};
            g8::gemm_phase(c.lds, c.tid, D, D * 2, D * 2, S, E);
            SEAM(pb + 8);
        }
        if (INL(9)) { FRESH(); phase_route(c, l); SEAM(pb + 9); }
        if (INL(10)) { FRESH(); phase_scatter(c, l); SEAM(pb + 10); }
        if (INL(11)) { FRESH();
            LAS int* tab = (LAS int*)(c.lds + 131072); g8::moe_units(tab, WSP(int, WS_META), 8, c.G, (int)blockIdx.x, c.tid);
            g8::SchedMoeG S{(const char*)WSP(bf16_t, WS_H), (const char*)(WSP(bf16_t, WS_WGU) + (size_t)l * NEXP * 2048 * D), tab, 8, (size_t)2048 * D * 2, WSP(int, WS_ROWTOK)};
            g8::EpiSwiglu E{WSP(bf16_t, WS_ACT), c.b_gate_up + (size_t)l * NEXP * 2048, WSP(float, WS_RSROW), c.lds + 131072 + 8192};
            g8::gemm_phase(c.lds, c.tid, D, D * 2, D * 2, S, E);
            SEAM(pb + 11);
        }
        if (INL(12)) { FRESH();
            LAS int* tab = (LAS int*)(c.lds + 131072); g8::moe_units(tab, WSP(int, WS_META), 4, c.G, (int)blockIdx.x, c.tid);
            g8::SchedMoe S{(const char*)WSP(bf16_t, WS_ACT), (const char*)(WSP(bf16_t, WS_WD) + (size_t)l * NEXP * D * D), tab, 4, (size_t)D * D * 2};
            g8::EpiDown E{WSP(bf16_t, WS_XBUF), c.b_down + (size_t)l * NEXP * D};
            g8::gemm_phase(c.lds, c.tid, D, D * 2, D * 2, S, E);
            SEAM(pb + 12);
        }
        if (INL(13)) { FRESH(); phase_combine(c, l); SEAM(pb + 13); }
    }
__global__ void __launch_bounds__(NTHREADS, 2) mk_fwd(Args args) {
    extern __shared__ __attribute__((aligned(16))) unsigned char lds_raw[];
    Ctx c;
    c.x_in = args.in[0]; c.norm1_w = args.in[1]; c.w_in = args.in[2]; c.ret_gn_w = args.in[3]; c.qk_norm_w = args.in[4]; c.cmp_pos = args.in[5]; c.cmp_w1 = args.in[6]; c.cmp_w2 = args.in[7];
    c.w_o_ret = args.in[8]; c.w_o_nsa = args.in[9]; c.w_out = args.in[10]; c.norm2_w = args.in[11]; c.router_w = args.in[12]; c.router_b = args.in[13]; c.w_gate_up = args.in[14]; c.b_gate_up = args.in[15];
    c.w_down = args.in[16]; c.b_down = args.in[17];
    c.out = args.out; c.ws = args.ws; c.lds = (LAS unsigned char*)lds_raw;
    c.tid = threadIdx.x; c.lane = c.tid & 63; c.wave = __builtin_amdgcn_readfirstlane(c.tid >> 6); c.G = gridDim.x; c.gw = blockIdx.x * NWAVES + c.wave;
    volatile LAS unsigned* lctl = (volatile LAS unsigned*)(c.lds + LDS_CTL_OFF);
    if (c.tid < 16) lctl[c.tid] = 0u;
    __syncthreads();
    const int lo = args.ph_lo, hi = args.ph_hi;
    XcdBarrier bar; bar.bar = WSP(unsigned, WS_CTL); bar.x = 0; bar.st = lctl;
    if (hi - lo > 1) bar = xcd_barrier_post(WSP(unsigned, WS_CTL), lctl);
    if ((PH_MASK & 1) && IN(0)) { FRESH(); phase_prologue(c); SEAM(0); }

    run_layer<0>(c, bar, lo, hi); run_layer<1>(c, bar, lo, hi); run_layer<2>(c, bar, lo, hi); run_layer<3>(c, bar, lo, hi);
#undef IN
#undef INL
#undef SEAM
}


extern "C" void kernel_launch(void* const* d_in, const int* in_sizes, int n_in, void* d_out, int out_size, void* d_ws, size_t ws_size, hipStream_t stream) {
    static int grid = 0;
    if (grid == 0) {
        if (n_in != 18 || out_size != NTOK * D || ws_size < WS_END) { fprintf(stderr, "kernel_launch: unexpected shapes (n_in %d out %d ws %zu need %zu)\n", n_in, out_size, ws_size, (size_t)WS_END); grid = -1; return; }
        int dev = 0, cus = 0;
        if (hipGetDevice(&dev) != hipSuccess || hipDeviceGetAttribute(&cus, hipDeviceAttributeMultiprocessorCount, dev) != hipSuccess) { grid = -1; return; }
        if (hipFuncSetAttribute((const void*)mk_fwd, hipFuncAttributeMaxDynamicSharedMemorySize, LDS_BYTES) != hipSuccess) { fprintf(stderr, "kernel_launch: hipFuncSetAttribute failed\n"); grid = -1; return; }
        int per_cu = 0;
        if (hipOccupancyMaxActiveBlocksPerMultiprocessor(&per_cu, (const void*)mk_fwd, NTHREADS, LDS_BYTES) != hipSuccess || per_cu < 1) fprintf(stderr, "kernel_launch: occupancy query says %d\n", per_cu);
        (void)hipGetLastError();
        grid = cus;
    }
    if (grid < 0) return;
    (void)hipMemsetAsync((char*)d_ws + WS_CTL, 0, CTL_BYTES, stream);
    Args a{};
    for (int i = 0; i < 18; ++i) a.in[i] = (const float*)d_in[i];
    a.out = (float*)d_out; a.ws = (unsigned char*)d_ws;
#if MK_ONE_LAUNCH
    a.ph_lo = 0; a.ph_hi = N_PHASES;
    hipLaunchKernelGGL(mk_fwd, dim3(grid), dim3(NTHREADS), LDS_BYTES, stream, a);
#else
    for (int p = 0; p < N_PHASES; ++p) { a.ph_lo = p; a.ph_hi = p + 1; hipLaunchKernelGGL(mk_fwd, dim3(grid), dim3(NTHREADS), LDS_BYTES, stream, a); }
#endif
}
```
